# Optimizing an MI355X kernel written in HIP

```python
import jax
import jax.numpy as jnp
from jax import lax
import numpy as np

D_MODEL = 1024
BATCH = 4
SEQ = 4096
DEPTH = 2

NORM_EPS = 1e-6
ROPE_BASE = 10000.0

RW_HEADS = 4
RW_HEAD_DIM = 64
RW_DIM = RW_HEADS * RW_HEAD_DIM
RW_DECAY_RANK = 32
RW_A_RANK = 32
RW_V_RANK = 32
RW_GATE_RANK = 64
RW_GN_EPS = 64e-5
RW_IN = 3 * RW_DIM + RW_DECAY_RANK + RW_A_RANK + RW_GATE_RANK

RET_HEADS = 4
RET_HEAD_DIM = 64
RET_DIM = RET_HEADS * RET_HEAD_DIM
RET_CHUNK = 128
RET_IN = 4 * RET_DIM

MLA_HEADS = 8
MLA_NOPE = 64
MLA_ROPE = 32
MLA_V = 64
MLA_Q_RANK = 384
MLA_KV_RANK = 256
MLA_DIM = MLA_HEADS * MLA_V
MLA_IN = MLA_Q_RANK + MLA_KV_RANK + MLA_ROPE
ATTN_BLOCK = 128

IN_DIM = RW_IN + RET_IN + MLA_IN
MIX_DIM = RW_DIM + RET_DIM + MLA_DIM
D_FF = -(-(8 * D_MODEL) // (3 * 256)) * 256

kernel_name = 'hymba_rwkv7_retnet_mla_block'


def rms_norm(x, g):
    xf = x.astype(jnp.float32)
    y = xf * lax.rsqrt(jnp.mean(xf * xf, axis=-1, keepdims=True) + NORM_EPS)
    return (y * g.astype(jnp.float32)).astype(x.dtype)


def rope(x, positions):
    d = x.shape[-1]
    inv = ROPE_BASE ** (-jnp.arange(0, d, 2, dtype=jnp.float32) / d)
    ang = positions.astype(jnp.float32)[..., None] * inv
    ang = ang.reshape(ang.shape[:2] + (1,) * (x.ndim - 3) + ang.shape[-1:])
    cos, sin = jnp.cos(ang), jnp.sin(ang)
    xf = x.astype(jnp.float32)
    x1, x2 = xf[..., : d // 2], xf[..., d // 2:]
    return jnp.concatenate([x1 * cos - x2 * sin, x2 * cos + x1 * sin], axis=-1).astype(x.dtype)


def token_shift(p):
    return jnp.pad(p, ((0, 0), (1, 0), (0, 0)))[:, :-1]


def rwkv7_mixer(p, mu, w0, w2, a0, a2, g2, k_k, k_a, r_k, gn_w, gn_b, v_first, v_res):
    B, S, _ = p.shape
    p = p.astype(jnp.float32)
    ps = p + (token_shift(p) - p) * mu
    o1, o2, o3 = RW_DIM, 2 * RW_DIM, 3 * RW_DIM
    o4, o5 = o3 + RW_DECAY_RANK, o3 + RW_DECAY_RANK + RW_A_RANK
    r, k, v = ps[..., :o1], ps[..., o1:o2], ps[..., o2:o3]
    wd, ad, gd = ps[..., o3:o4], ps[..., o4:o5], ps[..., o5:]
    w = -jax.nn.softplus(-(w0 + jnp.tanh(wd) @ w2)) - 0.5
    decay = jnp.exp(-jnp.exp(w))
    a = jax.nn.sigmoid(a0 + ad @ a2)
    g = jax.nn.sigmoid(gd) @ g2
    if v_res is None:
        v_first = v
    else:
        v0, v1, v2 = v_res
        v = v + (v_first - v) * jax.nn.sigmoid(v0 + (v @ v1) @ v2)
    heads = lambda t: t.reshape(B, S, RW_HEADS, RW_HEAD_DIM)
    kk = heads(k * k_k)
    kk = kk * lax.rsqrt(jnp.maximum(jnp.sum(kk * kk, axis=-1, keepdims=True), 1e-24))
    k = k * (1.0 + (a - 1.0) * k_a)
    r_h, k_h, v_h, w_h, a_h = heads(r), heads(k), heads(v), heads(decay), heads(a)

    def step(state, inp):
        rt, kt, vt, wt, kkt, at = inp
        sa = jnp.einsum('bhvk,bhk->bhv', state, -kkt)
        state = (state * wt[:, :, None, :] + sa[..., None] * (kkt * at)[:, :, None, :]
                 + vt[..., None] * kt[:, :, None, :])
        return state, jnp.einsum('bhvk,bhk->bhv', state, rt)

    xs = tuple(jnp.moveaxis(t, 1, 0) for t in (r_h, k_h, v_h, w_h, kk, a_h))
    s0 = jnp.zeros((B, RW_HEADS, RW_HEAD_DIM, RW_HEAD_DIM), jnp.float32)
    _, y = lax.scan(step, s0, xs)
    y = jnp.moveaxis(y, 0, 1)
    mean = jnp.mean(y, axis=-1, keepdims=True)
    var = jnp.mean(jnp.square(y - mean), axis=-1, keepdims=True)
    y = ((y - mean) * lax.rsqrt(var + RW_GN_EPS)).reshape(B, S, RW_DIM) * gn_w + gn_b
    bonus = jnp.sum(r_h * k_h * r_k, axis=-1, keepdims=True) * v_h
    y = (y + bonus.reshape(B, S, RW_DIM)) * g
    return y, v_first


def retention_mixer(p, positions):
    B, S, _ = p.shape
    p = p.astype(jnp.float32)
    q, k, v, g = jnp.split(p, 4, axis=-1)
    heads = lambda t: t.reshape(B, S, RET_HEADS, RET_HEAD_DIM)
    q = rope(heads(q), positions)
    k = rope(heads(k), positions) * (RET_HEAD_DIM ** -0.5)
    v = heads(v)
    log_gamma = jnp.log(1.0 - 2.0 ** (-5.0 - jnp.arange(RET_HEADS, dtype=jnp.float32)))
    n_chunks = S // RET_CHUNK
    chunk = lambda t: t.reshape(B, n_chunks, RET_CHUNK, RET_HEADS, RET_HEAD_DIM).transpose(0, 3, 1, 2, 4)
    qc, kc, vc = chunk(q), chunk(k), chunk(v)
    idx = jnp.arange(RET_CHUNK, dtype=jnp.float32)
    diff = idx[:, None] - idx[None, :]
    dmask = jnp.where(diff >= 0, jnp.exp(log_gamma[:, None, None] * jnp.maximum(diff, 0.0)), 0.0)
    inner = jnp.einsum('bhnqd,bhnkd->bhnqk', qc, kc) * dmask[:, None]
    inner = jnp.einsum('bhnqk,bhnkd->bhnqd', inner, vc)
    q_dec = jnp.exp(log_gamma[:, None] * (idx + 1.0))
    k_dec = jnp.exp(log_gamma[:, None] * (RET_CHUNK - 1.0 - idx))
    chunk_dec = jnp.exp(log_gamma * RET_CHUNK)
    kv_chunk = jnp.einsum('bhnkd,bhnke->nbhde', kc * k_dec[:, None, :, None], vc)

    def step(R, kv_i):
        return R * chunk_dec[None, :, None, None] + kv_i, R

    R0 = jnp.zeros((B, RET_HEADS, RET_HEAD_DIM, RET_HEAD_DIM), jnp.float32)
    _, R_prev = lax.scan(step, R0, kv_chunk)
    cross = jnp.einsum('bhnqd,nbhde->bhnqe', qc * q_dec[:, None, :, None], R_prev)
    y = (inner + cross).transpose(0, 2, 3, 1, 4).reshape(B, S, RET_HEADS, RET_HEAD_DIM)
    y = y * lax.rsqrt(jnp.mean(y * y, axis=-1, keepdims=True) + NORM_EPS)
    return jax.nn.silu(g) * y.reshape(B, S, RET_DIM)


def mla_mixer(p, positions, q_norm, kv_norm, w_q_up, w_kv_up):
    B, S, _ = p.shape
    q_lat = p[..., :MLA_Q_RANK]
    kv_lat = p[..., MLA_Q_RANK:MLA_Q_RANK + MLA_KV_RANK]
    k_rope = rope(p[..., MLA_Q_RANK + MLA_KV_RANK:], positions)
    q = (rms_norm(q_lat, q_norm) @ w_q_up).reshape(B, S, MLA_HEADS, MLA_NOPE + MLA_ROPE)
    q_nope, q_rope = q[..., :MLA_NOPE], rope(q[..., MLA_NOPE:], positions)
    kv = (rms_norm(kv_lat, kv_norm) @ w_kv_up).reshape(B, S, MLA_HEADS, MLA_NOPE + MLA_V)
    k_nope, v = kv[..., :MLA_NOPE], kv[..., MLA_NOPE:]
    scale = (MLA_NOPE + MLA_ROPE) ** -0.5
    n_blocks = S // ATTN_BLOCK
    blk = lambda t: t.reshape(B, n_blocks, ATTN_BLOCK, MLA_HEADS, t.shape[-1]).transpose(1, 0, 3, 2, 4)
    qn_b, qr_b = blk(q_nope), blk(q_rope)
    key_idx = jnp.arange(S)

    def attend(args):
        qn, qr, i = args
        s = (jnp.einsum('bhqd,bkhd->bhqk', qn, k_nope)
             + jnp.einsum('bhqr,bkr->bhqk', qr, k_rope)).astype(jnp.float32) * scale
        q_idx = i * ATTN_BLOCK + jnp.arange(ATTN_BLOCK)
        s = jnp.where(key_idx[None, :] <= q_idx[:, None], s, -jnp.inf)
        pr = jax.nn.softmax(s, axis=-1).astype(v.dtype)
        return jnp.einsum('bhqk,bkhd->bqhd', pr, v)

    o = lax.map(attend, (qn_b, qr_b, jnp.arange(n_blocks)))
    return o.transpose(1, 0, 2, 3, 4).reshape(B, S, MLA_DIM)


def setup_inputs(seed: int = 0) -> dict:
    key = jax.random.key(seed)
    keys = jax.random.split(key, 32)
    nrm = lambda i, shape, scale: scale * jax.random.normal(keys[i], shape, jnp.float32)
    L = DEPTH
    ch = jnp.linspace(0.0, 1.0, RW_DIM, dtype=jnp.float32)
    return {
        'x': nrm(0, (BATCH, SEQ, D_MODEL), 1.0),
        'positions': jnp.broadcast_to(jnp.arange(SEQ, dtype=jnp.int32), (BATCH, SEQ)),
        'attn_norm': 1.0 + nrm(1, (L, D_MODEL), 0.05),
        'w_in': nrm(2, (L, D_MODEL, IN_DIM), D_MODEL ** -0.5),
        'w_out': nrm(3, (L, MIX_DIM, D_MODEL), MIX_DIM ** -0.5),
        'rw_mu': jax.random.uniform(keys[4], (L, RW_IN), jnp.float32),
        'rw_w0': -6.0 + 5.0 * ch ** 0.85 + nrm(5, (L, RW_DIM), 0.1),
        'rw_w2': nrm(6, (L, RW_DECAY_RANK, RW_DIM), 0.5 * RW_DECAY_RANK ** -0.5),
        'rw_a0': nrm(7, (L, RW_DIM), 0.1),
        'rw_a2': nrm(8, (L, RW_A_RANK, RW_DIM), RW_A_RANK ** -0.5),
        'rw_g2': nrm(9, (L, RW_GATE_RANK, RW_DIM), RW_GATE_RANK ** -0.5),
        'rw_k_k': 0.85 + nrm(10, (L, RW_DIM), 0.05),
        'rw_k_a': 1.0 + nrm(11, (L, RW_DIM), 0.05),
        'rw_r_k': nrm(12, (L, RW_HEADS, RW_HEAD_DIM), 0.1),
        'rw_gn_w': 1.0 + nrm(13, (L, RW_DIM), 0.05),
        'rw_gn_b': nrm(14, (L, RW_DIM), 0.01),
        'rw_v0': 1.0 + nrm(15, (L - 1, RW_DIM), 0.1),
        'rw_v1': nrm(16, (L - 1, RW_DIM, RW_V_RANK), RW_DIM ** -0.5),
        'rw_v2': nrm(17, (L - 1, RW_V_RANK, RW_DIM), 0.5 * RW_V_RANK ** -0.5),
        'mla_q_norm': 1.0 + nrm(18, (L, MLA_Q_RANK), 0.05),
        'mla_kv_norm': 1.0 + nrm(19, (L, MLA_KV_RANK), 0.05),
        'mla_w_q_up': nrm(20, (L, MLA_Q_RANK, MLA_HEADS * (MLA_NOPE + MLA_ROPE)), MLA_Q_RANK ** -0.5),
        'mla_w_kv_up': nrm(21, (L, MLA_KV_RANK, MLA_HEADS * (MLA_NOPE + MLA_V)), MLA_KV_RANK ** -0.5),
        'ffn_norm': 1.0 + nrm(22, (L, D_MODEL), 0.05),
        'w_gate_up': nrm(23, (L, D_MODEL, 2 * D_FF), D_MODEL ** -0.5),
        'w_down': nrm(24, (L, D_FF, D_MODEL), D_FF ** -0.5),
        'final_norm': 1.0 + nrm(25, (D_MODEL,), 0.05),
    }


def reference(x, positions, attn_norm, w_in, w_out, rw_mu, rw_w0, rw_w2, rw_a0, rw_a2, rw_g2,
              rw_k_k, rw_k_a, rw_r_k, rw_gn_w, rw_gn_b, rw_v0, rw_v1, rw_v2, mla_q_norm, mla_kv_norm,
              mla_w_q_up, mla_w_kv_up, ffn_norm, w_gate_up, w_down, final_norm):
    h = x
    v_first = None
    for l in range(DEPTH):
        hn = rms_norm(h, attn_norm[l])
        proj = hn @ w_in[l]
        p_a = proj[..., :RW_IN]
        p_b = proj[..., RW_IN:RW_IN + RET_IN]
        p_c = proj[..., RW_IN + RET_IN:]
        v_res = None if l == 0 else (rw_v0[l - 1], rw_v1[l - 1], rw_v2[l - 1])
        y_a, v_first = rwkv7_mixer(p_a, rw_mu[l], rw_w0[l], rw_w2[l], rw_a0[l], rw_a2[l], rw_g2[l],
                                   rw_k_k[l], rw_k_a[l], rw_r_k[l], rw_gn_w[l], rw_gn_b[l], v_first, v_res)
        y_b = retention_mixer(p_b, positions)
        y_c = mla_mixer(p_c, positions, mla_q_norm[l], mla_kv_norm[l], mla_w_q_up[l], mla_w_kv_up[l])
        mix = jnp.concatenate([y_a.astype(h.dtype), y_b.astype(h.dtype), y_c.astype(h.dtype)], axis=-1)
        h = h + mix @ w_out[l]
        hn = rms_norm(h, ffn_norm[l])
        gu = hn @ w_gate_up[l]
        h = h + (jax.nn.silu(gu[..., :D_FF]) * gu[..., D_FF:]) @ w_down[l]
    return rms_norm(h, final_norm)
```

```cpp
#include <hip/hip_runtime.h>
#include <hip/hip_cooperative_groups.h>
#include <cstdio>
#include <cstdint>
namespace cg = cooperative_groups;

#define LAS __attribute__((address_space(3)))
typedef unsigned short bf16_t;
typedef short bf16x8 __attribute__((ext_vector_type(8)));
typedef float f32x2 __attribute__((ext_vector_type(2)));
typedef float f32x4 __attribute__((ext_vector_type(4)));
typedef float f32x16 __attribute__((ext_vector_type(16)));
typedef unsigned u32x4 __attribute__((ext_vector_type(4)));
typedef unsigned u32x2 __attribute__((ext_vector_type(2)));

constexpr int BATCH = 4, SEQ = 4096, T = BATCH * SEQ, DM = 1024, DEPTH = 2;
constexpr int RW_IN = 896, IN_DIM = 2592, D_FF = 2816;
constexpr int NPROJ = 2816;
constexpr float NORM_EPS = 1e-6f;

constexpr size_t MiB = 1u << 20;
constexpr size_t WS_CTL = 0;
constexpr size_t WS_COSR = 1 * MiB, WS_SINR = 3 * MiB, WS_COSM = 5 * MiB, WS_SINM = 6 * MiB;
constexpr size_t WS_BS = 7 * MiB;
constexpr size_t WS_RPREV = 8 * MiB;
constexpr size_t WS_WIN = 12 * MiB;
constexpr size_t WS_WQ = WS_WIN + 5632 * 1024;
constexpr size_t WS_WKV = WS_WQ + 768 * 384 * 2;
constexpr size_t WS_WO = WS_WKV + 1024 * 256 * 2;
constexpr size_t WS_VFIRST = 21 * MiB;
constexpr size_t WS_VBUF = 29 * MiB;
constexpr size_t WS_GBUF = 37 * MiB;
constexpr size_t WS_X = 45 * MiB;
constexpr size_t WS_QN = WS_X, WS_KVN = WS_X + 12 * MiB;
constexpr size_t WS_KR = 253 * MiB;
constexpr size_t WS_PA = 77 * MiB;
constexpr size_t WS_YA = WS_PA, WS_YB = WS_PA + 16 * MiB;
constexpr size_t WS_PB = 109 * MiB;
constexpr size_t WS_PC = 141 * MiB;
constexpr size_t WS_ACT = 77 * MiB;
constexpr size_t WS_KN = 165 * MiB;
constexpr size_t WS_VT = 181 * MiB;
constexpr size_t WS_REC = 197 * MiB;
constexpr size_t WS_WGU = 197 * MiB, WS_WDN = 208 * MiB;
constexpr size_t WS_KVT = 245 * MiB;
constexpr size_t WS_END = 254 * MiB;

constexpr int LDS_BYTES = 131072 + 1024;

__device__ __forceinline__ int sgpr_opaque(int v) { asm volatile("" : "+s"(v)); return v; }
__device__ __forceinline__ int tid_opaque() { int t = __builtin_amdgcn_workitem_id_x(); asm volatile("" : "+v"(t)); return t; }
__device__ __forceinline__ unsigned cvt_pk_bf16(float lo, float hi) { unsigned r; asm volatile("v_cvt_pk_bf16_f32 %0, %1, %2" : "=v"(r) : "v"(lo), "v"(hi)); return r; }
__device__ __forceinline__ bf16_t f2bf(float f) { return (bf16_t)(cvt_pk_bf16(f, 0.f) & 0xffffu); }
__device__ __forceinline__ float bf2f(bf16_t v) { return __uint_as_float(((unsigned)v) << 16); }
__device__ __forceinline__ float bflo(unsigned u) { return __uint_as_float(u << 16); }
__device__ __forceinline__ float bfhi(unsigned u) { return __uint_as_float(u & 0xffff0000u); }
__device__ __forceinline__ float sigmoidf_(float x) { return __builtin_amdgcn_rcpf(1.f + __expf(-x)); }
template <int CTRL> __device__ __forceinline__ float dpp_mov(float x) { return __builtin_bit_cast(float, __builtin_amdgcn_mov_dpp(__builtin_bit_cast(int, x), CTRL, 0xf, 0xf, true)); }
__device__ __forceinline__ float allreduce16(float x) {
    x += dpp_mov<0xB1>(x); x += dpp_mov<0x4E>(x); x += dpp_mov<0x141>(x); x += dpp_mov<0x140>(x); return x;
}
__device__ __forceinline__ float wave_sum(float v) { v = allreduce16(v); v += __shfl_xor(v, 16); v += __shfl_xor(v, 32); return v; }
__device__ __forceinline__ int crow(int r, int hi) { return (r & 3) + 8 * (r >> 2) + 4 * hi; }
#define MFMA32(a, b, c) __builtin_amdgcn_mfma_f32_32x32x16_bf16((a), (b), (c), 0, 0, 0)

namespace pg8 {
#define PG8_LAS __attribute__((address_space(3)))
constexpr int BM = 256, BK = 64, HALF = 128, HTB = HALF * BK * 2, STAGE_BYTES = 8 * HTB, NXCD = 8, WGM = 8;
__host__ __device__ __forceinline__ int lds_byte(int r, int c) { const int st = (r >> 4) * 2 + (c >> 5), rr = r & 15, cc = c & 31, ob = rr * 64 + cc * 2; return st * 1024 + (ob ^ (((ob >> 9) & 1) << 5)); }
__host__ __device__ __forceinline__ void stage_rc(int b, int& R, int& C) { const int st = b / 1024, sb = b % 1024, swz = sb ^ (((sb >> 9) & 1) << 5); R = (st >> 1) * 16 + swz / 64; C = (st & 1) * 32 + (swz % 64) / 2; }
__host__ __device__ __forceinline__ int perm32(int rho) { const int n = rho >> 4, i = rho & 15; return 8 * (i >> 2) + 4 * n + (i & 3); }
struct Unit { int pm, pn; };
struct Gemm { const bf16_t* A; const bf16_t* Bt; int M, N, K; };
struct StaticOrder {
    int nM, nN, nwg, G, c;
    __host__ __device__ void init(int M, int N, int G_, int c_) { nM = M / BM; nN = N / BM; nwg = nM * nN; G = G_; c = c_; }
    __host__ __device__ bool next(int i, Unit& u) const {
        const long L = (long)i * G + c; if (L >= nwg) return false;
        int wgid = (int)L; { const int q = nwg / NXCD, r = nwg % NXCD, xcd = wgid % NXCD, off = wgid / NXCD; wgid = (xcd < r ? xcd * (q + 1) : r * (q + 1) + (xcd - r) * q) + off; }
        const int nig = WGM * nN, gid = wgid / nig, fm = gid * WGM, gsz = (nM - fm) < WGM ? (nM - fm) : WGM;
        u.pm = fm + ((wgid % nig) % gsz); u.pn = (wgid % nig) / gsz; return true;
    }
    __device__ __forceinline__ void a_ready(const Unit&) const {}
    __device__ __forceinline__ void done(const Unit&) const {}
};

template <class Epi, class Sched, bool ALIGN_EPI = false, bool SP2 = false>
__device__ __forceinline__ void gemm_phase(PG8_LAS unsigned char* lds, const Gemm g, const Sched& S, const Epi& E) {
    const int tid = tid_opaque(), wid = __builtin_amdgcn_readfirstlane(tid >> 6), lane = tid & 63, wr = wid >> 2, wc = wid & 3, fr = lane & 15, fq = lane >> 4;
    const int K = g.K, nt = K / BK;
    unsigned voffA[2], voffB[2];
#pragma unroll
    for (int i = 0; i < 2; ++i) { int R, C; stage_rc(tid * 16 + i * 8192, R, C); const int Rb = Epi::PERM ? ((R & ~31) + perm32(R & 31)) : R;
        voffA[i] = (unsigned)(R * K + C) * 2u; voffB[i] = (unsigned)(Rb * K + C) * 2u; }
    const size_t kstep = (size_t)(BK * 2);
    const size_t hstep = (size_t)HALF * K * 2;
    const size_t tstep = 2 * hstep;
    const unsigned ldsw = (unsigned)wid * 1024u;
    const int aoff = lds_byte(wr * 64 + fr, fq * 8), boff = lds_byte(wc * 32 + fr, fq * 8);
#define PG8_SA(b, h) (((b) * 2 + (h)) * HTB)
#define PG8_SB(b, h) ((4 + (b) * 2 + (h)) * HTB)
#define PG8_STAGE(bufoff, gbase, voff) do { _Pragma("unroll") for (int _i = 0; _i < 2; ++_i) \
        __builtin_amdgcn_global_load_lds((const unsigned*)((const char*)(gbase) + (voff)[_i]), (PG8_LAS unsigned*)(lds + (bufoff) + ldsw + _i * 8192), 16, 0, 0); } while (0)
#define PG8_LDA(dst, b, h) do { _Pragma("unroll") for (int m = 0; m < 4; ++m) _Pragma("unroll") for (int k = 0; k < 2; ++k) dst[m][k] = *(const PG8_LAS bf16x8*)(lds + PG8_SA(b, h) + aoff + m * 2048 + k * 1024); } while (0)
#define PG8_LDB(dst, b, h) do { _Pragma("unroll") for (int n = 0; n < 2; ++n) _Pragma("unroll") for (int k = 0; k < 2; ++k) dst[n][k] = *(const PG8_LAS bf16x8*)(lds + PG8_SB(b, h) + boff + n * 2048 + k * 1024); } while (0)
#define PG8_MMA(ai, bj, At, Bt) do { __builtin_amdgcn_s_setprio(1); _Pragma("unroll") for (int m = 0; m < 4; ++m) _Pragma("unroll") for (int n = 0; n < 2; ++n) _Pragma("unroll") for (int k = 0; k < 2; ++k) \
        acc[ai][bj][m][n] = __builtin_amdgcn_mfma_f32_16x16x32_bf16(Bt[n][k], At[m][k], acc[ai][bj][m][n], 0, 0, 0); __builtin_amdgcn_s_setprio(0); } while (0)
#define PG8_WAIT_V(n) asm volatile("s_waitcnt vmcnt(" #n ")" ::: "memory")
#define PG8_WAIT_L(n) asm volatile("s_waitcnt lgkmcnt(" #n ")" ::: "memory")
#define PG8_BAR __builtin_amdgcn_s_barrier()
#define PG8_SCHED __builtin_amdgcn_sched_barrier(0)
    Unit cur, nxt; int ui = 0;
    if (!S.next(0, cur)) return;
    f32x4 acc[2][2][4][2];
#pragma unroll
    for (int a = 0; a < 2; ++a)
#pragma unroll
        for (int b = 0; b < 2; ++b)
#pragma unroll
            for (int m = 0; m < 4; ++m)
#pragma unroll
                for (int n = 0; n < 2; ++n) acc[a][b][m][n] = (f32x4){0.f, 0.f, 0.f, 0.f};
    bf16x8 At[4][2], B0[2][2], B1[2][2];
    const char* cA = (const char*)g.A + (size_t)cur.pm * tstep; const char* cB = (const char*)g.Bt + (size_t)cur.pn * tstep;
    S.a_ready(cur);
    if constexpr (SP2) {
        PG8_STAGE(PG8_SB(0, 0), cB, voffB); PG8_STAGE(PG8_SB(0, 1), cB + hstep, voffB); PG8_STAGE(PG8_SA(0, 0), cA, voffA); PG8_STAGE(PG8_SA(0, 1), cA + hstep, voffA);
        if (wr == 1) PG8_BAR;
        PG8_WAIT_V(2); PG8_BAR;
        PG8_STAGE(PG8_SB(1, 0), cB + kstep, voffB); PG8_STAGE(PG8_SA(1, 0), cA + kstep, voffA); PG8_STAGE(PG8_SB(1, 1), cB + hstep + kstep, voffB);
        PG8_WAIT_V(6); PG8_BAR;
    } else {
        PG8_STAGE(PG8_SB(0, 0), cB, voffB); PG8_STAGE(PG8_SA(0, 0), cA, voffA); PG8_STAGE(PG8_SB(0, 1), cB + hstep, voffB); PG8_STAGE(PG8_SA(0, 1), cA + hstep, voffA);
        if (wr == 1) PG8_BAR;
        PG8_WAIT_V(4); PG8_BAR;
        PG8_STAGE(PG8_SB(1, 0), cB + kstep, voffB); PG8_STAGE(PG8_SA(1, 0), cA + kstep, voffA); PG8_STAGE(PG8_SB(1, 1), cB + hstep + kstep, voffB);
        PG8_WAIT_V(6); PG8_BAR;
    }
    for (;;) {
        const bool has_next = S.next(ui + 1, nxt);
        const char* nA = has_next ? (const char*)g.A + (size_t)nxt.pm * tstep : cA; const char* nB = has_next ? (const char*)g.Bt + (size_t)nxt.pn * tstep : cB;
        for (int t = 0; t < nt; t += 2) {
            const bool last = (t == nt - 2);
            const char* a1 = cA + (size_t)(t + 1) * kstep;
            const char* a2 = last ? nA : cA + (size_t)(t + 2) * kstep; const char* b2 = last ? nB : cB + (size_t)(t + 2) * kstep;
            const char* a3 = a2 + kstep; const char* b3 = b2 + kstep;
            if (last && has_next) S.a_ready(nxt);
            if constexpr (SP2) {
            PG8_LDB(B0, 0, 0); PG8_LDB(B1, 0, 1); PG8_SCHED; PG8_LDA(At, 0, 0); PG8_STAGE(PG8_SA(1, 1), a1 + hstep, voffA);
            PG8_WAIT_V(8); PG8_WAIT_L(0); PG8_BAR; PG8_MMA(0, 0, At, B0); PG8_MMA(0, 1, At, B1); PG8_BAR; PG8_SCHED;
            PG8_LDA(At, 0, 1); PG8_STAGE(PG8_SB(0, 0), b2, voffB); PG8_STAGE(PG8_SB(0, 1), b2 + hstep, voffB); PG8_STAGE(PG8_SA(0, 0), a2, voffA);
            PG8_WAIT_V(8); PG8_WAIT_L(0); PG8_BAR; PG8_MMA(1, 0, At, B0); PG8_MMA(1, 1, At, B1); PG8_BAR; PG8_SCHED;
            PG8_LDB(B0, 1, 0); PG8_LDB(B1, 1, 1); PG8_SCHED; PG8_LDA(At, 1, 0); PG8_STAGE(PG8_SA(0, 1), a2 + hstep, voffA);
            PG8_WAIT_V(8); PG8_WAIT_L(0); PG8_BAR; PG8_MMA(0, 0, At, B0); PG8_MMA(0, 1, At, B1); PG8_BAR; PG8_SCHED;
            PG8_LDA(At, 1, 1); PG8_STAGE(PG8_SB(1, 0), b3, voffB); PG8_STAGE(PG8_SB(1, 1), b3 + hstep, voffB); PG8_STAGE(PG8_SA(1, 0), a3, voffA);
            PG8_WAIT_V(8); PG8_WAIT_L(0); PG8_BAR; PG8_MMA(1, 0, At, B0); PG8_MMA(1, 1, At, B1); PG8_BAR; PG8_SCHED;
            } else {
            PG8_LDB(B0, 0, 0); PG8_SCHED; PG8_LDA(At, 0, 0); PG8_STAGE(PG8_SA(1, 1), a1 + hstep, voffA);
            PG8_WAIT_L(8); PG8_BAR; PG8_WAIT_L(0); PG8_MMA(0, 0, At, B0); PG8_BAR; PG8_SCHED;
            PG8_LDB(B1, 0, 1); PG8_STAGE(PG8_SB(0, 0), b2, voffB);
            PG8_BAR; PG8_WAIT_L(0); PG8_MMA(0, 1, At, B1); PG8_BAR;
            PG8_LDA(At, 0, 1); PG8_STAGE(PG8_SA(0, 0), a2, voffA);
            PG8_BAR; PG8_WAIT_L(0); PG8_MMA(1, 0, At, B0); PG8_BAR; PG8_SCHED;
            PG8_STAGE(PG8_SB(0, 1), b2 + hstep, voffB);
            PG8_WAIT_V(6); PG8_BAR; PG8_MMA(1, 1, At, B1); PG8_BAR;
            PG8_LDB(B0, 1, 0); PG8_SCHED; PG8_LDA(At, 1, 0); PG8_STAGE(PG8_SA(0, 1), a2 + hstep, voffA);
            PG8_WAIT_L(8); PG8_BAR; PG8_WAIT_L(0); PG8_MMA(0, 0, At, B0); PG8_BAR; PG8_SCHED;
            PG8_LDB(B1, 1, 1); PG8_STAGE(PG8_SB(1, 0), b3, voffB);
            PG8_BAR; PG8_WAIT_L(0); PG8_MMA(0, 1, At, B1); PG8_BAR;
            PG8_LDA(At, 1, 1); PG8_STAGE(PG8_SA(1, 0), a3, voffA);
            PG8_BAR; PG8_WAIT_L(0); PG8_MMA(1, 0, At, B0); PG8_BAR; PG8_SCHED;
            PG8_STAGE(PG8_SB(1, 1), b3 + hstep, voffB);
            PG8_WAIT_V(6); PG8_BAR; PG8_MMA(1, 1, At, B1); PG8_BAR;
            }
        }
        if constexpr (ALIGN_EPI) { if (wr == 0) PG8_BAR; }
        E(acc, cur, wr, wc, fr, fq); S.done(cur);
        if (!has_next) break;
#pragma unroll
        for (int a = 0; a < 2; ++a)
#pragma unroll
            for (int b = 0; b < 2; ++b)
#pragma unroll
                for (int m = 0; m < 4; ++m)
#pragma unroll
                    for (int n = 0; n < 2; ++n) acc[a][b][m][n] = (f32x4){0.f, 0.f, 0.f, 0.f};
        cur = nxt; cA = nA; cB = nB; ++ui;
        if constexpr (ALIGN_EPI) { if (wr == 1) PG8_BAR; }
    }
    PG8_WAIT_V(0);
    if constexpr (!ALIGN_EPI) { if (wr == 0) PG8_BAR; }
    PG8_BAR;
#undef PG8_SA
#undef PG8_SB
#undef PG8_STAGE
#undef PG8_LDA
#undef PG8_LDB
#undef PG8_MMA
#undef PG8_WAIT_V
#undef PG8_WAIT_L
#undef PG8_BAR
#undef PG8_SCHED
}

__device__ __forceinline__ u32x4 pack8(const f32x4 v0, const f32x4 v1) { u32x4 w; w.x = cvt_pk_bf16(v0[0], v0[1]); w.y = cvt_pk_bf16(v0[2], v0[3]); w.z = cvt_pk_bf16(v1[0], v1[1]); w.w = cvt_pk_bf16(v1[2], v1[3]); return w; }

struct EpiProj {
    static constexpr bool PERM = true;
    bf16_t *pa, *pb, *pc;
    __device__ __forceinline__ void operator()(const f32x4 (&acc)[2][2][4][2], const Unit& u, int wr, int wc, int fr, int fq) const {
        bf16_t* base; int ldc, colt;
        if (u.pn < 4) { base = pa; ldc = 1024; colt = u.pn * 256; } else if (u.pn < 8) { base = pb; ldc = 1024; colt = (u.pn - 4) * 256; } else { base = pc; ldc = 768; colt = (u.pn - 8) * 256; }
        const int row0 = u.pm * BM + wr * 64 + fr, col0 = colt + wc * 32 + 8 * fq;
#pragma unroll
        for (int ai = 0; ai < 2; ++ai)
#pragma unroll
            for (int m = 0; m < 4; ++m) { bf16_t* rowp = base + (size_t)(row0 + ai * HALF + m * 16) * ldc + col0;
#pragma unroll
                for (int bj = 0; bj < 2; ++bj) *(u32x4*)(rowp + bj * HALF) = pack8(acc[ai][bj][m][0], acc[ai][bj][m][1]); }
    }
};
struct EpiPlain {
    static constexpr bool PERM = true;
    bf16_t* O; int ldc;
    __device__ __forceinline__ void operator()(const f32x4 (&acc)[2][2][4][2], const Unit& u, int wr, int wc, int fr, int fq) const {
        const int row0 = u.pm * BM + wr * 64 + fr, col0 = u.pn * BM + wc * 32 + 8 * fq;
#pragma unroll
        for (int ai = 0; ai < 2; ++ai)
#pragma unroll
            for (int m = 0; m < 4; ++m) { bf16_t* rowp = O + (size_t)(row0 + ai * HALF + m * 16) * ldc + col0;
#pragma unroll
                for (int bj = 0; bj < 2; ++bj) *(u32x4*)(rowp + bj * HALF) = pack8(acc[ai][bj][m][0], acc[ai][bj][m][1]); }
    }
};
struct EpiRes {
    static constexpr bool PERM = false;
    const float* base; float* out;
    __device__ __forceinline__ void operator()(const f32x4 (&acc)[2][2][4][2], const Unit& u, int wr, int wc, int fr, int fq) const {
        const int row0 = u.pm * BM + wr * 64 + fr, col0 = u.pn * BM + wc * 32 + 4 * fq;
#pragma unroll
        for (int ai = 0; ai < 2; ++ai)
#pragma unroll
            for (int m = 0; m < 4; ++m) { const size_t off = (size_t)(row0 + ai * HALF + m * 16) * 1024 + col0;
#pragma unroll
                for (int bj = 0; bj < 2; ++bj)
#pragma unroll
                    for (int n = 0; n < 2; ++n) { const f32x4 bs = *(const f32x4*)(base + off + bj * HALF + n * 16); *(f32x4*)(out + off + bj * HALF + n * 16) = bs + acc[ai][bj][m][n]; } }
    }
};
struct EpiSwiGLU {
    static constexpr bool PERM = true;
    bf16_t* act;
    __device__ __forceinline__ void operator()(const f32x4 (&acc)[2][2][4][2], const Unit& u, int wr, int wc, int fr, int fq) const {
        const int row0 = u.pm * BM + wr * 64 + fr, col0 = u.pn * 128 + wc * 32 + 8 * fq;
#pragma unroll
        for (int ai = 0; ai < 2; ++ai)
#pragma unroll
            for (int m = 0; m < 4; ++m) { f32x4 o[2];
#pragma unroll
                for (int n = 0; n < 2; ++n)
#pragma unroll
                    for (int i = 0; i < 4; ++i) { const float gt = acc[ai][0][m][n][i], up = acc[ai][1][m][n][i]; o[n][i] = gt * up * __builtin_amdgcn_rcpf(1.f + __expf(-gt)); }
                *(u32x4*)(act + (size_t)(row0 + ai * HALF + m * 16) * D_FF + col0) = pack8(o[0], o[1]); }
    }
};
}

struct Params { const void* in[27]; float* out; unsigned char* ws; };
enum { I_X = 0, I_POS, I_ATTN_NORM, I_W_IN, I_W_OUT, I_MU, I_W0, I_W2, I_A0, I_A2, I_G2, I_KK, I_KA, I_RK, I_GNW, I_GNB, I_V0, I_V1, I_V2,
       I_QNORM, I_KVNORM, I_WQUP, I_WKVUP, I_FFN_NORM, I_WGU, I_WDN, I_FINAL };

__device__ __forceinline__ void transpose_item(const float* W, int K, int N, bf16_t* WT, int mode, LAS float* scr, int item, int lane) {
    const int nblk = N / 32, kb = item / nblk, nb = item % nblk, k0 = 64 * kb, n0 = 32 * nb;
    int d0 = n0;
    if (mode == 1) d0 = (n0 < 896) ? n0 : n0 + 128;
    else if (mode == 2) { const int j = (n0 < D_FF) ? n0 : n0 - D_FF; d0 = 256 * (j >> 7) + (j & 127) + ((n0 < D_FF) ? 0 : 128); }
#pragma unroll 8
    for (int i = 0; i < 32; ++i) { const int kk = 2 * i + (lane >> 5); scr[kk * 33 + (lane & 31)] = W[(size_t)(k0 + kk) * N + n0 + (lane & 31)]; }
    asm volatile("s_waitcnt lgkmcnt(0)" ::: "memory");
    const int c = lane & 7;
#pragma unroll
    for (int j = 0; j < 4; ++j) { const int n = (lane >> 3) + 8 * j; const LAS float* s = scr + (8 * c) * 33 + n;
        u32x4 o; o.x = cvt_pk_bf16(s[0 * 33], s[1 * 33]); o.y = cvt_pk_bf16(s[2 * 33], s[3 * 33]); o.z = cvt_pk_bf16(s[4 * 33], s[5 * 33]); o.w = cvt_pk_bf16(s[6 * 33], s[7 * 33]);
        *(u32x4*)(WT + (size_t)(d0 + n) * K + k0 + 8 * c) = o; }
    asm volatile("s_waitcnt lgkmcnt(0)" ::: "memory");
}

__device__ __forceinline__ void rms_rows2_bf16(const float* __restrict__ x0row, const float* __restrict__ x1row, const float* __restrict__ g, bf16_t* __restrict__ o0row, bf16_t* __restrict__ o1row, int lane) {
    const f32x4* xa = (const f32x4*)x0row + lane; const f32x4* xb = (const f32x4*)x1row + lane; const f32x4* gr = (const f32x4*)g + lane;
    f32x4 va[4], vb[4]; float sa = 0.f, sb = 0.f;
#pragma unroll
    for (int j = 0; j < 4; ++j) { va[j] = xa[64 * j]; vb[j] = xb[64 * j]; }
#pragma unroll
    for (int j = 0; j < 4; ++j) { sa += (va[j].x * va[j].x + va[j].y * va[j].y) + (va[j].z * va[j].z + va[j].w * va[j].w); sb += (vb[j].x * vb[j].x + vb[j].y * vb[j].y) + (vb[j].z * vb[j].z + vb[j].w * vb[j].w); }
    const float ra = rsqrtf(wave_sum(sa) * (1.f / 1024.f) + NORM_EPS), rb = rsqrtf(wave_sum(sb) * (1.f / 1024.f) + NORM_EPS);
    u32x2* oa = (u32x2*)o0row + lane; u32x2* ob = (u32x2*)o1row + lane;
#pragma unroll
    for (int j = 0; j < 4; ++j) { const f32x4 gg = gr[64 * j]; u32x2 w;
        w.x = cvt_pk_bf16(va[j].x * ra * gg.x, va[j].y * ra * gg.y); w.y = cvt_pk_bf16(va[j].z * ra * gg.z, va[j].w * ra * gg.w); oa[64 * j] = w;
        w.x = cvt_pk_bf16(vb[j].x * rb * gg.x, vb[j].y * rb * gg.y); w.y = cvt_pk_bf16(vb[j].z * rb * gg.z, vb[j].w * rb * gg.w); ob[64 * j] = w; }
}
__device__ __forceinline__ void rms_row_bf16(const float* xrow, const float* g, bf16_t* orow, int lane) {
    const f32x4* xr = (const f32x4*)xrow + lane; const f32x4* gr = (const f32x4*)g + lane;
    f32x4 v[4]; float s = 0.f;
#pragma unroll
    for (int j = 0; j < 4; ++j) { v[j] = xr[64 * j]; s += (v[j].x * v[j].x + v[j].y * v[j].y) + (v[j].z * v[j].z + v[j].w * v[j].w); }
    const float rstd = rsqrtf(wave_sum(s) * (1.f / 1024.f) + NORM_EPS);
    u32x2* o8 = (u32x2*)orow + lane;
#pragma unroll
    for (int j = 0; j < 4; ++j) { const f32x4 gg = gr[64 * j]; u32x2 w; w.x = cvt_pk_bf16(v[j].x * rstd * gg.x, v[j].y * rstd * gg.y); w.y = cvt_pk_bf16(v[j].z * rstd * gg.z, v[j].w * rstd * gg.w); o8[64 * j] = w; }
}

constexpr int KROW = 104, VROW = 72;
constexpr int ATT_KB = 64 * KROW * 2, ATT_VB = 64 * VROW * 2;
constexpr int ATT_SCR = 2 * (ATT_KB + ATT_VB);

__device__ __forceinline__ void att_unit(LAS unsigned char* lds, int b, int h, int qb, const bf16_t* __restrict__ q, const bf16_t* __restrict__ kvb, const bf16_t* __restrict__ kr,
                                         const float* __restrict__ cosM, const float* __restrict__ sinM, bf16_t* __restrict__ mix) {
    const int tid = tid_opaque(), lane = tid & 63, w = tid >> 6, r32 = lane & 31, hi = lane >> 5;
    LAS float* scr = (LAS float*)(lds + ATT_SCR) + w * 32;
    const int qrow = qb * 256 + w * 32 + r32; const size_t tok = (size_t)b * SEQ + qrow;
    bf16x8 qf[6];
    {
        const bf16_t* qp = q + tok * 768 + h * 96 + hi * 8;
#pragma unroll
        for (int d0 = 0; d0 < 4; ++d0) qf[d0] = *(const bf16x8*)(qp + d0 * 16);
        const u32x4 x1 = *(const u32x4*)(qp + 64), x2 = *(const u32x4*)(qp + 80);
        const f32x4 c0 = *(const f32x4*)(cosM + tok * 16 + hi * 8), c1 = *(const f32x4*)(cosM + tok * 16 + hi * 8 + 4);
        const f32x4 s0 = *(const f32x4*)(sinM + tok * 16 + hi * 8), s1 = *(const f32x4*)(sinM + tok * 16 + hi * 8 + 4);
        float a[8], bb[8], cs[8] = {c0.x, c0.y, c0.z, c0.w, c1.x, c1.y, c1.z, c1.w}, sn[8] = {s0.x, s0.y, s0.z, s0.w, s1.x, s1.y, s1.z, s1.w};
#pragma unroll
        for (int j = 0; j < 4; ++j) { a[2 * j] = bflo(x1[j]); a[2 * j + 1] = bfhi(x1[j]); bb[2 * j] = bflo(x2[j]); bb[2 * j + 1] = bfhi(x2[j]); }
        u32x4 o1, o2;
#pragma unroll
        for (int j = 0; j < 4; ++j) {
            o1[j] = cvt_pk_bf16(a[2 * j] * cs[2 * j] - bb[2 * j] * sn[2 * j], a[2 * j + 1] * cs[2 * j + 1] - bb[2 * j + 1] * sn[2 * j + 1]);
            o2[j] = cvt_pk_bf16(bb[2 * j] * cs[2 * j] + a[2 * j] * sn[2 * j], bb[2 * j + 1] * cs[2 * j + 1] + a[2 * j + 1] * sn[2 * j + 1]); }
        qf[4] = __builtin_bit_cast(bf16x8, o1); qf[5] = __builtin_bit_cast(bf16x8, o2);
    }
    const int k_key = tid >> 3, k_ch = tid & 7;
    const int r_key = (tid & 255) >> 2, r_ch = tid & 3;
    const bf16_t* kn_src = kvb + ((size_t)b * SEQ + k_key) * 1024 + h * 128 + k_ch * 8;
    const bf16_t* kr_src = kr + ((size_t)b * SEQ + r_key) * 32 + r_ch * 8;
    const int kn_dst = (k_key * KROW + k_ch * 8) * 2, kr_dst = (r_key * KROW + 64 + r_ch * 8) * 2, vt_dst = (k_ch * 8 * VROW + k_key) * 2;
#define ATT_VWRITE(bufoff, gv) do { LAS bf16_t* vd_ = (LAS bf16_t*)(lds + 2 * ATT_KB + (bufoff) + vt_dst); _Pragma("unroll") for (int j_ = 0; j_ < 4; ++j_) { \
        vd_[(2 * j_) * VROW] = (bf16_t)((gv)[j_] & 0xffffu); vd_[(2 * j_ + 1) * VROW] = (bf16_t)((gv)[j_] >> 16); } } while (0)
    const int ntiles = 4 * qb + 4;
    u32x4 gk, gr, gv;
    gk = *(const u32x4*)kn_src; gv = *(const u32x4*)(kn_src + 64); if (tid < 256) gr = *(const u32x4*)kr_src;
    *(LAS u32x4*)(lds + kn_dst) = gk; ATT_VWRITE(0, gv); if (tid < 256) *(LAS u32x4*)(lds + kr_dst) = gr;
    __syncthreads();
    f32x16 o0, o1;
#pragma unroll
    for (int r = 0; r < 16; ++r) { o0[r] = 0.f; o1[r] = 0.f; }
    float mrow = -1e30f, lrow = 0.f;
    const float SC = 0.10206207261596577f * 1.4426950408889634f;
    const int wq0 = qb * 256 + w * 32;
    for (int kt = 0; kt < ntiles; ++kt) {
        const int cur = kt & 1;
        if (kt + 1 < ntiles) { const size_t ko = (size_t)(kt + 1) * 64; gk = *(const u32x4*)(kn_src + ko * 1024); gv = *(const u32x4*)(kn_src + ko * 1024 + 64); if (tid < 256) gr = *(const u32x4*)(kr_src + ko * 32); }
        const int k0 = kt * 64;
        if (k0 <= wq0 + 31) {
            const LAS unsigned char* Kb = lds + cur * ATT_KB; const LAS unsigned char* Vb = lds + 2 * ATT_KB + cur * ATT_VB;
            f32x16 p0, p1;
#pragma unroll
            for (int r = 0; r < 16; ++r) { p0[r] = 0.f; p1[r] = 0.f; }
#pragma unroll
            for (int d0 = 0; d0 < 6; ++d0) {
                const bf16x8 k0f = *(const LAS bf16x8*)(Kb + (r32 * KROW + d0 * 16 + hi * 8) * 2);
                const bf16x8 k1f = *(const LAS bf16x8*)(Kb + ((32 + r32) * KROW + d0 * 16 + hi * 8) * 2);
                p0 = MFMA32(k0f, qf[d0], p0); p1 = MFMA32(k1f, qf[d0], p1);
            }
            const bool need_mask = (k0 + 63 > wq0);
            float mx = -1e30f;
            if (need_mask) {
#pragma unroll
                for (int r = 0; r < 16; ++r) { const int key = k0 + crow(r, hi); if (key > qrow) p0[r] = -1e30f; if (key + 32 > qrow) p1[r] = -1e30f; }
            }
#pragma unroll
            for (int r = 0; r < 16; ++r) mx = fmaxf(mx, fmaxf(p0[r], p1[r]));
            mx = fmaxf(mx, __shfl_xor(mx, 32)) * SC;
            const float mnew = fmaxf(mrow, mx);
            const bool grew = __any(mnew > mrow);
            const float alpha = __builtin_amdgcn_exp2f(mrow - mnew); mrow = mnew;
            float ls = 0.f;
#pragma unroll
            for (int r = 0; r < 16; ++r) { p0[r] = __builtin_amdgcn_exp2f(__builtin_fmaf(p0[r], SC, -mnew)); p1[r] = __builtin_amdgcn_exp2f(__builtin_fmaf(p1[r], SC, -mnew)); ls += p0[r] + p1[r]; }
            lrow = lrow * alpha + ls;
            if (grew) {
                if (hi == 0) scr[r32] = alpha;
                asm volatile("s_waitcnt lgkmcnt(0)" ::: "memory");
#pragma unroll
                for (int i = 0; i < 4; ++i) { const f32x4 al = *(const LAS f32x4*)(scr + 8 * i + 4 * hi);
#pragma unroll
                    for (int j = 0; j < 4; ++j) { o0[4 * i + j] *= al[j]; o1[4 * i + j] *= al[j]; } }
                asm volatile("s_waitcnt lgkmcnt(0)" ::: "memory");
            }
#pragma unroll
            for (int s = 0; s < 4; ++s) {
                u32x4 pw;
#pragma unroll
                for (int j = 0; j < 4; ++j) pw[j] = (s < 2) ? cvt_pk_bf16(p0[8 * (s & 1) + 2 * j], p0[8 * (s & 1) + 2 * j + 1]) : cvt_pk_bf16(p1[8 * (s & 1) + 2 * j], p1[8 * (s & 1) + 2 * j + 1]);
                const bf16x8 pa = __builtin_bit_cast(bf16x8, pw);
#pragma unroll
                for (int dvh = 0; dvh < 2; ++dvh) {
                    const LAS unsigned char* vp = Vb + ((dvh * 32 + r32) * VROW + 16 * s + 4 * hi) * 2;
                    const u32x2 lo = *(const LAS u32x2*)vp, hh = *(const LAS u32x2*)(vp + 16);
                    u32x4 vv; vv.x = lo.x; vv.y = lo.y; vv.z = hh.x; vv.w = hh.y;
                    if (dvh == 0) o0 = MFMA32(pa, __builtin_bit_cast(bf16x8, vv), o0); else o1 = MFMA32(pa, __builtin_bit_cast(bf16x8, vv), o1);
                }
            }
        }
        if (kt + 1 < ntiles) { const int nx = cur ^ 1; *(LAS u32x4*)(lds + nx * ATT_KB + kn_dst) = gk; ATT_VWRITE(nx * ATT_VB, gv); if (tid < 256) *(LAS u32x4*)(lds + nx * ATT_KB + kr_dst) = gr; }
        __syncthreads();
    }
    float lt = lrow + __shfl_xor(lrow, 32);
    if (hi == 0) scr[r32] = 1.f / lt;
    asm volatile("s_waitcnt lgkmcnt(0)" ::: "memory");
#pragma unroll
    for (int i = 0; i < 4; ++i) { const f32x4 il = *(const LAS f32x4*)(scr + 8 * i + 4 * hi);
#pragma unroll
        for (int j = 0; j < 4; ++j) { const int r = 4 * i + j; const size_t orow = (size_t)b * SEQ + qb * 256 + w * 32 + crow(r, hi);
            mix[orow * 1024 + 512 + h * 64 + r32] = f2bf(o0[r] * il[j]); mix[orow * 1024 + 512 + h * 64 + 32 + r32] = f2bf(o1[r] * il[j]); } }
    asm volatile("s_waitcnt lgkmcnt(0)" ::: "memory");
}

__device__ __forceinline__ void ret_unit(LAS unsigned char* lds, int b, int h, int jb, const bf16_t* __restrict__ pb, const float* __restrict__ cosR, const float* __restrict__ sinR,
                                         const bf16_t* __restrict__ rprev, float* __restrict__ yb) {
    const int tid = tid_opaque(), lane = tid & 63, w = tid >> 6, r32 = lane & 31, hi = lane >> 5;
    const float lg2 = log2f(1.f - exp2f(-5.f - (float)h));
    const int qrow = jb * 256 + w * 32 + r32; const size_t tok = (size_t)b * SEQ + qrow;
    const int chunk = qrow >> 7;
    bf16x8 qf[4], qx[4];
    {
        const bf16_t* qp = pb + tok * 1024 + h * 64 + hi * 8;
        const float qdec = exp2f(lg2 * (float)((qrow & 127) + 1));
#pragma unroll
        for (int d0 = 0; d0 < 2; ++d0) {
            const u32x4 x1 = *(const u32x4*)(qp + d0 * 16), x2 = *(const u32x4*)(qp + d0 * 16 + 32);
            const float* cp = cosR + tok * 32 + d0 * 16 + hi * 8; const float* sp = sinR + tok * 32 + d0 * 16 + hi * 8;
            const f32x4 c0 = *(const f32x4*)cp, c1 = *(const f32x4*)(cp + 4), s0 = *(const f32x4*)sp, s1 = *(const f32x4*)(sp + 4);
            const float cs[8] = {c0.x, c0.y, c0.z, c0.w, c1.x, c1.y, c1.z, c1.w}, sn[8] = {s0.x, s0.y, s0.z, s0.w, s1.x, s1.y, s1.z, s1.w};
            u32x4 o1, o2, y1, y2;
#pragma unroll
            for (int j = 0; j < 4; ++j) {
                const float a0 = bflo(x1[j]), a1 = bfhi(x1[j]), b0 = bflo(x2[j]), b1 = bfhi(x2[j]);
                const float r0 = a0 * cs[2 * j] - b0 * sn[2 * j], r1 = a1 * cs[2 * j + 1] - b1 * sn[2 * j + 1];
                const float t0 = b0 * cs[2 * j] + a0 * sn[2 * j], t1 = b1 * cs[2 * j + 1] + a1 * sn[2 * j + 1];
                o1[j] = cvt_pk_bf16(r0, r1); o2[j] = cvt_pk_bf16(t0, t1); y1[j] = cvt_pk_bf16(r0 * qdec, r1 * qdec); y2[j] = cvt_pk_bf16(t0 * qdec, t1 * qdec); }
            qf[d0] = __builtin_bit_cast(bf16x8, o1); qf[d0 + 2] = __builtin_bit_cast(bf16x8, o2); qx[d0] = __builtin_bit_cast(bf16x8, y1); qx[d0 + 2] = __builtin_bit_cast(bf16x8, y2);
        }
    }
    f32x16 o0, o1;
#pragma unroll
    for (int r = 0; r < 16; ++r) { o0[r] = 0.f; o1[r] = 0.f; }
    {
        const bf16_t* rp = rprev + ((size_t)((b * 4 + h) * 32 + chunk)) * 4096;
#pragma unroll
        for (int d0 = 0; d0 < 4; ++d0) {
            const bf16x8 r0 = *(const bf16x8*)(rp + (size_t)r32 * 64 + d0 * 16 + hi * 8), r1 = *(const bf16x8*)(rp + (size_t)(32 + r32) * 64 + d0 * 16 + hi * 8);
            o0 = MFMA32(qx[d0], r0, o0); o1 = MFMA32(qx[d0], r1, o1);
        }
    }
    const int l_key = (tid & 255) >> 2, l_c = tid & 3;
    for (int kt = 0; kt < 4; ++kt) {
        const int k0 = jb * 256 + kt * 64;
        __syncthreads();
        if (tid < 256) {
            const size_t kt_tok = (size_t)b * SEQ + k0 + l_key; const bf16_t* kp = pb + kt_tok * 1024 + 256 + h * 64 + l_c * 8;
            const u32x4 x1 = *(const u32x4*)kp, x2 = *(const u32x4*)(kp + 32);
            const float* cp = cosR + kt_tok * 32 + l_c * 8; const float* sp = sinR + kt_tok * 32 + l_c * 8;
            const f32x4 c0 = *(const f32x4*)cp, c1 = *(const f32x4*)(cp + 4), s0 = *(const f32x4*)sp, s1 = *(const f32x4*)(sp + 4);
            const float cs[8] = {c0.x, c0.y, c0.z, c0.w, c1.x, c1.y, c1.z, c1.w}, sn[8] = {s0.x, s0.y, s0.z, s0.w, s1.x, s1.y, s1.z, s1.w};
            u32x4 o1v, o2v;
#pragma unroll
            for (int j = 0; j < 4; ++j) {
                const float a0 = bflo(x1[j]), a1 = bfhi(x1[j]), b0 = bflo(x2[j]), b1 = bfhi(x2[j]);
                o1v[j] = cvt_pk_bf16((a0 * cs[2 * j] - b0 * sn[2 * j]) * 0.125f, (a1 * cs[2 * j + 1] - b1 * sn[2 * j + 1]) * 0.125f);
                o2v[j] = cvt_pk_bf16((b0 * cs[2 * j] + a0 * sn[2 * j]) * 0.125f, (b1 * cs[2 * j + 1] + a1 * sn[2 * j + 1]) * 0.125f); }
            *(LAS u32x4*)(lds + (l_key * KROW + l_c * 8) * 2) = o1v; *(LAS u32x4*)(lds + (l_key * KROW + 32 + l_c * 8) * 2) = o2v;
        } else {
            const size_t vt_tok = (size_t)b * SEQ + k0 + l_key; const bf16_t* vp = pb + vt_tok * 1024 + 512 + h * 64 + l_c * 16;
            const u32x4 x1 = *(const u32x4*)vp, x2 = *(const u32x4*)(vp + 8);
            LAS bf16_t* vd = (LAS bf16_t*)(lds + 2 * ATT_KB) + l_key;
#pragma unroll
            for (int j = 0; j < 4; ++j) { vd[(l_c * 16 + 2 * j) * VROW] = (bf16_t)(x1[j] & 0xffffu); vd[(l_c * 16 + 2 * j + 1) * VROW] = (bf16_t)(x1[j] >> 16);
                                          vd[(l_c * 16 + 8 + 2 * j) * VROW] = (bf16_t)(x2[j] & 0xffffu); vd[(l_c * 16 + 8 + 2 * j + 1) * VROW] = (bf16_t)(x2[j] >> 16); }
        }
        __syncthreads();
        if ((k0 >> 7) == chunk && k0 <= jb * 256 + w * 32 + 31) {
            const LAS unsigned char* Kb = lds; const LAS unsigned char* Vb = lds + 2 * ATT_KB;
            f32x16 p0, p1;
#pragma unroll
            for (int r = 0; r < 16; ++r) { p0[r] = 0.f; p1[r] = 0.f; }
#pragma unroll
            for (int d0 = 0; d0 < 4; ++d0) {
                const bf16x8 k0f = *(const LAS bf16x8*)(Kb + (r32 * KROW + d0 * 16 + hi * 8) * 2);
                const bf16x8 k1f = *(const LAS bf16x8*)(Kb + ((32 + r32) * KROW + d0 * 16 + hi * 8) * 2);
                p0 = MFMA32(k0f, qf[d0], p0); p1 = MFMA32(k1f, qf[d0], p1);
            }
#pragma unroll
            for (int r = 0; r < 16; ++r) {
                const int df0 = qrow - (k0 + crow(r, hi)), df1 = df0 - 32;
                p0[r] = (df0 >= 0) ? p0[r] * __builtin_amdgcn_exp2f(lg2 * (float)df0) : 0.f;
                p1[r] = (df1 >= 0) ? p1[r] * __builtin_amdgcn_exp2f(lg2 * (float)df1) : 0.f;
            }
#pragma unroll
            for (int s = 0; s < 4; ++s) {
                u32x4 pw;
#pragma unroll
                for (int j = 0; j < 4; ++j) pw[j] = (s < 2) ? cvt_pk_bf16(p0[8 * (s & 1) + 2 * j], p0[8 * (s & 1) + 2 * j + 1]) : cvt_pk_bf16(p1[8 * (s & 1) + 2 * j], p1[8 * (s & 1) + 2 * j + 1]);
                const bf16x8 pa = __builtin_bit_cast(bf16x8, pw);
#pragma unroll
                for (int dvh = 0; dvh < 2; ++dvh) {
                    const LAS unsigned char* vp = Vb + ((dvh * 32 + r32) * VROW + 16 * s + 4 * hi) * 2;
                    const u32x2 lo = *(const LAS u32x2*)vp, hh = *(const LAS u32x2*)(vp + 16);
                    u32x4 vv; vv.x = lo.x; vv.y = lo.y; vv.z = hh.x; vv.w = hh.y;
                    if (dvh == 0) o0 = MFMA32(pa, __builtin_bit_cast(bf16x8, vv), o0); else o1 = MFMA32(pa, __builtin_bit_cast(bf16x8, vv), o1);
                }
            }
        }
    }
#pragma unroll
    for (int r = 0; r < 16; ++r) { const size_t orow = (size_t)b * SEQ + jb * 256 + w * 32 + crow(r, hi);
        yb[orow * 256 + h * 64 + r32] = o0[r]; yb[orow * 256 + h * 64 + 32 + r32] = o1[r]; }
}

__device__ __forceinline__ void ret_kv_unit(LAS unsigned char* lds, int bh, int ci, const bf16_t* __restrict__ pb, const float* __restrict__ cosR, const float* __restrict__ sinR, float* __restrict__ kvt) {
    const int tid = tid_opaque(); const int b = bh >> 2, h = bh & 3;
    LAS float* Ks = (LAS float*)lds;
    LAS float* Vs = Ks + 128 * 64;
    const float lg2 = log2f(1.f - exp2f(-5.f - (float)h));
    __syncthreads();
    {
        const int i = tid & 31; float x1[8], x2[8], cc[8], ss[8];
#pragma unroll
        for (int it = 0; it < 8; ++it) { const int t = (tid >> 5) + 16 * it; const size_t tok = (size_t)b * SEQ + ci * 128 + t;
            x1[it] = bf2f(pb[tok * 1024 + 256 + h * 64 + i]); x2[it] = bf2f(pb[tok * 1024 + 256 + h * 64 + 32 + i]); cc[it] = cosR[tok * 32 + i]; ss[it] = sinR[tok * 32 + i]; }
#pragma unroll
        for (int it = 0; it < 8; ++it) { const int t = (tid >> 5) + 16 * it; const float sc = 0.125f * exp2f(lg2 * (float)(127 - t));
            Ks[t * 64 + i] = (x1[it] * cc[it] - x2[it] * ss[it]) * sc; Ks[t * 64 + 32 + i] = (x2[it] * cc[it] + x1[it] * ss[it]) * sc; }
        u32x4 vr[2];
#pragma unroll
        for (int it = 0; it < 2; ++it) { const int ch = tid + 512 * it, t = ch >> 3, c8 = ch & 7; vr[it] = *(const u32x4*)(pb + ((size_t)b * SEQ + ci * 128 + t) * 1024 + 512 + h * 64 + c8 * 8); }
#pragma unroll
        for (int it = 0; it < 2; ++it) { const int ch = tid + 512 * it, t = ch >> 3, c8 = ch & 7; LAS float* d = Vs + t * 64 + c8 * 8;
            *(LAS f32x4*)d = (f32x4){bflo(vr[it].x), bfhi(vr[it].x), bflo(vr[it].y), bfhi(vr[it].y)}; *(LAS f32x4*)(d + 4) = (f32x4){bflo(vr[it].z), bfhi(vr[it].z), bflo(vr[it].w), bfhi(vr[it].w)}; }
    }
    __syncthreads();
    const int e = tid >> 3, d0 = (tid & 7) * 8;
    float acc[8];
#pragma unroll
    for (int j = 0; j < 8; ++j) acc[j] = 0.f;
    for (int t = 0; t < 128; ++t) {
        const float v = Vs[t * 64 + e]; const f32x4 ka = *(const LAS f32x4*)(Ks + t * 64 + d0), kb = *(const LAS f32x4*)(Ks + t * 64 + d0 + 4);
        acc[0] += v * ka.x; acc[1] += v * ka.y; acc[2] += v * ka.z; acc[3] += v * ka.w; acc[4] += v * kb.x; acc[5] += v * kb.y; acc[6] += v * kb.z; acc[7] += v * kb.w;
    }
    float* o = kvt + ((size_t)(bh * 32 + ci)) * 4096 + e * 64 + d0;
    *(f32x4*)o = (f32x4){acc[0], acc[1], acc[2], acc[3]}; *(f32x4*)(o + 4) = (f32x4){acc[4], acc[5], acc[6], acc[7]};
}

struct PrepW { bf16x8 Bw[2], Ba[2], Bv[2], Bg[2][2], Bv1[2]; };
__device__ __forceinline__ bf16x8 pack_col8(const float* W, int ld, int k0, int n) {
    float t[8];
#pragma unroll
    for (int j = 0; j < 8; ++j) t[j] = W[(size_t)(k0 + j) * ld + n];
    u32x4 o; o.x = cvt_pk_bf16(t[0], t[1]); o.y = cvt_pk_bf16(t[2], t[3]); o.z = cvt_pk_bf16(t[4], t[5]); o.w = cvt_pk_bf16(t[6], t[7]);
    return __builtin_bit_cast(bf16x8, o);
}
__device__ __forceinline__ bf16x8 pack_f8(const f32x4 a, const f32x4 b) {
    u32x4 o; o.x = cvt_pk_bf16(a.x, a.y); o.y = cvt_pk_bf16(a.z, a.w); o.z = cvt_pk_bf16(b.x, b.y); o.w = cvt_pk_bf16(b.z, b.w);
    return __builtin_bit_cast(bf16x8, o);
}
#define MFMA16(a, b, c) __builtin_amdgcn_mfma_f32_16x16x32_bf16((a), (b), (c), 0, 0, 0)
__device__ __forceinline__ void prep_fetch_rows(unsigned (&raw)[17], const bf16_t* __restrict__ pa, int t0, int c2) {
    raw[0] = ((t0 & (SEQ - 1)) == 0) ? 0u : *(const unsigned*)(pa + (size_t)(t0 - 1) * 1024 + c2);
#pragma unroll
    for (int t = 0; t < 16; ++t) raw[t + 1] = *(const unsigned*)(pa + (size_t)(t0 + t) * 1024 + c2);
}
constexpr int PSW = 900;
__device__ __forceinline__ void rwkv_prep_tile(LAS unsigned char* lds, int tile, int next_tile, unsigned (&raw)[17], int layer, const Params& P, int z, const PrepW& W, const bf16_t* __restrict__ pa, unsigned char* __restrict__ rec,
                                               bf16_t* __restrict__ vbuf, bf16_t* __restrict__ gbuf, bf16_t* __restrict__ vfirst, float* __restrict__ bs, float* __restrict__ cs) {
    const int tid = tid_opaque(), lane = tid & 63;
    LAS float* PS = (LAS float*)lds;
    LAS float* VV = PS + 16 * PSW;
    const float* mu = (const float*)P.in[I_MU + z] + layer * RW_IN;
    const float* w0 = (const float*)P.in[I_W0 + z] + layer * 256; const float* w2 = (const float*)P.in[I_W2 + z] + layer * 32 * 256;
    const float* a0 = (const float*)P.in[I_A0 + z] + layer * 256; const float* a2 = (const float*)P.in[I_A2 + z] + layer * 32 * 256;
    const float* g2 = (const float*)P.in[I_G2 + z] + layer * 64 * 256;
    const float* k_k = (const float*)P.in[I_KK + z] + layer * 256; const float* k_a = (const float*)P.in[I_KA + z] + layer * 256; const float* r_k = (const float*)P.in[I_RK + z] + layer * 256;
    const float* v0 = (const float*)P.in[I_V0 + z] + (layer > 0 ? (layer - 1) * 256 : 0);
    const float* v1 = (const float*)P.in[I_V1 + z] + (layer > 0 ? (layer - 1) * 256 * 32 : 0);
    const float* v2 = (const float*)P.in[I_V2 + z] + (layer > 0 ? (layer - 1) * 32 * 256 : 0);
    const int t0 = tile * 16;
    __syncthreads();
    if (tid < 448) {
        const int c2 = tid * 2; const float mu0 = mu[c2], mu1 = mu[c2 + 1];
#pragma unroll
        for (int t = 0; t < 16; ++t) {
            float x0 = bflo(raw[t + 1]), x1 = bfhi(raw[t + 1]); const float y0 = bflo(raw[t]), y1 = bfhi(raw[t]);
            x0 = x0 + (y0 - x0) * mu0; x1 = x1 + (y1 - x1) * mu1;
            if (c2 >= 768) { if (c2 < 800) { x0 = 2.f * sigmoidf_(2.f * x0) - 1.f; x1 = 2.f * sigmoidf_(2.f * x1) - 1.f; } else if (c2 >= 832) { x0 = sigmoidf_(x0); x1 = sigmoidf_(x1); } }
            *(LAS f32x2*)(PS + t * PSW + c2) = (f32x2){x0, x1};
        }
        if (next_tile >= 0) prep_fetch_rows(raw, pa, next_tile * 16, c2);
    }
    if (layer > 0) VV[tid] = 0.f;
    __syncthreads();
    const int wv = tid >> 6, l16 = lane & 15, lq = lane >> 4;
    LAS float* LR = VV + 512;
    const f32x4 zero4 = {0.f, 0.f, 0.f, 0.f};
    if (layer > 0) {
        const LAS float* ap = PS + l16 * PSW + 512 + 32 * wv + 8 * lq;
        const bf16x8 A = pack_f8(*(const LAS f32x4*)ap, *(const LAS f32x4*)(ap + 4));
#pragma unroll
        for (int nt = 0; nt < 2; ++nt) { const f32x4 d = MFMA16(A, W.Bv1[nt], zero4);
#pragma unroll
            for (int r = 0; r < 4; ++r) (void)__builtin_amdgcn_ds_faddf(VV + (4 * lq + r) * 32 + 16 * nt + l16, d[r], 0, 0, false); }
        __syncthreads();
    }
    {
        const LAS float* ap = PS + l16 * PSW + 768 + 8 * lq;
        const bf16x8 Aw = pack_f8(*(const LAS f32x4*)ap, *(const LAS f32x4*)(ap + 4)), Aa = pack_f8(*(const LAS f32x4*)(ap + 32), *(const LAS f32x4*)(ap + 36));
        const bf16x8 Ag0 = pack_f8(*(const LAS f32x4*)(ap + 64), *(const LAS f32x4*)(ap + 68)), Ag1 = pack_f8(*(const LAS f32x4*)(ap + 96), *(const LAS f32x4*)(ap + 100));
        bf16x8 Av = Aw;
        if (layer > 0) { const LAS float* vp = VV + l16 * 32 + 8 * lq; Av = pack_f8(*(const LAS f32x4*)vp, *(const LAS f32x4*)(vp + 4)); }
#pragma unroll
        for (int nt = 0; nt < 2; ++nt) {
            const f32x4 dw = MFMA16(Aw, W.Bw[nt], zero4), da = MFMA16(Aa, W.Ba[nt], zero4);
            f32x4 dg = MFMA16(Ag0, W.Bg[nt][0], zero4); dg = MFMA16(Ag1, W.Bg[nt][1], dg);
            f32x4 dv = zero4; if (layer > 0) dv = MFMA16(Av, W.Bv[nt], zero4);
            const int ch = 16 * (2 * wv + nt) + l16;
#pragma unroll
            for (int r = 0; r < 4; ++r) { LAS float* o = LR + (4 * lq + r) * 256 + ch; o[0] = dw[r]; o[4096] = da[r]; o[8192] = dg[r]; o[12288] = dv[r]; }
        }
    }
    __syncthreads();
    const int c = tid & 255, th = tid >> 8;
    float aw[8], aa[8], ag[8], av[8];
#pragma unroll
    for (int i = 0; i < 8; ++i) { const LAS float* o = LR + (th * 8 + i) * 256 + c; aw[i] = o[0]; aa[i] = o[4096]; ag[i] = o[8192]; av[i] = o[12288]; }
    const float w0c = w0[c], a0c = a0[c], kkc = k_k[c], kac = k_a[c], rkc = r_k[c], v0c = (layer > 0) ? v0[c] : 0.f;
    const int head = c >> 6, kq = (c & 63) >> 2, e = c & 3;
    float kk_[8], b_[8], kp_[8], dec_[8];
#pragma unroll
    for (int i = 0; i < 8; ++i) {
        const int t = th * 8 + i; const size_t tok = (size_t)t0 + t;
        const float r = PS[t * PSW + c], k = PS[t * PSW + 256 + c]; float v = PS[t * PSW + 512 + c];
        const float decay = __expf(-0.6065306597126334f * sigmoidf_(w0c + aw[i]));
        const float a = sigmoidf_(a0c + aa[i]);
        if (layer > 0) { const float vf = bf2f(vfirst[tok * 256 + c]); v = v + (vf - v) * sigmoidf_(v0c + av[i]); }
        else vfirst[tok * 256 + c] = f2bf(v);
        const float kkp = k * kkc; const float ss = wave_sum(kkp * kkp); const float kk = kkp * rsqrtf(fmaxf(ss, 1e-24f));
        const float kp = k * (1.f + (a - 1.f) * kac);
        const float bsum = wave_sum(r * kp * rkc);
        kk_[i] = kk; b_[i] = kk * a; kp_[i] = kp; dec_[i] = decay;
        const size_t ri = tok * 256 + c;
        ((float*)rec)[ri] = decay; ((bf16_t*)(rec + 16 * MiB))[ri] = f2bf(r); ((bf16_t*)(rec + 24 * MiB))[ri] = f2bf(kp); ((bf16_t*)(rec + 40 * MiB))[ri] = f2bf(kk * a);
        if ((i & 1) == 0) ((bf16_t*)(rec + 32 * MiB))[ri] = f2bf(-kk);
        else {
            const float d1 = wave_sum(b_[i - 1] * kk), d2 = wave_sum(kp_[i - 1] * kk);
            ((bf16_t*)(rec + 32 * MiB))[ri] = f2bf(kk_[i - 1] * d1 - dec_[i - 1] * kk);
            if (lane == 0) cs[tok * 4 + head] = -d2;
        }
        vbuf[tok * 256 + c] = f2bf(v); gbuf[tok * 256 + c] = f2bf(ag[i]);
        if (lane == 0) bs[tok * 4 + head] = bsum;
    }
}

constexpr int SC_TC = 32;
constexpr int SC_REC_F = SC_TC * 16 * 20;
constexpr int SC_V_F = SC_TC * 20;
__device__ __forceinline__ void scan_load_chunk(LAS float* recb, LAS float* vb, const unsigned char* __restrict__ rec, const bf16_t* __restrict__ vbuf, const float* __restrict__ cs, size_t tok0, int h, int v0, int lt) {
#pragma unroll
    for (int it = 0; it < 2; ++it) {
        const int p = lt + it * 256, step = p >> 4, kq = p & 15;
        const size_t ri = (tok0 + step) * 256 + h * 64 + 4 * kq;
        const f32x4 wv = *(const f32x4*)((const float*)rec + ri);
        const u32x2 rr = *(const u32x2*)((const bf16_t*)(rec + 16 * MiB) + ri), kk2 = *(const u32x2*)((const bf16_t*)(rec + 24 * MiB) + ri);
        const u32x2 nn = *(const u32x2*)((const bf16_t*)(rec + 32 * MiB) + ri), bb = *(const u32x2*)((const bf16_t*)(rec + 40 * MiB) + ri);
        const u32x4 a = {rr.x, rr.y, kk2.x, kk2.y}, bq = {nn.x, nn.y, bb.x, bb.y};
        LAS float* d = recb + (step * 16 + kq) * 20;
        *(LAS f32x4*)d = wv;
        *(LAS f32x4*)(d + 4) = (f32x4){bflo(a.x), bfhi(a.x), bflo(a.y), bfhi(a.y)};
        *(LAS f32x4*)(d + 8) = (f32x4){bflo(a.z), bfhi(a.z), bflo(a.w), bfhi(a.w)};
        *(LAS f32x4*)(d + 12) = (f32x4){bflo(bq.x), bfhi(bq.x), bflo(bq.y), bfhi(bq.y)};
        *(LAS f32x4*)(d + 16) = (f32x4){bflo(bq.z), bfhi(bq.z), bflo(bq.w), bfhi(bq.w)};
    }
    if (lt < 128) { const int step = lt >> 2, qd = lt & 3;
        const u32x2 x = *(const u32x2*)(vbuf + (tok0 + step) * 256 + h * 64 + v0 + 4 * qd);
        *(LAS f32x4*)(vb + step * 20 + 4 * qd) = (f32x4){bflo(x.x), bfhi(x.x), bflo(x.y), bfhi(x.y)}; }
    else if (lt < 128 + SC_TC) { const int step = lt - 128; vb[step * 20 + 16] = cs[(tok0 + step) * 4 + h]; }
}
__device__ __forceinline__ void rwkv_scan_block(LAS unsigned char* lds, int blk, const unsigned char* __restrict__ rec, const bf16_t* __restrict__ vbuf, const float* __restrict__ cs, float* __restrict__ ya) {
    const int tid = tid_opaque(), lane = tid & 63, w = tid >> 6;
    const int bh = blk >> 2, b = bh >> 2, h = bh & 3, v0 = (blk & 3) * 16;
    LAS float* RECB = (LAS float*)lds;
    LAS float* VB = RECB + 2 * SC_REC_F;
    const size_t tokb = (size_t)b * SEQ;
    const int rowl = lane >> 4, kq = lane & 15, row = v0 + 4 * (w & 3) + rowl;
    f32x2 Sa = {0.f, 0.f}, Sb = {0.f, 0.f}; float ykeep = 0.f;
    __syncthreads();
    if (w >= 4) scan_load_chunk(RECB, VB, rec, vbuf, cs, tokb, h, v0, tid - 256);
    for (int c = 0; c < SEQ / SC_TC; ++c) {
        __syncthreads();
        const int buf = c & 1;
        if (w >= 4) { if (c + 1 < SEQ / SC_TC) scan_load_chunk(RECB + (buf ^ 1) * SC_REC_F, VB + (buf ^ 1) * SC_V_F, rec, vbuf, cs, tokb + (size_t)(c + 1) * SC_TC, h, v0, tid - 256); }
        else {
            const LAS float* rb = RECB + buf * SC_REC_F + kq * 20; const LAS float* vb = VB + buf * SC_V_F;
            float* yo = ya + (tokb + (size_t)c * SC_TC + kq) * 256 + h * 64 + row;
#define SC_LD(P, st) do { const LAS float* R_ = rb + (st) * 320; P##w = *(const LAS f32x4*)R_; P##r = *(const LAS f32x4*)(R_ + 4); P##k = *(const LAS f32x4*)(R_ + 8); \
                          P##n = *(const LAS f32x4*)(R_ + 12); P##b = *(const LAS f32x4*)(R_ + 16); P##v = vb[(st) * 20 + 4 * w + rowl]; } while (0)
#define LO2(q_) ((f32x2){(q_).x, (q_).y})
#define HI2(q_) ((f32x2){(q_).z, (q_).w})
            f32x4 Aw, Ar, Ak, An, Ab, Bw, Br, Bk, Bn, Bb, Cw, Cr, Ck, Cn, Cb, Dw, Dr, Dk, Dn, Db; float Av, Bv, Cv, Dv, Bc, Dc;
            SC_LD(A, 0); SC_LD(B, 1); Bc = vb[1 * 20 + 16];
#pragma unroll
            for (int st = 0; st < SC_TC; st += 4) {
                if (st + 2 < SC_TC) { SC_LD(C, st + 2); SC_LD(D, st + 3); Dc = vb[(st + 3) * 20 + 16]; }
#define SC_PAIR(E, O, Oc, S0) do { \
                f32x2 d0 = Sa * LO2(E##n); d0 = Sb * HI2(E##n) + d0; f32x2 d1 = Sa * LO2(O##n); d1 = Sb * HI2(O##n) + d1; \
                const f32x2 ve = {E##v, E##v}, vo = {O##v, O##v}; \
                f32x2 ta = ve * LO2(E##k), tb = ve * HI2(E##k); ta = Sa * LO2(E##w) + ta; tb = Sb * HI2(E##w) + tb; \
                const float sa0 = allreduce16(d0.x + d0.y); const float sa1 = allreduce16(d1.x + d1.y) + E##v * Oc; \
                const f32x2 s0 = {sa0, sa0}, s1 = {sa1, sa1}; \
                Sa = s0 * LO2(E##b) + ta; Sb = s0 * HI2(E##b) + tb; \
                f32x2 e0 = Sa * LO2(E##r); e0 = Sb * HI2(E##r) + e0; \
                f32x2 ua = vo * LO2(O##k), ub = vo * HI2(O##k); ua = Sa * LO2(O##w) + ua; ub = Sb * HI2(O##w) + ub; \
                Sa = s1 * LO2(O##b) + ua; Sb = s1 * HI2(O##b) + ub; \
                f32x2 e1 = Sa * LO2(O##r); e1 = Sb * HI2(O##r) + e1; \
                Y0 = e0.x + e0.y; Y1 = e1.x + e1.y; } while (0)
                float yp0, yp1, yp2, yp3;
#define Y0 yp0
#define Y1 yp1
                SC_PAIR(A, B, Bc, st);
#undef Y0
#undef Y1
                if (st + 4 < SC_TC) { SC_LD(A, st + 4); SC_LD(B, st + 5); Bc = vb[(st + 5) * 20 + 16]; }
#define Y0 yp2
#define Y1 yp3
                SC_PAIR(C, D, Dc, st + 2);
#undef Y0
#undef Y1
                {
                    const unsigned long long b0 = 0xAAAAAAAAAAAAAAAAull, b1 = 0xCCCCCCCCCCCCCCCCull;
                    float s01, x01, s23, x23;
                    asm volatile("v_cndmask_b32_e64 %0, %1, %2, %3" : "=v"(s01) : "v"(yp0), "v"(yp1), "s"(b0));
                    asm volatile("v_cndmask_b32_e64 %0, %1, %2, %3" : "=v"(x01) : "v"(yp1), "v"(yp0), "s"(b0));
                    asm volatile("v_cndmask_b32_e64 %0, %1, %2, %3" : "=v"(s23) : "v"(yp2), "v"(yp3), "s"(b0));
                    asm volatile("v_cndmask_b32_e64 %0, %1, %2, %3" : "=v"(x23) : "v"(yp3), "v"(yp2), "s"(b0));
                    const float a01 = s01 + dpp_mov<0xB1>(x01), a23 = s23 + dpp_mov<0xB1>(x23);
                    float sq, xq;
                    asm volatile("v_cndmask_b32_e64 %0, %1, %2, %3" : "=v"(sq) : "v"(a01), "v"(a23), "s"(b1));
                    asm volatile("v_cndmask_b32_e64 %0, %1, %2, %3" : "=v"(xq) : "v"(a23), "v"(a01), "s"(b1));
                    float yq = sq + dpp_mov<0x4E>(xq);
                    yq += dpp_mov<0x128>(yq); yq += dpp_mov<0x124>(yq);
                    const unsigned long long mk = 0x000F000F000F000Full << (st & 15);
                    asm volatile("v_cndmask_b32_e64 %0, %0, %1, %2" : "+v"(ykeep) : "v"(yq), "s"(mk));
                }
                if ((st & 15) == 12) yo[(size_t)(st - 12) * 256] = ykeep;
            }
#undef SC_PAIR
#undef SC_LD
#undef LO2
#undef HI2
        }
    }
}

#define XB_TMO      128
#define XB_XCNT(j)  (256  + 64 * (j))
#define XB_XSUB(j)  (1280 + 64 * (j))
#define XB_XGEN(j)  (2304 + 64 * (j))
#define XB_TOP      3328
#define XB_TOPGEN   3392
#define XB_SPIN_CAP (1u << 20)
__device__ __forceinline__ unsigned xb_ld(unsigned* p)              { return __hip_atomic_load(p, __ATOMIC_RELAXED, __HIP_MEMORY_SCOPE_AGENT); }
__device__ __forceinline__ unsigned xb_add(unsigned* p, unsigned v) { return __hip_atomic_fetch_add(p, v, __ATOMIC_RELAXED, __HIP_MEMORY_SCOPE_AGENT); }
__device__ __forceinline__ unsigned xb_xcc_id() { return (unsigned)__builtin_amdgcn_s_getreg((3 << 11) | 20) & 0xFu; }
#define XB_SPIN(cond, bar) do { unsigned _sp = 0; while (cond) { __builtin_amdgcn_s_sleep(1); \
    if ((++_sp & 255u) == 0u) { if (xb_ld(&(bar)[XB_TMO])) break; if (_sp > XB_SPIN_CAP) { atomicAdd(&(bar)[XB_TMO], 1u); break; } } } } while (0)
struct XcdBarrier { unsigned* bar; unsigned x; volatile LAS unsigned* st; };
__device__ __forceinline__ XcdBarrier xcd_barrier_post(unsigned* bar, volatile LAS unsigned* st) {
    XcdBarrier b; b.bar = bar; b.x = xb_xcc_id(); b.st = st;
    if (__builtin_amdgcn_workitem_id_x() == 0) (void)xb_add(&bar[XB_XCNT(b.x)], 1u);
    return b;
}
__device__ __forceinline__ void xcd_barrier_complete(unsigned* bar, unsigned x, unsigned& nloc, unsigned& nx) {
    const unsigned G = gridDim.x * gridDim.y * gridDim.z;
    unsigned sum, cnt, mine, sp = 0u;
    for (;;) {
        sum = 0u; cnt = 0u; mine = 0u;
#pragma unroll
        for (unsigned j = 0; j < 16; ++j) { const unsigned c = xb_ld(&bar[XB_XCNT(j)]); sum += c; cnt += (c > 0u) ? 1u : 0u; mine = (j == x) ? c : mine; }
        if (sum == G) break;
        __builtin_amdgcn_s_sleep(1);
        if ((++sp & 255u) == 0u) { if (xb_ld(&bar[XB_TMO])) break; if (sp > XB_SPIN_CAP) { atomicAdd(&bar[XB_TMO], 1u); break; } }
    }
    nloc = mine > 0u ? mine : 1u; nx = cnt > 0u ? cnt : 1u;
}
__device__ __forceinline__ void xcd_barrier(const XcdBarrier& b, const unsigned k) {
    asm volatile("s_waitcnt vmcnt(0)" ::: "memory");
    __syncthreads();
    if (__builtin_amdgcn_workitem_id_x() == 0) {
        unsigned* bar = b.bar;
        __builtin_amdgcn_s_waitcnt(0);
        unsigned nloc = b.st[0], nx = b.st[1];
        if (nloc == 0u) { xcd_barrier_complete(bar, b.x, nloc, nx); b.st[0] = nloc; b.st[1] = nx; }
        const unsigned old = xb_add(&bar[XB_XSUB(b.x)], 1u);
        const unsigned gen = old / nloc;
        if (old + 1u == (gen + 1u) * nloc) {
            __builtin_amdgcn_fence(__ATOMIC_RELEASE, "agent");
            asm volatile("s_waitcnt vmcnt(0)" ::: "memory");
            const unsigned og = xb_add(&bar[XB_TOP], 1u);
            const unsigned tg = og / nx;
            if (og + 1u == (tg + 1u) * nx) xb_add(&bar[XB_TOPGEN], 1u);
            else XB_SPIN(xb_ld(&bar[XB_TOPGEN]) == tg, bar);
            __builtin_amdgcn_fence(__ATOMIC_ACQUIRE, "agent");
            asm volatile("s_waitcnt vmcnt(0)" ::: "memory");
        } else {
            XB_SPIN(xb_ld(&bar[XB_TOPGEN]) < k, bar);
            __builtin_amdgcn_fence(__ATOMIC_ACQUIRE, "agent");
            asm volatile("s_waitcnt vmcnt(0)" ::: "memory");
        }
    }
    __syncthreads();
}


#define PIN(i) ((const float*)P.in[(i) + z])
constexpr int NPH = 9;
template <int PH> __device__ __forceinline__ void run_phase(const Params& P, LAS unsigned char* lds) {
        int z; asm volatile("s_mov_b32 %0, 0" : "=s"(z));
        unsigned char* ws = P.ws + z;
        constexpr int layer = PH / NPH, k = PH - layer * NPH;
        const int tid = tid_opaque(), lane = tid & 63, wave = __builtin_amdgcn_readfirstlane(tid >> 6), G = sgpr_opaque(gridDim.x), blk = sgpr_opaque(blockIdx.x);
        const int gw = blk * 8 + wave, NGW = G * 8;
        float* hbuf = P.out + z;
        bf16_t* XN = (bf16_t*)(ws + WS_X);
        if constexpr (PH == NPH * DEPTH) {
            const float* g = PIN(I_FINAL);
            for (int m = gw; m < T; m += NGW) {
                f32x4* xr = (f32x4*)(hbuf + (size_t)m * 1024) + lane; const f32x4* gr = (const f32x4*)g + lane;
                f32x4 v[4]; float s = 0.f;
#pragma unroll
                for (int j = 0; j < 4; ++j) { v[j] = xr[64 * j]; s += (v[j].x * v[j].x + v[j].y * v[j].y) + (v[j].z * v[j].z + v[j].w * v[j].w); }
                const float rstd = rsqrtf(wave_sum(s) * (1.f / 1024.f) + NORM_EPS);
#pragma unroll
                for (int j = 0; j < 4; ++j) xr[64 * j] = v[j] * rstd * gr[64 * j];
            }
            return;
        } else if constexpr (k == 0) {
            const float* hin = (layer == 0) ? PIN(I_X) : hbuf;
            LAS float* tscr = (LAS float*)(lds + wave * 16384);
            bf16_t* Win_t = (bf16_t*)(ws + WS_WIN); bf16_t* Wq_t = (bf16_t*)(ws + WS_WQ); bf16_t* Wkv_t = (bf16_t*)(ws + WS_WKV); bf16_t* Wo_t = (bf16_t*)(ws + WS_WO);
            const float* Win = PIN(I_W_IN) + (size_t)layer * DM * IN_DIM;
            const float* Wq = PIN(I_WQUP) + (size_t)layer * 384 * 768;
            const float* Wkv = PIN(I_WKVUP) + (size_t)layer * 256 * 1024;
            const float* Wo = PIN(I_W_OUT) + (size_t)layer * 1024 * 1024;
            constexpr int IT_IN = 16 * 81, IT_Q = 6 * 24, IT_KV = 4 * 32, IT_O = 16 * 32;
            for (int it = gw; it < IT_IN + IT_Q + IT_KV + IT_O; it += NGW) {
                int r = it;
                if (r < IT_IN) { transpose_item(Win, 1024, IN_DIM, Win_t, 1, tscr, r, lane); continue; } r -= IT_IN;
                if (r < IT_Q) { transpose_item(Wq, 384, 768, Wq_t, 0, tscr, r, lane); continue; } r -= IT_Q;
                if (r < IT_KV) { transpose_item(Wkv, 256, 1024, Wkv_t, 0, tscr, r, lane); continue; } r -= IT_KV;
                transpose_item(Wo, 1024, 1024, Wo_t, 0, tscr, r, lane);
            }
            for (int i = blk * 512 + tid; i < 224 * 128; i += G * 512) { const int rr = i >> 7, cc = i & 127; const int row = (rr < 128) ? 896 + rr : 2720 + (rr - 128);
                *(u32x4*)(Win_t + (size_t)row * 1024 + cc * 8) = (u32x4){0u, 0u, 0u, 0u}; }
            if (layer == 0) {
                const int* pos = (const int*)P.in[I_POS + z];
                float* cosR = (float*)(ws + WS_COSR); float* sinR = (float*)(ws + WS_SINR); float* cosM = (float*)(ws + WS_COSM); float* sinM = (float*)(ws + WS_SINM);
                for (int i = blk * 512 + tid; i < T * 32; i += G * 512) { const int tok = i >> 5, f = i & 31;
                    const float inv = exp2f(-(float)f * (1.f / 32.f) * 13.287712379549449f); const float ang = (float)pos[tok] * inv;
                    double rev = (double)ang * 0.15915494309189535; rev -= floor(rev); const float a = (float)(rev * 6.283185307179586);
                    cosR[i] = __cosf(a); sinR[i] = __sinf(a); }
                for (int i = blk * 512 + tid; i < T * 16; i += G * 512) { const int tok = i >> 4, f = i & 15;
                    const float inv = exp2f(-(float)f * (1.f / 16.f) * 13.287712379549449f); const float ang = (float)pos[tok] * inv;
                    double rev = (double)ang * 0.15915494309189535; rev -= floor(rev); const float a = (float)(rev * 6.283185307179586);
                    cosM[i] = __cosf(a); sinM[i] = __sinf(a); }
            }
            const float* g = PIN(I_ATTN_NORM) + layer * 1024;
            for (int m = gw; m < T; m += 2 * NGW) rms_rows2_bf16(hin + (size_t)m * 1024, hin + (size_t)(m + NGW) * 1024, g, XN + (size_t)m * 1024, XN + (size_t)(m + NGW) * 1024, lane);
        } else if constexpr (k == 1) {
            pg8::Gemm g{XN, (bf16_t*)(ws + WS_WIN), T, NPROJ, 1024}; pg8::StaticOrder S; S.init(T, NPROJ, G, blk);
            pg8::EpiProj E{(bf16_t*)(ws + WS_PA), (bf16_t*)(ws + WS_PB), (bf16_t*)(ws + WS_PC)};
            pg8::gemm_phase<pg8::EpiProj, pg8::StaticOrder, true, true>(lds, g, S, E);
        } else if constexpr (k == 2) {
            bf16_t* pa = (bf16_t*)(ws + WS_PA); bf16_t* pb = (bf16_t*)(ws + WS_PB); bf16_t* pc = (bf16_t*)(ws + WS_PC);
            float* cosR = (float*)(ws + WS_COSR); float* sinR = (float*)(ws + WS_SINR); float* cosM = (float*)(ws + WS_COSM); float* sinM = (float*)(ws + WS_SINM);
            PrepW W;
            {
                const int l16 = lane & 15, lq = lane >> 4;
                const float* w2 = PIN(I_W2) + layer * 32 * 256; const float* a2 = PIN(I_A2) + layer * 32 * 256; const float* g2 = PIN(I_G2) + layer * 64 * 256;
                const float* v1 = PIN(I_V1) + (layer > 0 ? (layer - 1) * 256 * 32 : 0); const float* v2 = PIN(I_V2) + (layer > 0 ? (layer - 1) * 32 * 256 : 0);
#pragma unroll
                for (int nt = 0; nt < 2; ++nt) { const int n = 16 * (2 * wave + nt) + l16;
                    W.Bw[nt] = pack_col8(w2, 256, 8 * lq, n); W.Ba[nt] = pack_col8(a2, 256, 8 * lq, n);
                    W.Bg[nt][0] = pack_col8(g2, 256, 8 * lq, n); W.Bg[nt][1] = pack_col8(g2, 256, 32 + 8 * lq, n);
                    W.Bv[nt] = pack_col8(v2, 256, 8 * lq, n); W.Bv1[nt] = pack_col8(v1, 32, 32 * wave + 8 * lq, 16 * nt + l16); }
            }
            unsigned raw[17];
            if (tid < 448 && blk < T / 16) prep_fetch_rows(raw, pa, blk * 16, tid * 2);
            for (int tile = blk; tile < T / 16; tile += G) rwkv_prep_tile(lds, tile, (tile + G < T / 16) ? tile + G : -1, raw, layer, P, z, W, pa, ws + WS_REC, (bf16_t*)(ws + WS_VBUF), (bf16_t*)(ws + WS_GBUF), (bf16_t*)(ws + WS_VFIRST), (float*)(ws + WS_BS), (float*)(ws + WS_BS + 512 * 1024));
            for (int u = blk; u < 512; u += G) ret_kv_unit(lds, u >> 5, u & 31, pb, cosR, sinR, (float*)(ws + WS_KVT));
        } else if constexpr (k == 3) {
            LAS unsigned* misc = (LAS unsigned*)(lds + 131072);
            unsigned* ctl = (unsigned*)(ws + WS_CTL);
            float* cosR = (float*)(ws + WS_COSR); float* sinR = (float*)(ws + WS_SINR); float* cosM = (float*)(ws + WS_COSM); float* sinM = (float*)(ws + WS_SINM);
            unsigned* sbar = ctl + 64 * (8 + layer);
            const int NB = G - 64;
            if (blk < 64) {
                rwkv_scan_block(lds, blk, ws + WS_REC, (bf16_t*)(ws + WS_VBUF), (const float*)(ws + WS_BS + 512 * 1024), (float*)(ws + WS_YA));
                if (tid == 0) { unsigned sp = 0; while (xb_ld(sbar) < (unsigned)NB) { __builtin_amdgcn_s_sleep(4); if (++sp > (1u << 22)) break; }
                    __builtin_amdgcn_fence(__ATOMIC_ACQUIRE, "agent"); asm volatile("s_waitcnt vmcnt(0)" ::: "memory"); }
                __syncthreads();
            } else {
                const int cb = blk - 64;
                {
                    const int gwn = cb * 8 + wave, NGWn = NB * 8;
                    bf16_t* pc = (bf16_t*)(ws + WS_PC);
            bf16_t* qn = (bf16_t*)(ws + WS_QN); bf16_t* kvn = (bf16_t*)(ws + WS_KVN); bf16_t* kr = (bf16_t*)(ws + WS_KR);
            const float* qg = PIN(I_QNORM) + layer * 384; const float* kg = PIN(I_KVNORM) + layer * 256;
            for (int m0 = gwn; m0 < T; m0 += 2 * NGWn) {
                float xq[2][6], xk[2][4], x1[2], x2[2], cc[2], sn[2];
#pragma unroll
                for (int u = 0; u < 2; ++u) { const int m = (m0 + u * NGWn < T) ? m0 + u * NGWn : T - 1; const bf16_t* row = pc + (size_t)m * 768;
#pragma unroll
                    for (int j = 0; j < 6; ++j) xq[u][j] = bf2f(row[lane + 64 * j]);
#pragma unroll
                    for (int j = 0; j < 4; ++j) xk[u][j] = bf2f(row[384 + lane + 64 * j]);
                    x1[u] = bf2f(row[640 + (lane & 15)]); x2[u] = bf2f(row[656 + (lane & 15)]); cc[u] = cosM[(size_t)m * 16 + (lane & 15)]; sn[u] = sinM[(size_t)m * 16 + (lane & 15)]; }
#pragma unroll
                for (int u = 0; u < 2; ++u) { const int m = m0 + u * NGWn; if (m >= T) continue;
                    float sq = 0.f, sk = 0.f;
#pragma unroll
                    for (int j = 0; j < 6; ++j) sq += xq[u][j] * xq[u][j];
#pragma unroll
                    for (int j = 0; j < 4; ++j) sk += xk[u][j] * xk[u][j];
                    const float rq = rsqrtf(wave_sum(sq) * (1.f / 384.f) + NORM_EPS), rk = rsqrtf(wave_sum(sk) * (1.f / 256.f) + NORM_EPS);
#pragma unroll
                    for (int j = 0; j < 6; ++j) qn[(size_t)m * 384 + lane + 64 * j] = f2bf(xq[u][j] * rq * qg[lane + 64 * j]);
#pragma unroll
                    for (int j = 0; j < 4; ++j) kvn[(size_t)m * 256 + lane + 64 * j] = f2bf(xk[u][j] * rk * kg[lane + 64 * j]);
                    if (lane < 16) { kr[(size_t)m * 32 + lane] = f2bf(x1[u] * cc[u] - x2[u] * sn[u]); kr[(size_t)m * 32 + 16 + lane] = f2bf(x2[u] * cc[u] + x1[u] * sn[u]); }
                }
            }
                    unsigned* sbar0 = ctl + 64 * (12 + layer);
                    asm volatile("s_waitcnt vmcnt(0)" ::: "memory");
                    __syncthreads();
                    if (tid == 0) {
                        __builtin_amdgcn_fence(__ATOMIC_RELEASE, "agent"); asm volatile("s_waitcnt vmcnt(0)" ::: "memory");
                        xb_add(sbar0, 1u);
                        unsigned sp = 0; while (xb_ld(sbar0) < (unsigned)NB) { __builtin_amdgcn_s_sleep(4); if (++sp > (1u << 22)) break; }
                        __builtin_amdgcn_fence(__ATOMIC_ACQUIRE, "agent"); asm volatile("s_waitcnt vmcnt(0)" ::: "memory");
                    }
                    __syncthreads();
                }
                bf16_t* rprev = (bf16_t*)(ws + WS_RPREV); const float* kvt = (const float*)(ws + WS_KVT);
                for (int i = cb * 512 + tid; i < 16 * 4096; i += NB * 512) { const int bh = i >> 12, el = i & 4095; const int h = bh & 3;
                    const float cd = exp2f(128.f * log2f(1.f - exp2f(-5.f - (float)h)));
                    float R = 0.f;
#pragma unroll 8
                    for (int ci = 0; ci < 32; ++ci) { rprev[((size_t)(bh * 32 + ci)) * 4096 + el] = f2bf(R); R = R * cd + kvt[((size_t)(bh * 32 + ci)) * 4096 + el]; } }
                __syncthreads();
                { pg8::Gemm g{(bf16_t*)(ws + WS_QN), (bf16_t*)(ws + WS_WQ), T, 768, 384}; pg8::StaticOrder S; S.init(T, 768, NB, cb); pg8::EpiPlain E{(bf16_t*)(ws + WS_PC), 768};
                  pg8::gemm_phase<pg8::EpiPlain, pg8::StaticOrder, true, true>(lds, g, S, E); }
                { pg8::Gemm g{(bf16_t*)(ws + WS_KVN), (bf16_t*)(ws + WS_WKV), T, 1024, 256}; pg8::StaticOrder S; S.init(T, 1024, NB, cb); pg8::EpiPlain E{(bf16_t*)(ws + WS_KN), 1024};
                  pg8::gemm_phase<pg8::EpiPlain, pg8::StaticOrder, true, true>(lds, g, S, E); }
                asm volatile("s_waitcnt vmcnt(0)" ::: "memory");
                __syncthreads();
                if (tid == 0) {
                    __builtin_amdgcn_fence(__ATOMIC_RELEASE, "agent"); asm volatile("s_waitcnt vmcnt(0)" ::: "memory");
                    xb_add(sbar, 1u);
                    unsigned sp = 0; while (xb_ld(sbar) < (unsigned)NB) { __builtin_amdgcn_s_sleep(4); if (++sp > (1u << 22)) break; }
                    __builtin_amdgcn_fence(__ATOMIC_ACQUIRE, "agent"); asm volatile("s_waitcnt vmcnt(0)" ::: "memory");
                }
                __syncthreads();
            }
            unsigned* qctr = ctl + 64 * (1 + layer);
            for (;;) {
                __syncthreads();
                if (tid == 0) misc[0] = atomicAdd(qctr, 1u);
                __syncthreads();
                const int u = (int)misc[0];
                if (u >= 768) break;
                if (u < 512) { const int qb = 15 - (u >> 5), bh = u & 31; att_unit(lds, bh >> 3, bh & 7, qb, (bf16_t*)(ws + WS_PC), (bf16_t*)(ws + WS_KN), (bf16_t*)(ws + WS_KR), cosM, sinM, XN); }
                else { const int v = u - 512; const int bh = v & 15, jb = v >> 4; ret_unit(lds, bh >> 2, bh & 3, jb, (bf16_t*)(ws + WS_PB), cosR, sinR, (bf16_t*)(ws + WS_RPREV), (float*)(ws + WS_YB)); }
            }
        } else if constexpr (k == 4) {
            LAS float* tscr = (LAS float*)(lds + wave * 16384);
            const float* __restrict__ ya = (const float*)(ws + WS_YA); const float* __restrict__ yb = (const float*)(ws + WS_YB); const float* __restrict__ bs = (const float*)(ws + WS_BS);
            const bf16_t* __restrict__ vbuf = (const bf16_t*)(ws + WS_VBUF); const bf16_t* __restrict__ gbuf = (const bf16_t*)(ws + WS_GBUF); const bf16_t* __restrict__ pb = (const bf16_t*)(ws + WS_PB);
            const float* __restrict__ gnw = PIN(I_GNW) + layer * 256; const float* __restrict__ gnb = PIN(I_GNB) + layer * 256;
            bf16_t* __restrict__ XNw = XN;
#pragma unroll 4
            for (int m = gw; m < T; m += NGW) {
                const int c = 4 * lane, head = lane >> 4;
                const f32x4 y = *(const f32x4*)(ya + (size_t)m * 256 + c);
                const float mean = allreduce16((y.x + y.y) + (y.z + y.w)) * (1.f / 64.f);
                const f32x4 d = y - mean;
                const float var = allreduce16((d.x * d.x + d.y * d.y) + (d.z * d.z + d.w * d.w)) * (1.f / 64.f);
                const float rs = rsqrtf(var + 64e-5f);
                const f32x4 gw4 = *(const f32x4*)(gnw + c), gb4 = *(const f32x4*)(gnb + c);
                const u32x2 vv = *(const u32x2*)(vbuf + (size_t)m * 256 + c), gg = *(const u32x2*)(gbuf + (size_t)m * 256 + c);
                const float bsc = bs[(size_t)m * 4 + head];
                const float o0 = (d.x * rs * gw4.x + gb4.x + bsc * bflo(vv.x)) * bflo(gg.x), o1 = (d.y * rs * gw4.y + gb4.y + bsc * bfhi(vv.x)) * bfhi(gg.x);
                const float o2 = (d.z * rs * gw4.z + gb4.z + bsc * bflo(vv.y)) * bflo(gg.y), o3 = (d.w * rs * gw4.w + gb4.w + bsc * bfhi(vv.y)) * bfhi(gg.y);
                u32x2 w; w.x = cvt_pk_bf16(o0, o1); w.y = cvt_pk_bf16(o2, o3);
                *(u32x2*)(XNw + (size_t)m * 1024 + c) = w;
                const f32x4 zz = *(const f32x4*)(yb + (size_t)m * 256 + c);
                const float ms = allreduce16((zz.x * zz.x + zz.y * zz.y) + (zz.z * zz.z + zz.w * zz.w)) * (1.f / 64.f);
                const float rz = rsqrtf(ms + NORM_EPS);
                const u32x2 gt = *(const u32x2*)(pb + (size_t)m * 1024 + 768 + c);
                const float g0 = bflo(gt.x), g1 = bfhi(gt.x), g2v = bflo(gt.y), g3 = bfhi(gt.y);
                u32x2 w2; w2.x = cvt_pk_bf16(zz.x * rz * g0 * sigmoidf_(g0), zz.y * rz * g1 * sigmoidf_(g1)); w2.y = cvt_pk_bf16(zz.z * rz * g2v * sigmoidf_(g2v), zz.w * rz * g3 * sigmoidf_(g3));
                *(u32x2*)(XNw + (size_t)m * 1024 + 256 + c) = w2;
            }
            const float* Wgu = PIN(I_WGU) + (size_t)layer * 1024 * 2 * D_FF; const float* Wdn = PIN(I_WDN) + (size_t)layer * D_FF * 1024;
            bf16_t* Wgu_t = (bf16_t*)(ws + WS_WGU); bf16_t* Wdn_t = (bf16_t*)(ws + WS_WDN);
            constexpr int IT_GU = 16 * 176, IT_DN = 44 * 32;
            for (int it = gw; it < IT_GU + IT_DN; it += NGW) {
                if (it < IT_GU) transpose_item(Wgu, 1024, 2 * D_FF, Wgu_t, 2, tscr, it, lane);
                else transpose_item(Wdn, D_FF, 1024, Wdn_t, 0, tscr, it - IT_GU, lane);
            }
        } else if constexpr (k == 5) {
            const float* hin = (layer == 0) ? PIN(I_X) : hbuf;
            pg8::Gemm g{XN, (bf16_t*)(ws + WS_WO), T, 1024, 1024}; pg8::StaticOrder S; S.init(T, 1024, G, blk); pg8::EpiRes E{hin, hbuf};
            pg8::gemm_phase<pg8::EpiRes, pg8::StaticOrder, true, true>(lds, g, S, E);
        } else if constexpr (k == 6) {
            const float* g = PIN(I_FFN_NORM) + layer * 1024;
            for (int m = gw; m < T; m += 2 * NGW) rms_rows2_bf16(hbuf + (size_t)m * 1024, hbuf + (size_t)(m + NGW) * 1024, g, XN + (size_t)m * 1024, XN + (size_t)(m + NGW) * 1024, lane);
        } else if constexpr (k == 7) {
            pg8::Gemm g{XN, (bf16_t*)(ws + WS_WGU), T, 2 * D_FF, 1024}; pg8::StaticOrder S; S.init(T, 2 * D_FF, G, blk); pg8::EpiSwiGLU E{(bf16_t*)(ws + WS_ACT)};
            pg8::gemm_phase<pg8::EpiSwiGLU, pg8::StaticOrder, true, true>(lds, g, S, E);
        } else {
            pg8::Gemm g{(bf16_t*)(ws + WS_ACT), (bf16_t*)(ws + WS_WDN), T, 1024, D_FF}; pg8::StaticOrder S; S.init(T, 1024, G, blk); pg8::EpiRes E{hbuf, hbuf};
            pg8::gemm_phase<pg8::EpiRes, pg8::StaticOrder, true, true>(lds, g, S, E);
        }
}

template <int PH> __device__ __forceinline__ void run_all(const Params& P, LAS unsigned char* lds, cg::grid_group& grid, const XcdBarrier& bar) {
    run_phase<PH>(P, lds);
    if constexpr (PH < NPH * DEPTH) {
        xcd_barrier(bar, (unsigned)PH + 1u);
        run_all<PH + 1>(P, lds, grid, bar);
    }
}
__global__ void __launch_bounds__(512) hymba_fwd(Params P) {
    extern __shared__ __attribute__((aligned(16))) unsigned char lds_raw[];
    LAS unsigned char* lds = (LAS unsigned char*)lds_raw;
    cg::grid_group grid = cg::this_grid();
    LAS unsigned* misc = (LAS unsigned*)(lds + 131072);
    if (__builtin_amdgcn_workitem_id_x() < 32) misc[__builtin_amdgcn_workitem_id_x()] = 0u;
    __syncthreads();
    if (P.ws == nullptr) grid.sync();
    const XcdBarrier bar = xcd_barrier_post((unsigned*)(P.ws + WS_CTL) + 4096, (volatile LAS unsigned*)(misc + 8));
    run_all<0>(P, lds, grid, bar);
}
extern "C" void kernel_launch(void* const* d_in, const int* in_sizes, int n_in, void* d_out, int out_size, void* d_ws, size_t ws_size, hipStream_t stream) {
    static int grid = 0;
    if (grid == 0) {
        if (n_in != 27 || out_size != T * DM || ws_size < WS_END) { fprintf(stderr, "kernel_launch: unexpected shapes (n_in %d, out %d, ws %zu)\n", n_in, out_size, ws_size); grid = -1; return; }
        int dev = 0, cus = 0, per_cu = 0;
        (void)hipGetDevice(&dev); (void)hipDeviceGetAttribute(&cus, hipDeviceAttributeMultiprocessorCount, dev);
        if (hipFuncSetAttribute((const void*)hymba_fwd, hipFuncAttributeMaxDynamicSharedMemorySize, LDS_BYTES) != hipSuccess) { fprintf(stderr, "kernel_launch: hipFuncSetAttribute failed\n"); grid = -1; return; }
        if (hipOccupancyMaxActiveBlocksPerMultiprocessor(&per_cu, (const void*)hymba_fwd, 512, LDS_BYTES) != hipSuccess || per_cu < 1) { fprintf(stderr, "kernel_launch: occupancy query failed (%d)\n", per_cu); grid = -1; return; }
        (void)hipGetLastError();
        grid = cus;
        if (grid < 64) { fprintf(stderr, "kernel_launch: needs >= 64 CUs\n"); grid = -1; return; }
    }
    if (grid < 0) return;
    (void)hipMemsetAsync((char*)d_ws + WS_CTL, 0, 1 * MiB, stream);
    Params p{};
    for (int i = 0; i < 27; ++i) p.in[i] = d_in[i];
    p.out = (float*)d_out; p.ws = (unsigned char*)d_ws;
    void* args[] = {&p};
    hipError_t e = hipLaunchCooperativeKernel((const void*)hymba_fwd, dim3(grid), dim3(512), args, LDS_BYTES, stream);
    if (e != hipSuccess) fprintf(stderr, "kernel_launch: cooperative launch failed: %s (grid %d)\n", hipGetErrorString(e), grid);
}
```

```cpp
#include <hip/hip_runtime.h>
#include <hip/hip_cooperative_groups.h>
#include <cstdio>
#include <cstdint>
namespace cg = cooperative_groups;

#define LAS __attribute__((address_space(3)))
typedef unsigned short bf16_t;
typedef short bf16x8 __attribute__((ext_vector_type(8)));
typedef float f32x2 __attribute__((ext_vector_type(2)));
typedef float f32x4 __attribute__((ext_vector_type(4)));
typedef float f32x16 __attribute__((ext_vector_type(16)));
typedef unsigned u32x4 __attribute__((ext_vector_type(4)));
typedef unsigned u32x2 __attribute__((ext_vector_type(2)));

constexpr int BATCH = 4, SEQ = 4096, T = BATCH * SEQ, DM = 1024, DEPTH = 2;
constexpr int RW_IN = 896, IN_DIM = 2592, D_FF = 2816;
constexpr int NPROJ = 2816;
constexpr float NORM_EPS = 1e-6f;

constexpr size_t MiB = 1u << 20;
constexpr size_t WS_CTL = 0;
constexpr size_t WS_COSR = 1 * MiB, WS_SINR = 3 * MiB, WS_COSM = 5 * MiB, WS_SINM = 6 * MiB;
constexpr size_t WS_BS = 7 * MiB;
constexpr size_t WS_RPREV = 8 * MiB;
constexpr size_t WS_WIN = 12 * MiB;
constexpr size_t WS_WQ = WS_WIN + 5632 * 1024;
constexpr size_t WS_WKV = WS_WQ + 768 * 384 * 2;
constexpr size_t WS_WO = WS_WKV + 1024 * 256 * 2;
constexpr size_t WS_VFIRST = 21 * MiB;
constexpr size_t WS_VBUF = 29 * MiB;
constexpr size_t WS_GBUF = 37 * MiB;
constexpr size_t WS_X = 45 * MiB;
constexpr size_t WS_QN = WS_X, WS_KVN = WS_X + 12 * MiB;
constexpr size_t WS_KR = 253 * MiB;
constexpr size_t WS_PA = 77 * MiB;
constexpr size_t WS_YA = WS_PA, WS_YB = WS_PA + 16 * MiB;
constexpr size_t WS_PB = 109 * MiB;
constexpr size_t WS_PC = 141 * MiB;
constexpr size_t WS_ACT = 77 * MiB;
constexpr size_t WS_KN = 165 * MiB;
constexpr size_t WS_VT = 181 * MiB;
constexpr size_t WS_REC = 197 * MiB;
constexpr size_t WS_WGU = 197 * MiB, WS_WDN = 208 * MiB;
constexpr size_t WS_KVT = 245 * MiB;
constexpr size_t WS_END = 254 * MiB;

constexpr int LDS_BYTES = 131072 + 1024;

__device__ __forceinline__ int sgpr_opaque(int v) { asm volatile("" : "+s"(v)); return v; }
__device__ __forceinline__ int tid_opaque() { int t = __builtin_amdgcn_workitem_id_x(); asm volatile("" : "+v"(t)); return t; }
__device__ __forceinline__ unsigned cvt_pk_bf16(float lo, float hi) { unsigned r; asm volatile("v_cvt_pk_bf16_f32 %0, %1, %2" : "=v"(r) : "v"(lo), "v"(hi)); return r; }
__device__ __forceinline__ bf16_t f2bf(float f) { return (bf16_t)(cvt_pk_bf16(f, 0.f) & 0xffffu); }
__device__ __forceinline__ float bf2f(bf16_t v) { return __uint_as_float(((unsigned)v) << 16); }
__device__ __forceinline__ float bflo(unsigned u) { return __uint_as_float(u << 16); }
__device__ __forceinline__ float bfhi(unsigned u) { return __uint_as_float(u & 0xffff0000u); }
__device__ __forceinline__ float sigmoidf_(float x) { return __builtin_amdgcn_rcpf(1.f + __expf(-x)); }
template <int CTRL> __device__ __forceinline__ float dpp_mov(float x) { return __builtin_bit_cast(float, __builtin_amdgcn_mov_dpp(__builtin_bit_cast(int, x), CTRL, 0xf, 0xf, true)); }
__device__ __forceinline__ float allreduce16(float x) {
    x += dpp_mov<0xB1>(x); x += dpp_mov<0x4E>(x); x += dpp_mov<0x141>(x); x += dpp_mov<0x140>(x); return x;
}
__device__ __forceinline__ float wave_sum(float v) { v = allreduce16(v); v += __shfl_xor(v, 16); v += __shfl_xor(v, 32); return v; }
__device__ __forceinline__ int crow(int r, int hi) { return (r & 3) + 8 * (r >> 2) + 4 * hi; }
#define MFMA32(a, b, c) __builtin_amdgcn_mfma_f32_32x32x16_bf16((a), (b), (c), 0, 0, 0)

namespace pg8 {
#define PG8_LAS __attribute__((address_space(3)))
constexpr int BM = 256, BK = 64, HALF = 128, HTB = HALF * BK * 2, STAGE_BYTES = 8 * HTB, NXCD = 8, WGM = 8;
__host__ __device__ __forceinline__ int lds_byte(int r, int c) { const int st = (r >> 4) * 2 + (c >> 5), rr = r & 15, cc = c & 31, ob = rr * 64 + cc * 2; return st * 1024 + (ob ^ (((ob >> 9) & 1) << 5)); }
__host__ __device__ __forceinline__ void stage_rc(int b, int& R, int& C) { const int st = b / 1024, sb = b % 1024, swz = sb ^ (((sb >> 9) & 1) << 5); R = (st >> 1) * 16 + swz / 64; C = (st & 1) * 32 + (swz % 64) / 2; }
__host__ __device__ __forceinline__ int perm32(int rho) { const int n = rho >> 4, i = rho & 15; return 8 * (i >> 2) + 4 * n + (i & 3); }
struct Unit { int pm, pn; };
struct Gemm { const bf16_t* A; const bf16_t* Bt; int M, N, K; };
struct StaticOrder {
    int nM, nN, nwg, G, c;
    __host__ __device__ void init(int M, int N, int G_, int c_) { nM = M / BM; nN = N / BM; nwg = nM * nN; G = G_; c = c_; }
    __host__ __device__ bool next(int i, Unit& u) const {
        const long L = (long)i * G + c; if (L >= nwg) return false;
        int wgid = (int)L; { const int q = nwg / NXCD, r = nwg % NXCD, xcd = wgid % NXCD, off = wgid / NXCD; wgid = (xcd < r ? xcd * (q + 1) : r * (q + 1) + (xcd - r) * q) + off; }
        const int nig = WGM * nN, gid = wgid / nig, fm = gid * WGM, gsz = (nM - fm) < WGM ? (nM - fm) : WGM;
        u.pm = fm + ((wgid % nig) % gsz); u.pn = (wgid % nig) / gsz; return true;
    }
    __device__ __forceinline__ void a_ready(const Unit&) const {}
    __device__ __forceinline__ void done(const Unit&) const {}
};

template <class Epi, class Sched, bool ALIGN_EPI = false, bool SP2 = false>
__device__ __forceinline__ void gemm_phase(PG8_LAS unsigned char* lds, const Gemm g, const Sched& S, const Epi& E) {
    const int tid = tid_opaque(), wid = __builtin_amdgcn_readfirstlane(tid >> 6), lane = tid & 63, wr = wid >> 2, wc = wid & 3, fr = lane & 15, fq = lane >> 4;
    const int K = g.K, nt = K / BK;
    unsigned voffA[2], voffB[2];
#pragma unroll
    for (int i = 0; i < 2; ++i) { int R, C; stage_rc(tid * 16 + i * 8192, R, C); const int Rb = Epi::PERM ? ((R & ~31) + perm32(R & 31)) : R;
        voffA[i] = (unsigned)(R * K + C) * 2u; voffB[i] = (unsigned)(Rb * K + C) * 2u; }
    const size_t kstep = (size_t)(BK * 2);
    const size_t hstep = (size_t)HALF * K * 2;
    const size_t tstep = 2 * hstep;
    const unsigned ldsw = (unsigned)wid * 1024u;
    const int aoff = lds_byte(wr * 64 + fr, fq * 8), boff = lds_byte(wc * 32 + fr, fq * 8);
#define PG8_SA(b, h) (((b) * 2 + (h)) * HTB)
#define PG8_SB(b, h) ((4 + (b) * 2 + (h)) * HTB)
#define PG8_STAGE(bufoff, gbase, voff) do { _Pragma("unroll") for (int _i = 0; _i < 2; ++_i) \
        __builtin_amdgcn_global_load_lds((const unsigned*)((const char*)(gbase) + (voff)[_i]), (PG8_LAS unsigned*)(lds + (bufoff) + ldsw + _i * 8192), 16, 0, 0); } while (0)
#define PG8_LDA(dst, b, h) do { _Pragma("unroll") for (int m = 0; m < 4; ++m) _Pragma("unroll") for (int k = 0; k < 2; ++k) dst[m][k] = *(const PG8_LAS bf16x8*)(lds + PG8_SA(b, h) + aoff + m * 2048 + k * 1024); } while (0)
#define PG8_LDB(dst, b, h) do { _Pragma("unroll") for (int n = 0; n < 2; ++n) _Pragma("unroll") for (int k = 0; k < 2; ++k) dst[n][k] = *(const PG8_LAS bf16x8*)(lds + PG8_SB(b, h) + boff + n * 2048 + k * 1024); } while (0)
#define PG8_MMA(ai, bj, At, Bt) do { __builtin_amdgcn_s_setprio(1); _Pragma("unroll") for (int m = 0; m < 4; ++m) _Pragma("unroll") for (int n = 0; n < 2; ++n) _Pragma("unroll") for (int k = 0; k < 2; ++k) \
        acc[ai][bj][m][n] = __builtin_amdgcn_mfma_f32_16x16x32_bf16(Bt[n][k], At[m][k], acc[ai][bj][m][n], 0, 0, 0); __builtin_amdgcn_s_setprio(0); } while (0)
#define PG8_WAIT_V(n) asm volatile("s_waitcnt vmcnt(" #n ")" ::: "memory")
#define PG8_WAIT_L(n) asm volatile("s_waitcnt lgkmcnt(" #n ")" ::: "memory")
#define PG8_BAR __builtin_amdgcn_s_barrier()
#define PG8_SCHED __builtin_amdgcn_sched_barrier(0)
    Unit cur, nxt; int ui = 0;
    if (!S.next(0, cur)) return;
    f32x4 acc[2][2][4][2];
#pragma unroll
    for (int a = 0; a < 2; ++a)
#pragma unroll
        for (int b = 0; b < 2; ++b)
#pragma unroll
            for (int m = 0; m < 4; ++m)
#pragma unroll
                for (int n = 0; n < 2; ++n) acc[a][b][m][n] = (f32x4){0.f, 0.f, 0.f, 0.f};
    bf16x8 At[4][2], B0[2][2], B1[2][2];
    const char* cA = (const char*)g.A + (size_t)cur.pm * tstep; const char* cB = (const char*)g.Bt + (size_t)cur.pn * tstep;
    S.a_ready(cur);
    if constexpr (SP2) {
        PG8_STAGE(PG8_SB(0, 0), cB, voffB); PG8_STAGE(PG8_SB(0, 1), cB + hstep, voffB); PG8_STAGE(PG8_SA(0, 0), cA, voffA); PG8_STAGE(PG8_SA(0, 1), cA + hstep, voffA);
        if (wr == 1) PG8_BAR;
        PG8_WAIT_V(2); PG8_BAR;
        PG8_STAGE(PG8_SB(1, 0), cB + kstep, voffB); PG8_STAGE(PG8_SA(1, 0), cA + kstep, voffA); PG8_STAGE(PG8_SB(1, 1), cB + hstep + kstep, voffB);
        PG8_WAIT_V(6); PG8_BAR;
    } else {
        PG8_STAGE(PG8_SB(0, 0), cB, voffB); PG8_STAGE(PG8_SA(0, 0), cA, voffA); PG8_STAGE(PG8_SB(0, 1), cB + hstep, voffB); PG8_STAGE(PG8_SA(0, 1), cA + hstep, voffA);
        if (wr == 1) PG8_BAR;
        PG8_WAIT_V(4); PG8_BAR;
        PG8_STAGE(PG8_SB(1, 0), cB + kstep, voffB); PG8_STAGE(PG8_SA(1, 0), cA + kstep, voffA); PG8_STAGE(PG8_SB(1, 1), cB + hstep + kstep, voffB);
        PG8_WAIT_V(6); PG8_BAR;
    }
    for (;;) {
        const bool has_next = S.next(ui + 1, nxt);
        const char* nA = has_next ? (const char*)g.A + (size_t)nxt.pm * tstep : cA; const char* nB = has_next ? (const char*)g.Bt + (size_t)nxt.pn * tstep : cB;
        for (int t = 0; t < nt; t += 2) {
            const bool last = (t == nt - 2);
            const char* a1 = cA + (size_t)(t + 1) * kstep;
            const char* a2 = last ? nA : cA + (size_t)(t + 2) * kstep; const char* b2 = last ? nB : cB + (size_t)(t + 2) * kstep;
            const char* a3 = a2 + kstep; const char* b3 = b2 + kstep;
            if (last && has_next) S.a_ready(nxt);
            if constexpr (SP2) {
            PG8_LDB(B0, 0, 0); PG8_LDB(B1, 0, 1); PG8_SCHED; PG8_LDA(At, 0, 0); PG8_STAGE(PG8_SA(1, 1), a1 + hstep, voffA);
            PG8_WAIT_V(8); PG8_WAIT_L(0); PG8_BAR; PG8_MMA(0, 0, At, B0); PG8_MMA(0, 1, At, B1); PG8_BAR; PG8_SCHED;
            PG8_LDA(At, 0, 1); PG8_STAGE(PG8_SB(0, 0), b2, voffB); PG8_STAGE(PG8_SB(0, 1), b2 + hstep, voffB); PG8_STAGE(PG8_SA(0, 0), a2, voffA);
            PG8_WAIT_V(8); PG8_WAIT_L(0); PG8_BAR; PG8_MMA(1, 0, At, B0); PG8_MMA(1, 1, At, B1); PG8_BAR; PG8_SCHED;
            PG8_LDB(B0, 1, 0); PG8_LDB(B1, 1, 1); PG8_SCHED; PG8_LDA(At, 1, 0); PG8_STAGE(PG8_SA(0, 1), a2 + hstep, voffA);
            PG8_WAIT_V(8); PG8_WAIT_L(0); PG8_BAR; PG8_MMA(0, 0, At, B0); PG8_MMA(0, 1, At, B1); PG8_BAR; PG8_SCHED;
            PG8_LDA(At, 1, 1); PG8_STAGE(PG8_SB(1, 0), b3, voffB); PG8_STAGE(PG8_SB(1, 1), b3 + hstep, voffB); PG8_STAGE(PG8_SA(1, 0), a3, voffA);
            PG8_WAIT_V(8); PG8_WAIT_L(0); PG8_BAR; PG8_MMA(1, 0, At, B0); PG8_MMA(1, 1, At, B1); PG8_BAR; PG8_SCHED;
            } else {
            PG8_LDB(B0, 0, 0); PG8_SCHED; PG8_LDA(At, 0, 0); PG8_STAGE(PG8_SA(1, 1), a1 + hstep, voffA);
            PG8_WAIT_L(8); PG8_BAR; PG8_WAIT_L(0); PG8_MMA(0, 0, At, B0); PG8_BAR; PG8_SCHED;
            PG8_LDB(B1, 0, 1); PG8_STAGE(PG8_SB(0, 0), b2, voffB);
            PG8_BAR; PG8_WAIT_L(0); PG8_MMA(0, 1, At, B1); PG8_BAR;
            PG8_LDA(At, 0, 1); PG8_STAGE(PG8_SA(0, 0), a2, voffA);
            PG8_BAR; PG8_WAIT_L(0); PG8_MMA(1, 0, At, B0); PG8_BAR; PG8_SCHED;
            PG8_STAGE(PG8_SB(0, 1), b2 + hstep, voffB);
            PG8_WAIT_V(6); PG8_BAR; PG8_MMA(1, 1, At, B1); PG8_BAR;
            PG8_LDB(B0, 1, 0); PG8_SCHED; PG8_LDA(At, 1, 0); PG8_STAGE(PG8_SA(0, 1), a2 + hstep, voffA);
            PG8_WAIT_L(8); PG8_BAR; PG8_WAIT_L(0); PG8_MMA(0, 0, At, B0); PG8_BAR; PG8_SCHED;
            PG8_LDB(B1, 1, 1); PG8_STAGE(PG8_SB(1, 0), b3, voffB);
            PG8_BAR; PG8_WAIT_L(0); PG8_MMA(0, 1, At, B1); PG8_BAR;
            PG8_LDA(At, 1, 1); PG8_STAGE(PG8_SA(1, 0), a3, voffA);
            PG8_BAR; PG8_WAIT_L(0); PG8_MMA(1, 0, At, B0); PG8_BAR; PG8_SCHED;
            PG8_STAGE(PG8_SB(1, 1), b3 + hstep, voffB);
            PG8_WAIT_V(6); PG8_BAR; PG8_MMA(1, 1, At, B1); PG8_BAR;
            }
        }
        if constexpr (ALIGN_EPI) { if (wr == 0) PG8_BAR; }
        E(acc, cur, wr, wc, fr, fq); S.done(cur);
        if (!has_next) break;
#pragma unroll
        for (int a = 0; a < 2; ++a)
#pragma unroll
            for (int b = 0; b < 2; ++b)
#pragma unroll
                for (int m = 0; m < 4; ++m)
#pragma unroll
                    for (int n = 0; n < 2; ++n) acc[a][b][m][n] = (f32x4){0.f, 0.f, 0.f, 0.f};
        cur = nxt; cA = nA; cB = nB; ++ui;
        if constexpr (ALIGN_EPI) { if (wr == 1) PG8_BAR; }
    }
    PG8_WAIT_V(0);
    if constexpr (!ALIGN_EPI) { if (wr == 0) PG8_BAR; }
    PG8_BAR;
#undef PG8_SA
#undef PG8_SB
#undef PG8_STAGE
#undef PG8_LDA
#undef PG8_LDB
#undef PG8_MMA
#undef PG8_WAIT_V
#undef PG8_WAIT_L
#undef PG8_BAR
#undef PG8_SCHED
}

__device__ __forceinline__ u32x4 pack8(const f32x4 v0, const f32x4 v1) { u32x4 w; w.x = cvt_pk_bf16(v0[0], v0[1]); w.y = cvt_pk_bf16(v0[2], v0[3]); w.z = cvt_pk_bf16(v1[0], v1[1]); w.w = cvt_pk_bf16(v1[2], v1[3]); return w; }

struct EpiProj {
    static constexpr bool PERM = true;
    bf16_t *pa, *pb, *pc;
    __device__ __forceinline__ void operator()(const f32x4 (&acc)[2][2][4][2], const Unit& u, int wr, int wc, int fr, int fq) const {
        bf16_t* base; int ldc, colt;
        if (u.pn < 4) { base = pa; ldc = 1024; colt = u.pn * 256; } else if (u.pn < 8) { base = pb; ldc = 1024; colt = (u.pn - 4) * 256; } else { base = pc; ldc = 768; colt = (u.pn - 8) * 256; }
        const int row0 = u.pm * BM + wr * 64 + fr, col0 = colt + wc * 32 + 8 * fq;
#pragma unroll
        for (int ai = 0; ai < 2; ++ai)
#pragma unroll
            for (int m = 0; m < 4; ++m) { bf16_t* rowp = base + (size_t)(row0 + ai * HALF + m * 16) * ldc + col0;
#pragma unroll
                for (int bj = 0; bj < 2; ++bj) *(u32x4*)(rowp + bj * HALF) = pack8(acc[ai][bj][m][0], acc[ai][bj][m][1]); }
    }
};
struct EpiPlain {
    static constexpr bool PERM = true;
    bf16_t* O; int ldc;
    __device__ __forceinline__ void operator()(const f32x4 (&acc)[2][2][4][2], const Unit& u, int wr, int wc, int fr, int fq) const {
        const int row0 = u.pm * BM + wr * 64 + fr, col0 = u.pn * BM + wc * 32 + 8 * fq;
#pragma unroll
        for (int ai = 0; ai < 2; ++ai)
#pragma unroll
            for (int m = 0; m < 4; ++m) { bf16_t* rowp = O + (size_t)(row0 + ai * HALF + m * 16) * ldc + col0;
#pragma unroll
                for (int bj = 0; bj < 2; ++bj) *(u32x4*)(rowp + bj * HALF) = pack8(acc[ai][bj][m][0], acc[ai][bj][m][1]); }
    }
};
struct EpiRes {
    static constexpr bool PERM = false;
    const float* base; float* out;
    __device__ __forceinline__ void operator()(const f32x4 (&acc)[2][2][4][2], const Unit& u, int wr, int wc, int fr, int fq) const {
        const int row0 = u.pm * BM + wr * 64 + fr, col0 = u.pn * BM + wc * 32 + 4 * fq;
#pragma unroll
        for (int ai = 0; ai < 2; ++ai)
#pragma unroll
            for (int m = 0; m < 4; ++m) { const size_t off = (size_t)(row0 + ai * HALF + m * 16) * 1024 + col0;
#pragma unroll
                for (int bj = 0; bj < 2; ++bj)
#pragma unroll
                    for (int n = 0; n < 2; ++n) { const f32x4 bs = *(const f32x4*)(base + off + bj * HALF + n * 16); *(f32x4*)(out + off + bj * HALF + n * 16) = bs + acc[ai][bj][m][n]; } }
    }
};
struct EpiSwiGLU {
    static constexpr bool PERM = true;
    bf16_t* act;
    __device__ __forceinline__ void operator()(const f32x4 (&acc)[2][2][4][2], const Unit& u, int wr, int wc, int fr, int fq) const {
        const int row0 = u.pm * BM + wr * 64 + fr, col0 = u.pn * 128 + wc * 32 + 8 * fq;
#pragma unroll
        for (int ai = 0; ai < 2; ++ai)
#pragma unroll
            for (int m = 0; m < 4; ++m) { f32x4 o[2];
#pragma unroll
                for (int n = 0; n < 2; ++n)
#pragma unroll
                    for (int i = 0; i < 4; ++i) { const float gt = acc[ai][0][m][n][i], up = acc[ai][1][m][n][i]; o[n][i] = gt * up * __builtin_amdgcn_rcpf(1.f + __expf(-gt)); }
                *(u32x4*)(act + (size_t)(row0 + ai * HALF + m * 16) * D_FF + col0) = pack8(o[0], o[1]); }
    }
};
}

struct Params { const void* in[27]; float* out; unsigned char* ws; };
enum { I_X = 0, I_POS, I_ATTN_NORM, I_W_IN, I_W_OUT, I_MU, I_W0, I_W2, I_A0, I_A2, I_G2, I_KK, I_KA, I_RK, I_GNW, I_GNB, I_V0, I_V1, I_V2,
       I_QNORM, I_KVNORM, I_WQUP, I_WKVUP, I_FFN_NORM, I_WGU, I_WDN, I_FINAL };

__device__ __forceinline__ void transpose_item(const float* W, int K, int N, bf16_t* WT, int mode, LAS float* scr, int item, int lane) {
    const int nblk = N / 32, kb = item / nblk, nb = item % nblk, k0 = 64 * kb, n0 = 32 * nb;
    int d0 = n0;
    if (mode == 1) d0 = (n0 < 896) ? n0 : n0 + 128;
    else if (mode == 2) { const int j = (n0 < D_FF) ? n0 : n0 - D_FF; d0 = 256 * (j >> 7) + (j & 127) + ((n0 < D_FF) ? 0 : 128); }
#pragma unroll 8
    for (int i = 0; i < 32; ++i) { const int kk = 2 * i + (lane >> 5); scr[kk * 33 + (lane & 31)] = W[(size_t)(k0 + kk) * N + n0 + (lane & 31)]; }
    asm volatile("s_waitcnt lgkmcnt(0)" ::: "memory");
    const int c = lane & 7;
#pragma unroll
    for (int j = 0; j < 4; ++j) { const int n = (lane >> 3) + 8 * j; const LAS float* s = scr + (8 * c) * 33 + n;
        u32x4 o; o.x = cvt_pk_bf16(s[0 * 33], s[1 * 33]); o.y = cvt_pk_bf16(s[2 * 33], s[3 * 33]); o.z = cvt_pk_bf16(s[4 * 33], s[5 * 33]); o.w = cvt_pk_bf16(s[6 * 33], s[7 * 33]);
        *(u32x4*)(WT + (size_t)(d0 + n) * K + k0 + 8 * c) = o; }
    asm volatile("s_waitcnt lgkmcnt(0)" ::: "memory");
}

__device__ __forceinline__ void rms_rows2_bf16(const float* __restrict__ x0row, const float* __restrict__ x1row, const float* __restrict__ g, bf16_t* __restrict__ o0row, bf16_t* __restrict__ o1row, int lane) {
    const f32x4* xa = (const f32x4*)x0row + lane; const f32x4* xb = (const f32x4*)x1row + lane; const f32x4* gr = (const f32x4*)g + lane;
    f32x4 va[4], vb[4]; float sa = 0.f, sb = 0.f;
#pragma unroll
    for (int j = 0; j < 4; ++j) { va[j] = xa[64 * j]; vb[j] = xb[64 * j]; }
#pragma unroll
    for (int j = 0; j < 4; ++j) { sa += (va[j].x * va[j].x + va[j].y * va[j].y) + (va[j].z * va[j].z + va[j].w * va[j].w); sb += (vb[j].x * vb[j].x + vb[j].y * vb[j].y) + (vb[j].z * vb[j].z + vb[j].w * vb[j].w); }
    const float ra = rsqrtf(wave_sum(sa) * (1.f / 1024.f) + NORM_EPS), rb = rsqrtf(wave_sum(sb) * (1.f / 1024.f) + NORM_EPS);
    u32x2* oa = (u32x2*)o0row + lane; u32x2* ob = (u32x2*)o1row + lane;
#pragma unroll
    for (int j = 0; j < 4; ++j) { const f32x4 gg = gr[64 * j]; u32x2 w;
        w.x = cvt_pk_bf16(va[j].x * ra * gg.x, va[j].y * ra * gg.y); w.y = cvt_pk_bf16(va[j].z * ra * gg.z, va[j].w * ra * gg.w); oa[64 * j] = w;
        w.x = cvt_pk_bf16(vb[j].x * rb * gg.x, vb[j].y * rb * gg.y); w.y = cvt_pk_bf16(vb[j].z * rb * gg.z, vb[j].w * rb * gg.w); ob[64 * j] = w; }
}
__device__ __forceinline__ void rms_row_bf16(const float* xrow, const float* g, bf16_t* orow, int lane) {
    const f32x4* xr = (const f32x4*)xrow + lane; const f32x4* gr = (const f32x4*)g + lane;
    f32x4 v[4]; float s = 0.f;
#pragma unroll
    for (int j = 0; j < 4; ++j) { v[j] = xr[64 * j]; s += (v[j].x * v[j].x + v[j].y * v[j].y) + (v[j].z * v[j].z + v[j].w * v[j].w); }
    const float rstd = rsqrtf(wave_sum(s) * (1.f / 1024.f) + NORM_EPS);
    u32x2* o8 = (u32x2*)orow + lane;
#pragma unroll
    for (int j = 0; j < 4; ++j) { const f32x4 gg = gr[64 * j]; u32x2 w; w.x = cvt_pk_bf16(v[j].x * rstd * gg.x, v[j].y * rstd * gg.y); w.y = cvt_pk_bf16(v[j].z * rstd * gg.z, v[j].w * rstd * gg.w); o8[64 * j] = w; }
}

constexpr int KROW = 104, VROW = 72;
constexpr int ATT_KB = 64 * KROW * 2, ATT_VB = 64 * VROW * 2;
constexpr int ATT_SCR = 2 * (ATT_KB + ATT_VB);

__device__ __forceinline__ void att_unit(LAS unsigned char* lds, int b, int h, int qb, const bf16_t* __restrict__ q, const bf16_t* __restrict__ kvb, const bf16_t* __restrict__ kr,
                                         const float* __restrict__ cosM, const float* __restrict__ sinM, bf16_t* __restrict__ mix) {
    const int tid = tid_opaque(), lane = tid & 63, w = tid >> 6, r32 = lane & 31, hi = lane >> 5;
    LAS float* scr = (LAS float*)(lds + ATT_SCR) + w * 32;
    const int qrow = qb * 256 + w * 32 + r32; const size_t tok = (size_t)b * SEQ + qrow;
    bf16x8 qf[6];
    {
        const bf16_t* qp = q + tok * 768 + h * 96 + hi * 8;
#pragma unroll
        for (int d0 = 0; d0 < 4; ++d0) qf[d0] = *(const bf16x8*)(qp + d0 * 16);
        const u32x4 x1 = *(const u32x4*)(qp + 64), x2 = *(const u32x4*)(qp + 80);
        const f32x4 c0 = *(const f32x4*)(cosM + tok * 16 + hi * 8), c1 = *(const f32x4*)(cosM + tok * 16 + hi * 8 + 4);
        const f32x4 s0 = *(const f32x4*)(sinM + tok * 16 + hi * 8), s1 = *(const f32x4*)(sinM + tok * 16 + hi * 8 + 4);
        float a[8], bb[8], cs[8] = {c0.x, c0.y, c0.z, c0.w, c1.x, c1.y, c1.z, c1.w}, sn[8] = {s0.x, s0.y, s0.z, s0.w, s1.x, s1.y, s1.z, s1.w};
#pragma unroll
        for (int j = 0; j < 4; ++j) { a[2 * j] = bflo(x1[j]); a[2 * j + 1] = bfhi(x1[j]); bb[2 * j] = bflo(x2[j]); bb[2 * j + 1] = bfhi(x2[j]); }
        u32x4 o1, o2;
#pragma unroll
        for (int j = 0; j < 4; ++j) {
            o1[j] = cvt_pk_bf16(a[2 * j] * cs[2 * j] - bb[2 * j] * sn[2 * j], a[2 * j + 1] * cs[2 * j + 1] - bb[2 * j + 1] * sn[2 * j + 1]);
            o2[j] = cvt_pk_bf16(bb[2 * j] * cs[2 * j] + a[2 * j] * sn[2 * j], bb[2 * j + 1] * cs[2 * j + 1] + a[2 * j + 1] * sn[2 * j + 1]); }
        qf[4] = __builtin_bit_cast(bf16x8, o1); qf[5] = __builtin_bit_cast(bf16x8, o2);
    }
    const int k_key = tid >> 3, k_ch = tid & 7;
    const int r_key = (tid & 255) >> 2, r_ch = tid & 3;
    const bf16_t* kn_src = kvb + ((size_t)b * SEQ + k_key) * 1024 + h * 128 + k_ch * 8;
    const bf16_t* kr_src = kr + ((size_t)b * SEQ + r_key) * 32 + r_ch * 8;
    const int kn_dst = (k_key * KROW + k_ch * 8) * 2, kr_dst = (r_key * KROW + 64 + r_ch * 8) * 2, vt_dst = (k_ch * 8 * VROW + k_key) * 2;
#define ATT_VWRITE(bufoff, gv) do { LAS bf16_t* vd_ = (LAS bf16_t*)(lds + 2 * ATT_KB + (bufoff) + vt_dst); _Pragma("unroll") for (int j_ = 0; j_ < 4; ++j_) { \
        vd_[(2 * j_) * VROW] = (bf16_t)((gv)[j_] & 0xffffu); vd_[(2 * j_ + 1) * VROW] = (bf16_t)((gv)[j_] >> 16); } } while (0)
    const int ntiles = 4 * qb + 4;
    u32x4 gk, gr, gv;
    gk = *(const u32x4*)kn_src; gv = *(const u32x4*)(kn_src + 64); if (tid < 256) gr = *(const u32x4*)kr_src;
    *(LAS u32x4*)(lds + kn_dst) = gk; ATT_VWRITE(0, gv); if (tid < 256) *(LAS u32x4*)(lds + kr_dst) = gr;
    __syncthreads();
    f32x16 o0, o1;
#pragma unroll
    for (int r = 0; r < 16; ++r) { o0[r] = 0.f; o1[r] = 0.f; }
    float mrow = -1e30f, lrow = 0.f;
    const float SC = 0.10206207261596577f * 1.4426950408889634f;
    const int wq0 = qb * 256 + w * 32;
    for (int kt = 0; kt < ntiles; ++kt) {
        const int cur = kt & 1;
        if (kt + 1 < ntiles) { const size_t ko = (size_t)(kt + 1) * 64; gk = *(const u32x4*)(kn_src + ko * 1024); gv = *(const u32x4*)(kn_src + ko * 1024 + 64); if (tid < 256) gr = *(const u32x4*)(kr_src + ko * 32); }
        const int k0 = kt * 64;
        if (k0 <= wq0 + 31) {
            const LAS unsigned char* Kb = lds + cur * ATT_KB; const LAS unsigned char* Vb = lds + 2 * ATT_KB + cur * ATT_VB;
            f32x16 p0, p1;
#pragma unroll
            for (int r = 0; r < 16; ++r) { p0[r] = 0.f; p1[r] = 0.f; }
#pragma unroll
            for (int d0 = 0; d0 < 6; ++d0) {
                const bf16x8 k0f = *(const LAS bf16x8*)(Kb + (r32 * KROW + d0 * 16 + hi * 8) * 2);
                const bf16x8 k1f = *(const LAS bf16x8*)(Kb + ((32 + r32) * KROW + d0 * 16 + hi * 8) * 2);
                p0 = MFMA32(k0f, qf[d0], p0); p1 = MFMA32(k1f, qf[d0], p1);
            }
            const bool need_mask = (k0 + 63 > wq0);
            float mx = -1e30f;
            if (need_mask) {
#pragma unroll
                for (int r = 0; r < 16; ++r) { const int key = k0 + crow(r, hi); if (key > qrow) p0[r] = -1e30f; if (key + 32 > qrow) p1[r] = -1e30f; }
            }
#pragma unroll
            for (int r = 0; r < 16; ++r) mx = fmaxf(mx, fmaxf(p0[r], p1[r]));
            mx = fmaxf(mx, __shfl_xor(mx, 32)) * SC;
            const float mnew = fmaxf(mrow, mx);
            const bool grew = __any(mnew > mrow);
            const float alpha = __builtin_amdgcn_exp2f(mrow - mnew); mrow = mnew;
            float ls = 0.f;
#pragma unroll
            for (int r = 0; r < 16; ++r) { p0[r] = __builtin_amdgcn_exp2f(__builtin_fmaf(p0[r], SC, -mnew)); p1[r] = __builtin_amdgcn_exp2f(__builtin_fmaf(p1[r], SC, -mnew)); ls += p0[r] + p1[r]; }
            lrow = lrow * alpha + ls;
            if (grew) {
                if (hi == 0) scr[r32] = alpha;
                asm volatile("s_waitcnt lgkmcnt(0)" ::: "memory");
#pragma unroll
                for (int i = 0; i < 4; ++i) { const f32x4 al = *(const LAS f32x4*)(scr + 8 * i + 4 * hi);
#pragma unroll
                    for (int j = 0; j < 4; ++j) { o0[4 * i + j] *= al[j]; o1[4 * i + j] *= al[j]; } }
                asm volatile("s_waitcnt lgkmcnt(0)" ::: "memory");
            }
#pragma unroll
            for (int s = 0; s < 4; ++s) {
                u32x4 pw;
#pragma unroll
                for (int j = 0; j < 4; ++j) pw[j] = (s < 2) ? cvt_pk_bf16(p0[8 * (s & 1) + 2 * j], p0[8 * (s & 1) + 2 * j + 1]) : cvt_pk_bf16(p1[8 * (s & 1) + 2 * j], p1[8 * (s & 1) + 2 * j + 1]);
                const bf16x8 pa = __builtin_bit_cast(bf16x8, pw);
#pragma unroll
                for (int dvh = 0; dvh < 2; ++dvh) {
                    const LAS unsigned char* vp = Vb + ((dvh * 32 + r32) * VROW + 16 * s + 4 * hi) * 2;
                    const u32x2 lo = *(const LAS u32x2*)vp, hh = *(const LAS u32x2*)(vp + 16);
                    u32x4 vv; vv.x = lo.x; vv.y = lo.y; vv.z = hh.x; vv.w = hh.y;
                    if (dvh == 0) o0 = MFMA32(pa, __builtin_bit_cast(bf16x8, vv), o0); else o1 = MFMA32(pa, __builtin_bit_cast(bf16x8, vv), o1);
                }
            }
        }
        if (kt + 1 < ntiles) { const int nx = cur ^ 1; *(LAS u32x4*)(lds + nx * ATT_KB + kn_dst) = gk; ATT_VWRITE(nx * ATT_VB, gv); if (tid < 256) *(LAS u32x4*)(lds + nx * ATT_KB + kr_dst) = gr; }
        __syncthreads();
    }
    float lt = lrow + __shfl_xor(lrow, 32);
    if (hi == 0) scr[r32] = 1.f / lt;
    asm volatile("s_waitcnt lgkmcnt(0)" ::: "memory");
#pragma unroll
    for (int i = 0; i < 4; ++i) { const f32x4 il = *(const LAS f32x4*)(scr + 8 * i + 4 * hi);
#pragma unroll
        for (int j = 0; j < 4; ++j) { const int r = 4 * i + j; const size_t orow = (size_t)b * SEQ + qb * 256 + w * 32 + crow(r, hi);
            mix[orow * 1024 + 512 + h * 64 + r32] = f2bf(o0[r] * il[j]); mix[orow * 1024 + 512 + h * 64 + 32 + r32] = f2bf(o1[r] * il[j]); } }
    asm volatile("s_waitcnt lgkmcnt(0)" ::: "memory");
}

__device__ __forceinline__ void ret_unit(LAS unsigned char* lds, int b, int h, int jb, const bf16_t* __restrict__ pb, const float* __restrict__ cosR, const float* __restrict__ sinR,
                                         const bf16_t* __restrict__ rprev, float* __restrict__ yb) {
    const int tid = tid_opaque(), lane = tid & 63, w = tid >> 6, r32 = lane & 31, hi = lane >> 5;
    const float lg2 = log2f(1.f - exp2f(-5.f - (float)h));
    const int qrow = jb * 256 + w * 32 + r32; const size_t tok = (size_t)b * SEQ + qrow;
    const int chunk = qrow >> 7;
    bf16x8 qf[4], qx[4];
    {
        const bf16_t* qp = pb + tok * 1024 + h * 64 + hi * 8;
        const float qdec = exp2f(lg2 * (float)((qrow & 127) + 1));
#pragma unroll
        for (int d0 = 0; d0 < 2; ++d0) {
            const u32x4 x1 = *(const u32x4*)(qp + d0 * 16), x2 = *(const u32x4*)(qp + d0 * 16 + 32);
            const float* cp = cosR + tok * 32 + d0 * 16 + hi * 8; const float* sp = sinR + tok * 32 + d0 * 16 + hi * 8;
            const f32x4 c0 = *(const f32x4*)cp, c1 = *(const f32x4*)(cp + 4), s0 = *(const f32x4*)sp, s1 = *(const f32x4*)(sp + 4);
            const float cs[8] = {c0.x, c0.y, c0.z, c0.w, c1.x, c1.y, c1.z, c1.w}, sn[8] = {s0.x, s0.y, s0.z, s0.w, s1.x, s1.y, s1.z, s1.w};
            u32x4 o1, o2, y1, y2;
#pragma unroll
            for (int j = 0; j < 4; ++j) {
                const float a0 = bflo(x1[j]), a1 = bfhi(x1[j]), b0 = bflo(x2[j]), b1 = bfhi(x2[j]);
                const float r0 = a0 * cs[2 * j] - b0 * sn[2 * j], r1 = a1 * cs[2 * j + 1] - b1 * sn[2 * j + 1];
                const float t0 = b0 * cs[2 * j] + a0 * sn[2 * j], t1 = b1 * cs[2 * j + 1] + a1 * sn[2 * j + 1];
                o1[j] = cvt_pk_bf16(r0, r1); o2[j] = cvt_pk_bf16(t0, t1); y1[j] = cvt_pk_bf16(r0 * qdec, r1 * qdec); y2[j] = cvt_pk_bf16(t0 * qdec, t1 * qdec); }
            qf[d0] = __builtin_bit_cast(bf16x8, o1); qf[d0 + 2] = __builtin_bit_cast(bf16x8, o2); qx[d0] = __builtin_bit_cast(bf16x8, y1); qx[d0 + 2] = __builtin_bit_cast(bf16x8, y2);
        }
    }
    f32x16 o0, o1;
#pragma unroll
    for (int r = 0; r < 16; ++r) { o0[r] = 0.f; o1[r] = 0.f; }
    {
        const bf16_t* rp = rprev + ((size_t)((b * 4 + h) * 32 + chunk)) * 4096;
#pragma unroll
        for (int d0 = 0; d0 < 4; ++d0) {
            const bf16x8 r0 = *(const bf16x8*)(rp + (size_t)r32 * 64 + d0 * 16 + hi * 8), r1 = *(const bf16x8*)(rp + (size_t)(32 + r32) * 64 + d0 * 16 + hi * 8);
            o0 = MFMA32(qx[d0], r0, o0); o1 = MFMA32(qx[d0], r1, o1);
        }
    }
    const int l_key = (tid & 255) >> 2, l_c = tid & 3;
    for (int kt = 0; kt < 4; ++kt) {
        const int k0 = jb * 256 + kt * 64;
        __syncthreads();
        if (tid < 256) {
            const size_t kt_tok = (size_t)b * SEQ + k0 + l_key; const bf16_t* kp = pb + kt_tok * 1024 + 256 + h * 64 + l_c * 8;
            const u32x4 x1 = *(const u32x4*)kp, x2 = *(const u32x4*)(kp + 32);
            const float* cp = cosR + kt_tok * 32 + l_c * 8; const float* sp = sinR + kt_tok * 32 + l_c * 8;
            const f32x4 c0 = *(const f32x4*)cp, c1 = *(const f32x4*)(cp + 4), s0 = *(const f32x4*)sp, s1 = *(const f32x4*)(sp + 4);
            const float cs[8] = {c0.x, c0.y, c0.z, c0.w, c1.x, c1.y, c1.z, c1.w}, sn[8] = {s0.x, s0.y, s0.z, s0.w, s1.x, s1.y, s1.z, s1.w};
            u32x4 o1v, o2v;
#pragma unroll
            for (int j = 0; j < 4; ++j) {
                const float a0 = bflo(x1[j]), a1 = bfhi(x1[j]), b0 = bflo(x2[j]), b1 = bfhi(x2[j]);
                o1v[j] = cvt_pk_bf16((a0 * cs[2 * j] - b0 * sn[2 * j]) * 0.125f, (a1 * cs[2 * j + 1] - b1 * sn[2 * j + 1]) * 0.125f);
                o2v[j] = cvt_pk_bf16((b0 * cs[2 * j] + a0 * sn[2 * j]) * 0.125f, (b1 * cs[2 * j + 1] + a1 * sn[2 * j + 1]) * 0.125f); }
            *(LAS u32x4*)(lds + (l_key * KROW + l_c * 8) * 2) = o1v; *(LAS u32x4*)(lds + (l_key * KROW + 32 + l_c * 8) * 2) = o2v;
        } else {
            const size_t vt_tok = (size_t)b * SEQ + k0 + l_key; const bf16_t* vp = pb + vt_tok * 1024 + 512 + h * 64 + l_c * 16;
            const u32x4 x1 = *(const u32x4*)vp, x2 = *(const u32x4*)(vp + 8);
            LAS bf16_t* vd = (LAS bf16_t*)(lds + 2 * ATT_KB) + l_key;
#pragma unroll
            for (int j = 0; j < 4; ++j) { vd[(l_c * 16 + 2 * j) * VROW] = (bf16_t)(x1[j] & 0xffffu); vd[(l_c * 16 + 2 * j + 1) * VROW] = (bf16_t)(x1[j] >> 16);
                                          vd[(l_c * 16 + 8 + 2 * j) * VROW] = (bf16_t)(x2[j] & 0xffffu); vd[(l_c * 16 + 8 + 2 * j + 1) * VROW] = (bf16_t)(x2[j] >> 16); }
        }
        __syncthreads();
        if ((k0 >> 7) == chunk && k0 <= jb * 256 + w * 32 + 31) {
            const LAS unsigned char* Kb = lds; const LAS unsigned char* Vb = lds + 2 * ATT_KB;
            f32x16 p0, p1;
#pragma unroll
            for (int r = 0; r < 16; ++r) { p0[r] = 0.f; p1[r] = 0.f; }
#pragma unroll
            for (int d0 = 0; d0 < 4; ++d0) {
                const bf16x8 k0f = *(const LAS bf16x8*)(Kb + (r32 * KROW + d0 * 16 + hi * 8) * 2);
                const bf16x8 k1f = *(const LAS bf16x8*)(Kb + ((32 + r32) * KROW + d0 * 16 + hi * 8) * 2);
                p0 = MFMA32(k0f, qf[d0], p0); p1 = MFMA32(k1f, qf[d0], p1);
            }
#pragma unroll
            for (int r = 0; r < 16; ++r) {
                const int df0 = qrow - (k0 + crow(r, hi)), df1 = df0 - 32;
                p0[r] = (df0 >= 0) ? p0[r] * __builtin_amdgcn_exp2f(lg2 * (float)df0) : 0.f;
                p1[r] = (df1 >= 0) ? p1[r] * __builtin_amdgcn_exp2f(lg2 * (float)df1) : 0.f;
            }
#pragma unroll
            for (int s = 0; s < 4; ++s) {
                u32x4 pw;
#pragma unroll
                for (int j = 0; j < 4; ++j) pw[j] = (s < 2) ? cvt_pk_bf16(p0[8 * (s & 1) + 2 * j], p0[8 * (s & 1) + 2 * j + 1]) : cvt_pk_bf16(p1[8 * (s & 1) + 2 * j], p1[8 * (s & 1) + 2 * j + 1]);
                const bf16x8 pa = __builtin_bit_cast(bf16x8, pw);
#pragma unroll
                for (int dvh = 0; dvh < 2; ++dvh) {
                    const LAS unsigned char* vp = Vb + ((dvh * 32 + r32) * VROW + 16 * s + 4 * hi) * 2;
                    const u32x2 lo = *(const LAS u32x2*)vp, hh = *(const LAS u32x2*)(vp + 16);
                    u32x4 vv; vv.x = lo.x; vv.y = lo.y; vv.z = hh.x; vv.w = hh.y;
                    if (dvh == 0) o0 = MFMA32(pa, __builtin_bit_cast(bf16x8, vv), o0); else o1 = MFMA32(pa, __builtin_bit_cast(bf16x8, vv), o1);
                }
            }
        }
    }
#pragma unroll
    for (int r = 0; r < 16; ++r) { const size_t orow = (size_t)b * SEQ + jb * 256 + w * 32 + crow(r, hi);
        yb[orow * 256 + h * 64 + r32] = o0[r]; yb[orow * 256 + h * 64 + 32 + r32] = o1[r]; }
}

__device__ __forceinline__ void ret_kv_unit(LAS unsigned char* lds, int bh, int ci, const bf16_t* __restrict__ pb, const float* __restrict__ cosR, const float* __restrict__ sinR, float* __restrict__ kvt) {
    const int tid = tid_opaque(); const int b = bh >> 2, h = bh & 3;
    LAS float* Ks = (LAS float*)lds;
    LAS float* Vs = Ks + 128 * 64;
    const float lg2 = log2f(1.f - exp2f(-5.f - (float)h));
    __syncthreads();
    {
        const int i = tid & 31; float x1[8], x2[8], cc[8], ss[8];
#pragma unroll
        for (int it = 0; it < 8; ++it) { const int t = (tid >> 5) + 16 * it; const size_t tok = (size_t)b * SEQ + ci * 128 + t;
            x1[it] = bf2f(pb[tok * 1024 + 256 + h * 64 + i]); x2[it] = bf2f(pb[tok * 1024 + 256 + h * 64 + 32 + i]); cc[it] = cosR[tok * 32 + i]; ss[it] = sinR[tok * 32 + i]; }
#pragma unroll
        for (int it = 0; it < 8; ++it) { const int t = (tid >> 5) + 16 * it; const float sc = 0.125f * exp2f(lg2 * (float)(127 - t));
            Ks[t * 64 + i] = (x1[it] * cc[it] - x2[it] * ss[it]) * sc; Ks[t * 64 + 32 + i] = (x2[it] * cc[it] + x1[it] * ss[it]) * sc; }
        u32x4 vr[2];
#pragma unroll
        for (int it = 0; it < 2; ++it) { const int ch = tid + 512 * it, t = ch >> 3, c8 = ch & 7; vr[it] = *(const u32x4*)(pb + ((size_t)b * SEQ + ci * 128 + t) * 1024 + 512 + h * 64 + c8 * 8); }
#pragma unroll
        for (int it = 0; it < 2; ++it) { const int ch = tid + 512 * it, t = ch >> 3, c8 = ch & 7; LAS float* d = Vs + t * 64 + c8 * 8;
            *(LAS f32x4*)d = (f32x4){bflo(vr[it].x), bfhi(vr[it].x), bflo(vr[it].y), bfhi(vr[it].y)}; *(LAS f32x4*)(d + 4) = (f32x4){bflo(vr[it].z), bfhi(vr[it].z), bflo(vr[it].w), bfhi(vr[it].w)}; }
    }
    __syncthreads();
    const int e = tid >> 3, d0 = (tid & 7) * 8;
    float acc[8];
#pragma unroll
    for (int j = 0; j < 8; ++j) acc[j] = 0.f;
    for (int t = 0; t < 128; ++t) {
        const float v = Vs[t * 64 + e]; const f32x4 ka = *(const LAS f32x4*)(Ks + t * 64 + d0), kb = *(const LAS f32x4*)(Ks + t * 64 + d0 + 4);
        acc[0] += v * ka.x; acc[1] += v * ka.y; acc[2] += v * ka.z; acc[3] += v * ka.w; acc[4] += v * kb.x; acc[5] += v * kb.y; acc[6] += v * kb.z; acc[7] += v * kb.w;
    }
    float* o = kvt + ((size_t)(bh * 32 + ci)) * 4096 + e * 64 + d0;
    *(f32x4*)o = (f32x4){acc[0], acc[1], acc[2], acc[3]}; *(f32x4*)(o + 4) = (f32x4){acc[4], acc[5], acc[6], acc[7]};
}

struct PrepW { bf16x8 Bw[2], Ba[2], Bv[2], Bg[2][2], Bv1[2]; };
__device__ __forceinline__ bf16x8 pack_col8(const float* W, int ld, int k0, int n) {
    float t[8];
#pragma unroll
    for (int j = 0; j < 8; ++j) t[j] = W[(size_t)(k0 + j) * ld + n];
    u32x4 o; o.x = cvt_pk_bf16(t[0], t[1]); o.y = cvt_pk_bf16(t[2], t[3]); o.z = cvt_pk_bf16(t[4], t[5]); o.w = cvt_pk_bf16(t[6], t[7]);
    return __builtin_bit_cast(bf16x8, o);
}
__device__ __forceinline__ bf16x8 pack_f8(const f32x4 a, const f32x4 b) {
    u32x4 o; o.x = cvt_pk_bf16(a.x, a.y); o.y = cvt_pk_bf16(a.z, a.w); o.z = cvt_pk_bf16(b.x, b.y); o.w = cvt_pk_bf16(b.z, b.w);
    return __builtin_bit_cast(bf16x8, o);
}
#define MFMA16(a, b, c) __builtin_amdgcn_mfma_f32_16x16x32_bf16((a), (b), (c), 0, 0, 0)
__device__ __forceinline__ void prep_fetch_rows(unsigned (&raw)[17], const bf16_t* __restrict__ pa, int t0, int c2) {
    raw[0] = ((t0 & (SEQ - 1)) == 0) ? 0u : *(const unsigned*)(pa + (size_t)(t0 - 1) * 1024 + c2);
#pragma unroll
    for (int t = 0; t < 16; ++t) raw[t + 1] = *(const unsigned*)(pa + (size_t)(t0 + t) * 1024 + c2);
}
constexpr int PSW = 900;
__device__ __forceinline__ void rwkv_prep_tile(LAS unsigned char* lds, int tile, int next_tile, unsigned (&raw)[17], int layer, const Params& P, int z, const PrepW& W, const bf16_t* __restrict__ pa, unsigned char* __restrict__ rec,
                                               bf16_t* __restrict__ vbuf, bf16_t* __restrict__ gbuf, bf16_t* __restrict__ vfirst, float* __restrict__ bs, float* __restrict__ cs) {
    const int tid = tid_opaque(), lane = tid & 63;
    LAS float* PS = (LAS float*)lds;
    LAS float* VV = PS + 16 * PSW;
    const float* mu = (const float*)P.in[I_MU + z] + layer * RW_IN;
    const float* w0 = (const float*)P.in[I_W0 + z] + layer * 256; const float* w2 = (const float*)P.in[I_W2 + z] + layer * 32 * 256;
    const float* a0 = (const float*)P.in[I_A0 + z] + layer * 256; const float* a2 = (const float*)P.in[I_A2 + z] + layer * 32 * 256;
    const float* g2 = (const float*)P.in[I_G2 + z] + layer * 64 * 256;
    const float* k_k = (const float*)P.in[I_KK + z] + layer * 256; const float* k_a = (const float*)P.in[I_KA + z] + layer * 256; const float* r_k = (const float*)P.in[I_RK + z] + layer * 256;
    const float* v0 = (const float*)P.in[I_V0 + z] + (layer > 0 ? (layer - 1) * 256 : 0);
    const float* v1 = (const float*)P.in[I_V1 + z] + (layer > 0 ? (layer - 1) * 256 * 32 : 0);
    const float* v2 = (const float*)P.in[I_V2 + z] + (layer > 0 ? (layer - 1) * 32 * 256 : 0);
    const int t0 = tile * 16;
    __syncthreads();
    if (tid < 448) {
        const int c2 = tid * 2; const float mu0 = mu[c2], mu1 = mu[c2 + 1];
#pragma unroll
        for (int t = 0; t < 16; ++t) {
            float x0 = bflo(raw[t + 1]), x1 = bfhi(raw[t + 1]); const float y0 = bflo(raw[t]), y1 = bfhi(raw[t]);
            x0 = x0 + (y0 - x0) * mu0; x1 = x1 + (y1 - x1) * mu1;
            if (c2 >= 768) { if (c2 < 800) { x0 = 2.f * sigmoidf_(2.f * x0) - 1.f; x1 = 2.f * sigmoidf_(2.f * x1) - 1.f; } else if (c2 >= 832) { x0 = sigmoidf_(x0); x1 = sigmoidf_(x1); } }
            *(LAS f32x2*)(PS + t * PSW + c2) = (f32x2){x0, x1};
        }
        if (next_tile >= 0) prep_fetch_rows(raw, pa, next_tile * 16, c2);
    }
    if (layer > 0) VV[tid] = 0.f;
    __syncthreads();
    const int wv = tid >> 6, l16 = lane & 15, lq = lane >> 4;
    LAS float* LR = VV + 512;
    const f32x4 zero4 = {0.f, 0.f, 0.f, 0.f};
    if (layer > 0) {
        const LAS float* ap = PS + l16 * PSW + 512 + 32 * wv + 8 * lq;
        const bf16x8 A = pack_f8(*(const LAS f32x4*)ap, *(const LAS f32x4*)(ap + 4));
#pragma unroll
        for (int nt = 0; nt < 2; ++nt) { const f32x4 d = MFMA16(A, W.Bv1[nt], zero4);
#pragma unroll
            for (int r = 0; r < 4; ++r) (void)__builtin_amdgcn_ds_faddf(VV + (4 * lq + r) * 32 + 16 * nt + l16, d[r], 0, 0, false); }
        __syncthreads();
    }
    {
        const LAS float* ap = PS + l16 * PSW + 768 + 8 * lq;
        const bf16x8 Aw = pack_f8(*(const LAS f32x4*)ap, *(const LAS f32x4*)(ap + 4)), Aa = pack_f8(*(const LAS f32x4*)(ap + 32), *(const LAS f32x4*)(ap + 36));
        const bf16x8 Ag0 = pack_f8(*(const LAS f32x4*)(ap + 64), *(const LAS f32x4*)(ap + 68)), Ag1 = pack_f8(*(const LAS f32x4*)(ap + 96), *(const LAS f32x4*)(ap + 100));
        bf16x8 Av = Aw;
        if (layer > 0) { const LAS float* vp = VV + l16 * 32 + 8 * lq; Av = pack_f8(*(const LAS f32x4*)vp, *(const LAS f32x4*)(vp + 4)); }
#pragma unroll
        for (int nt = 0; nt < 2; ++nt) {
            const f32x4 dw = MFMA16(Aw, W.Bw[nt], zero4), da = MFMA16(Aa, W.Ba[nt], zero4);
            f32x4 dg = MFMA16(Ag0, W.Bg[nt][0], zero4); dg = MFMA16(Ag1, W.Bg[nt][1], dg);
            f32x4 dv = zero4; if (layer > 0) dv = MFMA16(Av, W.Bv[nt], zero4);
            const int ch = 16 * (2 * wv + nt) + l16;
#pragma unroll
            for (int r = 0; r < 4; ++r) { LAS float* o = LR + (4 * lq + r) * 256 + ch; o[0] = dw[r]; o[4096] = da[r]; o[8192] = dg[r]; o[12288] = dv[r]; }
        }
    }
    __syncthreads();
    const int c = tid & 255, th = tid >> 8;
    float aw[8], aa[8], ag[8], av[8];
#pragma unroll
    for (int i = 0; i < 8; ++i) { const LAS float* o = LR + (th * 8 + i) * 256 + c; aw[i] = o[0]; aa[i] = o[4096]; ag[i] = o[8192]; av[i] = o[12288]; }
    const float w0c = w0[c], a0c = a0[c], kkc = k_k[c], kac = k_a[c], rkc = r_k[c], v0c = (layer > 0) ? v0[c] : 0.f;
    const int head = c >> 6, kq = (c & 63) >> 2, e = c & 3;
    float kk_[8], b_[8], kp_[8], dec_[8];
#pragma unroll
    for (int i = 0; i < 8; ++i) {
        const int t = th * 8 + i; const size_t tok = (size_t)t0 + t;
        const float r = PS[t * PSW + c], k = PS[t * PSW + 256 + c]; float v = PS[t * PSW + 512 + c];
        const float decay = __expf(-0.6065306597126334f * sigmoidf_(w0c + aw[i]));
        const float a = sigmoidf_(a0c + aa[i]);
        if (layer > 0) { const float vf = bf2f(vfirst[tok * 256 + c]); v = v + (vf - v) * sigmoidf_(v0c + av[i]); }
        else vfirst[tok * 256 + c] = f2bf(v);
        const float kkp = k * kkc; const float ss = wave_sum(kkp * kkp); const float kk = kkp * rsqrtf(fmaxf(ss, 1e-24f));
        const float kp = k * (1.f + (a - 1.f) * kac);
        const float bsum = wave_sum(r * kp * rkc);
        kk_[i] = kk; b_[i] = kk * a; kp_[i] = kp; dec_[i] = decay;
        const size_t ri = tok * 256 + c;
        ((float*)rec)[ri] = decay; ((bf16_t*)(rec + 16 * MiB))[ri] = f2bf(r); ((bf16_t*)(rec + 24 * MiB))[ri] = f2bf(kp); ((bf16_t*)(rec + 40 * MiB))[ri] = f2bf(kk * a);
        if ((i & 1) == 0) ((bf16_t*)(rec + 32 * MiB))[ri] = f2bf(-kk);
        else {
            const float d1 = wave_sum(b_[i - 1] * kk), d2 = wave_sum(kp_[i - 1] * kk);
            ((bf16_t*)(rec + 32 * MiB))[ri] = f2bf(kk_[i - 1] * d1 - dec_[i - 1] * kk);
            if (lane == 0) cs[tok * 4 + head] = -d2;
        }
        vbuf[tok * 256 + c] = f2bf(v); gbuf[tok * 256 + c] = f2bf(ag[i]);
        if (lane == 0) bs[tok * 4 + head] = bsum;
    }
}

constexpr int SC_TC = 32;
constexpr int SC_REC_F = SC_TC * 16 * 20;
constexpr int SC_V_F = SC_TC * 20;
__device__ __forceinline__ void scan_load_chunk(LAS float* recb, LAS float* vb, const unsigned char* __restrict__ rec, const bf16_t* __restrict__ vbuf, const float* __restrict__ cs, size_t tok0, int h, int v0, int lt) {
#pragma unroll
    for (int it = 0; it < 2; ++it) {
        const int p = lt + it * 256, step = p >> 4, kq = p & 15;
        const size_t ri = (tok0 + step) * 256 + h * 64 + 4 * kq;
        const f32x4 wv = *(const f32x4*)((const float*)rec + ri);
        const u32x2 rr = *(const u32x2*)((const bf16_t*)(rec + 16 * MiB) + ri), kk2 = *(const u32x2*)((const bf16_t*)(rec + 24 * MiB) + ri);
        const u32x2 nn = *(const u32x2*)((const bf16_t*)(rec + 32 * MiB) + ri), bb = *(const u32x2*)((const bf16_t*)(rec + 40 * MiB) + ri);
        const u32x4 a = {rr.x, rr.y, kk2.x, kk2.y}, bq = {nn.x, nn.y, bb.x, bb.y};
        LAS float* d = recb + (step * 16 + kq) * 20;
        *(LAS f32x4*)d = wv;
        *(LAS f32x4*)(d + 4) = (f32x4){bflo(a.x), bfhi(a.x), bflo(a.y), bfhi(a.y)};
        *(LAS f32x4*)(d + 8) = (f32x4){bflo(a.z), bfhi(a.z), bflo(a.w), bfhi(a.w)};
        *(LAS f32x4*)(d + 12) = (f32x4){bflo(bq.x), bfhi(bq.x), bflo(bq.y), bfhi(bq.y)};
        *(LAS f32x4*)(d + 16) = (f32x4){bflo(bq.z), bfhi(bq.z), bflo(bq.w), bfhi(bq.w)};
    }
    if (lt < 128) { const int step = lt >> 2, qd = lt & 3;
        const u32x2 x = *(const u32x2*)(vbuf + (tok0 + step) * 256 + h * 64 + v0 + 4 * qd);
        *(LAS f32x4*)(vb + step * 20 + 4 * qd) = (f32x4){bflo(x.x), bfhi(x.x), bflo(x.y), bfhi(x.y)}; }
    else if (lt < 128 + SC_TC) { const int step = lt - 128; vb[step * 20 + 16] = cs[(tok0 + step) * 4 + h]; }
}
__device__ __forceinline__ void rwkv_scan_block(LAS unsigned char* lds, int blk, const unsigned char* __restrict__ rec, const bf16_t* __restrict__ vbuf, const float* __restrict__ cs, float* __restrict__ ya) {
    const int tid = tid_opaque(), lane = tid & 63, w = tid >> 6;
    const int bh = blk >> 2, b = bh >> 2, h = bh & 3, v0 = (blk & 3) * 16;
    LAS float* RECB = (LAS float*)lds;
    LAS float* VB = RECB + 2 * SC_REC_F;
    const size_t tokb = (size_t)b * SEQ;
    const int rowl = lane >> 4, kq = lane & 15, row = v0 + 4 * (w & 3) + rowl;
    f32x2 Sa = {0.f, 0.f}, Sb = {0.f, 0.f}; float ykeep = 0.f;
    __syncthreads();
    if (w >= 4) scan_load_chunk(RECB, VB, rec, vbuf, cs, tokb, h, v0, tid - 256);
    for (int c = 0; c < SEQ / SC_TC; ++c) {
        __syncthreads();
        const int buf = c & 1;
        if (w >= 4) { if (c + 1 < SEQ / SC_TC) scan_load_chunk(RECB + (buf ^ 1) * SC_REC_F, VB + (buf ^ 1) * SC_V_F, rec, vbuf, cs, tokb + (size_t)(c + 1) * SC_TC, h, v0, tid - 256); }
        else {
            const LAS float* rb = RECB + buf * SC_REC_F + kq * 20; const LAS float* vb = VB + buf * SC_V_F;
            float* yo = ya + (tokb + (size_t)c * SC_TC + kq) * 256 + h * 64 + row;
#define SC_LD(P, st) do { const LAS float* R_ = rb + (st) * 320; P##w = *(const LAS f32x4*)R_; P##r = *(const LAS f32x4*)(R_ + 4); P##k = *(const LAS f32x4*)(R_ + 8); \
                          P##n = *(const LAS f32x4*)(R_ + 12); P##b = *(const LAS f32x4*)(R_ + 16); P##v = vb[(st) * 20 + 4 * w + rowl]; } while (0)
#define LO2(q_) ((f32x2){(q_).x, (q_).y})
#define HI2(q_) ((f32x2){(q_).z, (q_).w})
            f32x4 Aw, Ar, Ak, An, Ab, Bw, Br, Bk, Bn, Bb, Cw, Cr, Ck, Cn, Cb, Dw, Dr, Dk, Dn, Db; float Av, Bv, Cv, Dv, Bc, Dc;
            SC_LD(A, 0); SC_LD(B, 1); Bc = vb[1 * 20 + 16];
#pragma unroll
            for (int st = 0; st < SC_TC; st += 4) {
                if (st + 2 < SC_TC) { SC_LD(C, st + 2); SC_LD(D, st + 3); Dc = vb[(st + 3) * 20 + 16]; }
#define SC_PAIR(E, O, Oc, S0) do { \
                f32x2 d0 = Sa * LO2(E##n); d0 = Sb * HI2(E##n) + d0; f32x2 d1 = Sa * LO2(O##n); d1 = Sb * HI2(O##n) + d1; \
                const f32x2 ve = {E##v, E##v}, vo = {O##v, O##v}; \
                f32x2 ta = ve * LO2(E##k), tb = ve * HI2(E##k); ta = Sa * LO2(E##w) + ta; tb = Sb * HI2(E##w) + tb; \
                const float sa0 = allreduce16(d0.x + d0.y); const float sa1 = allreduce16(d1.x + d1.y) + E##v * Oc; \
                const f32x2 s0 = {sa0, sa0}, s1 = {sa1, sa1}; \
                Sa = s0 * LO2(E##b) + ta; Sb = s0 * HI2(E##b) + tb; \
                f32x2 e0 = Sa * LO2(E##r); e0 = Sb * HI2(E##r) + e0; \
                f32x2 ua = vo * LO2(O##k), ub = vo * HI2(O##k); ua = Sa * LO2(O##w) + ua; ub = Sb * HI2(O##w) + ub; \
                Sa = s1 * LO2(O##b) + ua; Sb = s1 * HI2(O##b) + ub; \
                f32x2 e1 = Sa * LO2(O##r); e1 = Sb * HI2(O##r) + e1; \
                Y0 = e0.x + e0.y; Y1 = e1.x + e1.y; } while (0)
                float yp0, yp1, yp2, yp3;
#define Y0 yp0
#define Y1 yp1
                SC_PAIR(A, B, Bc, st);
#undef Y0
#undef Y1
                if (st + 4 < SC_TC) { SC_LD(A, st + 4); SC_LD(B, st + 5); Bc = vb[(st + 5) * 20 + 16]; }
#define Y0 yp2
#define Y1 yp3
                SC_PAIR(C, D, Dc, st + 2);
#undef Y0
#undef Y1
                {
                    const unsigned long long b0 = 0xAAAAAAAAAAAAAAAAull, b1 = 0xCCCCCCCCCCCCCCCCull;
                    float s01, x01, s23, x23;
                    asm volatile("v_cndmask_b32_e64 %0, %1, %2, %3" : "=v"(s01) : "v"(yp0), "v"(yp1), "s"(b0));
                    asm volatile("v_cndmask_b32_e64 %0, %1, %2, %3" : "=v"(x01) : "v"(yp1), "v"(yp0), "s"(b0));
                    asm volatile("v_cndmask_b32_e64 %0, %1, %2, %3" : "=v"(s23) : "v"(yp2), "v"(yp3), "s"(b0));
                    asm volatile("v_cndmask_b32_e64 %0, %1, %2, %3" : "=v"(x23) : "v"(yp3), "v"(yp2), "s"(b0));
                    const float a01 = s01 + dpp_mov<0xB1>(x01), a23 = s23 + dpp_mov<0xB1>(x23);
                    float sq, xq;
                    asm volatile("v_cndmask_b32_e64 %0, %1, %2, %3" : "=v"(sq) : "v"(a01), "v"(a23), "s"(b1));
                    asm volatile("v_cndmask_b32_e64 %0, %1, %2, %3" : "=v"(xq) : "v"(a23), "v"(a01), "s"(b1));
                    float yq = sq + dpp_mov<0x4E>(xq);
                    yq += dpp_mov<0x128>(yq); yq += dpp_mov<0x124>(yq);
                    const unsigned long long mk = 0x000F000F000F000Full << (st & 15);
                    asm volatile("v_cndmask_b32_e64 %0, %0, %1, %2" : "+v"(ykeep) : "v"(yq), "s"(mk));
                }
                if ((st & 15) == 12) yo[(size_t)(st - 12) * 256] = ykeep;
            }
#undef SC_PAIR
#undef SC_LD
#undef LO2
#undef HI2
        }
    }
}

#define XB_TMO      128
#define XB_XCNT(j)  (256  + 64 * (j))
#define XB_XSUB(j)  (1280 + 64 * (j))
#define XB_XGEN(j)  (2304 + 64 * (j))
#define XB_TOP      3328
#define XB_TOPGEN   3392
#define XB_SPIN_CAP (1u << 20)
__device__ __forceinline__ unsigned xb_ld(unsigned* p)              { return __hip_atomic_load(p, __ATOMIC_RELAXED, __HIP_MEMORY_SCOPE_AGENT); }
__device__ __forceinline__ unsigned xb_add(unsigned* p, unsigned v) { return __hip_atomic_fetch_add(p, v, __ATOMIC_RELAXED, __HIP_MEMORY_SCOPE_AGENT); }
__device__ __forceinline__ unsigned xb_xcc_id() { return (unsigned)__builtin_amdgcn_s_getreg((3 << 11) | 20) & 0xFu; }
#define XB_SPIN(cond, bar) do { unsigned _sp = 0; while (cond) { __builtin_amdgcn_s_sleep(1); \
    if ((++_sp & 255u) == 0u) { if (xb_ld(&(bar)[XB_TMO])) break; if (_sp > XB_SPIN_CAP) { atomicAdd(&(bar)[XB_TMO], 1u); break; } } } } while (0)
struct XcdBarrier { unsigned* bar; unsigned x; volatile LAS unsigned* st; };
__device__ __forceinline__ XcdBarrier xcd_barrier_post(unsigned* bar, volatile LAS unsigned* st) {
    XcdBarrier b; b.bar = bar; b.x = xb_xcc_id(); b.st = st;
    if (__builtin_amdgcn_workitem_id_x() == 0) (void)xb_add(&bar[XB_XCNT(b.x)], 1u);
    return b;
}
__device__ __forceinline__ void xcd_barrier_complete(unsigned* bar, unsigned x, unsigned& nloc, unsigned& nx) {
    const unsigned G = gridDim.x * gridDim.y * gridDim.z;
    unsigned sum, cnt, mine, sp = 0u;
    for (;;) {
        sum = 0u; cnt = 0u; mine = 0u;
#pragma unroll
        for (unsigned j = 0; j < 16; ++j) { const unsigned c = xb_ld(&bar[XB_XCNT(j)]); sum += c; cnt += (c > 0u) ? 1u : 0u; mine = (j == x) ? c : mine; }
        if (sum == G) break;
        __builtin_amdgcn_s_sleep(1);
        if ((++sp & 255u) == 0u) { if (xb_ld(&bar[XB_TMO])) break; if (sp > XB_SPIN_CAP) { atomicAdd(&bar[XB_TMO], 1u); break; } }
    }
    nloc = mine > 0u ? mine : 1u; nx = cnt > 0u ? cnt : 1u;
}
__device__ __forceinline__ void xcd_barrier(const XcdBarrier& b, const unsigned k) {
    asm volatile("s_waitcnt vmcnt(0)" ::: "memory");
    __syncthreads();
    if (__builtin_amdgcn_workitem_id_x() == 0) {
        unsigned* bar = b.bar;
        __builtin_amdgcn_s_waitcnt(0);
        unsigned nloc = b.st[0], nx = b.st[1];
        if (nloc == 0u) { xcd_barrier_complete(bar, b.x, nloc, nx); b.st[0] = nloc; b.st[1] = nx; }
        const unsigned old = xb_add(&bar[XB_XSUB(b.x)], 1u);
        const unsigned gen = old / nloc;
        if (old + 1u == (gen + 1u) * nloc) {
            __builtin_amdgcn_fence(__ATOMIC_RELEASE, "agent");
            asm volatile("s_waitcnt vmcnt(0)" ::: "memory");
            const unsigned og = xb_add(&bar[XB_TOP], 1u);
            const unsigned tg = og / nx;
            if (og + 1u == (tg + 1u) * nx) xb_add(&bar[XB_TOPGEN], 1u);
            else XB_SPIN(xb_ld(&bar[XB_TOPGEN]) == tg, bar);
            __builtin_amdgcn_fence(__ATOMIC_ACQUIRE, "agent");
            asm volatile("s_waitcnt vmcnt(0)" ::: "memory");
        } else {
            XB_SPIN(xb_ld(&bar[XB_TOPGEN]) < k, bar);
            __builtin_amdgcn_fence(__ATOMIC_ACQUIRE, "agent");
            asm volatile("s_waitcnt vmcnt(0)" ::: "memory");
        }
    }
    __syncthreads();
}


#define PIN(i) ((const float*)P.in[(i) + z])
constexpr int NPH = 9;
template <int PH> __device__ __forceinline__ void run_phase(const Params& P, LAS unsigned char* lds) {
        int z; asm volatile("s_mov_b32 %0, 0" : "=s"(z));
        unsigned char* ws = P.ws + z;
        constexpr int layer = PH / NPH, k = PH - layer * NPH;
        const int tid = tid_opaque(), lane = tid & 63, wave = __builtin_amdgcn_readfirstlane(tid >> 6), G = sgpr_opaque(gridDim.x), blk = sgpr_opaque(blockIdx.x);
        const int gw = blk * 8 + wave, NGW = G * 8;
        float* hbuf = P.out + z;
        bf16_t* XN = (bf16_t*)(ws + WS_X);
        if constexpr (PH == NPH * DEPTH) {
            const float* g = PIN(I_FINAL);
            for (int m = gw; m < T; m += NGW) {
                f32x4* xr = (f32x4*)(hbuf + (size_t)m * 1024) + lane; const f32x4* gr = (const f32x4*)g + lane;
                f32x4 v[4]; float s = 0.f;
#pragma unroll
                for (int j = 0; j < 4; ++j) { v[j] = xr[64 * j]; s += (v[j].x * v[j].x + v[j].y * v[j].y) + (v[j].z * v[j].z + v[j].w * v[j].w); }
                const float rstd = rsqrtf(wave_sum(s) * (1.f / 1024.f) + NORM_EPS);
#pragma unroll
                for (int j = 0; j < 4; ++j) xr[64 * j] = v[j] * rstd * gr[64 * j];
            }
            return;
        } else if constexpr (k == 0) {
            const float* hin = (layer == 0) ? PIN(I_X) : hbuf;
            LAS float* tscr = (LAS float*)(lds + wave * 16384);
            bf16_t* Win_t = (bf16_t*)(ws + WS_WIN); bf16_t* Wq_t = (bf16_t*)(ws + WS_WQ); bf16_t* Wkv_t = (bf16_t*)(ws + WS_WKV); bf16_t* Wo_t = (bf16_t*)(ws + WS_WO);
            const float* Win = PIN(I_W_IN) + (size_t)layer * DM * IN_DIM;
            const float* Wq = PIN(I_WQUP) + (size_t)layer * 384 * 768;
            const float* Wkv = PIN(I_WKVUP) + (size_t)layer * 256 * 1024;
            const float* Wo = PIN(I_W_OUT) + (size_t)layer * 1024 * 1024;
            constexpr int IT_IN = 16 * 81, IT_Q = 6 * 24, IT_KV = 4 * 32, IT_O = 16 * 32;
            if (layer == 0) for (int it = gw; it < IT_IN + IT_Q + IT_KV + IT_O; it += NGW) {
                int r = it;
                if (r < IT_IN) { transpose_item(Win, 1024, IN_DIM, Win_t, 1, tscr, r, lane); continue; } r -= IT_IN;
                if (r < IT_Q) { transpose_item(Wq, 384, 768, Wq_t, 0, tscr, r, lane); continue; } r -= IT_Q;
                if (r < IT_KV) { transpose_item(Wkv, 256, 1024, Wkv_t, 0, tscr, r, lane); continue; } r -= IT_KV;
                transpose_item(Wo, 1024, 1024, Wo_t, 0, tscr, r, lane);
            }
            for (int i = blk * 512 + tid; i < 224 * 128; i += G * 512) { const int rr = i >> 7, cc = i & 127; const int row = (rr < 128) ? 896 + rr : 2720 + (rr - 128);
                *(u32x4*)(Win_t + (size_t)row * 1024 + cc * 8) = (u32x4){0u, 0u, 0u, 0u}; }
            if (layer == 0) {
                const int* pos = (const int*)P.in[I_POS + z];
                float* cosR = (float*)(ws + WS_COSR); float* sinR = (float*)(ws + WS_SINR); float* cosM = (float*)(ws + WS_COSM); float* sinM = (float*)(ws + WS_SINM);
                for (int i = blk * 512 + tid; i < T * 32; i += G * 512) { const int tok = i >> 5, f = i & 31;
                    const float inv = exp2f(-(float)f * (1.f / 32.f) * 13.287712379549449f); const float ang = (float)pos[tok] * inv;
                    double rev = (double)ang * 0.15915494309189535; rev -= floor(rev); const float a = (float)(rev * 6.283185307179586);
                    cosR[i] = __cosf(a); sinR[i] = __sinf(a); }
                for (int i = blk * 512 + tid; i < T * 16; i += G * 512) { const int tok = i >> 4, f = i & 15;
                    const float inv = exp2f(-(float)f * (1.f / 16.f) * 13.287712379549449f); const float ang = (float)pos[tok] * inv;
                    double rev = (double)ang * 0.15915494309189535; rev -= floor(rev); const float a = (float)(rev * 6.283185307179586);
                    cosM[i] = __cosf(a); sinM[i] = __sinf(a); }
            }
            const float* g = PIN(I_ATTN_NORM) + layer * 1024;
            for (int m = gw; m < T; m += 2 * NGW) rms_rows2_bf16(hin + (size_t)m * 1024, hin + (size_t)(m + NGW) * 1024, g, XN + (size_t)m * 1024, XN + (size_t)(m + NGW) * 1024, lane);
        } else if constexpr (k == 1) {
            pg8::Gemm g{XN, (bf16_t*)(ws + WS_WIN), T, NPROJ, 1024}; pg8::StaticOrder S; S.init(T, NPROJ, G, blk);
            pg8::EpiProj E{(bf16_t*)(ws + WS_PA), (bf16_t*)(ws + WS_PB), (bf16_t*)(ws + WS_PC)};
            pg8::gemm_phase<pg8::EpiProj, pg8::StaticOrder, true, true>(lds, g, S, E);
        } else if constexpr (k == 2) {
            bf16_t* pa = (bf16_t*)(ws + WS_PA); bf16_t* pb = (bf16_t*)(ws + WS_PB); bf16_t* pc = (bf16_t*)(ws + WS_PC);
            float* cosR = (float*)(ws + WS_COSR); float* sinR = (float*)(ws + WS_SINR); float* cosM = (float*)(ws + WS_COSM); float* sinM = (float*)(ws + WS_SINM);
            PrepW W;
            {
                const int l16 = lane & 15, lq = lane >> 4;
                const float* w2 = PIN(I_W2) + layer * 32 * 256; const float* a2 = PIN(I_A2) + layer * 32 * 256; const float* g2 = PIN(I_G2) + layer * 64 * 256;
                const float* v1 = PIN(I_V1) + (layer > 0 ? (layer - 1) * 256 * 32 : 0); const float* v2 = PIN(I_V2) + (layer > 0 ? (layer - 1) * 32 * 256 : 0);
#pragma unroll
                for (int nt = 0; nt < 2; ++nt) { const int n = 16 * (2 * wave + nt) + l16;
                    W.Bw[nt] = pack_col8(w2, 256, 8 * lq, n); W.Ba[nt] = pack_col8(a2, 256, 8 * lq, n);
                    W.Bg[nt][0] = pack_col8(g2, 256, 8 * lq, n); W.Bg[nt][1] = pack_col8(g2, 256, 32 + 8 * lq, n);
                    W.Bv[nt] = pack_col8(v2, 256, 8 * lq, n); W.Bv1[nt] = pack_col8(v1, 32, 32 * wave + 8 * lq, 16 * nt + l16); }
            }
            unsigned raw[17];
            if (tid < 448 && blk < T / 16) prep_fetch_rows(raw, pa, blk * 16, tid * 2);
            for (int tile = blk; tile < T / 16; tile += G) rwkv_prep_tile(lds, tile, (tile + G < T / 16) ? tile + G : -1, raw, layer, P, z, W, pa, ws + WS_REC, (bf16_t*)(ws + WS_VBUF), (bf16_t*)(ws + WS_GBUF), (bf16_t*)(ws + WS_VFIRST), (float*)(ws + WS_BS), (float*)(ws + WS_BS + 512 * 1024));
            for (int u = blk; u < 512; u += G) ret_kv_unit(lds, u >> 5, u & 31, pb, cosR, sinR, (float*)(ws + WS_KVT));
        } else if constexpr (k == 3) {
            LAS unsigned* misc = (LAS unsigned*)(lds + 131072);
            unsigned* ctl = (unsigned*)(ws + WS_CTL);
            float* cosR = (float*)(ws + WS_COSR); float* sinR = (float*)(ws + WS_SINR); float* cosM = (float*)(ws + WS_COSM); float* sinM = (float*)(ws + WS_SINM);
            unsigned* sbar = ctl + 64 * (8 + layer);
            const int NB = G - 64;
            if (blk < 64) {
                rwkv_scan_block(lds, blk, ws + WS_REC, (bf16_t*)(ws + WS_VBUF), (const float*)(ws + WS_BS + 512 * 1024), (float*)(ws + WS_YA));
                if (tid == 0) { unsigned sp = 0; while (xb_ld(sbar) < (unsigned)NB) { __builtin_amdgcn_s_sleep(4); if (++sp > (1u << 22)) break; }
                    __builtin_amdgcn_fence(__ATOMIC_ACQUIRE, "agent"); asm volatile("s_waitcnt vmcnt(0)" ::: "memory"); }
                __syncthreads();
            } else {
                const int cb = blk - 64;
                {
                    const int gwn = cb * 8 + wave, NGWn = NB * 8;
                    bf16_t* pc = (bf16_t*)(ws + WS_PC);
            bf16_t* qn = (bf16_t*)(ws + WS_QN); bf16_t* kvn = (bf16_t*)(ws + WS_KVN); bf16_t* kr = (bf16_t*)(ws + WS_KR);
            const float* qg = PIN(I_QNORM) + layer * 384; const float* kg = PIN(I_KVNORM) + layer * 256;
            for (int m0 = gwn; m0 < T; m0 += 2 * NGWn) {
                float xq[2][6], xk[2][4], x1[2], x2[2], cc[2], sn[2];
#pragma unroll
                for (int u = 0; u < 2; ++u) { const int m = (m0 + u * NGWn < T) ? m0 + u * NGWn : T - 1; const bf16_t* row = pc + (size_t)m * 768;
#pragma unroll
                    for (int j = 0; j < 6; ++j) xq[u][j] = bf2f(row[lane + 64 * j]);
#pragma unroll
                    for (int j = 0; j < 4; ++j) xk[u][j] = bf2f(row[384 + lane + 64 * j]);
                    x1[u] = bf2f(row[640 + (lane & 15)]); x2[u] = bf2f(row[656 + (lane & 15)]); cc[u] = cosM[(size_t)m * 16 + (lane & 15)]; sn[u] = sinM[(size_t)m * 16 + (lane & 15)]; }
#pragma unroll
                for (int u = 0; u < 2; ++u) { const int m = m0 + u * NGWn; if (m >= T) continue;
                    float sq = 0.f, sk = 0.f;
#pragma unroll
                    for (int j = 0; j < 6; ++j) sq += xq[u][j] * xq[u][j];
#pragma unroll
                    for (int j = 0; j < 4; ++j) sk += xk[u][j] * xk[u][j];
                    const float rq = rsqrtf(wave_sum(sq) * (1.f / 384.f) + NORM_EPS), rk = rsqrtf(wave_sum(sk) * (1.f / 256.f) + NORM_EPS);
#pragma unroll
                    for (int j = 0; j < 6; ++j) qn[(size_t)m * 384 + lane + 64 * j] = f2bf(xq[u][j] * rq * qg[lane + 64 * j]);
#pragma unroll
                    for (int j = 0; j < 4; ++j) kvn[(size_t)m * 256 + lane + 64 * j] = f2bf(xk[u][j] * rk * kg[lane + 64 * j]);
                    if (lane < 16) { kr[(size_t)m * 32 + lane] = f2bf(x1[u] * cc[u] - x2[u] * sn[u]); kr[(size_t)m * 32 + 16 + lane] = f2bf(x2[u] * cc[u] + x1[u] * sn[u]); }
                }
            }
                    unsigned* sbar0 = ctl + 64 * (12 + layer);
                    asm volatile("s_waitcnt vmcnt(0)" ::: "memory");
                    __syncthreads();
                    if (tid == 0) {
                        __builtin_amdgcn_fence(__ATOMIC_RELEASE, "agent"); asm volatile("s_waitcnt vmcnt(0)" ::: "memory");
                        xb_add(sbar0, 1u);
                        unsigned sp = 0; while (xb_ld(sbar0) < (unsigned)NB) { __builtin_amdgcn_s_sleep(4); if (++sp > (1u << 22)) break; }
                        __builtin_amdgcn_fence(__ATOMIC_ACQUIRE, "agent"); asm volatile("s_waitcnt vmcnt(0)" ::: "memory");
                    }
                    __syncthreads();
                }
                bf16_t* rprev = (bf16_t*)(ws + WS_RPREV); const float* kvt = (const float*)(ws + WS_KVT);
                for (int i = cb * 512 + tid; i < 16 * 4096; i += NB * 512) { const int bh = i >> 12, el = i & 4095; const int h = bh & 3;
                    const float cd = exp2f(128.f * log2f(1.f - exp2f(-5.f - (float)h)));
                    float R = 0.f;
#pragma unroll 8
                    for (int ci = 0; ci < 32; ++ci) { rprev[((size_t)(bh * 32 + ci)) * 4096 + el] = f2bf(R); R = R * cd + kvt[((size_t)(bh * 32 + ci)) * 4096 + el]; } }
                __syncthreads();
                { pg8::Gemm g{(bf16_t*)(ws + WS_QN), (bf16_t*)(ws + WS_WQ), T, 768, 384}; pg8::StaticOrder S; S.init(T, 768, NB, cb); pg8::EpiPlain E{(bf16_t*)(ws + WS_PC), 768};
                  pg8::gemm_phase<pg8::EpiPlain, pg8::StaticOrder, true, true>(lds, g, S, E); }
                { pg8::Gemm g{(bf16_t*)(ws + WS_KVN), (bf16_t*)(ws + WS_WKV), T, 1024, 256}; pg8::StaticOrder S; S.init(T, 1024, NB, cb); pg8::EpiPlain E{(bf16_t*)(ws + WS_KN), 1024};
                  pg8::gemm_phase<pg8::EpiPlain, pg8::StaticOrder, true, true>(lds, g, S, E); }
                asm volatile("s_waitcnt vmcnt(0)" ::: "memory");
                __syncthreads();
                if (tid == 0) {
                    __builtin_amdgcn_fence(__ATOMIC_RELEASE, "agent"); asm volatile("s_waitcnt vmcnt(0)" ::: "memory");
                    xb_add(sbar, 1u);
                    unsigned sp = 0; while (xb_ld(sbar) < (unsigned)NB) { __builtin_amdgcn_s_sleep(4); if (++sp > (1u << 22)) break; }
                    __builtin_amdgcn_fence(__ATOMIC_ACQUIRE, "agent"); asm volatile("s_waitcnt vmcnt(0)" ::: "memory");
                }
                __syncthreads();
            }
            unsigned* qctr = ctl + 64 * (1 + layer);
            for (;;) {
                __syncthreads();
                if (tid == 0) misc[0] = atomicAdd(qctr, 1u);
                __syncthreads();
                const int u = (int)misc[0];
                if (u >= 768) break;
                if (u < 512) { const int qb = 15 - (u >> 5), bh = u & 31; att_unit(lds, bh >> 3, bh & 7, qb, (bf16_t*)(ws + WS_PC), (bf16_t*)(ws + WS_KN), (bf16_t*)(ws + WS_KR), cosM, sinM, XN); }
                else { const int v = u - 512; const int bh = v & 15, jb = v >> 4; ret_unit(lds, bh >> 2, bh & 3, jb, (bf16_t*)(ws + WS_PB), cosR, sinR, (bf16_t*)(ws + WS_RPREV), (float*)(ws + WS_YB)); }
            }
        } else if constexpr (k == 4) {
            LAS float* tscr = (LAS float*)(lds + wave * 16384);
            const float* __restrict__ ya = (const float*)(ws + WS_YA); const float* __restrict__ yb = (const float*)(ws + WS_YB); const float* __restrict__ bs = (const float*)(ws + WS_BS);
            const bf16_t* __restrict__ vbuf = (const bf16_t*)(ws + WS_VBUF); const bf16_t* __restrict__ gbuf = (const bf16_t*)(ws + WS_GBUF); const bf16_t* __restrict__ pb = (const bf16_t*)(ws + WS_PB);
            const float* __restrict__ gnw = PIN(I_GNW) + layer * 256; const float* __restrict__ gnb = PIN(I_GNB) + layer * 256;
            bf16_t* __restrict__ XNw = XN;
#pragma unroll 4
            for (int m = gw; m < T; m += NGW) {
                const int c = 4 * lane, head = lane >> 4;
                const f32x4 y = *(const f32x4*)(ya + (size_t)m * 256 + c);
                const float mean = allreduce16((y.x + y.y) + (y.z + y.w)) * (1.f / 64.f);
                const f32x4 d = y - mean;
                const float var = allreduce16((d.x * d.x + d.y * d.y) + (d.z * d.z + d.w * d.w)) * (1.f / 64.f);
                const float rs = rsqrtf(var + 64e-5f);
                const f32x4 gw4 = *(const f32x4*)(gnw + c), gb4 = *(const f32x4*)(gnb + c);
                const u32x2 vv = *(const u32x2*)(vbuf + (size_t)m * 256 + c), gg = *(const u32x2*)(gbuf + (size_t)m * 256 + c);
                const float bsc = bs[(size_t)m * 4 + head];
                const float o0 = (d.x * rs * gw4.x + gb4.x + bsc * bflo(vv.x)) * bflo(gg.x), o1 = (d.y * rs * gw4.y + gb4.y + bsc * bfhi(vv.x)) * bfhi(gg.x);
                const float o2 = (d.z * rs * gw4.z + gb4.z + bsc * bflo(vv.y)) * bflo(gg.y), o3 = (d.w * rs * gw4.w + gb4.w + bsc * bfhi(vv.y)) * bfhi(gg.y);
                u32x2 w; w.x = cvt_pk_bf16(o0, o1); w.y = cvt_pk_bf16(o2, o3);
                *(u32x2*)(XNw + (size_t)m * 1024 + c) = w;
                const f32x4 zz = *(const f32x4*)(yb + (size_t)m * 256 + c);
                const float ms = allreduce16((zz.x * zz.x + zz.y * zz.y) + (zz.z * zz.z + zz.w * zz.w)) * (1.f / 64.f);
                const float rz = rsqrtf(ms + NORM_EPS);
                const u32x2 gt = *(const u32x2*)(pb + (size_t)m * 1024 + 768 + c);
                const float g0 = bflo(gt.x), g1 = bfhi(gt.x), g2v = bflo(gt.y), g3 = bfhi(gt.y);
                u32x2 w2; w2.x = cvt_pk_bf16(zz.x * rz * g0 * sigmoidf_(g0), zz.y * rz * g1 * sigmoidf_(g1)); w2.y = cvt_pk_bf16(zz.z * rz * g2v * sigmoidf_(g2v), zz.w * rz * g3 * sigmoidf_(g3));
                *(u32x2*)(XNw + (size_t)m * 1024 + 256 + c) = w2;
            }
            const float* Wgu = PIN(I_WGU) + (size_t)layer * 1024 * 2 * D_FF; const float* Wdn = PIN(I_WDN) + (size_t)layer * D_FF * 1024;
            bf16_t* Wgu_t = (bf16_t*)(ws + WS_WGU); bf16_t* Wdn_t = (bf16_t*)(ws + WS_WDN);
            constexpr int IT_GU = 16 * 176, IT_DN = 44 * 32;
            for (int it = gw; it < IT_GU + IT_DN; it += NGW) {
                if (it < IT_GU) transpose_item(Wgu, 1024, 2 * D_FF, Wgu_t, 2, tscr, it, lane);
                else transpose_item(Wdn, D_FF, 1024, Wdn_t, 0, tscr, it - IT_GU, lane);
            }
        } else if constexpr (k == 5) {
            const float* hin = (layer == 0) ? PIN(I_X) : hbuf;
            pg8::Gemm g{XN, (bf16_t*)(ws + WS_WO), T, 1024, 1024}; pg8::StaticOrder S; S.init(T, 1024, G, blk); pg8::EpiRes E{hin, hbuf};
            pg8::gemm_phase<pg8::EpiRes, pg8::StaticOrder, true, true>(lds, g, S, E);
        } else if constexpr (k == 6) {
            const float* g = PIN(I_FFN_NORM) + layer * 1024;
            for (int m = gw; m < T; m += 2 * NGW) rms_rows2_bf16(hbuf + (size_t)m * 1024, hbuf + (size_t)(m + NGW) * 1024, g, XN + (size_t)m * 1024, XN + (size_t)(m + NGW) * 1024, lane);
            if constexpr (layer + 1 < DEPTH) {
                LAS float* tscr = (LAS float*)(lds + wave * 16384);
                const float* Win = PIN(I_W_IN) + (size_t)(layer + 1) * DM * IN_DIM; const float* Wq = PIN(I_WQUP) + (size_t)(layer + 1) * 384 * 768;
                const float* Wkv = PIN(I_WKVUP) + (size_t)(layer + 1) * 256 * 1024; const float* Wo = PIN(I_W_OUT) + (size_t)(layer + 1) * 1024 * 1024;
                constexpr int IT_IN = 16 * 81, IT_Q = 6 * 24, IT_KV = 4 * 32, IT_O = 16 * 32;
                for (int it = gw; it < IT_IN + IT_Q + IT_KV + IT_O; it += NGW) {
                    int r = it;
                    if (r < IT_IN) { transpose_item(Win, 1024, IN_DIM, (bf16_t*)(ws + WS_WIN), 1, tscr, r, lane); continue; } r -= IT_IN;
                    if (r < IT_Q) { transpose_item(Wq, 384, 768, (bf16_t*)(ws + WS_WQ), 0, tscr, r, lane); continue; } r -= IT_Q;
                    if (r < IT_KV) { transpose_item(Wkv, 256, 1024, (bf16_t*)(ws + WS_WKV), 0, tscr, r, lane); continue; } r -= IT_KV;
                    transpose_item(Wo, 1024, 1024, (bf16_t*)(ws + WS_WO), 0, tscr, r, lane);
                }
            }
        } else if constexpr (k == 7) {
            pg8::Gemm g{XN, (bf16_t*)(ws + WS_WGU), T, 2 * D_FF, 1024}; pg8::StaticOrder S; S.init(T, 2 * D_FF, G, blk); pg8::EpiSwiGLU E{(bf16_t*)(ws + WS_ACT)};
            pg8::gemm_phase<pg8::EpiSwiGLU, pg8::StaticOrder, true, true>(lds, g, S, E);
        } else {
            pg8::Gemm g{(bf16_t*)(ws + WS_ACT), (bf16_t*)(ws + WS_WDN), T, 1024, D_FF}; pg8::StaticOrder S; S.init(T, 1024, G, blk); pg8::EpiRes E{hbuf, hbuf};
            pg8::gemm_phase<pg8::EpiRes, pg8::StaticOrder, true, true>(lds, g, S, E);
        }
}

template <int PH> __device__ __forceinline__ void run_all(const Params& P, LAS unsigned char* lds, cg::grid_group& grid, const XcdBarrier& bar) {
    run_phase<PH>(P, lds);
    if constexpr (PH < NPH * DEPTH) {
        xcd_barrier(bar, (unsigned)PH + 1u);
        run_all<PH + 1>(P, lds, grid, bar);
    }
}
__global__ void __launch_bounds__(512) hymba_fwd(Params P) {
    extern __shared__ __attribute__((aligned(16))) unsigned char lds_raw[];
    LAS unsigned char* lds = (LAS unsigned char*)lds_raw;
    cg::grid_group grid = cg::this_grid();
    LAS unsigned* misc = (LAS unsigned*)(lds + 131072);
    if (__builtin_amdgcn_workitem_id_x() < 32) misc[__builtin_amdgcn_workitem_id_x()] = 0u;
    __syncthreads();
    if (P.ws == nullptr) grid.sync();
    const XcdBarrier bar = xcd_barrier_post((unsigned*)(P.ws + WS_CTL) + 4096, (volatile LAS unsigned*)(misc + 8));
    run_all<0>(P, lds, grid, bar);
}
extern "C" void kernel_launch(void* const* d_in, const int* in_sizes, int n_in, void* d_out, int out_size, void* d_ws, size_t ws_size, hipStream_t stream) {
    static int grid = 0;
    if (grid == 0) {
        if (n_in != 27 || out_size != T * DM || ws_size < WS_END) { fprintf(stderr, "kernel_launch: unexpected shapes (n_in %d, out %d, ws %zu)\n", n_in, out_size, ws_size); grid = -1; return; }
        int dev = 0, cus = 0, per_cu = 0;
        (void)hipGetDevice(&dev); (void)hipDeviceGetAttribute(&cus, hipDeviceAttributeMultiprocessorCount, dev);
        if (hipFuncSetAttribute((const void*)hymba_fwd, hipFuncAttributeMaxDynamicSharedMemorySize, LDS_BYTES) != hipSuccess) { fprintf(stderr, "kernel_launch: hipFuncSetAttribute failed\n"); grid = -1; return; }
        if (hipOccupancyMaxActiveBlocksPerMultiprocessor(&per_cu, (const void*)hymba_fwd, 512, LDS_BYTES) != hipSuccess || per_cu < 1) { fprintf(stderr, "kernel_launch: occupancy query failed (%d)\n", per_cu); grid = -1; return; }
        (void)hipGetLastError();
        grid = cus;
        if (grid < 64) { fprintf(stderr, "kernel_launch: needs >= 64 CUs\n"); grid = -1; return; }
    }
    if (grid < 0) return;
    (void)hipMemsetAsync((char*)d_ws + WS_CTL, 0, 1 * MiB, stream);
    Params p{};
    for (int i = 0; i < 27; ++i) p.in[i] = d_in[i];
    p.out = (float*)d_out; p.ws = (unsigned char*)d_ws;
    void* args[] = {&p};
    hipError_t e = hipLaunchCooperativeKernel((const void*)hymba_fwd, dim3(grid), dim3(512), args, LDS_BYTES, stream);
    if (e != hipSuccess) fprintf(stderr, "kernel_launch: cooperative launch failed: %s (grid %d)\n", hipGetErrorString(e), grid);
}
```

```cpp
#include <hip/hip_runtime.h>
#include <hip/hip_cooperative_groups.h>
#include <cstdio>
#include <cstdint>
namespace cg = cooperative_groups;

#define LAS __attribute__((address_space(3)))
typedef unsigned short bf16_t;
typedef short bf16x8 __attribute__((ext_vector_type(8)));
typedef float f32x2 __attribute__((ext_vector_type(2)));
typedef float f32x4 __attribute__((ext_vector_type(4)));
typedef float f32x16 __attribute__((ext_vector_type(16)));
typedef unsigned u32x4 __attribute__((ext_vector_type(4)));
typedef unsigned u32x2 __attribute__((ext_vector_type(2)));

constexpr int BATCH = 4, SEQ = 4096, T = BATCH * SEQ, DM = 1024, DEPTH = 2;
constexpr int RW_IN = 896, IN_DIM = 2592, D_FF = 2816;
constexpr int NPROJ = 2816;
constexpr float NORM_EPS = 1e-6f;

constexpr size_t MiB = 1u << 20;
constexpr size_t WS_CTL = 0;
constexpr size_t WS_COSR = 1 * MiB, WS_SINR = 3 * MiB, WS_COSM = 5 * MiB, WS_SINM = 6 * MiB;
constexpr size_t WS_BS = 7 * MiB;
constexpr size_t WS_RPREV = 8 * MiB;
constexpr size_t WS_WIN = 12 * MiB;
constexpr size_t WS_WQ = WS_WIN + 5632 * 1024;
constexpr size_t WS_WKV = WS_WQ + 768 * 384 * 2;
constexpr size_t WS_WO = WS_WKV + 1024 * 256 * 2;
constexpr size_t WS_VFIRST = 21 * MiB;
constexpr size_t WS_VBUF = 29 * MiB;
constexpr size_t WS_GBUF = 37 * MiB;
constexpr size_t WS_X = 45 * MiB;
constexpr size_t WS_QN = WS_X, WS_KVN = WS_X + 12 * MiB;
constexpr size_t WS_KR = 253 * MiB;
constexpr size_t WS_PA = 77 * MiB;
constexpr size_t WS_YA = WS_PA, WS_YB = WS_PA + 16 * MiB;
constexpr size_t WS_PB = 109 * MiB;
constexpr size_t WS_PC = 141 * MiB;
constexpr size_t WS_ACT = 77 * MiB;
constexpr size_t WS_KN = 165 * MiB;
constexpr size_t WS_VT = 181 * MiB;
constexpr size_t WS_REC = 197 * MiB;
constexpr size_t WS_WGU = 197 * MiB, WS_WDN = 208 * MiB;
constexpr size_t WS_KVT = 245 * MiB;
constexpr size_t WS_END = 254 * MiB;

constexpr int LDS_BYTES = 131072 + 1024;

__device__ __forceinline__ int sgpr_opaque(int v) { asm volatile("" : "+s"(v)); return v; }
__device__ __forceinline__ int tid_opaque() { int t = __builtin_amdgcn_workitem_id_x(); asm volatile("" : "+v"(t)); return t; }
__device__ __forceinline__ unsigned cvt_pk_bf16(float lo, float hi) { unsigned r; asm volatile("v_cvt_pk_bf16_f32 %0, %1, %2" : "=v"(r) : "v"(lo), "v"(hi)); return r; }
__device__ __forceinline__ bf16_t f2bf(float f) { return (bf16_t)(cvt_pk_bf16(f, 0.f) & 0xffffu); }
__device__ __forceinline__ float bf2f(bf16_t v) { return __uint_as_float(((unsigned)v) << 16); }
__device__ __forceinline__ float bflo(unsigned u) { return __uint_as_float(u << 16); }
__device__ __forceinline__ float bfhi(unsigned u) { return __uint_as_float(u & 0xffff0000u); }
__device__ __forceinline__ float sigmoidf_(float x) { return __builtin_amdgcn_rcpf(1.f + __expf(-x)); }
template <int CTRL> __device__ __forceinline__ float dpp_mov(float x) { return __builtin_bit_cast(float, __builtin_amdgcn_mov_dpp(__builtin_bit_cast(int, x), CTRL, 0xf, 0xf, true)); }
__device__ __forceinline__ float allreduce16(float x) {
    x += dpp_mov<0xB1>(x); x += dpp_mov<0x4E>(x); x += dpp_mov<0x141>(x); x += dpp_mov<0x140>(x); return x;
}
__device__ __forceinline__ float wave_sum(float v) { v = allreduce16(v); v += __shfl_xor(v, 16); v += __shfl_xor(v, 32); return v; }
__device__ __forceinline__ int crow(int r, int hi) { return (r & 3) + 8 * (r >> 2) + 4 * hi; }
#define MFMA32(a, b, c) __builtin_amdgcn_mfma_f32_32x32x16_bf16((a), (b), (c), 0, 0, 0)

namespace pg8 {
#define PG8_LAS __attribute__((address_space(3)))
constexpr int BM = 256, BK = 64, HALF = 128, HTB = HALF * BK * 2, STAGE_BYTES = 8 * HTB, NXCD = 8, WGM = 8;
__host__ __device__ __forceinline__ int lds_byte(int r, int c) { const int st = (r >> 4) * 2 + (c >> 5), rr = r & 15, cc = c & 31, ob = rr * 64 + cc * 2; return st * 1024 + (ob ^ (((ob >> 9) & 1) << 5)); }
__host__ __device__ __forceinline__ void stage_rc(int b, int& R, int& C) { const int st = b / 1024, sb = b % 1024, swz = sb ^ (((sb >> 9) & 1) << 5); R = (st >> 1) * 16 + swz / 64; C = (st & 1) * 32 + (swz % 64) / 2; }
__host__ __device__ __forceinline__ int perm32(int rho) { const int n = rho >> 4, i = rho & 15; return 8 * (i >> 2) + 4 * n + (i & 3); }
struct Unit { int pm, pn; };
struct Gemm { const bf16_t* A; const bf16_t* Bt; int M, N, K; };
struct StaticOrder {
    int nM, nN, nwg, G, c;
    __host__ __device__ void init(int M, int N, int G_, int c_) { nM = M / BM; nN = N / BM; nwg = nM * nN; G = G_; c = c_; }
    __host__ __device__ bool next(int i, Unit& u) const {
        const long L = (long)i * G + c; if (L >= nwg) return false;
        int wgid = (int)L; { const int q = nwg / NXCD, r = nwg % NXCD, xcd = wgid % NXCD, off = wgid / NXCD; wgid = (xcd < r ? xcd * (q + 1) : r * (q + 1) + (xcd - r) * q) + off; }
        const int nig = WGM * nN, gid = wgid / nig, fm = gid * WGM, gsz = (nM - fm) < WGM ? (nM - fm) : WGM;
        u.pm = fm + ((wgid % nig) % gsz); u.pn = (wgid % nig) / gsz; return true;
    }
    __device__ __forceinline__ void a_ready(const Unit&) const {}
    __device__ __forceinline__ void done(const Unit&) const {}
};

template <class Epi, class Sched, bool ALIGN_EPI = false, bool SP2 = false>
__device__ __forceinline__ void gemm_phase(PG8_LAS unsigned char* lds, const Gemm g, const Sched& S, const Epi& E) {
    const int tid = tid_opaque(), wid = __builtin_amdgcn_readfirstlane(tid >> 6), lane = tid & 63, wr = wid >> 2, wc = wid & 3, fr = lane & 15, fq = lane >> 4;
    const int K = g.K, nt = K / BK;
    unsigned voffA[2], voffB[2];
#pragma unroll
    for (int i = 0; i < 2; ++i) { int R, C; stage_rc(tid * 16 + i * 8192, R, C); const int Rb = Epi::PERM ? ((R & ~31) + perm32(R & 31)) : R;
        voffA[i] = (unsigned)(R * K + C) * 2u; voffB[i] = (unsigned)(Rb * K + C) * 2u; }
    const size_t kstep = (size_t)(BK * 2);
    const size_t hstep = (size_t)HALF * K * 2;
    const size_t tstep = 2 * hstep;
    const unsigned ldsw = (unsigned)wid * 1024u;
    const int aoff = lds_byte(wr * 64 + fr, fq * 8), boff = lds_byte(wc * 32 + fr, fq * 8);
#define PG8_SA(b, h) (((b) * 2 + (h)) * HTB)
#define PG8_SB(b, h) ((4 + (b) * 2 + (h)) * HTB)
#define PG8_STAGE(bufoff, gbase, voff) do { _Pragma("unroll") for (int _i = 0; _i < 2; ++_i) \
        __builtin_amdgcn_global_load_lds((const unsigned*)((const char*)(gbase) + (voff)[_i]), (PG8_LAS unsigned*)(lds + (bufoff) + ldsw + _i * 8192), 16, 0, 0); } while (0)
#define PG8_LDA(dst, b, h) do { _Pragma("unroll") for (int m = 0; m < 4; ++m) _Pragma("unroll") for (int k = 0; k < 2; ++k) dst[m][k] = *(const PG8_LAS bf16x8*)(lds + PG8_SA(b, h) + aoff + m * 2048 + k * 1024); } while (0)
#define PG8_LDB(dst, b, h) do { _Pragma("unroll") for (int n = 0; n < 2; ++n) _Pragma("unroll") for (int k = 0; k < 2; ++k) dst[n][k] = *(const PG8_LAS bf16x8*)(lds + PG8_SB(b, h) + boff + n * 2048 + k * 1024); } while (0)
#define PG8_MMA(ai, bj, At, Bt) do { __builtin_amdgcn_s_setprio(1); _Pragma("unroll") for (int m = 0; m < 4; ++m) _Pragma("unroll") for (int n = 0; n < 2; ++n) _Pragma("unroll") for (int k = 0; k < 2; ++k) \
        acc[ai][bj][m][n] = __builtin_amdgcn_mfma_f32_16x16x32_bf16(Bt[n][k], At[m][k], acc[ai][bj][m][n], 0, 0, 0); __builtin_amdgcn_s_setprio(0); } while (0)
#define PG8_WAIT_V(n) asm volatile("s_waitcnt vmcnt(" #n ")" ::: "memory")
#define PG8_WAIT_L(n) asm volatile("s_waitcnt lgkmcnt(" #n ")" ::: "memory")
#define PG8_BAR __builtin_amdgcn_s_barrier()
#define PG8_SCHED __builtin_amdgcn_sched_barrier(0)
    Unit cur, nxt; int ui = 0;
    if (!S.next(0, cur)) return;
    f32x4 acc[2][2][4][2];
#pragma unroll
    for (int a = 0; a < 2; ++a)
#pragma unroll
        for (int b = 0; b < 2; ++b)
#pragma unroll
            for (int m = 0; m < 4; ++m)
#pragma unroll
                for (int n = 0; n < 2; ++n) acc[a][b][m][n] = (f32x4){0.f, 0.f, 0.f, 0.f};
    bf16x8 At[4][2], B0[2][2], B1[2][2];
    const char* cA = (const char*)g.A + (size_t)cur.pm * tstep; const char* cB = (const char*)g.Bt + (size_t)cur.pn * tstep;
    S.a_ready(cur);
    if constexpr (SP2) {
        PG8_STAGE(PG8_SB(0, 0), cB, voffB); PG8_STAGE(PG8_SB(0, 1), cB + hstep, voffB); PG8_STAGE(PG8_SA(0, 0), cA, voffA); PG8_STAGE(PG8_SA(0, 1), cA + hstep, voffA);
        if (wr == 1) PG8_BAR;
        PG8_WAIT_V(2); PG8_BAR;
        PG8_STAGE(PG8_SB(1, 0), cB + kstep, voffB); PG8_STAGE(PG8_SA(1, 0), cA + kstep, voffA); PG8_STAGE(PG8_SB(1, 1), cB + hstep + kstep, voffB);
        PG8_WAIT_V(6); PG8_BAR;
    } else {
        PG8_STAGE(PG8_SB(0, 0), cB, voffB); PG8_STAGE(PG8_SA(0, 0), cA, voffA); PG8_STAGE(PG8_SB(0, 1), cB + hstep, voffB); PG8_STAGE(PG8_SA(0, 1), cA + hstep, voffA);
        if (wr == 1) PG8_BAR;
        PG8_WAIT_V(4); PG8_BAR;
        PG8_STAGE(PG8_SB(1, 0), cB + kstep, voffB); PG8_STAGE(PG8_SA(1, 0), cA + kstep, voffA); PG8_STAGE(PG8_SB(1, 1), cB + hstep + kstep, voffB);
        PG8_WAIT_V(6); PG8_BAR;
    }
    for (;;) {
        const bool has_next = S.next(ui + 1, nxt);
        const char* nA = has_next ? (const char*)g.A + (size_t)nxt.pm * tstep : cA; const char* nB = has_next ? (const char*)g.Bt + (size_t)nxt.pn * tstep : cB;
        for (int t = 0; t < nt; t += 2) {
            const bool last = (t == nt - 2);
            const char* a1 = cA + (size_t)(t + 1) * kstep;
            const char* a2 = last ? nA : cA + (size_t)(t + 2) * kstep; const char* b2 = last ? nB : cB + (size_t)(t + 2) * kstep;
            const char* a3 = a2 + kstep; const char* b3 = b2 + kstep;
            if (last && has_next) S.a_ready(nxt);
            if constexpr (SP2) {
            PG8_LDB(B0, 0, 0); PG8_LDB(B1, 0, 1); PG8_SCHED; PG8_LDA(At, 0, 0); PG8_STAGE(PG8_SA(1, 1), a1 + hstep, voffA);
            PG8_WAIT_V(8); PG8_WAIT_L(0); PG8_BAR; PG8_MMA(0, 0, At, B0); PG8_MMA(0, 1, At, B1); PG8_BAR; PG8_SCHED;
            PG8_LDA(At, 0, 1); PG8_STAGE(PG8_SB(0, 0), b2, voffB); PG8_STAGE(PG8_SB(0, 1), b2 + hstep, voffB); PG8_STAGE(PG8_SA(0, 0), a2, voffA);
            PG8_WAIT_V(8); PG8_WAIT_L(0); PG8_BAR; PG8_MMA(1, 0, At, B0); PG8_MMA(1, 1, At, B1); PG8_BAR; PG8_SCHED;
            PG8_LDB(B0, 1, 0); PG8_LDB(B1, 1, 1); PG8_SCHED; PG8_LDA(At, 1, 0); PG8_STAGE(PG8_SA(0, 1), a2 + hstep, voffA);
            PG8_WAIT_V(8); PG8_WAIT_L(0); PG8_BAR; PG8_MMA(0, 0, At, B0); PG8_MMA(0, 1, At, B1); PG8_BAR; PG8_SCHED;
            PG8_LDA(At, 1, 1); PG8_STAGE(PG8_SB(1, 0), b3, voffB); PG8_STAGE(PG8_SB(1, 1), b3 + hstep, voffB); PG8_STAGE(PG8_SA(1, 0), a3, voffA);
            PG8_WAIT_V(8); PG8_WAIT_L(0); PG8_BAR; PG8_MMA(1, 0, At, B0); PG8_MMA(1, 1, At, B1); PG8_BAR; PG8_SCHED;
            } else {
            PG8_LDB(B0, 0, 0); PG8_SCHED; PG8_LDA(At, 0, 0); PG8_STAGE(PG8_SA(1, 1), a1 + hstep, voffA);
            PG8_WAIT_L(8); PG8_BAR; PG8_WAIT_L(0); PG8_MMA(0, 0, At, B0); PG8_BAR; PG8_SCHED;
            PG8_LDB(B1, 0, 1); PG8_STAGE(PG8_SB(0, 0), b2, voffB);
            PG8_BAR; PG8_WAIT_L(0); PG8_MMA(0, 1, At, B1); PG8_BAR;
            PG8_LDA(At, 0, 1); PG8_STAGE(PG8_SA(0, 0), a2, voffA);
            PG8_BAR; PG8_WAIT_L(0); PG8_MMA(1, 0, At, B0); PG8_BAR; PG8_SCHED;
            PG8_STAGE(PG8_SB(0, 1), b2 + hstep, voffB);
            PG8_WAIT_V(6); PG8_BAR; PG8_MMA(1, 1, At, B1); PG8_BAR;
            PG8_LDB(B0, 1, 0); PG8_SCHED; PG8_LDA(At, 1, 0); PG8_STAGE(PG8_SA(0, 1), a2 + hstep, voffA);
            PG8_WAIT_L(8); PG8_BAR; PG8_WAIT_L(0); PG8_MMA(0, 0, At, B0); PG8_BAR; PG8_SCHED;
            PG8_LDB(B1, 1, 1); PG8_STAGE(PG8_SB(1, 0), b3, voffB);
            PG8_BAR; PG8_WAIT_L(0); PG8_MMA(0, 1, At, B1); PG8_BAR;
            PG8_LDA(At, 1, 1); PG8_STAGE(PG8_SA(1, 0), a3, voffA);
            PG8_BAR; PG8_WAIT_L(0); PG8_MMA(1, 0, At, B0); PG8_BAR; PG8_SCHED;
            PG8_STAGE(PG8_SB(1, 1), b3 + hstep, voffB);
            PG8_WAIT_V(6); PG8_BAR; PG8_MMA(1, 1, At, B1); PG8_BAR;
            }
        }
        if constexpr (ALIGN_EPI) { if (wr == 0) PG8_BAR; }
        E(acc, cur, wr, wc, fr, fq); S.done(cur);
        if (!has_next) break;
#pragma unroll
        for (int a = 0; a < 2; ++a)
#pragma unroll
            for (int b = 0; b < 2; ++b)
#pragma unroll
                for (int m = 0; m < 4; ++m)
#pragma unroll
                    for (int n = 0; n < 2; ++n) acc[a][b][m][n] = (f32x4){0.f, 0.f, 0.f, 0.f};
        cur = nxt; cA = nA; cB = nB; ++ui;
        if constexpr (ALIGN_EPI) { if (wr == 1) PG8_BAR; }
    }
    PG8_WAIT_V(0);
    if constexpr (!ALIGN_EPI) { if (wr == 0) PG8_BAR; }
    PG8_BAR;
#undef PG8_SA
#undef PG8_SB
#undef PG8_STAGE
#undef PG8_LDA
#undef PG8_LDB
#undef PG8_MMA
#undef PG8_WAIT_V
#undef PG8_WAIT_L
#undef PG8_BAR
#undef PG8_SCHED
}

__device__ __forceinline__ u32x4 pack8(const f32x4 v0, const f32x4 v1) { u32x4 w; w.x = cvt_pk_bf16(v0[0], v0[1]); w.y = cvt_pk_bf16(v0[2], v0[3]); w.z = cvt_pk_bf16(v1[0], v1[1]); w.w = cvt_pk_bf16(v1[2], v1[3]); return w; }

struct EpiProj {
    static constexpr bool PERM = true;
    bf16_t *pa, *pb, *pc;
    __device__ __forceinline__ void operator()(const f32x4 (&acc)[2][2][4][2], const Unit& u, int wr, int wc, int fr, int fq) const {
        bf16_t* base; int ldc, colt;
        if (u.pn < 4) { base = pa; ldc = 1024; colt = u.pn * 256; } else if (u.pn < 8) { base = pb; ldc = 1024; colt = (u.pn - 4) * 256; } else { base = pc; ldc = 768; colt = (u.pn - 8) * 256; }
        const int row0 = u.pm * BM + wr * 64 + fr, col0 = colt + wc * 32 + 8 * fq;
#pragma unroll
        for (int ai = 0; ai < 2; ++ai)
#pragma unroll
            for (int m = 0; m < 4; ++m) { bf16_t* rowp = base + (size_t)(row0 + ai * HALF + m * 16) * ldc + col0;
#pragma unroll
                for (int bj = 0; bj < 2; ++bj) *(u32x4*)(rowp + bj * HALF) = pack8(acc[ai][bj][m][0], acc[ai][bj][m][1]); }
    }
};
struct EpiPlain {
    static constexpr bool PERM = true;
    bf16_t* O; int ldc;
    __device__ __forceinline__ void operator()(const f32x4 (&acc)[2][2][4][2], const Unit& u, int wr, int wc, int fr, int fq) const {
        const int row0 = u.pm * BM + wr * 64 + fr, col0 = u.pn * BM + wc * 32 + 8 * fq;
#pragma unroll
        for (int ai = 0; ai < 2; ++ai)
#pragma unroll
            for (int m = 0; m < 4; ++m) { bf16_t* rowp = O + (size_t)(row0 + ai * HALF + m * 16) * ldc + col0;
#pragma unroll
                for (int bj = 0; bj < 2; ++bj) *(u32x4*)(rowp + bj * HALF) = pack8(acc[ai][bj][m][0], acc[ai][bj][m][1]); }
    }
};
struct EpiRes {
    static constexpr bool PERM = false;
    const float* base; float* out;
    __device__ __forceinline__ void operator()(const f32x4 (&acc)[2][2][4][2], const Unit& u, int wr, int wc, int fr, int fq) const {
        const int row0 = u.pm * BM + wr * 64 + fr, col0 = u.pn * BM + wc * 32 + 4 * fq;
#pragma unroll
        for (int ai = 0; ai < 2; ++ai)
#pragma unroll
            for (int m = 0; m < 4; ++m) { const size_t off = (size_t)(row0 + ai * HALF + m * 16) * 1024 + col0;
#pragma unroll
                for (int bj = 0; bj < 2; ++bj)
#pragma unroll
                    for (int n = 0; n < 2; ++n) { const f32x4 bs = *(const f32x4*)(base + off + bj * HALF + n * 16); *(f32x4*)(out + off + bj * HALF + n * 16) = bs + acc[ai][bj][m][n]; } }
    }
};
struct EpiSwiGLU {
    static constexpr bool PERM = true;
    bf16_t* act;
    __device__ __forceinline__ void operator()(const f32x4 (&acc)[2][2][4][2], const Unit& u, int wr, int wc, int fr, int fq) const {
        const int row0 = u.pm * BM + wr * 64 + fr, col0 = u.pn * 128 + wc * 32 + 8 * fq;
#pragma unroll
        for (int ai = 0; ai < 2; ++ai)
#pragma unroll
            for (int m = 0; m < 4; ++m) { f32x4 o[2];
#pragma unroll
                for (int n = 0; n < 2; ++n)
#pragma unroll
                    for (int i = 0; i < 4; ++i) { const float gt = acc[ai][0][m][n][i], up = acc[ai][1][m][n][i]; o[n][i] = gt * up * __builtin_amdgcn_rcpf(1.f + __expf(-gt)); }
                *(u32x4*)(act + (size_t)(row0 + ai * HALF + m * 16) * D_FF + col0) = pack8(o[0], o[1]); }
    }
};
}

struct Params { const void* in[27]; float* out; unsigned char* ws; };
enum { I_X = 0, I_POS, I_ATTN_NORM, I_W_IN, I_W_OUT, I_MU, I_W0, I_W2, I_A0, I_A2, I_G2, I_KK, I_KA, I_RK, I_GNW, I_GNB, I_V0, I_V1, I_V2,
       I_QNORM, I_KVNORM, I_WQUP, I_WKVUP, I_FFN_NORM, I_WGU, I_WDN, I_FINAL };

__device__ __forceinline__ void transpose_item(const float* W, int K, int N, bf16_t* WT, int mode, LAS float* scr, int item, int lane) {
    const int nblk = N / 32, kb = item / nblk, nb = item % nblk, k0 = 64 * kb, n0 = 32 * nb;
    int d0 = n0;
    if (mode == 1) d0 = (n0 < 896) ? n0 : n0 + 128;
    else if (mode == 2) { const int j = (n0 < D_FF) ? n0 : n0 - D_FF; d0 = 256 * (j >> 7) + (j & 127) + ((n0 < D_FF) ? 0 : 128); }
#pragma unroll 8
    for (int i = 0; i < 32; ++i) { const int kk = 2 * i + (lane >> 5); scr[kk * 33 + (lane & 31)] = W[(size_t)(k0 + kk) * N + n0 + (lane & 31)]; }
    asm volatile("s_waitcnt lgkmcnt(0)" ::: "memory");
    const int c = lane & 7;
#pragma unroll
    for (int j = 0; j < 4; ++j) { const int n = (lane >> 3) + 8 * j; const LAS float* s = scr + (8 * c) * 33 + n;
        u32x4 o; o.x = cvt_pk_bf16(s[0 * 33], s[1 * 33]); o.y = cvt_pk_bf16(s[2 * 33], s[3 * 33]); o.z = cvt_pk_bf16(s[4 * 33], s[5 * 33]); o.w = cvt_pk_bf16(s[6 * 33], s[7 * 33]);
        *(u32x4*)(WT + (size_t)(d0 + n) * K + k0 + 8 * c) = o; }
    asm volatile("s_waitcnt lgkmcnt(0)" ::: "memory");
}

__device__ __forceinline__ void rms_rows2_bf16(const float* __restrict__ x0row, const float* __restrict__ x1row, const float* __restrict__ g, bf16_t* __restrict__ o0row, bf16_t* __restrict__ o1row, int lane) {
    const f32x4* xa = (const f32x4*)x0row + lane; const f32x4* xb = (const f32x4*)x1row + lane; const f32x4* gr = (const f32x4*)g + lane;
    f32x4 va[4], vb[4]; float sa = 0.f, sb = 0.f;
#pragma unroll
    for (int j = 0; j < 4; ++j) { va[j] = xa[64 * j]; vb[j] = xb[64 * j]; }
#pragma unroll
    for (int j = 0; j < 4; ++j) { sa += (va[j].x * va[j].x + va[j].y * va[j].y) + (va[j].z * va[j].z + va[j].w * va[j].w); sb += (vb[j].x * vb[j].x + vb[j].y * vb[j].y) + (vb[j].z * vb[j].z + vb[j].w * vb[j].w); }
    const float ra = rsqrtf(wave_sum(sa) * (1.f / 1024.f) + NORM_EPS), rb = rsqrtf(wave_sum(sb) * (1.f / 1024.f) + NORM_EPS);
    u32x2* oa = (u32x2*)o0row + lane; u32x2* ob = (u32x2*)o1row + lane;
#pragma unroll
    for (int j = 0; j < 4; ++j) { const f32x4 gg = gr[64 * j]; u32x2 w;
        w.x = cvt_pk_bf16(va[j].x * ra * gg.x, va[j].y * ra * gg.y); w.y = cvt_pk_bf16(va[j].z * ra * gg.z, va[j].w * ra * gg.w); oa[64 * j] = w;
        w.x = cvt_pk_bf16(vb[j].x * rb * gg.x, vb[j].y * rb * gg.y); w.y = cvt_pk_bf16(vb[j].z * rb * gg.z, vb[j].w * rb * gg.w); ob[64 * j] = w; }
}
__device__ __forceinline__ void rms_row_bf16(const float* xrow, const float* g, bf16_t* orow, int lane) {
    const f32x4* xr = (const f32x4*)xrow + lane; const f32x4* gr = (const f32x4*)g + lane;
    f32x4 v[4]; float s = 0.f;
#pragma unroll
    for (int j = 0; j < 4; ++j) { v[j] = xr[64 * j]; s += (v[j].x * v[j].x + v[j].y * v[j].y) + (v[j].z * v[j].z + v[j].w * v[j].w); }
    const float rstd = rsqrtf(wave_sum(s) * (1.f / 1024.f) + NORM_EPS);
    u32x2* o8 = (u32x2*)orow + lane;
#pragma unroll
    for (int j = 0; j < 4; ++j) { const f32x4 gg = gr[64 * j]; u32x2 w; w.x = cvt_pk_bf16(v[j].x * rstd * gg.x, v[j].y * rstd * gg.y); w.y = cvt_pk_bf16(v[j].z * rstd * gg.z, v[j].w * rstd * gg.w); o8[64 * j] = w; }
}

constexpr int KROW = 104, VROW = 72;
constexpr int ATT_KB = 64 * KROW * 2, ATT_VB = 64 * VROW * 2;
constexpr int ATT_SCR = 2 * (ATT_KB + ATT_VB);

__device__ __forceinline__ void att_unit(LAS unsigned char* lds, int b, int h, int qb, const bf16_t* __restrict__ q, const bf16_t* __restrict__ kvb, const bf16_t* __restrict__ kr,
                                         const float* __restrict__ cosM, const float* __restrict__ sinM, bf16_t* __restrict__ mix) {
    const int tid = tid_opaque(), lane = tid & 63, w = tid >> 6, r32 = lane & 31, hi = lane >> 5;
    LAS float* scr = (LAS float*)(lds + ATT_SCR) + w * 32;
    const int qrow = qb * 256 + w * 32 + r32; const size_t tok = (size_t)b * SEQ + qrow;
    bf16x8 qf[6];
    {
        const bf16_t* qp = q + tok * 768 + h * 96 + hi * 8;
#pragma unroll
        for (int d0 = 0; d0 < 4; ++d0) qf[d0] = *(const bf16x8*)(qp + d0 * 16);
        const u32x4 x1 = *(const u32x4*)(qp + 64), x2 = *(const u32x4*)(qp + 80);
        const f32x4 c0 = *(const f32x4*)(cosM + tok * 16 + hi * 8), c1 = *(const f32x4*)(cosM + tok * 16 + hi * 8 + 4);
        const f32x4 s0 = *(const f32x4*)(sinM + tok * 16 + hi * 8), s1 = *(const f32x4*)(sinM + tok * 16 + hi * 8 + 4);
        float a[8], bb[8], cs[8] = {c0.x, c0.y, c0.z, c0.w, c1.x, c1.y, c1.z, c1.w}, sn[8] = {s0.x, s0.y, s0.z, s0.w, s1.x, s1.y, s1.z, s1.w};
#pragma unroll
        for (int j = 0; j < 4; ++j) { a[2 * j] = bflo(x1[j]); a[2 * j + 1] = bfhi(x1[j]); bb[2 * j] = bflo(x2[j]); bb[2 * j + 1] = bfhi(x2[j]); }
        u32x4 o1, o2;
#pragma unroll
        for (int j = 0; j < 4; ++j) {
            o1[j] = cvt_pk_bf16(a[2 * j] * cs[2 * j] - bb[2 * j] * sn[2 * j], a[2 * j + 1] * cs[2 * j + 1] - bb[2 * j + 1] * sn[2 * j + 1]);
            o2[j] = cvt_pk_bf16(bb[2 * j] * cs[2 * j] + a[2 * j] * sn[2 * j], bb[2 * j + 1] * cs[2 * j + 1] + a[2 * j + 1] * sn[2 * j + 1]); }
        qf[4] = __builtin_bit_cast(bf16x8, o1); qf[5] = __builtin_bit_cast(bf16x8, o2);
    }
    const int k_key = tid >> 3, k_ch = tid & 7;
    const int r_key = (tid & 255) >> 2, r_ch = tid & 3;
    const bf16_t* kn_src = kvb + ((size_t)b * SEQ + k_key) * 1024 + h * 128 + k_ch * 8;
    const bf16_t* kr_src = kr + ((size_t)b * SEQ + r_key) * 32 + r_ch * 8;
    const int kn_dst = (k_key * KROW + k_ch * 8) * 2, kr_dst = (r_key * KROW + 64 + r_ch * 8) * 2, vt_dst = (k_ch * 8 * VROW + k_key) * 2;
#define ATT_VWRITE(bufoff, gv) do { LAS bf16_t* vd_ = (LAS bf16_t*)(lds + 2 * ATT_KB + (bufoff) + vt_dst); _Pragma("unroll") for (int j_ = 0; j_ < 4; ++j_) { \
        vd_[(2 * j_) * VROW] = (bf16_t)((gv)[j_] & 0xffffu); vd_[(2 * j_ + 1) * VROW] = (bf16_t)((gv)[j_] >> 16); } } while (0)
    const int ntiles = 4 * qb + 4;
    u32x4 gk, gr, gv;
    gk = *(const u32x4*)kn_src; gv = *(const u32x4*)(kn_src + 64); if (tid < 256) gr = *(const u32x4*)kr_src;
    *(LAS u32x4*)(lds + kn_dst) = gk; ATT_VWRITE(0, gv); if (tid < 256) *(LAS u32x4*)(lds + kr_dst) = gr;
    __syncthreads();
    f32x16 o0, o1;
#pragma unroll
    for (int r = 0; r < 16; ++r) { o0[r] = 0.f; o1[r] = 0.f; }
    float mrow = -1e30f, lrow = 0.f;
    const float SC = 0.10206207261596577f * 1.4426950408889634f;
    const int wq0 = qb * 256 + w * 32;
    for (int kt = 0; kt < ntiles; ++kt) {
        const int cur = kt & 1;
        if (kt + 1 < ntiles) { const size_t ko = (size_t)(kt + 1) * 64; gk = *(const u32x4*)(kn_src + ko * 1024); gv = *(const u32x4*)(kn_src + ko * 1024 + 64); if (tid < 256) gr = *(const u32x4*)(kr_src + ko * 32); }
        const int k0 = kt * 64;
        if (k0 <= wq0 + 31) {
            const LAS unsigned char* Kb = lds + cur * ATT_KB; const LAS unsigned char* Vb = lds + 2 * ATT_KB + cur * ATT_VB;
            f32x16 p0, p1;
#pragma unroll
            for (int r = 0; r < 16; ++r) { p0[r] = 0.f; p1[r] = 0.f; }
#pragma unroll
            for (int d0 = 0; d0 < 6; ++d0) {
                const bf16x8 k0f = *(const LAS bf16x8*)(Kb + (r32 * KROW + d0 * 16 + hi * 8) * 2);
                const bf16x8 k1f = *(const LAS bf16x8*)(Kb + ((32 + r32) * KROW + d0 * 16 + hi * 8) * 2);
                p0 = MFMA32(k0f, qf[d0], p0); p1 = MFMA32(k1f, qf[d0], p1);
            }
            const bool need_mask = (k0 + 63 > wq0);
            float mx = -1e30f;
            if (need_mask) {
#pragma unroll
                for (int r = 0; r < 16; ++r) { const int key = k0 + crow(r, hi); if (key > qrow) p0[r] = -1e30f; if (key + 32 > qrow) p1[r] = -1e30f; }
            }
#pragma unroll
            for (int r = 0; r < 16; ++r) mx = fmaxf(mx, fmaxf(p0[r], p1[r]));
            mx = fmaxf(mx, __shfl_xor(mx, 32)) * SC;
            const float mnew = fmaxf(mrow, mx);
            const bool grew = __any(mnew > mrow);
            const float alpha = __builtin_amdgcn_exp2f(mrow - mnew); mrow = mnew;
            float ls = 0.f;
#pragma unroll
            for (int r = 0; r < 16; ++r) { p0[r] = __builtin_amdgcn_exp2f(__builtin_fmaf(p0[r], SC, -mnew)); p1[r] = __builtin_amdgcn_exp2f(__builtin_fmaf(p1[r], SC, -mnew)); ls += p0[r] + p1[r]; }
            lrow = lrow * alpha + ls;
            if (grew) {
                if (hi == 0) scr[r32] = alpha;
                asm volatile("s_waitcnt lgkmcnt(0)" ::: "memory");
#pragma unroll
                for (int i = 0; i < 4; ++i) { const f32x4 al = *(const LAS f32x4*)(scr + 8 * i + 4 * hi);
#pragma unroll
                    for (int j = 0; j < 4; ++j) { o0[4 * i + j] *= al[j]; o1[4 * i + j] *= al[j]; } }
                asm volatile("s_waitcnt lgkmcnt(0)" ::: "memory");
            }
#pragma unroll
            for (int s = 0; s < 4; ++s) {
                u32x4 pw;
#pragma unroll
                for (int j = 0; j < 4; ++j) pw[j] = (s < 2) ? cvt_pk_bf16(p0[8 * (s & 1) + 2 * j], p0[8 * (s & 1) + 2 * j + 1]) : cvt_pk_bf16(p1[8 * (s & 1) + 2 * j], p1[8 * (s & 1) + 2 * j + 1]);
                const bf16x8 pa = __builtin_bit_cast(bf16x8, pw);
#pragma unroll
                for (int dvh = 0; dvh < 2; ++dvh) {
                    const LAS unsigned char* vp = Vb + ((dvh * 32 + r32) * VROW + 16 * s + 4 * hi) * 2;
                    const u32x2 lo = *(const LAS u32x2*)vp, hh = *(const LAS u32x2*)(vp + 16);
                    u32x4 vv; vv.x = lo.x; vv.y = lo.y; vv.z = hh.x; vv.w = hh.y;
                    if (dvh == 0) o0 = MFMA32(pa, __builtin_bit_cast(bf16x8, vv), o0); else o1 = MFMA32(pa, __builtin_bit_cast(bf16x8, vv), o1);
                }
            }
        }
        if (kt + 1 < ntiles) { const int nx = cur ^ 1; *(LAS u32x4*)(lds + nx * ATT_KB + kn_dst) = gk; ATT_VWRITE(nx * ATT_VB, gv); if (tid < 256) *(LAS u32x4*)(lds + nx * ATT_KB + kr_dst) = gr; }
        __syncthreads();
    }
    float lt = lrow + __shfl_xor(lrow, 32);
    if (hi == 0) scr[r32] = 1.f / lt;
    asm volatile("s_waitcnt lgkmcnt(0)" ::: "memory");
#pragma unroll
    for (int i = 0; i < 4; ++i) { const f32x4 il = *(const LAS f32x4*)(scr + 8 * i + 4 * hi);
#pragma unroll
        for (int j = 0; j < 4; ++j) { const int r = 4 * i + j; const size_t orow = (size_t)b * SEQ + qb * 256 + w * 32 + crow(r, hi);
            mix[orow * 1024 + 512 + h * 64 + r32] = f2bf(o0[r] * il[j]); mix[orow * 1024 + 512 + h * 64 + 32 + r32] = f2bf(o1[r] * il[j]); } }
    asm volatile("s_waitcnt lgkmcnt(0)" ::: "memory");
}

__device__ __forceinline__ void ret_unit(LAS unsigned char* lds, int b, int h, int jb, const bf16_t* __restrict__ pb, const float* __restrict__ cosR, const float* __restrict__ sinR,
                                         const bf16_t* __restrict__ rprev, float* __restrict__ yb) {
    const int tid = tid_opaque(), lane = tid & 63, w = tid >> 6, r32 = lane & 31, hi = lane >> 5;
    const float lg2 = log2f(1.f - exp2f(-5.f - (float)h));
    const int qrow = jb * 256 + w * 32 + r32; const size_t tok = (size_t)b * SEQ + qrow;
    const int chunk = qrow >> 7;
    bf16x8 qf[4], qx[4];
    {
        const bf16_t* qp = pb + tok * 1024 + h * 64 + hi * 8;
        const float qdec = exp2f(lg2 * (float)((qrow & 127) + 1));
#pragma unroll
        for (int d0 = 0; d0 < 2; ++d0) {
            const u32x4 x1 = *(const u32x4*)(qp + d0 * 16), x2 = *(const u32x4*)(qp + d0 * 16 + 32);
            const float* cp = cosR + tok * 32 + d0 * 16 + hi * 8; const float* sp = sinR + tok * 32 + d0 * 16 + hi * 8;
            const f32x4 c0 = *(const f32x4*)cp, c1 = *(const f32x4*)(cp + 4), s0 = *(const f32x4*)sp, s1 = *(const f32x4*)(sp + 4);
            const float cs[8] = {c0.x, c0.y, c0.z, c0.w, c1.x, c1.y, c1.z, c1.w}, sn[8] = {s0.x, s0.y, s0.z, s0.w, s1.x, s1.y, s1.z, s1.w};
            u32x4 o1, o2, y1, y2;
#pragma unroll
            for (int j = 0; j < 4; ++j) {
                const float a0 = bflo(x1[j]), a1 = bfhi(x1[j]), b0 = bflo(x2[j]), b1 = bfhi(x2[j]);
                const float r0 = a0 * cs[2 * j] - b0 * sn[2 * j], r1 = a1 * cs[2 * j + 1] - b1 * sn[2 * j + 1];
                const float t0 = b0 * cs[2 * j] + a0 * sn[2 * j], t1 = b1 * cs[2 * j + 1] + a1 * sn[2 * j + 1];
                o1[j] = cvt_pk_bf16(r0, r1); o2[j] = cvt_pk_bf16(t0, t1); y1[j] = cvt_pk_bf16(r0 * qdec, r1 * qdec); y2[j] = cvt_pk_bf16(t0 * qdec, t1 * qdec); }
            qf[d0] = __builtin_bit_cast(bf16x8, o1); qf[d0 + 2] = __builtin_bit_cast(bf16x8, o2); qx[d0] = __builtin_bit_cast(bf16x8, y1); qx[d0 + 2] = __builtin_bit_cast(bf16x8, y2);
        }
    }
    f32x16 o0, o1;
#pragma unroll
    for (int r = 0; r < 16; ++r) { o0[r] = 0.f; o1[r] = 0.f; }
    {
        const bf16_t* rp = rprev + ((size_t)((b * 4 + h) * 32 + chunk)) * 4096;
#pragma unroll
        for (int d0 = 0; d0 < 4; ++d0) {
            const bf16x8 r0 = *(const bf16x8*)(rp + (size_t)r32 * 64 + d0 * 16 + hi * 8), r1 = *(const bf16x8*)(rp + (size_t)(32 + r32) * 64 + d0 * 16 + hi * 8);
            o0 = MFMA32(qx[d0], r0, o0); o1 = MFMA32(qx[d0], r1, o1);
        }
    }
    const int l_key = (tid & 255) >> 2, l_c = tid & 3;
    for (int kt = 0; kt < 4; ++kt) {
        const int k0 = jb * 256 + kt * 64;
        __syncthreads();
        if (tid < 256) {
            const size_t kt_tok = (size_t)b * SEQ + k0 + l_key; const bf16_t* kp = pb + kt_tok * 1024 + 256 + h * 64 + l_c * 8;
            const u32x4 x1 = *(const u32x4*)kp, x2 = *(const u32x4*)(kp + 32);
            const float* cp = cosR + kt_tok * 32 + l_c * 8; const float* sp = sinR + kt_tok * 32 + l_c * 8;
            const f32x4 c0 = *(const f32x4*)cp, c1 = *(const f32x4*)(cp + 4), s0 = *(const f32x4*)sp, s1 = *(const f32x4*)(sp + 4);
            const float cs[8] = {c0.x, c0.y, c0.z, c0.w, c1.x, c1.y, c1.z, c1.w}, sn[8] = {s0.x, s0.y, s0.z, s0.w, s1.x, s1.y, s1.z, s1.w};
            u32x4 o1v, o2v;
#pragma unroll
            for (int j = 0; j < 4; ++j) {
                const float a0 = bflo(x1[j]), a1 = bfhi(x1[j]), b0 = bflo(x2[j]), b1 = bfhi(x2[j]);
                o1v[j] = cvt_pk_bf16((a0 * cs[2 * j] - b0 * sn[2 * j]) * 0.125f, (a1 * cs[2 * j + 1] - b1 * sn[2 * j + 1]) * 0.125f);
                o2v[j] = cvt_pk_bf16((b0 * cs[2 * j] + a0 * sn[2 * j]) * 0.125f, (b1 * cs[2 * j + 1] + a1 * sn[2 * j + 1]) * 0.125f); }
            *(LAS u32x4*)(lds + (l_key * KROW + l_c * 8) * 2) = o1v; *(LAS u32x4*)(lds + (l_key * KROW + 32 + l_c * 8) * 2) = o2v;
        } else {
            const size_t vt_tok = (size_t)b * SEQ + k0 + l_key; const bf16_t* vp = pb + vt_tok * 1024 + 512 + h * 64 + l_c * 16;
            const u32x4 x1 = *(const u32x4*)vp, x2 = *(const u32x4*)(vp + 8);
            LAS bf16_t* vd = (LAS bf16_t*)(lds + 2 * ATT_KB) + l_key;
#pragma unroll
            for (int j = 0; j < 4; ++j) { vd[(l_c * 16 + 2 * j) * VROW] = (bf16_t)(x1[j] & 0xffffu); vd[(l_c * 16 + 2 * j + 1) * VROW] = (bf16_t)(x1[j] >> 16);
                                          vd[(l_c * 16 + 8 + 2 * j) * VROW] = (bf16_t)(x2[j] & 0xffffu); vd[(l_c * 16 + 8 + 2 * j + 1) * VROW] = (bf16_t)(x2[j] >> 16); }
        }
        __syncthreads();
        if ((k0 >> 7) == chunk && k0 <= jb * 256 + w * 32 + 31) {
            const LAS unsigned char* Kb = lds; const LAS unsigned char* Vb = lds + 2 * ATT_KB;
            f32x16 p0, p1;
#pragma unroll
            for (int r = 0; r < 16; ++r) { p0[r] = 0.f; p1[r] = 0.f; }
#pragma unroll
            for (int d0 = 0; d0 < 4; ++d0) {
                const bf16x8 k0f = *(const LAS bf16x8*)(Kb + (r32 * KROW + d0 * 16 + hi * 8) * 2);
                const bf16x8 k1f = *(const LAS bf16x8*)(Kb + ((32 + r32) * KROW + d0 * 16 + hi * 8) * 2);
                p0 = MFMA32(k0f, qf[d0], p0); p1 = MFMA32(k1f, qf[d0], p1);
            }
#pragma unroll
            for (int r = 0; r < 16; ++r) {
                const int df0 = qrow - (k0 + crow(r, hi)), df1 = df0 - 32;
                p0[r] = (df0 >= 0) ? p0[r] * __builtin_amdgcn_exp2f(lg2 * (float)df0) : 0.f;
                p1[r] = (df1 >= 0) ? p1[r] * __builtin_amdgcn_exp2f(lg2 * (float)df1) : 0.f;
            }
#pragma unroll
            for (int s = 0; s < 4; ++s) {
                u32x4 pw;
#pragma unroll
                for (int j = 0; j < 4; ++j) pw[j] = (s < 2) ? cvt_pk_bf16(p0[8 * (s & 1) + 2 * j], p0[8 * (s & 1) + 2 * j + 1]) : cvt_pk_bf16(p1[8 * (s & 1) + 2 * j], p1[8 * (s & 1) + 2 * j + 1]);
                const bf16x8 pa = __builtin_bit_cast(bf16x8, pw);
#pragma unroll
                for (int dvh = 0; dvh < 2; ++dvh) {
                    const LAS unsigned char* vp = Vb + ((dvh * 32 + r32) * VROW + 16 * s + 4 * hi) * 2;
                    const u32x2 lo = *(const LAS u32x2*)vp, hh = *(const LAS u32x2*)(vp + 16);
                    u32x4 vv; vv.x = lo.x; vv.y = lo.y; vv.z = hh.x; vv.w = hh.y;
                    if (dvh == 0) o0 = MFMA32(pa, __builtin_bit_cast(bf16x8, vv), o0); else o1 = MFMA32(pa, __builtin_bit_cast(bf16x8, vv), o1);
                }
            }
        }
    }
#pragma unroll
    for (int r = 0; r < 16; ++r) { const size_t orow = (size_t)b * SEQ + jb * 256 + w * 32 + crow(r, hi);
        yb[orow * 256 + h * 64 + r32] = o0[r]; yb[orow * 256 + h * 64 + 32 + r32] = o1[r]; }
}

__device__ __forceinline__ void ret_kv_unit(LAS unsigned char* lds, int bh, int ci, const bf16_t* __restrict__ pb, const float* __restrict__ cosR, const float* __restrict__ sinR, float* __restrict__ kvt) {
    const int tid = tid_opaque(); const int b = bh >> 2, h = bh & 3;
    LAS float* Ks = (LAS float*)lds;
    LAS float* Vs = Ks + 128 * 64;
    const float lg2 = log2f(1.f - exp2f(-5.f - (float)h));
    __syncthreads();
    {
        const int i = tid & 31; float x1[8], x2[8], cc[8], ss[8];
#pragma unroll
        for (int it = 0; it < 8; ++it) { const int t = (tid >> 5) + 16 * it; const size_t tok = (size_t)b * SEQ + ci * 128 + t;
            x1[it] = bf2f(pb[tok * 1024 + 256 + h * 64 + i]); x2[it] = bf2f(pb[tok * 1024 + 256 + h * 64 + 32 + i]); cc[it] = cosR[tok * 32 + i]; ss[it] = sinR[tok * 32 + i]; }
#pragma unroll
        for (int it = 0; it < 8; ++it) { const int t = (tid >> 5) + 16 * it; const float sc = 0.125f * exp2f(lg2 * (float)(127 - t));
            Ks[t * 64 + i] = (x1[it] * cc[it] - x2[it] * ss[it]) * sc; Ks[t * 64 + 32 + i] = (x2[it] * cc[it] + x1[it] * ss[it]) * sc; }
        u32x4 vr[2];
#pragma unroll
        for (int it = 0; it < 2; ++it) { const int ch = tid + 512 * it, t = ch >> 3, c8 = ch & 7; vr[it] = *(const u32x4*)(pb + ((size_t)b * SEQ + ci * 128 + t) * 1024 + 512 + h * 64 + c8 * 8); }
#pragma unroll
        for (int it = 0; it < 2; ++it) { const int ch = tid + 512 * it, t = ch >> 3, c8 = ch & 7; LAS float* d = Vs + t * 64 + c8 * 8;
            *(LAS f32x4*)d = (f32x4){bflo(vr[it].x), bfhi(vr[it].x), bflo(vr[it].y), bfhi(vr[it].y)}; *(LAS f32x4*)(d + 4) = (f32x4){bflo(vr[it].z), bfhi(vr[it].z), bflo(vr[it].w), bfhi(vr[it].w)}; }
    }
    __syncthreads();
    const int e = tid >> 3, d0 = (tid & 7) * 8;
    float acc[8];
#pragma unroll
    for (int j = 0; j < 8; ++j) acc[j] = 0.f;
    for (int t = 0; t < 128; ++t) {
        const float v = Vs[t * 64 + e]; const f32x4 ka = *(const LAS f32x4*)(Ks + t * 64 + d0), kb = *(const LAS f32x4*)(Ks + t * 64 + d0 + 4);
        acc[0] += v * ka.x; acc[1] += v * ka.y; acc[2] += v * ka.z; acc[3] += v * ka.w; acc[4] += v * kb.x; acc[5] += v * kb.y; acc[6] += v * kb.z; acc[7] += v * kb.w;
    }
    float* o = kvt + ((size_t)(bh * 32 + ci)) * 4096 + e * 64 + d0;
    *(f32x4*)o = (f32x4){acc[0], acc[1], acc[2], acc[3]}; *(f32x4*)(o + 4) = (f32x4){acc[4], acc[5], acc[6], acc[7]};
}

struct PrepW { bf16x8 Bw[2], Ba[2], Bv[2], Bg[2][2], Bv1[2]; };
__device__ __forceinline__ bf16x8 pack_col8(const float* W, int ld, int k0, int n) {
    float t[8];
#pragma unroll
    for (int j = 0; j < 8; ++j) t[j] = W[(size_t)(k0 + j) * ld + n];
    u32x4 o; o.x = cvt_pk_bf16(t[0], t[1]); o.y = cvt_pk_bf16(t[2], t[3]); o.z = cvt_pk_bf16(t[4], t[5]); o.w = cvt_pk_bf16(t[6], t[7]);
    return __builtin_bit_cast(bf16x8, o);
}
__device__ __forceinline__ bf16x8 pack_f8(const f32x4 a, const f32x4 b) {
    u32x4 o; o.x = cvt_pk_bf16(a.x, a.y); o.y = cvt_pk_bf16(a.z, a.w); o.z = cvt_pk_bf16(b.x, b.y); o.w = cvt_pk_bf16(b.z, b.w);
    return __builtin_bit_cast(bf16x8, o);
}
#define MFMA16(a, b, c) __builtin_amdgcn_mfma_f32_16x16x32_bf16((a), (b), (c), 0, 0, 0)
__device__ __forceinline__ void prep_fetch_rows(unsigned (&raw)[17], const bf16_t* __restrict__ pa, int t0, int c2) {
    raw[0] = ((t0 & (SEQ - 1)) == 0) ? 0u : *(const unsigned*)(pa + (size_t)(t0 - 1) * 1024 + c2);
#pragma unroll
    for (int t = 0; t < 16; ++t) raw[t + 1] = *(const unsigned*)(pa + (size_t)(t0 + t) * 1024 + c2);
}
constexpr int PSW = 900;
__device__ __forceinline__ void rwkv_prep_tile(LAS unsigned char* lds, int tile, int next_tile, unsigned (&raw)[17], int layer, const Params& P, int z, const PrepW& W, const bf16_t* __restrict__ pa, unsigned char* __restrict__ rec,
                                               bf16_t* __restrict__ vbuf, bf16_t* __restrict__ gbuf, bf16_t* __restrict__ vfirst, float* __restrict__ bs, float* __restrict__ cs) {
    const int tid = tid_opaque(), lane = tid & 63;
    LAS float* PS = (LAS float*)lds;
    LAS float* VV = PS + 16 * PSW;
    const float* mu = (const float*)P.in[I_MU + z] + layer * RW_IN;
    const float* w0 = (const float*)P.in[I_W0 + z] + layer * 256; const float* w2 = (const float*)P.in[I_W2 + z] + layer * 32 * 256;
    const float* a0 = (const float*)P.in[I_A0 + z] + layer * 256; const float* a2 = (const float*)P.in[I_A2 + z] + layer * 32 * 256;
    const float* g2 = (const float*)P.in[I_G2 + z] + layer * 64 * 256;
    const float* k_k = (const float*)P.in[I_KK + z] + layer * 256; const float* k_a = (const float*)P.in[I_KA + z] + layer * 256; const float* r_k = (const float*)P.in[I_RK + z] + layer * 256;
    const float* v0 = (const float*)P.in[I_V0 + z] + (layer > 0 ? (layer - 1) * 256 : 0);
    const float* v1 = (const float*)P.in[I_V1 + z] + (layer > 0 ? (layer - 1) * 256 * 32 : 0);
    const float* v2 = (const float*)P.in[I_V2 + z] + (layer > 0 ? (layer - 1) * 32 * 256 : 0);
    const int t0 = tile * 16;
    __syncthreads();
    if (tid < 448) {
        const int c2 = tid * 2; const float mu0 = mu[c2], mu1 = mu[c2 + 1];
#pragma unroll
        for (int t = 0; t < 16; ++t) {
            float x0 = bflo(raw[t + 1]), x1 = bfhi(raw[t + 1]); const float y0 = bflo(raw[t]), y1 = bfhi(raw[t]);
            x0 = x0 + (y0 - x0) * mu0; x1 = x1 + (y1 - x1) * mu1;
            if (c2 >= 768) { if (c2 < 800) { x0 = 2.f * sigmoidf_(2.f * x0) - 1.f; x1 = 2.f * sigmoidf_(2.f * x1) - 1.f; } else if (c2 >= 832) { x0 = sigmoidf_(x0); x1 = sigmoidf_(x1); } }
            *(LAS f32x2*)(PS + t * PSW + c2) = (f32x2){x0, x1};
        }
        if (next_tile >= 0) prep_fetch_rows(raw, pa, next_tile * 16, c2);
    }
    if (layer > 0) VV[tid] = 0.f;
    __syncthreads();
    const int wv = tid >> 6, l16 = lane & 15, lq = lane >> 4;
    LAS float* LR = VV + 512;
    const f32x4 zero4 = {0.f, 0.f, 0.f, 0.f};
    if (layer > 0) {
        const LAS float* ap = PS + l16 * PSW + 512 + 32 * wv + 8 * lq;
        const bf16x8 A = pack_f8(*(const LAS f32x4*)ap, *(const LAS f32x4*)(ap + 4));
#pragma unroll
        for (int nt = 0; nt < 2; ++nt) { const f32x4 d = MFMA16(A, W.Bv1[nt], zero4);
#pragma unroll
            for (int r = 0; r < 4; ++r) (void)__builtin_amdgcn_ds_faddf(VV + (4 * lq + r) * 32 + 16 * nt + l16, d[r], 0, 0, false); }
        __syncthreads();
    }
    {
        const LAS float* ap = PS + l16 * PSW + 768 + 8 * lq;
        const bf16x8 Aw = pack_f8(*(const LAS f32x4*)ap, *(const LAS f32x4*)(ap + 4)), Aa = pack_f8(*(const LAS f32x4*)(ap + 32), *(const LAS f32x4*)(ap + 36));
        const bf16x8 Ag0 = pack_f8(*(const LAS f32x4*)(ap + 64), *(const LAS f32x4*)(ap + 68)), Ag1 = pack_f8(*(const LAS f32x4*)(ap + 96), *(const LAS f32x4*)(ap + 100));
        bf16x8 Av = Aw;
        if (layer > 0) { const LAS float* vp = VV + l16 * 32 + 8 * lq; Av = pack_f8(*(const LAS f32x4*)vp, *(const LAS f32x4*)(vp + 4)); }
#pragma unroll
        for (int nt = 0; nt < 2; ++nt) {
            const f32x4 dw = MFMA16(Aw, W.Bw[nt], zero4), da = MFMA16(Aa, W.Ba[nt], zero4);
            f32x4 dg = MFMA16(Ag0, W.Bg[nt][0], zero4); dg = MFMA16(Ag1, W.Bg[nt][1], dg);
            f32x4 dv = zero4; if (layer > 0) dv = MFMA16(Av, W.Bv[nt], zero4);
            const int ch = 16 * (2 * wv + nt) + l16;
#pragma unroll
            for (int r = 0; r < 4; ++r) { LAS float* o = LR + (4 * lq + r) * 256 + ch; o[0] = dw[r]; o[4096] = da[r]; o[8192] = dg[r]; o[12288] = dv[r]; }
        }
    }
    __syncthreads();
    const int c = tid & 255, th = tid >> 8;
    float aw[8], aa[8], ag[8], av[8];
#pragma unroll
    for (int i = 0; i < 8; ++i) { const LAS float* o = LR + (th * 8 + i) * 256 + c; aw[i] = o[0]; aa[i] = o[4096]; ag[i] = o[8192]; av[i] = o[12288]; }
    const float w0c = w0[c], a0c = a0[c], kkc = k_k[c], kac = k_a[c], rkc = r_k[c], v0c = (layer > 0) ? v0[c] : 0.f;
    const int head = c >> 6, kq = (c & 63) >> 2, e = c & 3;
    float kk_[8], b_[8], kp_[8], dec_[8], r_[8], v_[8], a_[8], q_[8];
#pragma unroll
    for (int i = 0; i < 8; ++i) {
        const int t = th * 8 + i; const size_t tok = (size_t)t0 + t;
        const float r = PS[t * PSW + c], k = PS[t * PSW + 256 + c]; float v = PS[t * PSW + 512 + c];
        dec_[i] = __expf(-0.6065306597126334f * sigmoidf_(w0c + aw[i]));
        const float a = sigmoidf_(a0c + aa[i]);
        if (layer > 0) { const float vf = bf2f(vfirst[tok * 256 + c]); v = v + (vf - v) * sigmoidf_(v0c + av[i]); }
        else vfirst[tok * 256 + c] = f2bf(v);
        r_[i] = r; v_[i] = v; a_[i] = a; kk_[i] = k * kkc; kp_[i] = k * (1.f + (a - 1.f) * kac);
        q_[i] = kk_[i] * kk_[i];
    }
#pragma unroll
    for (int i = 0; i < 8; ++i) q_[i] = wave_sum(q_[i]);
#pragma unroll
    for (int i = 0; i < 8; ++i) { kk_[i] *= rsqrtf(fmaxf(q_[i], 1e-24f)); b_[i] = kk_[i] * a_[i]; q_[i] = r_[i] * kp_[i] * rkc; }
#pragma unroll
    for (int i = 0; i < 8; ++i) q_[i] = wave_sum(q_[i]);
    float d1_[4], d2_[4];
#pragma unroll
    for (int j = 0; j < 4; ++j) { d1_[j] = b_[2 * j] * kk_[2 * j + 1]; d2_[j] = kp_[2 * j] * kk_[2 * j + 1]; }
#pragma unroll
    for (int j = 0; j < 4; ++j) { d1_[j] = wave_sum(d1_[j]); d2_[j] = wave_sum(d2_[j]); }
#pragma unroll
    for (int i = 0; i < 8; ++i) {
        const int t = th * 8 + i; const size_t tok = (size_t)t0 + t;
        const size_t ri = tok * 256 + c;
        ((float*)rec)[ri] = dec_[i]; ((bf16_t*)(rec + 16 * MiB))[ri] = f2bf(r_[i]); ((bf16_t*)(rec + 24 * MiB))[ri] = f2bf(kp_[i]); ((bf16_t*)(rec + 40 * MiB))[ri] = f2bf(b_[i]);
        if ((i & 1) == 0) ((bf16_t*)(rec + 32 * MiB))[ri] = f2bf(-kk_[i]);
        else {
            ((bf16_t*)(rec + 32 * MiB))[ri] = f2bf(kk_[i - 1] * d1_[i >> 1] - dec_[i - 1] * kk_[i]);
            if (lane == 0) cs[tok * 4 + head] = -d2_[i >> 1];
        }
        vbuf[tok * 256 + c] = f2bf(v_[i]); gbuf[tok * 256 + c] = f2bf(ag[i]);
        if (lane == 0) bs[tok * 4 + head] = q_[i];
    }
}

constexpr int SC_TC = 32;
constexpr int SC_REC_F = SC_TC * 16 * 20;
constexpr int SC_V_F = SC_TC * 20;
__device__ __forceinline__ void scan_load_chunk(LAS float* recb, LAS float* vb, const unsigned char* __restrict__ rec, const bf16_t* __restrict__ vbuf, const float* __restrict__ cs, size_t tok0, int h, int v0, int lt) {
#pragma unroll
    for (int it = 0; it < 2; ++it) {
        const int p = lt + it * 256, step = p >> 4, kq = p & 15;
        const size_t ri = (tok0 + step) * 256 + h * 64 + 4 * kq;
        const f32x4 wv = *(const f32x4*)((const float*)rec + ri);
        const u32x2 rr = *(const u32x2*)((const bf16_t*)(rec + 16 * MiB) + ri), kk2 = *(const u32x2*)((const bf16_t*)(rec + 24 * MiB) + ri);
        const u32x2 nn = *(const u32x2*)((const bf16_t*)(rec + 32 * MiB) + ri), bb = *(const u32x2*)((const bf16_t*)(rec + 40 * MiB) + ri);
        const u32x4 a = {rr.x, rr.y, kk2.x, kk2.y}, bq = {nn.x, nn.y, bb.x, bb.y};
        LAS float* d = recb + (step * 16 + kq) * 20;
        *(LAS f32x4*)d = wv;
        *(LAS f32x4*)(d + 4) = (f32x4){bflo(a.x), bfhi(a.x), bflo(a.y), bfhi(a.y)};
        *(LAS f32x4*)(d + 8) = (f32x4){bflo(a.z), bfhi(a.z), bflo(a.w), bfhi(a.w)};
        *(LAS f32x4*)(d + 12) = (f32x4){bflo(bq.x), bfhi(bq.x), bflo(bq.y), bfhi(bq.y)};
        *(LAS f32x4*)(d + 16) = (f32x4){bflo(bq.z), bfhi(bq.z), bflo(bq.w), bfhi(bq.w)};
    }
    if (lt < 128) { const int step = lt >> 2, qd = lt & 3;
        const u32x2 x = *(const u32x2*)(vbuf + (tok0 + step) * 256 + h * 64 + v0 + 4 * qd);
        *(LAS f32x4*)(vb + step * 20 + 4 * qd) = (f32x4){bflo(x.x), bfhi(x.x), bflo(x.y), bfhi(x.y)}; }
    else if (lt < 128 + SC_TC) { const int step = lt - 128; vb[step * 20 + 16] = cs[(tok0 + step) * 4 + h]; }
}
__device__ __forceinline__ void rwkv_scan_block(LAS unsigned char* lds, int blk, const unsigned char* __restrict__ rec, const bf16_t* __restrict__ vbuf, const float* __restrict__ cs, float* __restrict__ ya) {
    const int tid = tid_opaque(), lane = tid & 63, w = tid >> 6;
    const int bh = blk >> 2, b = bh >> 2, h = bh & 3, v0 = (blk & 3) * 16;
    LAS float* RECB = (LAS float*)lds;
    LAS float* VB = RECB + 2 * SC_REC_F;
    const size_t tokb = (size_t)b * SEQ;
    const int rowl = lane >> 4, kq = lane & 15, row = v0 + 4 * (w & 3) + rowl;
    f32x2 Sa = {0.f, 0.f}, Sb = {0.f, 0.f}; float ykeep = 0.f;
    __syncthreads();
    if (w >= 4) scan_load_chunk(RECB, VB, rec, vbuf, cs, tokb, h, v0, tid - 256);
    for (int c = 0; c < SEQ / SC_TC; ++c) {
        __syncthreads();
        const int buf = c & 1;
        if (w >= 4) { if (c + 1 < SEQ / SC_TC) scan_load_chunk(RECB + (buf ^ 1) * SC_REC_F, VB + (buf ^ 1) * SC_V_F, rec, vbuf, cs, tokb + (size_t)(c + 1) * SC_TC, h, v0, tid - 256); }
        else {
            const LAS float* rb = RECB + buf * SC_REC_F + kq * 20; const LAS float* vb = VB + buf * SC_V_F;
            float* yo = ya + (tokb + (size_t)c * SC_TC + kq) * 256 + h * 64 + row;
#define SC_LD(P, st) do { const LAS float* R_ = rb + (st) * 320; P##w = *(const LAS f32x4*)R_; P##r = *(const LAS f32x4*)(R_ + 4); P##k = *(const LAS f32x4*)(R_ + 8); \
                          P##n = *(const LAS f32x4*)(R_ + 12); P##b = *(const LAS f32x4*)(R_ + 16); P##v = vb[(st) * 20 + 4 * w + rowl]; } while (0)
#define LO2(q_) ((f32x2){(q_).x, (q_).y})
#define HI2(q_) ((f32x2){(q_).z, (q_).w})
            f32x4 Aw, Ar, Ak, An, Ab, Bw, Br, Bk, Bn, Bb, Cw, Cr, Ck, Cn, Cb, Dw, Dr, Dk, Dn, Db; float Av, Bv, Cv, Dv, Bc, Dc;
            SC_LD(A, 0); SC_LD(B, 1); Bc = vb[1 * 20 + 16];
#pragma unroll
            for (int st = 0; st < SC_TC; st += 4) {
                if (st + 2 < SC_TC) { SC_LD(C, st + 2); SC_LD(D, st + 3); Dc = vb[(st + 3) * 20 + 16]; }
#define SC_PAIR(E, O, Oc, S0) do { \
                f32x2 d0 = Sa * LO2(E##n); d0 = Sb * HI2(E##n) + d0; f32x2 d1 = Sa * LO2(O##n); d1 = Sb * HI2(O##n) + d1; \
                const f32x2 ve = {E##v, E##v}, vo = {O##v, O##v}; \
                f32x2 ta = ve * LO2(E##k), tb = ve * HI2(E##k); ta = Sa * LO2(E##w) + ta; tb = Sb * HI2(E##w) + tb; \
                const float sa0 = allreduce16(d0.x + d0.y); const float sa1 = allreduce16(d1.x + d1.y) + E##v * Oc; \
                const f32x2 s0 = {sa0, sa0}, s1 = {sa1, sa1}; \
                Sa = s0 * LO2(E##b) + ta; Sb = s0 * HI2(E##b) + tb; \
                f32x2 e0 = Sa * LO2(E##r); e0 = Sb * HI2(E##r) + e0; \
                f32x2 ua = vo * LO2(O##k), ub = vo * HI2(O##k); ua = Sa * LO2(O##w) + ua; ub = Sb * HI2(O##w) + ub; \
                Sa = s1 * LO2(O##b) + ua; Sb = s1 * HI2(O##b) + ub; \
                f32x2 e1 = Sa * LO2(O##r); e1 = Sb * HI2(O##r) + e1; \
                Y0 = e0.x + e0.y; Y1 = e1.x + e1.y; } while (0)
                float yp0, yp1, yp2, yp3;
#define Y0 yp0
#define Y1 yp1
                SC_PAIR(A, B, Bc, st);
#undef Y0
#undef Y1
                if (st + 4 < SC_TC) { SC_LD(A, st + 4); SC_LD(B, st + 5); Bc = vb[(st + 5) * 20 + 16]; }
#define Y0 yp2
#define Y1 yp3
                SC_PAIR(C, D, Dc, st + 2);
#undef Y0
#undef Y1
                {
                    const unsigned long long b0 = 0xAAAAAAAAAAAAAAAAull, b1 = 0xCCCCCCCCCCCCCCCCull;
                    float s01, x01, s23, x23;
                    asm volatile("v_cndmask_b32_e64 %0, %1, %2, %3" : "=v"(s01) : "v"(yp0), "v"(yp1), "s"(b0));
                    asm volatile("v_cndmask_b32_e64 %0, %1, %2, %3" : "=v"(x01) : "v"(yp1), "v"(yp0), "s"(b0));
                    asm volatile("v_cndmask_b32_e64 %0, %1, %2, %3" : "=v"(s23) : "v"(yp2), "v"(yp3), "s"(b0));
                    asm volatile("v_cndmask_b32_e64 %0, %1, %2, %3" : "=v"(x23) : "v"(yp3), "v"(yp2), "s"(b0));
                    const float a01 = s01 + dpp_mov<0xB1>(x01), a23 = s23 + dpp_mov<0xB1>(x23);
                    float sq, xq;
                    asm volatile("v_cndmask_b32_e64 %0, %1, %2, %3" : "=v"(sq) : "v"(a01), "v"(a23), "s"(b1));
                    asm volatile("v_cndmask_b32_e64 %0, %1, %2, %3" : "=v"(xq) : "v"(a23), "v"(a01), "s"(b1));
                    float yq = sq + dpp_mov<0x4E>(xq);
                    yq += dpp_mov<0x128>(yq); yq += dpp_mov<0x124>(yq);
                    const unsigned long long mk = 0x000F000F000F000Full << (st & 15);
                    asm volatile("v_cndmask_b32_e64 %0, %0, %1, %2" : "+v"(ykeep) : "v"(yq), "s"(mk));
                }
                if ((st & 15) == 12) yo[(size_t)(st - 12) * 256] = ykeep;
            }
#undef SC_PAIR
#undef SC_LD
#undef LO2
#undef HI2
        }
    }
}

#define XB_TMO      128
#define XB_XCNT(j)  (256  + 64 * (j))
#define XB_XSUB(j)  (1280 + 64 * (j))
#define XB_XGEN(j)  (2304 + 64 * (j))
#define XB_TOP      3328
#define XB_TOPGEN   3392
#define XB_SPIN_CAP (1u << 20)
__device__ __forceinline__ unsigned xb_ld(unsigned* p)              { return __hip_atomic_load(p, __ATOMIC_RELAXED, __HIP_MEMORY_SCOPE_AGENT); }
__device__ __forceinline__ unsigned xb_add(unsigned* p, unsigned v) { return __hip_atomic_fetch_add(p, v, __ATOMIC_RELAXED, __HIP_MEMORY_SCOPE_AGENT); }
__device__ __forceinline__ unsigned xb_xcc_id() { return (unsigned)__builtin_amdgcn_s_getreg((3 << 11) | 20) & 0xFu; }
#define XB_SPIN(cond, bar) do { unsigned _sp = 0; while (cond) { __builtin_amdgcn_s_sleep(1); \
    if ((++_sp & 255u) == 0u) { if (xb_ld(&(bar)[XB_TMO])) break; if (_sp > XB_SPIN_CAP) { atomicAdd(&(bar)[XB_TMO], 1u); break; } } } } while (0)
struct XcdBarrier { unsigned* bar; unsigned x; volatile LAS unsigned* st; };
__device__ __forceinline__ XcdBarrier xcd_barrier_post(unsigned* bar, volatile LAS unsigned* st) {
    XcdBarrier b; b.bar = bar; b.x = xb_xcc_id(); b.st = st;
    if (__builtin_amdgcn_workitem_id_x() == 0) (void)xb_add(&bar[XB_XCNT(b.x)], 1u);
    return b;
}
__device__ __forceinline__ void xcd_barrier_complete(unsigned* bar, unsigned x, unsigned& nloc, unsigned& nx) {
    const unsigned G = gridDim.x * gridDim.y * gridDim.z;
    unsigned sum, cnt, mine, sp = 0u;
    for (;;) {
        sum = 0u; cnt = 0u; mine = 0u;
#pragma unroll
        for (unsigned j = 0; j < 16; ++j) { const unsigned c = xb_ld(&bar[XB_XCNT(j)]); sum += c; cnt += (c > 0u) ? 1u : 0u; mine = (j == x) ? c : mine; }
        if (sum == G) break;
        __builtin_amdgcn_s_sleep(1);
        if ((++sp & 255u) == 0u) { if (xb_ld(&bar[XB_TMO])) break; if (sp > XB_SPIN_CAP) { atomicAdd(&bar[XB_TMO], 1u); break; } }
    }
    nloc = mine > 0u ? mine : 1u; nx = cnt > 0u ? cnt : 1u;
}
__device__ __forceinline__ void xcd_barrier(const XcdBarrier& b, const unsigned k) {
    asm volatile("s_waitcnt vmcnt(0)" ::: "memory");
    __syncthreads();
    if (__builtin_amdgcn_workitem_id_x() == 0) {
        unsigned* bar = b.bar;
        __builtin_amdgcn_s_waitcnt(0);
        unsigned nloc = b.st[0], nx = b.st[1];
        if (nloc == 0u) { xcd_barrier_complete(bar, b.x, nloc, nx); b.st[0] = nloc; b.st[1] = nx; }
        const unsigned old = xb_add(&bar[XB_XSUB(b.x)], 1u);
        const unsigned gen = old / nloc;
        if (old + 1u == (gen + 1u) * nloc) {
            __builtin_amdgcn_fence(__ATOMIC_RELEASE, "agent");
            asm volatile("s_waitcnt vmcnt(0)" ::: "memory");
            const unsigned og = xb_add(&bar[XB_TOP], 1u);
            const unsigned tg = og / nx;
            if (og + 1u == (tg + 1u) * nx) xb_add(&bar[XB_TOPGEN], 1u);
            else XB_SPIN(xb_ld(&bar[XB_TOPGEN]) == tg, bar);
            __builtin_amdgcn_fence(__ATOMIC_ACQUIRE, "agent");
            asm volatile("s_waitcnt vmcnt(0)" ::: "memory");
        } else {
            XB_SPIN(xb_ld(&bar[XB_TOPGEN]) < k, bar);
            __builtin_amdgcn_fence(__ATOMIC_ACQUIRE, "agent");
            asm volatile("s_waitcnt vmcnt(0)" ::: "memory");
        }
    }
    __syncthreads();
}


#define PIN(i) ((const float*)P.in[(i) + z])
constexpr int NPH = 9;
template <int PH> __device__ __forceinline__ void run_phase(const Params& P, LAS unsigned char* lds) {
        int z; asm volatile("s_mov_b32 %0, 0" : "=s"(z));
        unsigned char* ws = P.ws + z;
        constexpr int layer = PH / NPH, k = PH - layer * NPH;
        const int tid = tid_opaque(), lane = tid & 63, wave = __builtin_amdgcn_readfirstlane(tid >> 6), G = sgpr_opaque(gridDim.x), blk = sgpr_opaque(blockIdx.x);
        const int gw = blk * 8 + wave, NGW = G * 8;
        float* hbuf = P.out + z;
        bf16_t* XN = (bf16_t*)(ws + WS_X);
        if constexpr (PH == NPH * DEPTH) {
            const float* g = PIN(I_FINAL);
            for (int m = gw; m < T; m += NGW) {
                f32x4* xr = (f32x4*)(hbuf + (size_t)m * 1024) + lane; const f32x4* gr = (const f32x4*)g + lane;
                f32x4 v[4]; float s = 0.f;
#pragma unroll
                for (int j = 0; j < 4; ++j) { v[j] = xr[64 * j]; s += (v[j].x * v[j].x + v[j].y * v[j].y) + (v[j].z * v[j].z + v[j].w * v[j].w); }
                const float rstd = rsqrtf(wave_sum(s) * (1.f / 1024.f) + NORM_EPS);
#pragma unroll
                for (int j = 0; j < 4; ++j) xr[64 * j] = v[j] * rstd * gr[64 * j];
            }
            return;
        } else if constexpr (k == 0) {
            const float* hin = (layer == 0) ? PIN(I_X) : hbuf;
            LAS float* tscr = (LAS float*)(lds + wave * 16384);
            bf16_t* Win_t = (bf16_t*)(ws + WS_WIN); bf16_t* Wq_t = (bf16_t*)(ws + WS_WQ); bf16_t* Wkv_t = (bf16_t*)(ws + WS_WKV); bf16_t* Wo_t = (bf16_t*)(ws + WS_WO);
            const float* Win = PIN(I_W_IN) + (size_t)layer * DM * IN_DIM;
            const float* Wq = PIN(I_WQUP) + (size_t)layer * 384 * 768;
            const float* Wkv = PIN(I_WKVUP) + (size_t)layer * 256 * 1024;
            const float* Wo = PIN(I_W_OUT) + (size_t)layer * 1024 * 1024;
            constexpr int IT_IN = 16 * 81, IT_Q = 6 * 24, IT_KV = 4 * 32, IT_O = 16 * 32;
            if (layer == 0) for (int it = gw; it < IT_IN + IT_Q + IT_KV + IT_O; it += NGW) {
                int r = it;
                if (r < IT_IN) { transpose_item(Win, 1024, IN_DIM, Win_t, 1, tscr, r, lane); continue; } r -= IT_IN;
                if (r < IT_Q) { transpose_item(Wq, 384, 768, Wq_t, 0, tscr, r, lane); continue; } r -= IT_Q;
                if (r < IT_KV) { transpose_item(Wkv, 256, 1024, Wkv_t, 0, tscr, r, lane); continue; } r -= IT_KV;
                transpose_item(Wo, 1024, 1024, Wo_t, 0, tscr, r, lane);
            }
            for (int i = blk * 512 + tid; i < 224 * 128; i += G * 512) { const int rr = i >> 7, cc = i & 127; const int row = (rr < 128) ? 896 + rr : 2720 + (rr - 128);
                *(u32x4*)(Win_t + (size_t)row * 1024 + cc * 8) = (u32x4){0u, 0u, 0u, 0u}; }
            if (layer == 0) {
                const int* pos = (const int*)P.in[I_POS + z];
                float* cosR = (float*)(ws + WS_COSR); float* sinR = (float*)(ws + WS_SINR); float* cosM = (float*)(ws + WS_COSM); float* sinM = (float*)(ws + WS_SINM);
                for (int i = blk * 512 + tid; i < T * 32; i += G * 512) { const int tok = i >> 5, f = i & 31;
                    const float inv = exp2f(-(float)f * (1.f / 32.f) * 13.287712379549449f); const float ang = (float)pos[tok] * inv;
                    double rev = (double)ang * 0.15915494309189535; rev -= floor(rev); const float a = (float)(rev * 6.283185307179586);
                    cosR[i] = __cosf(a); sinR[i] = __sinf(a); }
                for (int i = blk * 512 + tid; i < T * 16; i += G * 512) { const int tok = i >> 4, f = i & 15;
                    const float inv = exp2f(-(float)f * (1.f / 16.f) * 13.287712379549449f); const float ang = (float)pos[tok] * inv;
                    double rev = (double)ang * 0.15915494309189535; rev -= floor(rev); const float a = (float)(rev * 6.283185307179586);
                    cosM[i] = __cosf(a); sinM[i] = __sinf(a); }
            }
            const float* g = PIN(I_ATTN_NORM) + layer * 1024;
            for (int m = gw; m < T; m += 2 * NGW) rms_rows2_bf16(hin + (size_t)m * 1024, hin + (size_t)(m + NGW) * 1024, g, XN + (size_t)m * 1024, XN + (size_t)(m + NGW) * 1024, lane);
        } else if constexpr (k == 1) {
            pg8::Gemm g{XN, (bf16_t*)(ws + WS_WIN), T, NPROJ, 1024}; pg8::StaticOrder S; S.init(T, NPROJ, G, blk);
            pg8::EpiProj E{(bf16_t*)(ws + WS_PA), (bf16_t*)(ws + WS_PB), (bf16_t*)(ws + WS_PC)};
            pg8::gemm_phase<pg8::EpiProj, pg8::StaticOrder, true, true>(lds, g, S, E);
        } else if constexpr (k == 2) {
            bf16_t* pa = (bf16_t*)(ws + WS_PA); bf16_t* pb = (bf16_t*)(ws + WS_PB); bf16_t* pc = (bf16_t*)(ws + WS_PC);
            float* cosR = (float*)(ws + WS_COSR); float* sinR = (float*)(ws + WS_SINR); float* cosM = (float*)(ws + WS_COSM); float* sinM = (float*)(ws + WS_SINM);
            PrepW W;
            {
                const int l16 = lane & 15, lq = lane >> 4;
                const float* w2 = PIN(I_W2) + layer * 32 * 256; const float* a2 = PIN(I_A2) + layer * 32 * 256; const float* g2 = PIN(I_G2) + layer * 64 * 256;
                const float* v1 = PIN(I_V1) + (layer > 0 ? (layer - 1) * 256 * 32 : 0); const float* v2 = PIN(I_V2) + (layer > 0 ? (layer - 1) * 32 * 256 : 0);
#pragma unroll
                for (int nt = 0; nt < 2; ++nt) { const int n = 16 * (2 * wave + nt) + l16;
                    W.Bw[nt] = pack_col8(w2, 256, 8 * lq, n); W.Ba[nt] = pack_col8(a2, 256, 8 * lq, n);
                    W.Bg[nt][0] = pack_col8(g2, 256, 8 * lq, n); W.Bg[nt][1] = pack_col8(g2, 256, 32 + 8 * lq, n);
                    W.Bv[nt] = pack_col8(v2, 256, 8 * lq, n); W.Bv1[nt] = pack_col8(v1, 32, 32 * wave + 8 * lq, 16 * nt + l16); }
            }
            unsigned raw[17];
            if (tid < 448 && blk < T / 16) prep_fetch_rows(raw, pa, blk * 16, tid * 2);
            for (int tile = blk; tile < T / 16; tile += G) rwkv_prep_tile(lds, tile, (tile + G < T / 16) ? tile + G : -1, raw, layer, P, z, W, pa, ws + WS_REC, (bf16_t*)(ws + WS_VBUF), (bf16_t*)(ws + WS_GBUF), (bf16_t*)(ws + WS_VFIRST), (float*)(ws + WS_BS), (float*)(ws + WS_BS + 512 * 1024));
            for (int u = blk; u < 512; u += G) ret_kv_unit(lds, u >> 5, u & 31, pb, cosR, sinR, (float*)(ws + WS_KVT));
        } else if constexpr (k == 3) {
            LAS unsigned* misc = (LAS unsigned*)(lds + 131072);
            unsigned* ctl = (unsigned*)(ws + WS_CTL);
            float* cosR = (float*)(ws + WS_COSR); float* sinR = (float*)(ws + WS_SINR); float* cosM = (float*)(ws + WS_COSM); float* sinM = (float*)(ws + WS_SINM);
            unsigned* sbar = ctl + 64 * (8 + layer);
            const int NB = G - 64;
            if (blk < 64) {
                rwkv_scan_block(lds, blk, ws + WS_REC, (bf16_t*)(ws + WS_VBUF), (const float*)(ws + WS_BS + 512 * 1024), (float*)(ws + WS_YA));
                if (tid == 0) { unsigned sp = 0; while (xb_ld(sbar) < (unsigned)NB) { __builtin_amdgcn_s_sleep(4); if (++sp > (1u << 22)) break; }
                    __builtin_amdgcn_fence(__ATOMIC_ACQUIRE, "agent"); asm volatile("s_waitcnt vmcnt(0)" ::: "memory"); }
                __syncthreads();
            } else {
                const int cb = blk - 64;
                {
                    const int gwn = cb * 8 + wave, NGWn = NB * 8;
                    bf16_t* pc = (bf16_t*)(ws + WS_PC);
            bf16_t* qn = (bf16_t*)(ws + WS_QN); bf16_t* kvn = (bf16_t*)(ws + WS_KVN); bf16_t* kr = (bf16_t*)(ws + WS_KR);
            const float* qg = PIN(I_QNORM) + layer * 384; const float* kg = PIN(I_KVNORM) + layer * 256;
            for (int m0 = gwn; m0 < T; m0 += 2 * NGWn) {
                float xq[2][6], xk[2][4], x1[2], x2[2], cc[2], sn[2];
#pragma unroll
                for (int u = 0; u < 2; ++u) { const int m = (m0 + u * NGWn < T) ? m0 + u * NGWn : T - 1; const bf16_t* row = pc + (size_t)m * 768;
#pragma unroll
                    for (int j = 0; j < 6; ++j) xq[u][j] = bf2f(row[lane + 64 * j]);
#pragma unroll
                    for (int j = 0; j < 4; ++j) xk[u][j] = bf2f(row[384 + lane + 64 * j]);
                    x1[u] = bf2f(row[640 + (lane & 15)]); x2[u] = bf2f(row[656 + (lane & 15)]); cc[u] = cosM[(size_t)m * 16 + (lane & 15)]; sn[u] = sinM[(size_t)m * 16 + (lane & 15)]; }
#pragma unroll
                for (int u = 0; u < 2; ++u) { const int m = m0 + u * NGWn; if (m >= T) continue;
                    float sq = 0.f, sk = 0.f;
#pragma unroll
                    for (int j = 0; j < 6; ++j) sq += xq[u][j] * xq[u][j];
#pragma unroll
                    for (int j = 0; j < 4; ++j) sk += xk[u][j] * xk[u][j];
                    const float rq = rsqrtf(wave_sum(sq) * (1.f / 384.f) + NORM_EPS), rk = rsqrtf(wave_sum(sk) * (1.f / 256.f) + NORM_EPS);
#pragma unroll
                    for (int j = 0; j < 6; ++j) qn[(size_t)m * 384 + lane + 64 * j] = f2bf(xq[u][j] * rq * qg[lane + 64 * j]);
#pragma unroll
                    for (int j = 0; j < 4; ++j) kvn[(size_t)m * 256 + lane + 64 * j] = f2bf(xk[u][j] * rk * kg[lane + 64 * j]);
                    if (lane < 16) { kr[(size_t)m * 32 + lane] = f2bf(x1[u] * cc[u] - x2[u] * sn[u]); kr[(size_t)m * 32 + 16 + lane] = f2bf(x2[u] * cc[u] + x1[u] * sn[u]); }
                }
            }
                    unsigned* sbar0 = ctl + 64 * (12 + layer);
                    asm volatile("s_waitcnt vmcnt(0)" ::: "memory");
                    __syncthreads();
                    if (tid == 0) {
                        __builtin_amdgcn_fence(__ATOMIC_RELEASE, "agent"); asm volatile("s_waitcnt vmcnt(0)" ::: "memory");
                        xb_add(sbar0, 1u);
                        unsigned sp = 0; while (xb_ld(sbar0) < (unsigned)NB) { __builtin_amdgcn_s_sleep(4); if (++sp > (1u << 22)) break; }
                        __builtin_amdgcn_fence(__ATOMIC_ACQUIRE, "agent"); asm volatile("s_waitcnt vmcnt(0)" ::: "memory");
                    }
                    __syncthreads();
                }
                bf16_t* rprev = (bf16_t*)(ws + WS_RPREV); const float* kvt = (const float*)(ws + WS_KVT);
                for (int i = cb * 512 + tid; i < 16 * 4096; i += NB * 512) { const int bh = i >> 12, el = i & 4095; const int h = bh & 3;
                    const float cd = exp2f(128.f * log2f(1.f - exp2f(-5.f - (float)h)));
                    float R = 0.f;
#pragma unroll 8
                    for (int ci = 0; ci < 32; ++ci) { rprev[((size_t)(bh * 32 + ci)) * 4096 + el] = f2bf(R); R = R * cd + kvt[((size_t)(bh * 32 + ci)) * 4096 + el]; } }
                __syncthreads();
                { pg8::Gemm g{(bf16_t*)(ws + WS_QN), (bf16_t*)(ws + WS_WQ), T, 768, 384}; pg8::StaticOrder S; S.init(T, 768, NB, cb); pg8::EpiPlain E{(bf16_t*)(ws + WS_PC), 768};
                  pg8::gemm_phase<pg8::EpiPlain, pg8::StaticOrder, true, true>(lds, g, S, E); }
                { pg8::Gemm g{(bf16_t*)(ws + WS_KVN), (bf16_t*)(ws + WS_WKV), T, 1024, 256}; pg8::StaticOrder S; S.init(T, 1024, NB, cb); pg8::EpiPlain E{(bf16_t*)(ws + WS_KN), 1024};
                  pg8::gemm_phase<pg8::EpiPlain, pg8::StaticOrder, true, true>(lds, g, S, E); }
                asm volatile("s_waitcnt vmcnt(0)" ::: "memory");
                __syncthreads();
                if (tid == 0) {
                    __builtin_amdgcn_fence(__ATOMIC_RELEASE, "agent"); asm volatile("s_waitcnt vmcnt(0)" ::: "memory");
                    xb_add(sbar, 1u);
                    unsigned sp = 0; while (xb_ld(sbar) < (unsigned)NB) { __builtin_amdgcn_s_sleep(4); if (++sp > (1u << 22)) break; }
                    __builtin_amdgcn_fence(__ATOMIC_ACQUIRE, "agent"); asm volatile("s_waitcnt vmcnt(0)" ::: "memory");
                }
                __syncthreads();
            }
            unsigned* qctr = ctl + 64 * (1 + layer);
            for (;;) {
                __syncthreads();
                if (tid == 0) misc[0] = atomicAdd(qctr, 1u);
                __syncthreads();
                const int u = (int)misc[0];
                if (u >= 768) break;
                if (u < 512) { const int qb = 15 - (u >> 5), bh = u & 31; att_unit(lds, bh >> 3, bh & 7, qb, (bf16_t*)(ws + WS_PC), (bf16_t*)(ws + WS_KN), (bf16_t*)(ws + WS_KR), cosM, sinM, XN); }
                else { const int v = u - 512; const int bh = v & 15, jb = v >> 4; ret_unit(lds, bh >> 2, bh & 3, jb, (bf16_t*)(ws + WS_PB), cosR, sinR, (bf16_t*)(ws + WS_RPREV), (float*)(ws + WS_YB)); }
            }
        } else if constexpr (k == 4) {
            LAS float* tscr = (LAS float*)(lds + wave * 16384);
            const float* __restrict__ ya = (const float*)(ws + WS_YA); const float* __restrict__ yb = (const float*)(ws + WS_YB); const float* __restrict__ bs = (const float*)(ws + WS_BS);
            const bf16_t* __restrict__ vbuf = (const bf16_t*)(ws + WS_VBUF); const bf16_t* __restrict__ gbuf = (const bf16_t*)(ws + WS_GBUF); const bf16_t* __restrict__ pb = (const bf16_t*)(ws + WS_PB);
            const float* __restrict__ gnw = PIN(I_GNW) + layer * 256; const float* __restrict__ gnb = PIN(I_GNB) + layer * 256;
            bf16_t* __restrict__ XNw = XN;
#pragma unroll 4
            for (int m = gw; m < T; m += NGW) {
                const int c = 4 * lane, head = lane >> 4;
                const f32x4 y = *(const f32x4*)(ya + (size_t)m * 256 + c);
                const float mean = allreduce16((y.x + y.y) + (y.z + y.w)) * (1.f / 64.f);
                const f32x4 d = y - mean;
                const float var = allreduce16((d.x * d.x + d.y * d.y) + (d.z * d.z + d.w * d.w)) * (1.f / 64.f);
                const float rs = rsqrtf(var + 64e-5f);
                const f32x4 gw4 = *(const f32x4*)(gnw + c), gb4 = *(const f32x4*)(gnb + c);
                const u32x2 vv = *(const u32x2*)(vbuf + (size_t)m * 256 + c), gg = *(const u32x2*)(gbuf + (size_t)m * 256 + c);
                const float bsc = bs[(size_t)m * 4 + head];
                const float o0 = (d.x * rs * gw4.x + gb4.x + bsc * bflo(vv.x)) * bflo(gg.x), o1 = (d.y * rs * gw4.y + gb4.y + bsc * bfhi(vv.x)) * bfhi(gg.x);
                const float o2 = (d.z * rs * gw4.z + gb4.z + bsc * bflo(vv.y)) * bflo(gg.y), o3 = (d.w * rs * gw4.w + gb4.w + bsc * bfhi(vv.y)) * bfhi(gg.y);
                u32x2 w; w.x = cvt_pk_bf16(o0, o1); w.y = cvt_pk_bf16(o2, o3);
                *(u32x2*)(XNw + (size_t)m * 1024 + c) = w;
                const f32x4 zz = *(const f32x4*)(yb + (size_t)m * 256 + c);
                const float ms = allreduce16((zz.x * zz.x + zz.y * zz.y) + (zz.z * zz.z + zz.w * zz.w)) * (1.f / 64.f);
                const float rz = rsqrtf(ms + NORM_EPS);
                const u32x2 gt = *(const u32x2*)(pb + (size_t)m * 1024 + 768 + c);
                const float g0 = bflo(gt.x), g1 = bfhi(gt.x), g2v = bflo(gt.y), g3 = bfhi(gt.y);
                u32x2 w2; w2.x = cvt_pk_bf16(zz.x * rz * g0 * sigmoidf_(g0), zz.y * rz * g1 * sigmoidf_(g1)); w2.y = cvt_pk_bf16(zz.z * rz * g2v * sigmoidf_(g2v), zz.w * rz * g3 * sigmoidf_(g3));
                *(u32x2*)(XNw + (size_t)m * 1024 + 256 + c) = w2;
            }
            const float* Wgu = PIN(I_WGU) + (size_t)layer * 1024 * 2 * D_FF; const float* Wdn = PIN(I_WDN) + (size_t)layer * D_FF * 1024;
            bf16_t* Wgu_t = (bf16_t*)(ws + WS_WGU); bf16_t* Wdn_t = (bf16_t*)(ws + WS_WDN);
            constexpr int IT_GU = 16 * 176, IT_DN = 44 * 32;
            for (int it = gw; it < IT_GU + IT_DN; it += NGW) {
                if (it < IT_GU) transpose_item(Wgu, 1024, 2 * D_FF, Wgu_t, 2, tscr, it, lane);
                else transpose_item(Wdn, D_FF, 1024, Wdn_t, 0, tscr, it - IT_GU, lane);
            }
        } else if constexpr (k == 5) {
            const float* hin = (layer == 0) ? PIN(I_X) : hbuf;
            pg8::Gemm g{XN, (bf16_t*)(ws + WS_WO), T, 1024, 1024}; pg8::StaticOrder S; S.init(T, 1024, G, blk); pg8::EpiRes E{hin, hbuf};
            pg8::gemm_phase<pg8::EpiRes, pg8::StaticOrder, true, true>(lds, g, S, E);
        } else if constexpr (k == 6) {
            const float* g = PIN(I_FFN_NORM) + layer * 1024;
            for (int m = gw; m < T; m += 2 * NGW) rms_rows2_bf16(hbuf + (size_t)m * 1024, hbuf + (size_t)(m + NGW) * 1024, g, XN + (size_t)m * 1024, XN + (size_t)(m + NGW) * 1024, lane);
            if constexpr (layer + 1 < DEPTH) {
                LAS float* tscr = (LAS float*)(lds + wave * 16384);
                const float* Win = PIN(I_W_IN) + (size_t)(layer + 1) * DM * IN_DIM; const float* Wq = PIN(I_WQUP) + (size_t)(layer + 1) * 384 * 768;
                const float* Wkv = PIN(I_WKVUP) + (size_t)(layer + 1) * 256 * 1024; const float* Wo = PIN(I_W_OUT) + (size_t)(layer + 1) * 1024 * 1024;
                constexpr int IT_IN = 16 * 81, IT_Q = 6 * 24, IT_KV = 4 * 32, IT_O = 16 * 32;
                for (int it = gw; it < IT_IN + IT_Q + IT_KV + IT_O; it += NGW) {
                    int r = it;
                    if (r < IT_IN) { transpose_item(Win, 1024, IN_DIM, (bf16_t*)(ws + WS_WIN), 1, tscr, r, lane); continue; } r -= IT_IN;
                    if (r < IT_Q) { transpose_item(Wq, 384, 768, (bf16_t*)(ws + WS_WQ), 0, tscr, r, lane); continue; } r -= IT_Q;
                    if (r < IT_KV) { transpose_item(Wkv, 256, 1024, (bf16_t*)(ws + WS_WKV), 0, tscr, r, lane); continue; } r -= IT_KV;
                    transpose_item(Wo, 1024, 1024, (bf16_t*)(ws + WS_WO), 0, tscr, r, lane);
                }
            }
        } else if constexpr (k == 7) {
            pg8::Gemm g{XN, (bf16_t*)(ws + WS_WGU), T, 2 * D_FF, 1024}; pg8::StaticOrder S; S.init(T, 2 * D_FF, G, blk); pg8::EpiSwiGLU E{(bf16_t*)(ws + WS_ACT)};
            pg8::gemm_phase<pg8::EpiSwiGLU, pg8::StaticOrder, true, true>(lds, g, S, E);
        } else {
            pg8::Gemm g{(bf16_t*)(ws + WS_ACT), (bf16_t*)(ws + WS_WDN), T, 1024, D_FF}; pg8::StaticOrder S; S.init(T, 1024, G, blk); pg8::EpiRes E{hbuf, hbuf};
            pg8::gemm_phase<pg8::EpiRes, pg8::StaticOrder, true, true>(lds, g, S, E);
        }
}

template <int PH> __device__ __forceinline__ void run_all(const Params& P, LAS unsigned char* lds, cg::grid_group& grid, const XcdBarrier& bar) {
    run_phase<PH>(P, lds);
    if constexpr (PH < NPH * DEPTH) {
        xcd_barrier(bar, (unsigned)PH + 1u);
        run_all<PH + 1>(P, lds, grid, bar);
    }
}
__global__ void __launch_bounds__(512) hymba_fwd(Params P) {
    extern __shared__ __attribute__((aligned(16))) unsigned char lds_raw[];
    LAS unsigned char* lds = (LAS unsigned char*)lds_raw;
    cg::grid_group grid = cg::this_grid();
    LAS unsigned* misc = (LAS unsigned*)(lds + 131072);
    if (__builtin_amdgcn_workitem_id_x() < 32) misc[__builtin_amdgcn_workitem_id_x()] = 0u;
    __syncthreads();
    if (P.ws == nullptr) grid.sync();
    const XcdBarrier bar = xcd_barrier_post((unsigned*)(P.ws + WS_CTL) + 4096, (volatile LAS unsigned*)(misc + 8));
    run_all<0>(P, lds, grid, bar);
}
extern "C" void kernel_launch(void* const* d_in, const int* in_sizes, int n_in, void* d_out, int out_size, void* d_ws, size_t ws_size, hipStream_t stream) {
    static int grid = 0;
    if (grid == 0) {
        if (n_in != 27 || out_size != T * DM || ws_size < WS_END) { fprintf(stderr, "kernel_launch: unexpected shapes (n_in %d, out %d, ws %zu)\n", n_in, out_size, ws_size); grid = -1; return; }
        int dev = 0, cus = 0, per_cu = 0;
        (void)hipGetDevice(&dev); (void)hipDeviceGetAttribute(&cus, hipDeviceAttributeMultiprocessorCount, dev);
        if (hipFuncSetAttribute((const void*)hymba_fwd, hipFuncAttributeMaxDynamicSharedMemorySize, LDS_BYTES) != hipSuccess) { fprintf(stderr, "kernel_launch: hipFuncSetAttribute failed\n"); grid = -1; return; }
        if (hipOccupancyMaxActiveBlocksPerMultiprocessor(&per_cu, (const void*)hymba_fwd, 512, LDS_BYTES) != hipSuccess || per_cu < 1) { fprintf(stderr, "kernel_launch: occupancy query failed (%d)\n", per_cu); grid = -1; return; }
        (void)hipGetLastError();
        grid = cus;
        if (grid < 64) { fprintf(stderr, "kernel_launch: needs >= 64 CUs\n"); grid = -1; return; }
    }
    if (grid < 0) return;
    (void)hipMemsetAsync((char*)d_ws + WS_CTL, 0, 1 * MiB, stream);
    Params p{};
    for (int i = 0; i < 27; ++i) p.in[i] = d_in[i];
    p.out = (float*)d_out; p.ws = (unsigned char*)d_ws;
    void* args[] = {&p};
    hipError_t e = hipLaunchCooperativeKernel((const void*)hymba_fwd, dim3(grid), dim3(512), args, LDS_BYTES, stream);
    if (e != hipSuccess) fprintf(stderr, "kernel_launch: cooperative launch failed: %s (grid %d)\n", hipGetErrorString(e), grid);
}
```

```cpp
#include <hip/hip_runtime.h>
#include <hip/hip_cooperative_groups.h>
#include <cstdio>
#include <cstdint>
namespace cg = cooperative_groups;

#define LAS __attribute__((address_space(3)))
typedef unsigned short bf16_t;
typedef short bf16x8 __attribute__((ext_vector_type(8)));
typedef float f32x2 __attribute__((ext_vector_type(2)));
typedef float f32x4 __attribute__((ext_vector_type(4)));
typedef float f32x16 __attribute__((ext_vector_type(16)));
typedef unsigned u32x4 __attribute__((ext_vector_type(4)));
typedef unsigned u32x2 __attribute__((ext_vector_type(2)));

constexpr int BATCH = 4, SEQ = 4096, T = BATCH * SEQ, DM = 1024, DEPTH = 2;
constexpr int RW_IN = 896, IN_DIM = 2592, D_FF = 2816;
constexpr int NPROJ = 2816;
constexpr float NORM_EPS = 1e-6f;

constexpr size_t MiB = 1u << 20;
constexpr size_t WS_CTL = 0;
constexpr size_t WS_COSR = 1 * MiB, WS_SINR = 3 * MiB, WS_COSM = 5 * MiB, WS_SINM = 6 * MiB;
constexpr size_t WS_BS = 7 * MiB;
constexpr size_t WS_RPREV = 8 * MiB;
constexpr size_t WS_WIN = 12 * MiB;
constexpr size_t WS_WQ = WS_WIN + 5632 * 1024;
constexpr size_t WS_WKV = WS_WQ + 768 * 384 * 2;
constexpr size_t WS_WO = WS_WKV + 1024 * 256 * 2;
constexpr size_t WS_VFIRST = 21 * MiB;
constexpr size_t WS_VBUF = 29 * MiB;
constexpr size_t WS_GBUF = 37 * MiB;
constexpr size_t WS_X = 45 * MiB;
constexpr size_t WS_QN = WS_X, WS_KVN = WS_X + 12 * MiB;
constexpr size_t WS_KR = 253 * MiB;
constexpr size_t WS_PA = 77 * MiB;
constexpr size_t WS_YA = WS_PA, WS_YB = WS_PA + 16 * MiB;
constexpr size_t WS_PB = 109 * MiB;
constexpr size_t WS_PC = 141 * MiB;
constexpr size_t WS_ACT = 77 * MiB;
constexpr size_t WS_KN = 165 * MiB;
constexpr size_t WS_VT = 181 * MiB;
constexpr size_t WS_REC = 197 * MiB;
constexpr size_t WS_WGU = 197 * MiB, WS_WDN = 208 * MiB;
constexpr size_t WS_KVT = 245 * MiB;
constexpr size_t WS_END = 254 * MiB;

constexpr int LDS_BYTES = 131072 + 1024;

__device__ __forceinline__ int sgpr_opaque(int v) { asm volatile("" : "+s"(v)); return v; }
__device__ __forceinline__ int tid_opaque() { int t = __builtin_amdgcn_workitem_id_x(); asm volatile("" : "+v"(t)); return t; }
__device__ __forceinline__ unsigned cvt_pk_bf16(float lo, float hi) { unsigned r; asm volatile("v_cvt_pk_bf16_f32 %0, %1, %2" : "=v"(r) : "v"(lo), "v"(hi)); return r; }
__device__ __forceinline__ bf16_t f2bf(float f) { return (bf16_t)(cvt_pk_bf16(f, 0.f) & 0xffffu); }
__device__ __forceinline__ float bf2f(bf16_t v) { return __uint_as_float(((unsigned)v) << 16); }
__device__ __forceinline__ float bflo(unsigned u) { return __uint_as_float(u << 16); }
__device__ __forceinline__ float bfhi(unsigned u) { return __uint_as_float(u & 0xffff0000u); }
__device__ __forceinline__ float sigmoidf_(float x) { return __builtin_amdgcn_rcpf(1.f + __expf(-x)); }
template <int CTRL> __device__ __forceinline__ float dpp_mov(float x) { return __builtin_bit_cast(float, __builtin_amdgcn_mov_dpp(__builtin_bit_cast(int, x), CTRL, 0xf, 0xf, true)); }
__device__ __forceinline__ float allreduce16(float x) {
    x += dpp_mov<0xB1>(x); x += dpp_mov<0x4E>(x); x += dpp_mov<0x141>(x); x += dpp_mov<0x140>(x); return x;
}
__device__ __forceinline__ float wave_sum(float v) { v = allreduce16(v); v += __shfl_xor(v, 16); v += __shfl_xor(v, 32); return v; }
__device__ __forceinline__ int crow(int r, int hi) { return (r & 3) + 8 * (r >> 2) + 4 * hi; }
#define MFMA32(a, b, c) __builtin_amdgcn_mfma_f32_32x32x16_bf16((a), (b), (c), 0, 0, 0)

namespace pg8 {
#define PG8_LAS __attribute__((address_space(3)))
constexpr int BM = 256, BK = 64, HALF = 128, HTB = HALF * BK * 2, STAGE_BYTES = 8 * HTB, NXCD = 8, WGM = 8;
__host__ __device__ __forceinline__ int lds_byte(int r, int c) { const int st = (r >> 4) * 2 + (c >> 5), rr = r & 15, cc = c & 31, ob = rr * 64 + cc * 2; return st * 1024 + (ob ^ (((ob >> 9) & 1) << 5)); }
__host__ __device__ __forceinline__ void stage_rc(int b, int& R, int& C) { const int st = b / 1024, sb = b % 1024, swz = sb ^ (((sb >> 9) & 1) << 5); R = (st >> 1) * 16 + swz / 64; C = (st & 1) * 32 + (swz % 64) / 2; }
__host__ __device__ __forceinline__ int perm32(int rho) { const int n = rho >> 4, i = rho & 15; return 8 * (i >> 2) + 4 * n + (i & 3); }
struct Unit { int pm, pn; };
struct Gemm { const bf16_t* A; const bf16_t* Bt; int M, N, K; };
struct StaticOrder {
    int nM, nN, nwg, G, c;
    __host__ __device__ void init(int M, int N, int G_, int c_) { nM = M / BM; nN = N / BM; nwg = nM * nN; G = G_; c = c_; }
    __host__ __device__ bool next(int i, Unit& u) const {
        const long L = (long)i * G + c; if (L >= nwg) return false;
        int wgid = (int)L; { const int q = nwg / NXCD, r = nwg % NXCD, xcd = wgid % NXCD, off = wgid / NXCD; wgid = (xcd < r ? xcd * (q + 1) : r * (q + 1) + (xcd - r) * q) + off; }
        const int nig = WGM * nN, gid = wgid / nig, fm = gid * WGM, gsz = (nM - fm) < WGM ? (nM - fm) : WGM;
        u.pm = fm + ((wgid % nig) % gsz); u.pn = (wgid % nig) / gsz; return true;
    }
    __device__ __forceinline__ void a_ready(const Unit&) const {}
    __device__ __forceinline__ void done(const Unit&) const {}
};

template <class Epi, class Sched, bool ALIGN_EPI = false, bool SP2 = false>
__device__ __forceinline__ void gemm_phase(PG8_LAS unsigned char* lds, const Gemm g, const Sched& S, const Epi& E) {
    const int tid = tid_opaque(), wid = __builtin_amdgcn_readfirstlane(tid >> 6), lane = tid & 63, wr = wid >> 2, wc = wid & 3, fr = lane & 15, fq = lane >> 4;
    const int K = g.K, nt = K / BK;
    unsigned voffA[2], voffB[2];
#pragma unroll
    for (int i = 0; i < 2; ++i) { int R, C; stage_rc(tid * 16 + i * 8192, R, C); const int Rb = Epi::PERM ? ((R & ~31) + perm32(R & 31)) : R;
        voffA[i] = (unsigned)(R * K + C) * 2u; voffB[i] = (unsigned)(Rb * K + C) * 2u; }
    const size_t kstep = (size_t)(BK * 2);
    const size_t hstep = (size_t)HALF * K * 2;
    const size_t tstep = 2 * hstep;
    const unsigned ldsw = (unsigned)wid * 1024u;
    const int aoff = lds_byte(wr * 64 + fr, fq * 8), boff = lds_byte(wc * 32 + fr, fq * 8);
#define PG8_SA(b, h) (((b) * 2 + (h)) * HTB)
#define PG8_SB(b, h) ((4 + (b) * 2 + (h)) * HTB)
#define PG8_STAGE(bufoff, gbase, voff) do { _Pragma("unroll") for (int _i = 0; _i < 2; ++_i) \
        __builtin_amdgcn_global_load_lds((const unsigned*)((const char*)(gbase) + (voff)[_i]), (PG8_LAS unsigned*)(lds + (bufoff) + ldsw + _i * 8192), 16, 0, 0); } while (0)
#define PG8_LDA(dst, b, h) do { _Pragma("unroll") for (int m = 0; m < 4; ++m) _Pragma("unroll") for (int k = 0; k < 2; ++k) dst[m][k] = *(const PG8_LAS bf16x8*)(lds + PG8_SA(b, h) + aoff + m * 2048 + k * 1024); } while (0)
#define PG8_LDB(dst, b, h) do { _Pragma("unroll") for (int n = 0; n < 2; ++n) _Pragma("unroll") for (int k = 0; k < 2; ++k) dst[n][k] = *(const PG8_LAS bf16x8*)(lds + PG8_SB(b, h) + boff + n * 2048 + k * 1024); } while (0)
#define PG8_MMA(ai, bj, At, Bt) do { __builtin_amdgcn_s_setprio(1); _Pragma("unroll") for (int m = 0; m < 4; ++m) _Pragma("unroll") for (int n = 0; n < 2; ++n) _Pragma("unroll") for (int k = 0; k < 2; ++k) \
        acc[ai][bj][m][n] = __builtin_amdgcn_mfma_f32_16x16x32_bf16(Bt[n][k], At[m][k], acc[ai][bj][m][n], 0, 0, 0); __builtin_amdgcn_s_setprio(0); } while (0)
#define PG8_WAIT_V(n) asm volatile("s_waitcnt vmcnt(" #n ")" ::: "memory")
#define PG8_WAIT_L(n) asm volatile("s_waitcnt lgkmcnt(" #n ")" ::: "memory")
#define PG8_BAR __builtin_amdgcn_s_barrier()
#define PG8_SCHED __builtin_amdgcn_sched_barrier(0)
    Unit cur, nxt; int ui = 0;
    if (!S.next(0, cur)) return;
    f32x4 acc[2][2][4][2];
#pragma unroll
    for (int a = 0; a < 2; ++a)
#pragma unroll
        for (int b = 0; b < 2; ++b)
#pragma unroll
            for (int m = 0; m < 4; ++m)
#pragma unroll
                for (int n = 0; n < 2; ++n) acc[a][b][m][n] = (f32x4){0.f, 0.f, 0.f, 0.f};
    bf16x8 At[4][2], B0[2][2], B1[2][2];
    const char* cA = (const char*)g.A + (size_t)cur.pm * tstep; const char* cB = (const char*)g.Bt + (size_t)cur.pn * tstep;
    S.a_ready(cur);
    if constexpr (SP2) {
        PG8_STAGE(PG8_SB(0, 0), cB, voffB); PG8_STAGE(PG8_SB(0, 1), cB + hstep, voffB); PG8_STAGE(PG8_SA(0, 0), cA, voffA); PG8_STAGE(PG8_SA(0, 1), cA + hstep, voffA);
        if (wr == 1) PG8_BAR;
        PG8_WAIT_V(2); PG8_BAR;
        PG8_STAGE(PG8_SB(1, 0), cB + kstep, voffB); PG8_STAGE(PG8_SA(1, 0), cA + kstep, voffA); PG8_STAGE(PG8_SB(1, 1), cB + hstep + kstep, voffB);
        PG8_WAIT_V(6); PG8_BAR;
    } else {
        PG8_STAGE(PG8_SB(0, 0), cB, voffB); PG8_STAGE(PG8_SA(0, 0), cA, voffA); PG8_STAGE(PG8_SB(0, 1), cB + hstep, voffB); PG8_STAGE(PG8_SA(0, 1), cA + hstep, voffA);
        if (wr == 1) PG8_BAR;
        PG8_WAIT_V(4); PG8_BAR;
        PG8_STAGE(PG8_SB(1, 0), cB + kstep, voffB); PG8_STAGE(PG8_SA(1, 0), cA + kstep, voffA); PG8_STAGE(PG8_SB(1, 1), cB + hstep + kstep, voffB);
        PG8_WAIT_V(6); PG8_BAR;
    }
    for (;;) {
        const bool has_next = S.next(ui + 1, nxt);
        const char* nA = has_next ? (const char*)g.A + (size_t)nxt.pm * tstep : cA; const char* nB = has_next ? (const char*)g.Bt + (size_t)nxt.pn * tstep : cB;
        for (int t = 0; t < nt; t += 2) {
            const bool last = (t == nt - 2);
            const char* a1 = cA + (size_t)(t + 1) * kstep;
            const char* a2 = last ? nA : cA + (size_t)(t + 2) * kstep; const char* b2 = last ? nB : cB + (size_t)(t + 2) * kstep;
            const char* a3 = a2 + kstep; const char* b3 = b2 + kstep;
            if (last && has_next) S.a_ready(nxt);
            if constexpr (SP2) {
            PG8_LDB(B0, 0, 0); PG8_LDB(B1, 0, 1); PG8_SCHED; PG8_LDA(At, 0, 0); PG8_STAGE(PG8_SA(1, 1), a1 + hstep, voffA);
            PG8_WAIT_V(8); PG8_WAIT_L(0); PG8_BAR; PG8_MMA(0, 0, At, B0); PG8_MMA(0, 1, At, B1); PG8_BAR; PG8_SCHED;
            PG8_LDA(At, 0, 1); PG8_STAGE(PG8_SB(0, 0), b2, voffB); PG8_STAGE(PG8_SB(0, 1), b2 + hstep, voffB); PG8_STAGE(PG8_SA(0, 0), a2, voffA);
            PG8_WAIT_V(8); PG8_WAIT_L(0); PG8_BAR; PG8_MMA(1, 0, At, B0); PG8_MMA(1, 1, At, B1); PG8_BAR; PG8_SCHED;
            PG8_LDB(B0, 1, 0); PG8_LDB(B1, 1, 1); PG8_SCHED; PG8_LDA(At, 1, 0); PG8_STAGE(PG8_SA(0, 1), a2 + hstep, voffA);
            PG8_WAIT_V(8); PG8_WAIT_L(0); PG8_BAR; PG8_MMA(0, 0, At, B0); PG8_MMA(0, 1, At, B1); PG8_BAR; PG8_SCHED;
            PG8_LDA(At, 1, 1); PG8_STAGE(PG8_SB(1, 0), b3, voffB); PG8_STAGE(PG8_SB(1, 1), b3 + hstep, voffB); PG8_STAGE(PG8_SA(1, 0), a3, voffA);
            PG8_WAIT_V(8); PG8_WAIT_L(0); PG8_BAR; PG8_MMA(1, 0, At, B0); PG8_MMA(1, 1, At, B1); PG8_BAR; PG8_SCHED;
            } else {
            PG8_LDB(B0, 0, 0); PG8_SCHED; PG8_LDA(At, 0, 0); PG8_STAGE(PG8_SA(1, 1), a1 + hstep, voffA);
            PG8_WAIT_L(8); PG8_BAR; PG8_WAIT_L(0); PG8_MMA(0, 0, At, B0); PG8_BAR; PG8_SCHED;
            PG8_LDB(B1, 0, 1); PG8_STAGE(PG8_SB(0, 0), b2, voffB);
            PG8_BAR; PG8_WAIT_L(0); PG8_MMA(0, 1, At, B1); PG8_BAR;
            PG8_LDA(At, 0, 1); PG8_STAGE(PG8_SA(0, 0), a2, voffA);
            PG8_BAR; PG8_WAIT_L(0); PG8_MMA(1, 0, At, B0); PG8_BAR; PG8_SCHED;
            PG8_STAGE(PG8_SB(0, 1), b2 + hstep, voffB);
            PG8_WAIT_V(6); PG8_BAR; PG8_MMA(1, 1, At, B1); PG8_BAR;
            PG8_LDB(B0, 1, 0); PG8_SCHED; PG8_LDA(At, 1, 0); PG8_STAGE(PG8_SA(0, 1), a2 + hstep, voffA);
            PG8_WAIT_L(8); PG8_BAR; PG8_WAIT_L(0); PG8_MMA(0, 0, At, B0); PG8_BAR; PG8_SCHED;
            PG8_LDB(B1, 1, 1); PG8_STAGE(PG8_SB(1, 0), b3, voffB);
            PG8_BAR; PG8_WAIT_L(0); PG8_MMA(0, 1, At, B1); PG8_BAR;
            PG8_LDA(At, 1, 1); PG8_STAGE(PG8_SA(1, 0), a3, voffA);
            PG8_BAR; PG8_WAIT_L(0); PG8_MMA(1, 0, At, B0); PG8_BAR; PG8_SCHED;
            PG8_STAGE(PG8_SB(1, 1), b3 + hstep, voffB);
            PG8_WAIT_V(6); PG8_BAR; PG8_MMA(1, 1, At, B1); PG8_BAR;
            }
        }
        if constexpr (ALIGN_EPI) { if (wr == 0) PG8_BAR; }
        E(acc, cur, wr, wc, fr, fq); S.done(cur);
        if (!has_next) break;
#pragma unroll
        for (int a = 0; a < 2; ++a)
#pragma unroll
            for (int b = 0; b < 2; ++b)
#pragma unroll
                for (int m = 0; m < 4; ++m)
#pragma unroll
                    for (int n = 0; n < 2; ++n) acc[a][b][m][n] = (f32x4){0.f, 0.f, 0.f, 0.f};
        cur = nxt; cA = nA; cB = nB; ++ui;
        if constexpr (ALIGN_EPI) { if (wr == 1) PG8_BAR; }
    }
    PG8_WAIT_V(0);
    if constexpr (!ALIGN_EPI) { if (wr == 0) PG8_BAR; }
    PG8_BAR;
#undef PG8_SA
#undef PG8_SB
#undef PG8_STAGE
#undef PG8_LDA
#undef PG8_LDB
#undef PG8_MMA
#undef PG8_WAIT_V
#undef PG8_WAIT_L
#undef PG8_BAR
#undef PG8_SCHED
}

__device__ __forceinline__ u32x4 pack8(const f32x4 v0, const f32x4 v1) { u32x4 w; w.x = cvt_pk_bf16(v0[0], v0[1]); w.y = cvt_pk_bf16(v0[2], v0[3]); w.z = cvt_pk_bf16(v1[0], v1[1]); w.w = cvt_pk_bf16(v1[2], v1[3]); return w; }

struct EpiProj {
    static constexpr bool PERM = true;
    bf16_t *pa, *pb, *pc;
    __device__ __forceinline__ void operator()(const f32x4 (&acc)[2][2][4][2], const Unit& u, int wr, int wc, int fr, int fq) const {
        bf16_t* base; int ldc, colt;
        if (u.pn < 4) { base = pa; ldc = 1024; colt = u.pn * 256; } else if (u.pn < 8) { base = pb; ldc = 1024; colt = (u.pn - 4) * 256; } else { base = pc; ldc = 768; colt = (u.pn - 8) * 256; }
        const int row0 = u.pm * BM + wr * 64 + fr, col0 = colt + wc * 32 + 8 * fq;
#pragma unroll
        for (int ai = 0; ai < 2; ++ai)
#pragma unroll
            for (int m = 0; m < 4; ++m) { bf16_t* rowp = base + (size_t)(row0 + ai * HALF + m * 16) * ldc + col0;
#pragma unroll
                for (int bj = 0; bj < 2; ++bj) *(u32x4*)(rowp + bj * HALF) = pack8(acc[ai][bj][m][0], acc[ai][bj][m][1]); }
    }
};
struct EpiPlain {
    static constexpr bool PERM = true;
    bf16_t* O; int ldc;
    __device__ __forceinline__ void operator()(const f32x4 (&acc)[2][2][4][2], const Unit& u, int wr, int wc, int fr, int fq) const {
        const int row0 = u.pm * BM + wr * 64 + fr, col0 = u.pn * BM + wc * 32 + 8 * fq;
#pragma unroll
        for (int ai = 0; ai < 2; ++ai)
#pragma unroll
            for (int m = 0; m < 4; ++m) { bf16_t* rowp = O + (size_t)(row0 + ai * HALF + m * 16) * ldc + col0;
#pragma unroll
                for (int bj = 0; bj < 2; ++bj) *(u32x4*)(rowp + bj * HALF) = pack8(acc[ai][bj][m][0], acc[ai][bj][m][1]); }
    }
};
struct EpiRes {
    static constexpr bool PERM = false;
    const float* base; float* out;
    __device__ __forceinline__ void operator()(const f32x4 (&acc)[2][2][4][2], const Unit& u, int wr, int wc, int fr, int fq) const {
        const int row0 = u.pm * BM + wr * 64 + fr, col0 = u.pn * BM + wc * 32 + 4 * fq;
#pragma unroll
        for (int ai = 0; ai < 2; ++ai)
#pragma unroll
            for (int m = 0; m < 4; ++m) { const size_t off = (size_t)(row0 + ai * HALF + m * 16) * 1024 + col0;
#pragma unroll
                for (int bj = 0; bj < 2; ++bj)
#pragma unroll
                    for (int n = 0; n < 2; ++n) { const f32x4 bs = *(const f32x4*)(base + off + bj * HALF + n * 16); *(f32x4*)(out + off + bj * HALF + n * 16) = bs + acc[ai][bj][m][n]; } }
    }
};
struct EpiSwiGLU {
    static constexpr bool PERM = true;
    bf16_t* act;
    __device__ __forceinline__ void operator()(const f32x4 (&acc)[2][2][4][2], const Unit& u, int wr, int wc, int fr, int fq) const {
        const int row0 = u.pm * BM + wr * 64 + fr, col0 = u.pn * 128 + wc * 32 + 8 * fq;
#pragma unroll
        for (int ai = 0; ai < 2; ++ai)
#pragma unroll
            for (int m = 0; m < 4; ++m) { f32x4 o[2];
#pragma unroll
                for (int n = 0; n < 2; ++n)
#pragma unroll
                    for (int i = 0; i < 4; ++i) { const float gt = acc[ai][0][m][n][i], up = acc[ai][1][m][n][i]; o[n][i] = gt * up * __builtin_amdgcn_rcpf(1.f + __expf(-gt)); }
                *(u32x4*)(act + (size_t)(row0 + ai * HALF + m * 16) * D_FF + col0) = pack8(o[0], o[1]); }
    }
};
}

struct Params { const void* in[27]; float* out; unsigned char* ws; };
enum { I_X = 0, I_POS, I_ATTN_NORM, I_W_IN, I_W_OUT, I_MU, I_W0, I_W2, I_A0, I_A2, I_G2, I_KK, I_KA, I_RK, I_GNW, I_GNB, I_V0, I_V1, I_V2,
       I_QNORM, I_KVNORM, I_WQUP, I_WKVUP, I_FFN_NORM, I_WGU, I_WDN, I_FINAL };

__device__ __forceinline__ void transpose_item(const float* W, int K, int N, bf16_t* WT, int mode, LAS float* scr, int item, int lane) {
    const int nblk = N / 32, kb = item / nblk, nb = item % nblk, k0 = 64 * kb, n0 = 32 * nb;
    int d0 = n0;
    if (mode == 1) d0 = (n0 < 896) ? n0 : n0 + 128;
    else if (mode == 2) { const int j = (n0 < D_FF) ? n0 : n0 - D_FF; d0 = 256 * (j >> 7) + (j & 127) + ((n0 < D_FF) ? 0 : 128); }
    float wv[32];
#pragma unroll
    for (int i = 0; i < 32; ++i) wv[i] = W[(size_t)(k0 + 2 * i + (lane >> 5)) * N + n0 + (lane & 31)];
#pragma unroll
    for (int i = 0; i < 32; ++i) scr[(2 * i + (lane >> 5)) * 33 + (lane & 31)] = wv[i];
    asm volatile("s_waitcnt lgkmcnt(0)" ::: "memory");
    const int c = lane & 7;
#pragma unroll
    for (int j = 0; j < 4; ++j) { const int n = (lane >> 3) + 8 * j; const LAS float* s = scr + (8 * c) * 33 + n;
        u32x4 o; o.x = cvt_pk_bf16(s[0 * 33], s[1 * 33]); o.y = cvt_pk_bf16(s[2 * 33], s[3 * 33]); o.z = cvt_pk_bf16(s[4 * 33], s[5 * 33]); o.w = cvt_pk_bf16(s[6 * 33], s[7 * 33]);
        *(u32x4*)(WT + (size_t)(d0 + n) * K + k0 + 8 * c) = o; }
    asm volatile("s_waitcnt lgkmcnt(0)" ::: "memory");
}

__device__ __forceinline__ void rms_rows2_bf16(const float* __restrict__ x0row, const float* __restrict__ x1row, const float* __restrict__ g, bf16_t* __restrict__ o0row, bf16_t* __restrict__ o1row, int lane) {
    const f32x4* xa = (const f32x4*)x0row + lane; const f32x4* xb = (const f32x4*)x1row + lane; const f32x4* gr = (const f32x4*)g + lane;
    f32x4 va[4], vb[4]; float sa = 0.f, sb = 0.f;
#pragma unroll
    for (int j = 0; j < 4; ++j) { va[j] = xa[64 * j]; vb[j] = xb[64 * j]; }
#pragma unroll
    for (int j = 0; j < 4; ++j) { sa += (va[j].x * va[j].x + va[j].y * va[j].y) + (va[j].z * va[j].z + va[j].w * va[j].w); sb += (vb[j].x * vb[j].x + vb[j].y * vb[j].y) + (vb[j].z * vb[j].z + vb[j].w * vb[j].w); }
    const float ra = rsqrtf(wave_sum(sa) * (1.f / 1024.f) + NORM_EPS), rb = rsqrtf(wave_sum(sb) * (1.f / 1024.f) + NORM_EPS);
    u32x2* oa = (u32x2*)o0row + lane; u32x2* ob = (u32x2*)o1row + lane;
#pragma unroll
    for (int j = 0; j < 4; ++j) { const f32x4 gg = gr[64 * j]; u32x2 w;
        w.x = cvt_pk_bf16(va[j].x * ra * gg.x, va[j].y * ra * gg.y); w.y = cvt_pk_bf16(va[j].z * ra * gg.z, va[j].w * ra * gg.w); oa[64 * j] = w;
        w.x = cvt_pk_bf16(vb[j].x * rb * gg.x, vb[j].y * rb * gg.y); w.y = cvt_pk_bf16(vb[j].z * rb * gg.z, vb[j].w * rb * gg.w); ob[64 * j] = w; }
}
__device__ __forceinline__ void rms_row_bf16(const float* xrow, const float* g, bf16_t* orow, int lane) {
    const f32x4* xr = (const f32x4*)xrow + lane; const f32x4* gr = (const f32x4*)g + lane;
    f32x4 v[4]; float s = 0.f;
#pragma unroll
    for (int j = 0; j < 4; ++j) { v[j] = xr[64 * j]; s += (v[j].x * v[j].x + v[j].y * v[j].y) + (v[j].z * v[j].z + v[j].w * v[j].w); }
    const float rstd = rsqrtf(wave_sum(s) * (1.f / 1024.f) + NORM_EPS);
    u32x2* o8 = (u32x2*)orow + lane;
#pragma unroll
    for (int j = 0; j < 4; ++j) { const f32x4 gg = gr[64 * j]; u32x2 w; w.x = cvt_pk_bf16(v[j].x * rstd * gg.x, v[j].y * rstd * gg.y); w.y = cvt_pk_bf16(v[j].z * rstd * gg.z, v[j].w * rstd * gg.w); o8[64 * j] = w; }
}

constexpr int KROW = 104, VROW = 72;
constexpr int ATT_KB = 64 * KROW * 2, ATT_VB = 64 * VROW * 2;
constexpr int ATT_SCR = 2 * (ATT_KB + ATT_VB);

__device__ __forceinline__ void att_unit(LAS unsigned char* lds, int b, int h, int qb, const bf16_t* __restrict__ q, const bf16_t* __restrict__ kvb, const bf16_t* __restrict__ kr,
                                         const float* __restrict__ cosM, const float* __restrict__ sinM, bf16_t* __restrict__ mix) {
    const int tid = tid_opaque(), lane = tid & 63, w = tid >> 6, r32 = lane & 31, hi = lane >> 5;
    LAS float* scr = (LAS float*)(lds + ATT_SCR) + w * 32;
    const int qrow = qb * 256 + w * 32 + r32; const size_t tok = (size_t)b * SEQ + qrow;
    bf16x8 qf[6];
    {
        const bf16_t* qp = q + tok * 768 + h * 96 + hi * 8;
#pragma unroll
        for (int d0 = 0; d0 < 4; ++d0) qf[d0] = *(const bf16x8*)(qp + d0 * 16);
        const u32x4 x1 = *(const u32x4*)(qp + 64), x2 = *(const u32x4*)(qp + 80);
        const f32x4 c0 = *(const f32x4*)(cosM + tok * 16 + hi * 8), c1 = *(const f32x4*)(cosM + tok * 16 + hi * 8 + 4);
        const f32x4 s0 = *(const f32x4*)(sinM + tok * 16 + hi * 8), s1 = *(const f32x4*)(sinM + tok * 16 + hi * 8 + 4);
        float a[8], bb[8], cs[8] = {c0.x, c0.y, c0.z, c0.w, c1.x, c1.y, c1.z, c1.w}, sn[8] = {s0.x, s0.y, s0.z, s0.w, s1.x, s1.y, s1.z, s1.w};
#pragma unroll
        for (int j = 0; j < 4; ++j) { a[2 * j] = bflo(x1[j]); a[2 * j + 1] = bfhi(x1[j]); bb[2 * j] = bflo(x2[j]); bb[2 * j + 1] = bfhi(x2[j]); }
        u32x4 o1, o2;
#pragma unroll
        for (int j = 0; j < 4; ++j) {
            o1[j] = cvt_pk_bf16(a[2 * j] * cs[2 * j] - bb[2 * j] * sn[2 * j], a[2 * j + 1] * cs[2 * j + 1] - bb[2 * j + 1] * sn[2 * j + 1]);
            o2[j] = cvt_pk_bf16(bb[2 * j] * cs[2 * j] + a[2 * j] * sn[2 * j], bb[2 * j + 1] * cs[2 * j + 1] + a[2 * j + 1] * sn[2 * j + 1]); }
        qf[4] = __builtin_bit_cast(bf16x8, o1); qf[5] = __builtin_bit_cast(bf16x8, o2);
    }
    const int k_key = tid >> 3, k_ch = tid & 7;
    const int r_key = (tid & 255) >> 2, r_ch = tid & 3;
    const bf16_t* kn_src = kvb + ((size_t)b * SEQ + k_key) * 1024 + h * 128 + k_ch * 8;
    const bf16_t* kr_src = kr + ((size_t)b * SEQ + r_key) * 32 + r_ch * 8;
    const int kn_dst = (k_key * KROW + k_ch * 8) * 2, kr_dst = (r_key * KROW + 64 + r_ch * 8) * 2, vt_dst = (k_ch * 8 * VROW + k_key) * 2;
#define ATT_VWRITE(bufoff, gv) do { LAS bf16_t* vd_ = (LAS bf16_t*)(lds + 2 * ATT_KB + (bufoff) + vt_dst); _Pragma("unroll") for (int j_ = 0; j_ < 4; ++j_) { \
        vd_[(2 * j_) * VROW] = (bf16_t)((gv)[j_] & 0xffffu); vd_[(2 * j_ + 1) * VROW] = (bf16_t)((gv)[j_] >> 16); } } while (0)
    const int ntiles = 4 * qb + 4;
    u32x4 gk, gr, gv;
    gk = *(const u32x4*)kn_src; gv = *(const u32x4*)(kn_src + 64); if (tid < 256) gr = *(const u32x4*)kr_src;
    *(LAS u32x4*)(lds + kn_dst) = gk; ATT_VWRITE(0, gv); if (tid < 256) *(LAS u32x4*)(lds + kr_dst) = gr;
    __syncthreads();
    f32x16 o0, o1;
#pragma unroll
    for (int r = 0; r < 16; ++r) { o0[r] = 0.f; o1[r] = 0.f; }
    float mrow = -1e30f, lrow = 0.f;
    const float SC = 0.10206207261596577f * 1.4426950408889634f;
    const int wq0 = qb * 256 + w * 32;
    for (int kt = 0; kt < ntiles; ++kt) {
        const int cur = kt & 1;
        if (kt + 1 < ntiles) { const size_t ko = (size_t)(kt + 1) * 64; gk = *(const u32x4*)(kn_src + ko * 1024); gv = *(const u32x4*)(kn_src + ko * 1024 + 64); if (tid < 256) gr = *(const u32x4*)(kr_src + ko * 32); }
        const int k0 = kt * 64;
        if (k0 <= wq0 + 31) {
            const LAS unsigned char* Kb = lds + cur * ATT_KB; const LAS unsigned char* Vb = lds + 2 * ATT_KB + cur * ATT_VB;
            f32x16 p0, p1;
#pragma unroll
            for (int r = 0; r < 16; ++r) { p0[r] = 0.f; p1[r] = 0.f; }
#pragma unroll
            for (int d0 = 0; d0 < 6; ++d0) {
                const bf16x8 k0f = *(const LAS bf16x8*)(Kb + (r32 * KROW + d0 * 16 + hi * 8) * 2);
                const bf16x8 k1f = *(const LAS bf16x8*)(Kb + ((32 + r32) * KROW + d0 * 16 + hi * 8) * 2);
                p0 = MFMA32(k0f, qf[d0], p0); p1 = MFMA32(k1f, qf[d0], p1);
            }
            const bool need_mask = (k0 + 63 > wq0);
            float mx = -1e30f;
            if (need_mask) {
#pragma unroll
                for (int r = 0; r < 16; ++r) { const int key = k0 + crow(r, hi); if (key > qrow) p0[r] = -1e30f; if (key + 32 > qrow) p1[r] = -1e30f; }
            }
#pragma unroll
            for (int r = 0; r < 16; ++r) mx = fmaxf(mx, fmaxf(p0[r], p1[r]));
            mx = fmaxf(mx, __shfl_xor(mx, 32)) * SC;
            const float mnew = fmaxf(mrow, mx);
            const bool grew = __any(mnew > mrow);
            const float alpha = __builtin_amdgcn_exp2f(mrow - mnew); mrow = mnew;
            float ls = 0.f;
#pragma unroll
            for (int r = 0; r < 16; ++r) { p0[r] = __builtin_amdgcn_exp2f(__builtin_fmaf(p0[r], SC, -mnew)); p1[r] = __builtin_amdgcn_exp2f(__builtin_fmaf(p1[r], SC, -mnew)); ls += p0[r] + p1[r]; }
            lrow = lrow * alpha + ls;
            if (grew) {
                if (hi == 0) scr[r32] = alpha;
                asm volatile("s_waitcnt lgkmcnt(0)" ::: "memory");
#pragma unroll
                for (int i = 0; i < 4; ++i) { const f32x4 al = *(const LAS f32x4*)(scr + 8 * i + 4 * hi);
#pragma unroll
                    for (int j = 0; j < 4; ++j) { o0[4 * i + j] *= al[j]; o1[4 * i + j] *= al[j]; } }
                asm volatile("s_waitcnt lgkmcnt(0)" ::: "memory");
            }
#pragma unroll
            for (int s = 0; s < 4; ++s) {
                u32x4 pw;
#pragma unroll
                for (int j = 0; j < 4; ++j) pw[j] = (s < 2) ? cvt_pk_bf16(p0[8 * (s & 1) + 2 * j], p0[8 * (s & 1) + 2 * j + 1]) : cvt_pk_bf16(p1[8 * (s & 1) + 2 * j], p1[8 * (s & 1) + 2 * j + 1]);
                const bf16x8 pa = __builtin_bit_cast(bf16x8, pw);
#pragma unroll
                for (int dvh = 0; dvh < 2; ++dvh) {
                    const LAS unsigned char* vp = Vb + ((dvh * 32 + r32) * VROW + 16 * s + 4 * hi) * 2;
                    const u32x2 lo = *(const LAS u32x2*)vp, hh = *(const LAS u32x2*)(vp + 16);
                    u32x4 vv; vv.x = lo.x; vv.y = lo.y; vv.z = hh.x; vv.w = hh.y;
                    if (dvh == 0) o0 = MFMA32(pa, __builtin_bit_cast(bf16x8, vv), o0); else o1 = MFMA32(pa, __builtin_bit_cast(bf16x8, vv), o1);
                }
            }
        }
        if (kt + 1 < ntiles) { const int nx = cur ^ 1; *(LAS u32x4*)(lds + nx * ATT_KB + kn_dst) = gk; ATT_VWRITE(nx * ATT_VB, gv); if (tid < 256) *(LAS u32x4*)(lds + nx * ATT_KB + kr_dst) = gr; }
        __syncthreads();
    }
    float lt = lrow + __shfl_xor(lrow, 32);
    if (hi == 0) scr[r32] = 1.f / lt;
    asm volatile("s_waitcnt lgkmcnt(0)" ::: "memory");
#pragma unroll
    for (int i = 0; i < 4; ++i) { const f32x4 il = *(const LAS f32x4*)(scr + 8 * i + 4 * hi);
#pragma unroll
        for (int j = 0; j < 4; ++j) { const int r = 4 * i + j; const size_t orow = (size_t)b * SEQ + qb * 256 + w * 32 + crow(r, hi);
            mix[orow * 1024 + 512 + h * 64 + r32] = f2bf(o0[r] * il[j]); mix[orow * 1024 + 512 + h * 64 + 32 + r32] = f2bf(o1[r] * il[j]); } }
    asm volatile("s_waitcnt lgkmcnt(0)" ::: "memory");
}

__device__ __forceinline__ void ret_unit(LAS unsigned char* lds, int b, int h, int jb, const bf16_t* __restrict__ pb, const float* __restrict__ cosR, const float* __restrict__ sinR,
                                         const bf16_t* __restrict__ rprev, float* __restrict__ yb) {
    const int tid = tid_opaque(), lane = tid & 63, w = tid >> 6, r32 = lane & 31, hi = lane >> 5;
    const float lg2 = log2f(1.f - exp2f(-5.f - (float)h));
    const int qrow = jb * 256 + w * 32 + r32; const size_t tok = (size_t)b * SEQ + qrow;
    const int chunk = qrow >> 7;
    bf16x8 qf[4], qx[4];
    {
        const bf16_t* qp = pb + tok * 1024 + h * 64 + hi * 8;
        const float qdec = exp2f(lg2 * (float)((qrow & 127) + 1));
#pragma unroll
        for (int d0 = 0; d0 < 2; ++d0) {
            const u32x4 x1 = *(const u32x4*)(qp + d0 * 16), x2 = *(const u32x4*)(qp + d0 * 16 + 32);
            const float* cp = cosR + tok * 32 + d0 * 16 + hi * 8; const float* sp = sinR + tok * 32 + d0 * 16 + hi * 8;
            const f32x4 c0 = *(const f32x4*)cp, c1 = *(const f32x4*)(cp + 4), s0 = *(const f32x4*)sp, s1 = *(const f32x4*)(sp + 4);
            const float cs[8] = {c0.x, c0.y, c0.z, c0.w, c1.x, c1.y, c1.z, c1.w}, sn[8] = {s0.x, s0.y, s0.z, s0.w, s1.x, s1.y, s1.z, s1.w};
            u32x4 o1, o2, y1, y2;
#pragma unroll
            for (int j = 0; j < 4; ++j) {
                const float a0 = bflo(x1[j]), a1 = bfhi(x1[j]), b0 = bflo(x2[j]), b1 = bfhi(x2[j]);
                const float r0 = a0 * cs[2 * j] - b0 * sn[2 * j], r1 = a1 * cs[2 * j + 1] - b1 * sn[2 * j + 1];
                const float t0 = b0 * cs[2 * j] + a0 * sn[2 * j], t1 = b1 * cs[2 * j + 1] + a1 * sn[2 * j + 1];
                o1[j] = cvt_pk_bf16(r0, r1); o2[j] = cvt_pk_bf16(t0, t1); y1[j] = cvt_pk_bf16(r0 * qdec, r1 * qdec); y2[j] = cvt_pk_bf16(t0 * qdec, t1 * qdec); }
            qf[d0] = __builtin_bit_cast(bf16x8, o1); qf[d0 + 2] = __builtin_bit_cast(bf16x8, o2); qx[d0] = __builtin_bit_cast(bf16x8, y1); qx[d0 + 2] = __builtin_bit_cast(bf16x8, y2);
        }
    }
    f32x16 o0, o1;
#pragma unroll
    for (int r = 0; r < 16; ++r) { o0[r] = 0.f; o1[r] = 0.f; }
    {
        const bf16_t* rp = rprev + ((size_t)((b * 4 + h) * 32 + chunk)) * 4096;
#pragma unroll
        for (int d0 = 0; d0 < 4; ++d0) {
            const bf16x8 r0 = *(const bf16x8*)(rp + (size_t)r32 * 64 + d0 * 16 + hi * 8), r1 = *(const bf16x8*)(rp + (size_t)(32 + r32) * 64 + d0 * 16 + hi * 8);
            o0 = MFMA32(qx[d0], r0, o0); o1 = MFMA32(qx[d0], r1, o1);
        }
    }
    const int l_key = (tid & 255) >> 2, l_c = tid & 3;
    for (int kt = 0; kt < 4; ++kt) {
        const int k0 = jb * 256 + kt * 64;
        __syncthreads();
        if (tid < 256) {
            const size_t kt_tok = (size_t)b * SEQ + k0 + l_key; const bf16_t* kp = pb + kt_tok * 1024 + 256 + h * 64 + l_c * 8;
            const u32x4 x1 = *(const u32x4*)kp, x2 = *(const u32x4*)(kp + 32);
            const float* cp = cosR + kt_tok * 32 + l_c * 8; const float* sp = sinR + kt_tok * 32 + l_c * 8;
            const f32x4 c0 = *(const f32x4*)cp, c1 = *(const f32x4*)(cp + 4), s0 = *(const f32x4*)sp, s1 = *(const f32x4*)(sp + 4);
            const float cs[8] = {c0.x, c0.y, c0.z, c0.w, c1.x, c1.y, c1.z, c1.w}, sn[8] = {s0.x, s0.y, s0.z, s0.w, s1.x, s1.y, s1.z, s1.w};
            u32x4 o1v, o2v;
#pragma unroll
            for (int j = 0; j < 4; ++j) {
                const float a0 = bflo(x1[j]), a1 = bfhi(x1[j]), b0 = bflo(x2[j]), b1 = bfhi(x2[j]);
                o1v[j] = cvt_pk_bf16((a0 * cs[2 * j] - b0 * sn[2 * j]) * 0.125f, (a1 * cs[2 * j + 1] - b1 * sn[2 * j + 1]) * 0.125f);
                o2v[j] = cvt_pk_bf16((b0 * cs[2 * j] + a0 * sn[2 * j]) * 0.125f, (b1 * cs[2 * j + 1] + a1 * sn[2 * j + 1]) * 0.125f); }
            *(LAS u32x4*)(lds + (l_key * KROW + l_c * 8) * 2) = o1v; *(LAS u32x4*)(lds + (l_key * KROW + 32 + l_c * 8) * 2) = o2v;
        } else {
            const size_t vt_tok = (size_t)b * SEQ + k0 + l_key; const bf16_t* vp = pb + vt_tok * 1024 + 512 + h * 64 + l_c * 16;
            const u32x4 x1 = *(const u32x4*)vp, x2 = *(const u32x4*)(vp + 8);
            LAS bf16_t* vd = (LAS bf16_t*)(lds + 2 * ATT_KB) + l_key;
#pragma unroll
            for (int j = 0; j < 4; ++j) { vd[(l_c * 16 + 2 * j) * VROW] = (bf16_t)(x1[j] & 0xffffu); vd[(l_c * 16 + 2 * j + 1) * VROW] = (bf16_t)(x1[j] >> 16);
                                          vd[(l_c * 16 + 8 + 2 * j) * VROW] = (bf16_t)(x2[j] & 0xffffu); vd[(l_c * 16 + 8 + 2 * j + 1) * VROW] = (bf16_t)(x2[j] >> 16); }
        }
        __syncthreads();
        if ((k0 >> 7) == chunk && k0 <= jb * 256 + w * 32 + 31) {
            const LAS unsigned char* Kb = lds; const LAS unsigned char* Vb = lds + 2 * ATT_KB;
            f32x16 p0, p1;
#pragma unroll
            for (int r = 0; r < 16; ++r) { p0[r] = 0.f; p1[r] = 0.f; }
#pragma unroll
            for (int d0 = 0; d0 < 4; ++d0) {
                const bf16x8 k0f = *(const LAS bf16x8*)(Kb + (r32 * KROW + d0 * 16 + hi * 8) * 2);
                const bf16x8 k1f = *(const LAS bf16x8*)(Kb + ((32 + r32) * KROW + d0 * 16 + hi * 8) * 2);
                p0 = MFMA32(k0f, qf[d0], p0); p1 = MFMA32(k1f, qf[d0], p1);
            }
#pragma unroll
            for (int r = 0; r < 16; ++r) {
                const int df0 = qrow - (k0 + crow(r, hi)), df1 = df0 - 32;
                p0[r] = (df0 >= 0) ? p0[r] * __builtin_amdgcn_exp2f(lg2 * (float)df0) : 0.f;
                p1[r] = (df1 >= 0) ? p1[r] * __builtin_amdgcn_exp2f(lg2 * (float)df1) : 0.f;
            }
#pragma unroll
            for (int s = 0; s < 4; ++s) {
                u32x4 pw;
#pragma unroll
                for (int j = 0; j < 4; ++j) pw[j] = (s < 2) ? cvt_pk_bf16(p0[8 * (s & 1) + 2 * j], p0[8 * (s & 1) + 2 * j + 1]) : cvt_pk_bf16(p1[8 * (s & 1) + 2 * j], p1[8 * (s & 1) + 2 * j + 1]);
                const bf16x8 pa = __builtin_bit_cast(bf16x8, pw);
#pragma unroll
                for (int dvh = 0; dvh < 2; ++dvh) {
                    const LAS unsigned char* vp = Vb + ((dvh * 32 + r32) * VROW + 16 * s + 4 * hi) * 2;
                    const u32x2 lo = *(const LAS u32x2*)vp, hh = *(const LAS u32x2*)(vp + 16);
                    u32x4 vv; vv.x = lo.x; vv.y = lo.y; vv.z = hh.x; vv.w = hh.y;
                    if (dvh == 0) o0 = MFMA32(pa, __builtin_bit_cast(bf16x8, vv), o0); else o1 = MFMA32(pa, __builtin_bit_cast(bf16x8, vv), o1);
                }
            }
        }
    }
#pragma unroll
    for (int r = 0; r < 16; ++r) { const size_t orow = (size_t)b * SEQ + jb * 256 + w * 32 + crow(r, hi);
        yb[orow * 256 + h * 64 + r32] = o0[r]; yb[orow * 256 + h * 64 + 32 + r32] = o1[r]; }
}

__device__ __forceinline__ void ret_kv_unit(LAS unsigned char* lds, int bh, int ci, const bf16_t* __restrict__ pb, const float* __restrict__ cosR, const float* __restrict__ sinR, float* __restrict__ kvt) {
    const int tid = tid_opaque(); const int b = bh >> 2, h = bh & 3;
    LAS float* Ks = (LAS float*)lds;
    LAS float* Vs = Ks + 128 * 64;
    const float lg2 = log2f(1.f - exp2f(-5.f - (float)h));
    __syncthreads();
    {
        const int i = tid & 31; float x1[8], x2[8], cc[8], ss[8];
#pragma unroll
        for (int it = 0; it < 8; ++it) { const int t = (tid >> 5) + 16 * it; const size_t tok = (size_t)b * SEQ + ci * 128 + t;
            x1[it] = bf2f(pb[tok * 1024 + 256 + h * 64 + i]); x2[it] = bf2f(pb[tok * 1024 + 256 + h * 64 + 32 + i]); cc[it] = cosR[tok * 32 + i]; ss[it] = sinR[tok * 32 + i]; }
#pragma unroll
        for (int it = 0; it < 8; ++it) { const int t = (tid >> 5) + 16 * it; const float sc = 0.125f * exp2f(lg2 * (float)(127 - t));
            Ks[t * 64 + i] = (x1[it] * cc[it] - x2[it] * ss[it]) * sc; Ks[t * 64 + 32 + i] = (x2[it] * cc[it] + x1[it] * ss[it]) * sc; }
        u32x4 vr[2];
#pragma unroll
        for (int it = 0; it < 2; ++it) { const int ch = tid + 512 * it, t = ch >> 3, c8 = ch & 7; vr[it] = *(const u32x4*)(pb + ((size_t)b * SEQ + ci * 128 + t) * 1024 + 512 + h * 64 + c8 * 8); }
#pragma unroll
        for (int it = 0; it < 2; ++it) { const int ch = tid + 512 * it, t = ch >> 3, c8 = ch & 7; LAS float* d = Vs + t * 64 + c8 * 8;
            *(LAS f32x4*)d = (f32x4){bflo(vr[it].x), bfhi(vr[it].x), bflo(vr[it].y), bfhi(vr[it].y)}; *(LAS f32x4*)(d + 4) = (f32x4){bflo(vr[it].z), bfhi(vr[it].z), bflo(vr[it].w), bfhi(vr[it].w)}; }
    }
    __syncthreads();
    const int e = tid >> 3, d0 = (tid & 7) * 8;
    float acc[8];
#pragma unroll
    for (int j = 0; j < 8; ++j) acc[j] = 0.f;
    for (int t = 0; t < 128; ++t) {
        const float v = Vs[t * 64 + e]; const f32x4 ka = *(const LAS f32x4*)(Ks + t * 64 + d0), kb = *(const LAS f32x4*)(Ks + t * 64 + d0 + 4);
        acc[0] += v * ka.x; acc[1] += v * ka.y; acc[2] += v * ka.z; acc[3] += v * ka.w; acc[4] += v * kb.x; acc[5] += v * kb.y; acc[6] += v * kb.z; acc[7] += v * kb.w;
    }
    float* o = kvt + ((size_t)(bh * 32 + ci)) * 4096 + e * 64 + d0;
    *(f32x4*)o = (f32x4){acc[0], acc[1], acc[2], acc[3]}; *(f32x4*)(o + 4) = (f32x4){acc[4], acc[5], acc[6], acc[7]};
}

struct PrepW { bf16x8 Bw[2], Ba[2], Bv[2], Bg[2][2], Bv1[2]; };
__device__ __forceinline__ bf16x8 pack_col8(const float* W, int ld, int k0, int n) {
    float t[8];
#pragma unroll
    for (int j = 0; j < 8; ++j) t[j] = W[(size_t)(k0 + j) * ld + n];
    u32x4 o; o.x = cvt_pk_bf16(t[0], t[1]); o.y = cvt_pk_bf16(t[2], t[3]); o.z = cvt_pk_bf16(t[4], t[5]); o.w = cvt_pk_bf16(t[6], t[7]);
    return __builtin_bit_cast(bf16x8, o);
}
__device__ __forceinline__ bf16x8 pack_f8(const f32x4 a, const f32x4 b) {
    u32x4 o; o.x = cvt_pk_bf16(a.x, a.y); o.y = cvt_pk_bf16(a.z, a.w); o.z = cvt_pk_bf16(b.x, b.y); o.w = cvt_pk_bf16(b.z, b.w);
    return __builtin_bit_cast(bf16x8, o);
}
#define MFMA16(a, b, c) __builtin_amdgcn_mfma_f32_16x16x32_bf16((a), (b), (c), 0, 0, 0)
__device__ __forceinline__ void prep_fetch_rows(unsigned (&raw)[17], const bf16_t* __restrict__ pa, int t0, int c2) {
    raw[0] = ((t0 & (SEQ - 1)) == 0) ? 0u : *(const unsigned*)(pa + (size_t)(t0 - 1) * 1024 + c2);
#pragma unroll
    for (int t = 0; t < 16; ++t) raw[t + 1] = *(const unsigned*)(pa + (size_t)(t0 + t) * 1024 + c2);
}
constexpr int PSW = 900;
struct PrepC { float mu0, mu1, w0c, a0c, kkc, kac, rkc, v0c; };
__device__ __forceinline__ void rwkv_prep_tile(LAS unsigned char* lds, int tile, int next_tile, unsigned (&raw)[17], const PrepC& PC, int layer, const Params& P, int z, const PrepW& W, const bf16_t* __restrict__ pa, unsigned char* __restrict__ rec,
                                               bf16_t* __restrict__ vbuf, bf16_t* __restrict__ gbuf, bf16_t* __restrict__ vfirst, float* __restrict__ bs, float* __restrict__ cs) {
    const int tid = tid_opaque(), lane = tid & 63;
    LAS float* PS = (LAS float*)lds;
    LAS float* VV = PS + 16 * PSW;
    const float* mu = (const float*)P.in[I_MU + z] + layer * RW_IN;
    const float* w0 = (const float*)P.in[I_W0 + z] + layer * 256; const float* w2 = (const float*)P.in[I_W2 + z] + layer * 32 * 256;
    const float* a0 = (const float*)P.in[I_A0 + z] + layer * 256; const float* a2 = (const float*)P.in[I_A2 + z] + layer * 32 * 256;
    const float* g2 = (const float*)P.in[I_G2 + z] + layer * 64 * 256;
    const float* k_k = (const float*)P.in[I_KK + z] + layer * 256; const float* k_a = (const float*)P.in[I_KA + z] + layer * 256; const float* r_k = (const float*)P.in[I_RK + z] + layer * 256;
    const float* v0 = (const float*)P.in[I_V0 + z] + (layer > 0 ? (layer - 1) * 256 : 0);
    const float* v1 = (const float*)P.in[I_V1 + z] + (layer > 0 ? (layer - 1) * 256 * 32 : 0);
    const float* v2 = (const float*)P.in[I_V2 + z] + (layer > 0 ? (layer - 1) * 32 * 256 : 0);
    const int t0 = tile * 16;
    __syncthreads();
    if (tid < 448) {
        const int c2 = tid * 2; const float mu0 = PC.mu0, mu1 = PC.mu1;
#pragma unroll
        for (int t = 0; t < 16; ++t) {
            float x0 = bflo(raw[t + 1]), x1 = bfhi(raw[t + 1]); const float y0 = bflo(raw[t]), y1 = bfhi(raw[t]);
            x0 = x0 + (y0 - x0) * mu0; x1 = x1 + (y1 - x1) * mu1;
            if (c2 >= 768) { if (c2 < 800) { x0 = 2.f * sigmoidf_(2.f * x0) - 1.f; x1 = 2.f * sigmoidf_(2.f * x1) - 1.f; } else if (c2 >= 832) { x0 = sigmoidf_(x0); x1 = sigmoidf_(x1); } }
            *(LAS f32x2*)(PS + t * PSW + c2) = (f32x2){x0, x1};
        }
        if (next_tile >= 0) prep_fetch_rows(raw, pa, next_tile * 16, c2);
    }
    if (layer > 0) VV[tid] = 0.f;
    __syncthreads();
    const int wv = tid >> 6, l16 = lane & 15, lq = lane >> 4;
    LAS float* LR = VV + 512;
    const f32x4 zero4 = {0.f, 0.f, 0.f, 0.f};
    if (layer > 0) {
        const LAS float* ap = PS + l16 * PSW + 512 + 32 * wv + 8 * lq;
        const bf16x8 A = pack_f8(*(const LAS f32x4*)ap, *(const LAS f32x4*)(ap + 4));
#pragma unroll
        for (int nt = 0; nt < 2; ++nt) { const f32x4 d = MFMA16(A, W.Bv1[nt], zero4);
#pragma unroll
            for (int r = 0; r < 4; ++r) (void)__builtin_amdgcn_ds_faddf(VV + (4 * lq + r) * 32 + 16 * nt + l16, d[r], 0, 0, false); }
        __syncthreads();
    }
    {
        const LAS float* ap = PS + l16 * PSW + 768 + 8 * lq;
        const bf16x8 Aw = pack_f8(*(const LAS f32x4*)ap, *(const LAS f32x4*)(ap + 4)), Aa = pack_f8(*(const LAS f32x4*)(ap + 32), *(const LAS f32x4*)(ap + 36));
        const bf16x8 Ag0 = pack_f8(*(const LAS f32x4*)(ap + 64), *(const LAS f32x4*)(ap + 68)), Ag1 = pack_f8(*(const LAS f32x4*)(ap + 96), *(const LAS f32x4*)(ap + 100));
        bf16x8 Av = Aw;
        if (layer > 0) { const LAS float* vp = VV + l16 * 32 + 8 * lq; Av = pack_f8(*(const LAS f32x4*)vp, *(const LAS f32x4*)(vp + 4)); }
#pragma unroll
        for (int nt = 0; nt < 2; ++nt) {
            const f32x4 dw = MFMA16(Aw, W.Bw[nt], zero4), da = MFMA16(Aa, W.Ba[nt], zero4);
            f32x4 dg = MFMA16(Ag0, W.Bg[nt][0], zero4); dg = MFMA16(Ag1, W.Bg[nt][1], dg);
            f32x4 dv = zero4; if (layer > 0) dv = MFMA16(Av, W.Bv[nt], zero4);
            const int ch = 16 * (2 * wv + nt) + l16;
#pragma unroll
            for (int r = 0; r < 4; ++r) { LAS float* o = LR + (4 * lq + r) * 256 + ch; o[0] = dw[r]; o[4096] = da[r]; o[8192] = dg[r]; o[12288] = dv[r]; }
        }
    }
    __syncthreads();
    const int c = tid & 255, th = tid >> 8;
    float aw[8], aa[8], ag[8], av[8];
#pragma unroll
    for (int i = 0; i < 8; ++i) { const LAS float* o = LR + (th * 8 + i) * 256 + c; aw[i] = o[0]; aa[i] = o[4096]; ag[i] = o[8192]; av[i] = o[12288]; }
    const float w0c = PC.w0c, a0c = PC.a0c, kkc = PC.kkc, kac = PC.kac, rkc = PC.rkc, v0c = PC.v0c;
    const int head = c >> 6, kq = (c & 63) >> 2, e = c & 3;
    float kk_[8], b_[8], kp_[8], dec_[8], r_[8], v_[8], a_[8], q_[8];
#pragma unroll
    for (int i = 0; i < 8; ++i) {
        const int t = th * 8 + i; const size_t tok = (size_t)t0 + t;
        const float r = PS[t * PSW + c], k = PS[t * PSW + 256 + c]; float v = PS[t * PSW + 512 + c];
        dec_[i] = __expf(-0.6065306597126334f * sigmoidf_(w0c + aw[i]));
        const float a = sigmoidf_(a0c + aa[i]);
        if (layer > 0) { const float vf = bf2f(vfirst[tok * 256 + c]); v = v + (vf - v) * sigmoidf_(v0c + av[i]); }
        else vfirst[tok * 256 + c] = f2bf(v);
        r_[i] = r; v_[i] = v; a_[i] = a; kk_[i] = k * kkc; kp_[i] = k * (1.f + (a - 1.f) * kac);
        q_[i] = kk_[i] * kk_[i];
    }
#pragma unroll
    for (int i = 0; i < 8; ++i) q_[i] = wave_sum(q_[i]);
#pragma unroll
    for (int i = 0; i < 8; ++i) { kk_[i] *= rsqrtf(fmaxf(q_[i], 1e-24f)); b_[i] = kk_[i] * a_[i]; q_[i] = r_[i] * kp_[i] * rkc; }
#pragma unroll
    for (int i = 0; i < 8; ++i) q_[i] = wave_sum(q_[i]);
    float d1_[4], d2_[4];
#pragma unroll
    for (int j = 0; j < 4; ++j) { d1_[j] = b_[2 * j] * kk_[2 * j + 1]; d2_[j] = kp_[2 * j] * kk_[2 * j + 1]; }
#pragma unroll
    for (int j = 0; j < 4; ++j) { d1_[j] = wave_sum(d1_[j]); d2_[j] = wave_sum(d2_[j]); }
#pragma unroll
    for (int i = 0; i < 8; ++i) {
        const int t = th * 8 + i; const size_t tok = (size_t)t0 + t;
        const size_t ri = tok * 256 + c;
        ((float*)rec)[ri] = dec_[i]; ((bf16_t*)(rec + 16 * MiB))[ri] = f2bf(r_[i]); ((bf16_t*)(rec + 24 * MiB))[ri] = f2bf(kp_[i]); ((bf16_t*)(rec + 40 * MiB))[ri] = f2bf(b_[i]);
        if ((i & 1) == 0) ((bf16_t*)(rec + 32 * MiB))[ri] = f2bf(-kk_[i]);
        else {
            ((bf16_t*)(rec + 32 * MiB))[ri] = f2bf(kk_[i - 1] * d1_[i >> 1] - dec_[i - 1] * kk_[i]);
            if (lane == 0) cs[tok * 4 + head] = -d2_[i >> 1];
        }
        vbuf[tok * 256 + c] = f2bf(v_[i]); gbuf[tok * 256 + c] = f2bf(ag[i]);
        if (lane == 0) bs[tok * 4 + head] = q_[i];
    }
}

constexpr int SC_TC = 32;
constexpr int SC_REC_F = SC_TC * 16 * 20;
constexpr int SC_V_F = SC_TC * 20;
__device__ __forceinline__ void scan_load_chunk(LAS float* recb, LAS float* vb, const unsigned char* __restrict__ rec, const bf16_t* __restrict__ vbuf, const float* __restrict__ cs, size_t tok0, int h, int v0, int lt) {
#pragma unroll
    for (int it = 0; it < 2; ++it) {
        const int p = lt + it * 256, step = p >> 4, kq = p & 15;
        const size_t ri = (tok0 + step) * 256 + h * 64 + 4 * kq;
        const f32x4 wv = *(const f32x4*)((const float*)rec + ri);
        const u32x2 rr = *(const u32x2*)((const bf16_t*)(rec + 16 * MiB) + ri), kk2 = *(const u32x2*)((const bf16_t*)(rec + 24 * MiB) + ri);
        const u32x2 nn = *(const u32x2*)((const bf16_t*)(rec + 32 * MiB) + ri), bb = *(const u32x2*)((const bf16_t*)(rec + 40 * MiB) + ri);
        const u32x4 a = {rr.x, rr.y, kk2.x, kk2.y}, bq = {nn.x, nn.y, bb.x, bb.y};
        LAS float* d = recb + (step * 16 + kq) * 20;
        *(LAS f32x4*)d = wv;
        *(LAS f32x4*)(d + 4) = (f32x4){bflo(a.x), bfhi(a.x), bflo(a.y), bfhi(a.y)};
        *(LAS f32x4*)(d + 8) = (f32x4){bflo(a.z), bfhi(a.z), bflo(a.w), bfhi(a.w)};
        *(LAS f32x4*)(d + 12) = (f32x4){bflo(bq.x), bfhi(bq.x), bflo(bq.y), bfhi(bq.y)};
        *(LAS f32x4*)(d + 16) = (f32x4){bflo(bq.z), bfhi(bq.z), bflo(bq.w), bfhi(bq.w)};
    }
    if (lt < 128) { const int step = lt >> 2, qd = lt & 3;
        const u32x2 x = *(const u32x2*)(vbuf + (tok0 + step) * 256 + h * 64 + v0 + 4 * qd);
        *(LAS f32x4*)(vb + step * 20 + 4 * qd) = (f32x4){bflo(x.x), bfhi(x.x), bflo(x.y), bfhi(x.y)}; }
    else if (lt < 128 + SC_TC) { const int step = lt - 128; vb[step * 20 + 16] = cs[(tok0 + step) * 4 + h]; }
}
__device__ __forceinline__ void rwkv_scan_block(LAS unsigned char* lds, int blk, const unsigned char* __restrict__ rec, const bf16_t* __restrict__ vbuf, const float* __restrict__ cs, float* __restrict__ ya) {
    const int tid = tid_opaque(), lane = tid & 63, w = tid >> 6;
    const int bh = blk >> 2, b = bh >> 2, h = bh & 3, v0 = (blk & 3) * 16;
    LAS float* RECB = (LAS float*)lds;
    LAS float* VB = RECB + 2 * SC_REC_F;
    const size_t tokb = (size_t)b * SEQ;
    const int rowl = lane >> 4, kq = lane & 15, row = v0 + 4 * (w & 3) + rowl;
    f32x2 Sa = {0.f, 0.f}, Sb = {0.f, 0.f}; float ykeep = 0.f;
    __syncthreads();
    if (w >= 4) scan_load_chunk(RECB, VB, rec, vbuf, cs, tokb, h, v0, tid - 256);
    for (int c = 0; c < SEQ / SC_TC; ++c) {
        __syncthreads();
        const int buf = c & 1;
        if (w >= 4) { if (c + 1 < SEQ / SC_TC) scan_load_chunk(RECB + (buf ^ 1) * SC_REC_F, VB + (buf ^ 1) * SC_V_F, rec, vbuf, cs, tokb + (size_t)(c + 1) * SC_TC, h, v0, tid - 256); }
        else {
            const LAS float* rb = RECB + buf * SC_REC_F + kq * 20; const LAS float* vb = VB + buf * SC_V_F;
            float* yo = ya + (tokb + (size_t)c * SC_TC + kq) * 256 + h * 64 + row;
#define SC_LD(P, st) do { const LAS float* R_ = rb + (st) * 320; P##w = *(const LAS f32x4*)R_; P##r = *(const LAS f32x4*)(R_ + 4); P##k = *(const LAS f32x4*)(R_ + 8); \
                          P##n = *(const LAS f32x4*)(R_ + 12); P##b = *(const LAS f32x4*)(R_ + 16); P##v = vb[(st) * 20 + 4 * w + rowl]; } while (0)
#define LO2(q_) ((f32x2){(q_).x, (q_).y})
#define HI2(q_) ((f32x2){(q_).z, (q_).w})
            f32x4 Aw, Ar, Ak, An, Ab, Bw, Br, Bk, Bn, Bb, Cw, Cr, Ck, Cn, Cb, Dw, Dr, Dk, Dn, Db; float Av, Bv, Cv, Dv, Bc, Dc;
            SC_LD(A, 0); SC_LD(B, 1); Bc = vb[1 * 20 + 16];
#pragma unroll
            for (int st = 0; st < SC_TC; st += 4) {
                if (st + 2 < SC_TC) { SC_LD(C, st + 2); SC_LD(D, st + 3); Dc = vb[(st + 3) * 20 + 16]; }
#define SC_PAIR(E, O, Oc, S0) do { \
                f32x2 d0 = Sa * LO2(E##n); d0 = Sb * HI2(E##n) + d0; f32x2 d1 = Sa * LO2(O##n); d1 = Sb * HI2(O##n) + d1; \
                const f32x2 ve = {E##v, E##v}, vo = {O##v, O##v}; \
                f32x2 ta = ve * LO2(E##k), tb = ve * HI2(E##k); ta = Sa * LO2(E##w) + ta; tb = Sb * HI2(E##w) + tb; \
                const float sa0 = allreduce16(d0.x + d0.y); const float sa1 = allreduce16(d1.x + d1.y) + E##v * Oc; \
                const f32x2 s0 = {sa0, sa0}, s1 = {sa1, sa1}; \
                Sa = s0 * LO2(E##b) + ta; Sb = s0 * HI2(E##b) + tb; \
                f32x2 e0 = Sa * LO2(E##r); e0 = Sb * HI2(E##r) + e0; \
                f32x2 ua = vo * LO2(O##k), ub = vo * HI2(O##k); ua = Sa * LO2(O##w) + ua; ub = Sb * HI2(O##w) + ub; \
                Sa = s1 * LO2(O##b) + ua; Sb = s1 * HI2(O##b) + ub; \
                f32x2 e1 = Sa * LO2(O##r); e1 = Sb * HI2(O##r) + e1; \
                Y0 = e0.x + e0.y; Y1 = e1.x + e1.y; } while (0)
                float yp0, yp1, yp2, yp3;
#define Y0 yp0
#define Y1 yp1
                SC_PAIR(A, B, Bc, st);
#undef Y0
#undef Y1
                if (st + 4 < SC_TC) { SC_LD(A, st + 4); SC_LD(B, st + 5); Bc = vb[(st + 5) * 20 + 16]; }
#define Y0 yp2
#define Y1 yp3
                SC_PAIR(C, D, Dc, st + 2);
#undef Y0
#undef Y1
                {
                    const unsigned long long b0 = 0xAAAAAAAAAAAAAAAAull, b1 = 0xCCCCCCCCCCCCCCCCull;
                    float s01, x01, s23, x23;
                    asm volatile("v_cndmask_b32_e64 %0, %1, %2, %3" : "=v"(s01) : "v"(yp0), "v"(yp1), "s"(b0));
                    asm volatile("v_cndmask_b32_e64 %0, %1, %2, %3" : "=v"(x01) : "v"(yp1), "v"(yp0), "s"(b0));
                    asm volatile("v_cndmask_b32_e64 %0, %1, %2, %3" : "=v"(s23) : "v"(yp2), "v"(yp3), "s"(b0));
                    asm volatile("v_cndmask_b32_e64 %0, %1, %2, %3" : "=v"(x23) : "v"(yp3), "v"(yp2), "s"(b0));
                    const float a01 = s01 + dpp_mov<0xB1>(x01), a23 = s23 + dpp_mov<0xB1>(x23);
                    float sq, xq;
                    asm volatile("v_cndmask_b32_e64 %0, %1, %2, %3" : "=v"(sq) : "v"(a01), "v"(a23), "s"(b1));
                    asm volatile("v_cndmask_b32_e64 %0, %1, %2, %3" : "=v"(xq) : "v"(a23), "v"(a01), "s"(b1));
                    float yq = sq + dpp_mov<0x4E>(xq);
                    yq += dpp_mov<0x128>(yq); yq += dpp_mov<0x124>(yq);
                    const unsigned long long mk = 0x000F000F000F000Full << (st & 15);
                    asm volatile("v_cndmask_b32_e64 %0, %0, %1, %2" : "+v"(ykeep) : "v"(yq), "s"(mk));
                }
                if ((st & 15) == 12) yo[(size_t)(st - 12) * 256] = ykeep;
            }
#undef SC_PAIR
#undef SC_LD
#undef LO2
#undef HI2
        }
    }
}

#define XB_TMO      128
#define XB_XCNT(j)  (256  + 64 * (j))
#define XB_XSUB(j)  (1280 + 64 * (j))
#define XB_XGEN(j)  (2304 + 64 * (j))
#define XB_TOP      3328
#define XB_TOPGEN   3392
#define XB_SPIN_CAP (1u << 20)
__device__ __forceinline__ unsigned xb_ld(unsigned* p)              { return __hip_atomic_load(p, __ATOMIC_RELAXED, __HIP_MEMORY_SCOPE_AGENT); }
__device__ __forceinline__ unsigned xb_add(unsigned* p, unsigned v) { return __hip_atomic_fetch_add(p, v, __ATOMIC_RELAXED, __HIP_MEMORY_SCOPE_AGENT); }
__device__ __forceinline__ unsigned xb_xcc_id() { return (unsigned)__builtin_amdgcn_s_getreg((3 << 11) | 20) & 0xFu; }
#define XB_SPIN(cond, bar) do { unsigned _sp = 0; while (cond) { __builtin_amdgcn_s_sleep(1); \
    if ((++_sp & 255u) == 0u) { if (xb_ld(&(bar)[XB_TMO])) break; if (_sp > XB_SPIN_CAP) { atomicAdd(&(bar)[XB_TMO], 1u); break; } } } } while (0)
struct XcdBarrier { unsigned* bar; unsigned x; volatile LAS unsigned* st; };
__device__ __forceinline__ XcdBarrier xcd_barrier_post(unsigned* bar, volatile LAS unsigned* st) {
    XcdBarrier b; b.bar = bar; b.x = xb_xcc_id(); b.st = st;
    if (__builtin_amdgcn_workitem_id_x() == 0) (void)xb_add(&bar[XB_XCNT(b.x)], 1u);
    return b;
}
__device__ __forceinline__ void xcd_barrier_complete(unsigned* bar, unsigned x, unsigned& nloc, unsigned& nx) {
    const unsigned G = gridDim.x * gridDim.y * gridDim.z;
    unsigned sum, cnt, mine, sp = 0u;
    for (;;) {
        sum = 0u; cnt = 0u; mine = 0u;
#pragma unroll
        for (unsigned j = 0; j < 16; ++j) { const unsigned c = xb_ld(&bar[XB_XCNT(j)]); sum += c; cnt += (c > 0u) ? 1u : 0u; mine = (j == x) ? c : mine; }
        if (sum == G) break;
        __builtin_amdgcn_s_sleep(1);
        if ((++sp & 255u) == 0u) { if (xb_ld(&bar[XB_TMO])) break; if (sp > XB_SPIN_CAP) { atomicAdd(&bar[XB_TMO], 1u); break; } }
    }
    nloc = mine > 0u ? mine : 1u; nx = cnt > 0u ? cnt : 1u;
}
__device__ __forceinline__ void xcd_barrier(const XcdBarrier& b, const unsigned k) {
    asm volatile("s_waitcnt vmcnt(0)" ::: "memory");
    __syncthreads();
    if (__builtin_amdgcn_workitem_id_x() == 0) {
        unsigned* bar = b.bar;
        __builtin_amdgcn_s_waitcnt(0);
        unsigned nloc = b.st[0], nx = b.st[1];
        if (nloc == 0u) { xcd_barrier_complete(bar, b.x, nloc, nx); b.st[0] = nloc; b.st[1] = nx; }
        const unsigned old = xb_add(&bar[XB_XSUB(b.x)], 1u);
        const unsigned gen = old / nloc;
        if (old + 1u == (gen + 1u) * nloc) {
            __builtin_amdgcn_fence(__ATOMIC_RELEASE, "agent");
            asm volatile("s_waitcnt vmcnt(0)" ::: "memory");
            const unsigned og = xb_add(&bar[XB_TOP], 1u);
            const unsigned tg = og / nx;
            if (og + 1u == (tg + 1u) * nx) xb_add(&bar[XB_TOPGEN], 1u);
            else XB_SPIN(xb_ld(&bar[XB_TOPGEN]) == tg, bar);
            __builtin_amdgcn_fence(__ATOMIC_ACQUIRE, "agent");
            asm volatile("s_waitcnt vmcnt(0)" ::: "memory");
        } else {
            XB_SPIN(xb_ld(&bar[XB_TOPGEN]) < k, bar);
            __builtin_amdgcn_fence(__ATOMIC_ACQUIRE, "agent");
            asm volatile("s_waitcnt vmcnt(0)" ::: "memory");
        }
    }
    __syncthreads();
}


#define PIN(i) ((const float*)P.in[(i) + z])
constexpr int NPH = 9;
template <int PH> __device__ __forceinline__ void run_phase(const Params& P, LAS unsigned char* lds) {
        int z; asm volatile("s_mov_b32 %0, 0" : "=s"(z));
        unsigned char* ws = P.ws + z;
        constexpr int layer = PH / NPH, k = PH - layer * NPH;
        const int tid = tid_opaque(), lane = tid & 63, wave = __builtin_amdgcn_readfirstlane(tid >> 6), G = sgpr_opaque(gridDim.x), blk = sgpr_opaque(blockIdx.x);
        const int gw = blk * 8 + wave, NGW = G * 8;
        float* hbuf = P.out + z;
        bf16_t* XN = (bf16_t*)(ws + WS_X);
        if constexpr (PH == NPH * DEPTH) {
            const float* g = PIN(I_FINAL);
            const f32x4* gr = (const f32x4*)g + lane;
            f32x4 gg[4];
#pragma unroll
            for (int j = 0; j < 4; ++j) gg[j] = gr[64 * j];
            for (int m = gw; m < T; m += 4 * NGW) {
                f32x4 v[4][4]; float rs[4];
#pragma unroll
                for (int r = 0; r < 4; ++r)
#pragma unroll
                    for (int j = 0; j < 4; ++j) v[r][j] = ((const f32x4*)(hbuf + (size_t)(m + r * NGW) * 1024) + lane)[64 * j];
#pragma unroll
                for (int r = 0; r < 4; ++r) { float s2 = 0.f;
#pragma unroll
                    for (int j = 0; j < 4; ++j) s2 += (v[r][j].x * v[r][j].x + v[r][j].y * v[r][j].y) + (v[r][j].z * v[r][j].z + v[r][j].w * v[r][j].w);
                    rs[r] = s2; }
#pragma unroll
                for (int r = 0; r < 4; ++r) rs[r] = rsqrtf(wave_sum(rs[r]) * (1.f / 1024.f) + NORM_EPS);
#pragma unroll
                for (int r = 0; r < 4; ++r)
#pragma unroll
                    for (int j = 0; j < 4; ++j) ((f32x4*)(hbuf + (size_t)(m + r * NGW) * 1024) + lane)[64 * j] = v[r][j] * rs[r] * gg[j];
            }
            return;
        } else if constexpr (k == 0) {
            const float* hin = (layer == 0) ? PIN(I_X) : hbuf;
            LAS float* tscr = (LAS float*)(lds + wave * 16384);
            bf16_t* Win_t = (bf16_t*)(ws + WS_WIN); bf16_t* Wq_t = (bf16_t*)(ws + WS_WQ); bf16_t* Wkv_t = (bf16_t*)(ws + WS_WKV); bf16_t* Wo_t = (bf16_t*)(ws + WS_WO);
            const float* Win = PIN(I_W_IN) + (size_t)layer * DM * IN_DIM;
            const float* Wq = PIN(I_WQUP) + (size_t)layer * 384 * 768;
            const float* Wkv = PIN(I_WKVUP) + (size_t)layer * 256 * 1024;
            const float* Wo = PIN(I_W_OUT) + (size_t)layer * 1024 * 1024;
            constexpr int IT_IN = 16 * 81, IT_Q = 6 * 24, IT_KV = 4 * 32, IT_O = 16 * 32;
            if (layer == 0) for (int it = gw; it < IT_IN + IT_Q + IT_KV + IT_O; it += NGW) {
                int r = it;
                if (r < IT_IN) { transpose_item(Win, 1024, IN_DIM, Win_t, 1, tscr, r, lane); continue; } r -= IT_IN;
                if (r < IT_Q) { transpose_item(Wq, 384, 768, Wq_t, 0, tscr, r, lane); continue; } r -= IT_Q;
                if (r < IT_KV) { transpose_item(Wkv, 256, 1024, Wkv_t, 0, tscr, r, lane); continue; } r -= IT_KV;
                transpose_item(Wo, 1024, 1024, Wo_t, 0, tscr, r, lane);
            }
            for (int i = blk * 512 + tid; i < 224 * 128; i += G * 512) { const int rr = i >> 7, cc = i & 127; const int row = (rr < 128) ? 896 + rr : 2720 + (rr - 128);
                *(u32x4*)(Win_t + (size_t)row * 1024 + cc * 8) = (u32x4){0u, 0u, 0u, 0u}; }
            if (layer == 0) {
                const int* pos = (const int*)P.in[I_POS + z];
                float* cosR = (float*)(ws + WS_COSR); float* sinR = (float*)(ws + WS_SINR); float* cosM = (float*)(ws + WS_COSM); float* sinM = (float*)(ws + WS_SINM);
                for (int i = blk * 512 + tid; i < T * 32; i += G * 512) { const int tok = i >> 5, f = i & 31;
                    const float inv = exp2f(-(float)f * (1.f / 32.f) * 13.287712379549449f); const float ang = (float)pos[tok] * inv;
                    double rev = (double)ang * 0.15915494309189535; rev -= floor(rev); const float a = (float)(rev * 6.283185307179586);
                    cosR[i] = __cosf(a); sinR[i] = __sinf(a); }
                for (int i = blk * 512 + tid; i < T * 16; i += G * 512) { const int tok = i >> 4, f = i & 15;
                    const float inv = exp2f(-(float)f * (1.f / 16.f) * 13.287712379549449f); const float ang = (float)pos[tok] * inv;
                    double rev = (double)ang * 0.15915494309189535; rev -= floor(rev); const float a = (float)(rev * 6.283185307179586);
                    cosM[i] = __cosf(a); sinM[i] = __sinf(a); }
            }
            const float* g = PIN(I_ATTN_NORM) + layer * 1024;
            for (int m = gw; m < T; m += 2 * NGW) rms_rows2_bf16(hin + (size_t)m * 1024, hin + (size_t)(m + NGW) * 1024, g, XN + (size_t)m * 1024, XN + (size_t)(m + NGW) * 1024, lane);
        } else if constexpr (k == 1) {
            pg8::Gemm g{XN, (bf16_t*)(ws + WS_WIN), T, NPROJ, 1024}; pg8::StaticOrder S; S.init(T, NPROJ, G, blk);
            pg8::EpiProj E{(bf16_t*)(ws + WS_PA), (bf16_t*)(ws + WS_PB), (bf16_t*)(ws + WS_PC)};
            pg8::gemm_phase<pg8::EpiProj, pg8::StaticOrder, true, true>(lds, g, S, E);
        } else if constexpr (k == 2) {
            bf16_t* pa = (bf16_t*)(ws + WS_PA); bf16_t* pb = (bf16_t*)(ws + WS_PB); bf16_t* pc = (bf16_t*)(ws + WS_PC);
            float* cosR = (float*)(ws + WS_COSR); float* sinR = (float*)(ws + WS_SINR); float* cosM = (float*)(ws + WS_COSM); float* sinM = (float*)(ws + WS_SINM);
            PrepW W;
            {
                const int l16 = lane & 15, lq = lane >> 4;
                const float* w2 = PIN(I_W2) + layer * 32 * 256; const float* a2 = PIN(I_A2) + layer * 32 * 256; const float* g2 = PIN(I_G2) + layer * 64 * 256;
                const float* v1 = PIN(I_V1) + (layer > 0 ? (layer - 1) * 256 * 32 : 0); const float* v2 = PIN(I_V2) + (layer > 0 ? (layer - 1) * 32 * 256 : 0);
#pragma unroll
                for (int nt = 0; nt < 2; ++nt) { const int n = 16 * (2 * wave + nt) + l16;
                    W.Bw[nt] = pack_col8(w2, 256, 8 * lq, n); W.Ba[nt] = pack_col8(a2, 256, 8 * lq, n);
                    W.Bg[nt][0] = pack_col8(g2, 256, 8 * lq, n); W.Bg[nt][1] = pack_col8(g2, 256, 32 + 8 * lq, n);
                    W.Bv[nt] = pack_col8(v2, 256, 8 * lq, n); W.Bv1[nt] = pack_col8(v1, 32, 32 * wave + 8 * lq, 16 * nt + l16); }
            }
            unsigned raw[17];
            if (tid < 448 && blk < T / 16) prep_fetch_rows(raw, pa, blk * 16, tid * 2);
            PrepC PC;
            { const int cc = tid & 255, c2 = (tid < 448) ? tid * 2 : 0;
              const float* mu = PIN(I_MU) + layer * RW_IN;
              PC.mu0 = mu[c2]; PC.mu1 = mu[c2 + 1]; PC.w0c = (PIN(I_W0) + layer * 256)[cc]; PC.a0c = (PIN(I_A0) + layer * 256)[cc]; PC.kkc = (PIN(I_KK) + layer * 256)[cc];
              PC.kac = (PIN(I_KA) + layer * 256)[cc]; PC.rkc = (PIN(I_RK) + layer * 256)[cc]; PC.v0c = (layer > 0) ? (PIN(I_V0) + (layer - 1) * 256)[cc] : 0.f; }
            for (int tile = blk; tile < T / 16; tile += G) rwkv_prep_tile(lds, tile, (tile + G < T / 16) ? tile + G : -1, raw, PC, layer, P, z, W, pa, ws + WS_REC, (bf16_t*)(ws + WS_VBUF), (bf16_t*)(ws + WS_GBUF), (bf16_t*)(ws + WS_VFIRST), (float*)(ws + WS_BS), (float*)(ws + WS_BS + 512 * 1024));
            for (int u = blk; u < 512; u += G) ret_kv_unit(lds, u >> 5, u & 31, pb, cosR, sinR, (float*)(ws + WS_KVT));
        } else if constexpr (k == 3) {
            LAS unsigned* misc = (LAS unsigned*)(lds + 131072);
            unsigned* ctl = (unsigned*)(ws + WS_CTL);
            float* cosR = (float*)(ws + WS_COSR); float* sinR = (float*)(ws + WS_SINR); float* cosM = (float*)(ws + WS_COSM); float* sinM = (float*)(ws + WS_SINM);
            unsigned* sbar = ctl + 64 * (8 + layer);
            const int NB = G - 64;
            if (blk < 64) {
                rwkv_scan_block(lds, blk, ws + WS_REC, (bf16_t*)(ws + WS_VBUF), (const float*)(ws + WS_BS + 512 * 1024), (float*)(ws + WS_YA));
                if (tid == 0) { unsigned sp = 0; while (xb_ld(sbar) < (unsigned)NB) { __builtin_amdgcn_s_sleep(4); if (++sp > (1u << 22)) break; }
                    __builtin_amdgcn_fence(__ATOMIC_ACQUIRE, "agent"); asm volatile("s_waitcnt vmcnt(0)" ::: "memory"); }
                __syncthreads();
            } else {
                const int cb = blk - 64;
                {
                    const int gwn = cb * 8 + wave, NGWn = NB * 8;
                    bf16_t* pc = (bf16_t*)(ws + WS_PC);
            bf16_t* qn = (bf16_t*)(ws + WS_QN); bf16_t* kvn = (bf16_t*)(ws + WS_KVN); bf16_t* kr = (bf16_t*)(ws + WS_KR);
            const float* qg = PIN(I_QNORM) + layer * 384; const float* kg = PIN(I_KVNORM) + layer * 256;
            float qgv[6], kgv[4];
#pragma unroll
            for (int j = 0; j < 6; ++j) qgv[j] = qg[lane + 64 * j];
#pragma unroll
            for (int j = 0; j < 4; ++j) kgv[j] = kg[lane + 64 * j];
            for (int m0 = gwn; m0 < T; m0 += 2 * NGWn) {
                float xq[2][6], xk[2][4], x1[2], x2[2], cc[2], sn[2];
#pragma unroll
                for (int u = 0; u < 2; ++u) { const int m = (m0 + u * NGWn < T) ? m0 + u * NGWn : T - 1; const bf16_t* row = pc + (size_t)m * 768;
#pragma unroll
                    for (int j = 0; j < 6; ++j) xq[u][j] = bf2f(row[lane + 64 * j]);
#pragma unroll
                    for (int j = 0; j < 4; ++j) xk[u][j] = bf2f(row[384 + lane + 64 * j]);
                    x1[u] = bf2f(row[640 + (lane & 15)]); x2[u] = bf2f(row[656 + (lane & 15)]); cc[u] = cosM[(size_t)m * 16 + (lane & 15)]; sn[u] = sinM[(size_t)m * 16 + (lane & 15)]; }
#pragma unroll
                for (int u = 0; u < 2; ++u) { const int m = m0 + u * NGWn; if (m >= T) continue;
                    float sq = 0.f, sk = 0.f;
#pragma unroll
                    for (int j = 0; j < 6; ++j) sq += xq[u][j] * xq[u][j];
#pragma unroll
                    for (int j = 0; j < 4; ++j) sk += xk[u][j] * xk[u][j];
                    const float rq = rsqrtf(wave_sum(sq) * (1.f / 384.f) + NORM_EPS), rk = rsqrtf(wave_sum(sk) * (1.f / 256.f) + NORM_EPS);
#pragma unroll
                    for (int j = 0; j < 6; ++j) qn[(size_t)m * 384 + lane + 64 * j] = f2bf(xq[u][j] * rq * qgv[j]);
#pragma unroll
                    for (int j = 0; j < 4; ++j) kvn[(size_t)m * 256 + lane + 64 * j] = f2bf(xk[u][j] * rk * kgv[j]);
                    if (lane < 16) { kr[(size_t)m * 32 + lane] = f2bf(x1[u] * cc[u] - x2[u] * sn[u]); kr[(size_t)m * 32 + 16 + lane] = f2bf(x2[u] * cc[u] + x1[u] * sn[u]); }
                }
            }
                    unsigned* sbar0 = ctl + 64 * (12 + layer);
                    asm volatile("s_waitcnt vmcnt(0)" ::: "memory");
                    __syncthreads();
                    if (tid == 0) {
                        __builtin_amdgcn_fence(__ATOMIC_RELEASE, "agent"); asm volatile("s_waitcnt vmcnt(0)" ::: "memory");
                        xb_add(sbar0, 1u);
                        unsigned sp = 0; while (xb_ld(sbar0) < (unsigned)NB) { __builtin_amdgcn_s_sleep(4); if (++sp > (1u << 22)) break; }
                        __builtin_amdgcn_fence(__ATOMIC_ACQUIRE, "agent"); asm volatile("s_waitcnt vmcnt(0)" ::: "memory");
                    }
                    __syncthreads();
                }
                bf16_t* rprev = (bf16_t*)(ws + WS_RPREV); const float* kvt = (const float*)(ws + WS_KVT);
                for (int i = cb * 512 + tid; i < 16 * 4096; i += NB * 512) { const int bh = i >> 12, el = i & 4095; const int h = bh & 3;
                    const float cd = exp2f(128.f * log2f(1.f - exp2f(-5.f - (float)h)));
                    float R = 0.f;
#pragma unroll 8
                    for (int ci = 0; ci < 32; ++ci) { rprev[((size_t)(bh * 32 + ci)) * 4096 + el] = f2bf(R); R = R * cd + kvt[((size_t)(bh * 32 + ci)) * 4096 + el]; } }
                __syncthreads();
                { pg8::Gemm g{(bf16_t*)(ws + WS_QN), (bf16_t*)(ws + WS_WQ), T, 768, 384}; pg8::StaticOrder S; S.init(T, 768, NB, cb); pg8::EpiPlain E{(bf16_t*)(ws + WS_PC), 768};
                  pg8::gemm_phase<pg8::EpiPlain, pg8::StaticOrder, true, true>(lds, g, S, E); }
                { pg8::Gemm g{(bf16_t*)(ws + WS_KVN), (bf16_t*)(ws + WS_WKV), T, 1024, 256}; pg8::StaticOrder S; S.init(T, 1024, NB, cb); pg8::EpiPlain E{(bf16_t*)(ws + WS_KN), 1024};
                  pg8::gemm_phase<pg8::EpiPlain, pg8::StaticOrder, true, true>(lds, g, S, E); }
                asm volatile("s_waitcnt vmcnt(0)" ::: "memory");
                __syncthreads();
                if (tid == 0) {
                    __builtin_amdgcn_fence(__ATOMIC_RELEASE, "agent"); asm volatile("s_waitcnt vmcnt(0)" ::: "memory");
                    xb_add(sbar, 1u);
                    unsigned sp = 0; while (xb_ld(sbar) < (unsigned)NB) { __builtin_amdgcn_s_sleep(4); if (++sp > (1u << 22)) break; }
                    __builtin_amdgcn_fence(__ATOMIC_ACQUIRE, "agent"); asm volatile("s_waitcnt vmcnt(0)" ::: "memory");
                }
                __syncthreads();
            }
            unsigned* qctr = ctl + 64 * (1 + layer);
            for (;;) {
                __syncthreads();
                if (tid == 0) misc[0] = atomicAdd(qctr, 1u);
                __syncthreads();
                const int u = (int)misc[0];
                if (u >= 768) break;
                if (u < 512) { const int qb = 15 - (u >> 5), bh = u & 31; att_unit(lds, bh >> 3, bh & 7, qb, (bf16_t*)(ws + WS_PC), (bf16_t*)(ws + WS_KN), (bf16_t*)(ws + WS_KR), cosM, sinM, XN); }
                else { const int v = u - 512; const int bh = v & 15, jb = v >> 4; ret_unit(lds, bh >> 2, bh & 3, jb, (bf16_t*)(ws + WS_PB), cosR, sinR, (bf16_t*)(ws + WS_RPREV), (float*)(ws + WS_YB)); }
            }
        } else if constexpr (k == 4) {
            LAS float* tscr = (LAS float*)(lds + wave * 16384);
            const float* __restrict__ ya = (const float*)(ws + WS_YA); const float* __restrict__ yb = (const float*)(ws + WS_YB); const float* __restrict__ bs = (const float*)(ws + WS_BS);
            const bf16_t* __restrict__ vbuf = (const bf16_t*)(ws + WS_VBUF); const bf16_t* __restrict__ gbuf = (const bf16_t*)(ws + WS_GBUF); const bf16_t* __restrict__ pb = (const bf16_t*)(ws + WS_PB);
            const float* __restrict__ gnw = PIN(I_GNW) + layer * 256; const float* __restrict__ gnb = PIN(I_GNB) + layer * 256;
            bf16_t* __restrict__ XNw = XN;
            const f32x4 gw4 = *(const f32x4*)(gnw + 4 * lane), gb4 = *(const f32x4*)(gnb + 4 * lane);
#pragma unroll 4
            for (int m = gw; m < T; m += NGW) {
                const int c = 4 * lane, head = lane >> 4;
                const f32x4 y = *(const f32x4*)(ya + (size_t)m * 256 + c);
                const float mean = allreduce16((y.x + y.y) + (y.z + y.w)) * (1.f / 64.f);
                const f32x4 d = y - mean;
                const float var = allreduce16((d.x * d.x + d.y * d.y) + (d.z * d.z + d.w * d.w)) * (1.f / 64.f);
                const float rs = rsqrtf(var + 64e-5f);
                const u32x2 vv = *(const u32x2*)(vbuf + (size_t)m * 256 + c), gg = *(const u32x2*)(gbuf + (size_t)m * 256 + c);
                const float bsc = bs[(size_t)m * 4 + head];
                const float o0 = (d.x * rs * gw4.x + gb4.x + bsc * bflo(vv.x)) * bflo(gg.x), o1 = (d.y * rs * gw4.y + gb4.y + bsc * bfhi(vv.x)) * bfhi(gg.x);
                const float o2 = (d.z * rs * gw4.z + gb4.z + bsc * bflo(vv.y)) * bflo(gg.y), o3 = (d.w * rs * gw4.w + gb4.w + bsc * bfhi(vv.y)) * bfhi(gg.y);
                u32x2 w; w.x = cvt_pk_bf16(o0, o1); w.y = cvt_pk_bf16(o2, o3);
                *(u32x2*)(XNw + (size_t)m * 1024 + c) = w;
                const f32x4 zz = *(const f32x4*)(yb + (size_t)m * 256 + c);
                const float ms = allreduce16((zz.x * zz.x + zz.y * zz.y) + (zz.z * zz.z + zz.w * zz.w)) * (1.f / 64.f);
                const float rz = rsqrtf(ms + NORM_EPS);
                const u32x2 gt = *(const u32x2*)(pb + (size_t)m * 1024 + 768 + c);
                const float g0 = bflo(gt.x), g1 = bfhi(gt.x), g2v = bflo(gt.y), g3 = bfhi(gt.y);
                u32x2 w2; w2.x = cvt_pk_bf16(zz.x * rz * g0 * sigmoidf_(g0), zz.y * rz * g1 * sigmoidf_(g1)); w2.y = cvt_pk_bf16(zz.z * rz * g2v * sigmoidf_(g2v), zz.w * rz * g3 * sigmoidf_(g3));
                *(u32x2*)(XNw + (size_t)m * 1024 + 256 + c) = w2;
            }
            const float* Wgu = PIN(I_WGU) + (size_t)layer * 1024 * 2 * D_FF; const float* Wdn = PIN(I_WDN) + (size_t)layer * D_FF * 1024;
            bf16_t* Wgu_t = (bf16_t*)(ws + WS_WGU); bf16_t* Wdn_t = (bf16_t*)(ws + WS_WDN);
            constexpr int IT_GU = 16 * 176, IT_DN = 44 * 32;
            for (int it = gw; it < IT_GU + IT_DN; it += NGW) {
                if (it < IT_GU) transpose_item(Wgu, 1024, 2 * D_FF, Wgu_t, 2, tscr, it, lane);
                else transpose_item(Wdn, D_FF, 1024, Wdn_t, 0, tscr, it - IT_GU, lane);
            }
        } else if constexpr (k == 5) {
            const float* hin = (layer == 0) ? PIN(I_X) : hbuf;
            pg8::Gemm g{XN, (bf16_t*)(ws + WS_WO), T, 1024, 1024}; pg8::StaticOrder S; S.init(T, 1024, G, blk); pg8::EpiRes E{hin, hbuf};
            pg8::gemm_phase<pg8::EpiRes, pg8::StaticOrder, true, true>(lds, g, S, E);
        } else if constexpr (k == 6) {
            const float* g = PIN(I_FFN_NORM) + layer * 1024;
            for (int m = gw; m < T; m += 2 * NGW) rms_rows2_bf16(hbuf + (size_t)m * 1024, hbuf + (size_t)(m + NGW) * 1024, g, XN + (size_t)m * 1024, XN + (size_t)(m + NGW) * 1024, lane);
            if constexpr (layer + 1 < DEPTH) {
                LAS float* tscr = (LAS float*)(lds + wave * 16384);
                const float* Win = PIN(I_W_IN) + (size_t)(layer + 1) * DM * IN_DIM; const float* Wq = PIN(I_WQUP) + (size_t)(layer + 1) * 384 * 768;
                const float* Wkv = PIN(I_WKVUP) + (size_t)(layer + 1) * 256 * 1024; const float* Wo = PIN(I_W_OUT) + (size_t)(layer + 1) * 1024 * 1024;
                constexpr int IT_IN = 16 * 81, IT_Q = 6 * 24, IT_KV = 4 * 32, IT_O = 16 * 32;
                for (int it = gw; it < IT_IN + IT_Q + IT_KV + IT_O; it += NGW) {
                    int r = it;
                    if (r < IT_IN) { transpose_item(Win, 1024, IN_DIM, (bf16_t*)(ws + WS_WIN), 1, tscr, r, lane); continue; } r -= IT_IN;
                    if (r < IT_Q) { transpose_item(Wq, 384, 768, (bf16_t*)(ws + WS_WQ), 0, tscr, r, lane); continue; } r -= IT_Q;
                    if (r < IT_KV) { transpose_item(Wkv, 256, 1024, (bf16_t*)(ws + WS_WKV), 0, tscr, r, lane); continue; } r -= IT_KV;
                    transpose_item(Wo, 1024, 1024, (bf16_t*)(ws + WS_WO), 0, tscr, r, lane);
                }
            }
        } else if constexpr (k == 7) {
            pg8::Gemm g{XN, (bf16_t*)(ws + WS_WGU), T, 2 * D_FF, 1024}; pg8::StaticOrder S; S.init(T, 2 * D_FF, G, blk); pg8::EpiSwiGLU E{(bf16_t*)(ws + WS_ACT)};
            pg8::gemm_phase<pg8::EpiSwiGLU, pg8::StaticOrder, true, true>(lds, g, S, E);
        } else {
            pg8::Gemm g{(bf16_t*)(ws + WS_ACT), (bf16_t*)(ws + WS_WDN), T, 1024, D_FF}; pg8::StaticOrder S; S.init(T, 1024, G, blk); pg8::EpiRes E{hbuf, hbuf};
            pg8::gemm_phase<pg8::EpiRes, pg8::StaticOrder, true, true>(lds, g, S, E);
        }
}

template <int PH> __device__ __forceinline__ void run_all(const Params& P, LAS unsigned char* lds, cg::grid_group& grid, const XcdBarrier& bar) {
    run_phase<PH>(P, lds);
    if constexpr (PH < NPH * DEPTH) {
        xcd_barrier(bar, (unsigned)PH + 1u);
        run_all<PH + 1>(P, lds, grid, bar);
    }
}
__global__ void __launch_bounds__(512) hymba_fwd(Params P) {
    extern __shared__ __attribute__((aligned(16))) unsigned char lds_raw[];
    LAS unsigned char* lds = (LAS unsigned char*)lds_raw;
    cg::grid_group grid = cg::this_grid();
    LAS unsigned* misc = (LAS unsigned*)(lds + 131072);
    if (__builtin_amdgcn_workitem_id_x() < 32) misc[__builtin_amdgcn_workitem_id_x()] = 0u;
    __syncthreads();
    if (P.ws == nullptr) grid.sync();
    const XcdBarrier bar = xcd_barrier_post((unsigned*)(P.ws + WS_CTL) + 4096, (volatile LAS unsigned*)(misc + 8));
    run_all<0>(P, lds, grid, bar);
}
extern "C" void kernel_launch(void* const* d_in, const int* in_sizes, int n_in, void* d_out, int out_size, void* d_ws, size_t ws_size, hipStream_t stream) {
    static int grid = 0;
    if (grid == 0) {
        if (n_in != 27 || out_size != T * DM || ws_size < WS_END) { fprintf(stderr, "kernel_launch: unexpected shapes (n_in %d, out %d, ws %zu)\n", n_in, out_size, ws_size); grid = -1; return; }
        int dev = 0, cus = 0, per_cu = 0;
        (void)hipGetDevice(&dev); (void)hipDeviceGetAttribute(&cus, hipDeviceAttributeMultiprocessorCount, dev);
        if (hipFuncSetAttribute((const void*)hymba_fwd, hipFuncAttributeMaxDynamicSharedMemorySize, LDS_BYTES) != hipSuccess) { fprintf(stderr, "kernel_launch: hipFuncSetAttribute failed\n"); grid = -1; return; }
        if (hipOccupancyMaxActiveBlocksPerMultiprocessor(&per_cu, (const void*)hymba_fwd, 512, LDS_BYTES) != hipSuccess || per_cu < 1) { fprintf(stderr, "kernel_launch: occupancy query failed (%d)\n", per_cu); grid = -1; return; }
        (void)hipGetLastError();
        grid = cus;
        if (grid < 64) { fprintf(stderr, "kernel_launch: needs >= 64 CUs\n"); grid = -1; return; }
    }
    if (grid < 0) return;
    (void)hipMemsetAsync((char*)d_ws + WS_CTL, 0, 1 * MiB, stream);
    Params p{};
    for (int i = 0; i < 27; ++i) p.in[i] = d_in[i];
    p.out = (float*)d_out; p.ws = (unsigned char*)d_ws;
    void* args[] = {&p};
    hipError_t e = hipLaunchCooperativeKernel((const void*)hymba_fwd, dim3(grid), dim3(512), args, LDS_BYTES, stream);
    if (e != hipSuccess) fprintf(stderr, "kernel_launch: cooperative launch failed: %s (grid %d)\n", hipGetErrorString(e), grid);
}
```

```cpp
#include <hip/hip_runtime.h>
#include <hip/hip_cooperative_groups.h>
#include <cstdio>
#include <cstdint>
namespace cg = cooperative_groups;

#define LAS __attribute__((address_space(3)))
typedef unsigned short bf16_t;
typedef short bf16x8 __attribute__((ext_vector_type(8)));
typedef float f32x2 __attribute__((ext_vector_type(2)));
typedef float f32x4 __attribute__((ext_vector_type(4)));
typedef float f32x16 __attribute__((ext_vector_type(16)));
typedef unsigned u32x4 __attribute__((ext_vector_type(4)));
typedef unsigned u32x2 __attribute__((ext_vector_type(2)));

constexpr int BATCH = 4, SEQ = 4096, T = BATCH * SEQ, DM = 1024, DEPTH = 2;
constexpr int RW_IN = 896, IN_DIM = 2592, D_FF = 2816;
constexpr int NPROJ = 2816;
constexpr float NORM_EPS = 1e-6f;

constexpr size_t MiB = 1u << 20;
constexpr size_t WS_CTL = 0;
constexpr size_t WS_COSR = 1 * MiB, WS_SINR = 3 * MiB, WS_COSM = 5 * MiB, WS_SINM = 6 * MiB;
constexpr size_t WS_BS = 7 * MiB;
constexpr size_t WS_RPREV = 8 * MiB;
constexpr size_t WS_WIN = 12 * MiB;
constexpr size_t WS_WQ = WS_WIN + 5632 * 1024;
constexpr size_t WS_WKV = WS_WQ + 768 * 384 * 2;
constexpr size_t WS_WO = WS_WKV + 1024 * 256 * 2;
constexpr size_t WS_VFIRST = 21 * MiB;
constexpr size_t WS_VBUF = 29 * MiB;
constexpr size_t WS_GBUF = 37 * MiB;
constexpr size_t WS_X = 45 * MiB;
constexpr size_t WS_QN = WS_X, WS_KVN = WS_X + 12 * MiB;
constexpr size_t WS_KR = 253 * MiB;
constexpr size_t WS_PA = 77 * MiB;
constexpr size_t WS_YA = WS_PA, WS_YB = WS_PA + 16 * MiB;
constexpr size_t WS_PB = 109 * MiB;
constexpr size_t WS_PC = 141 * MiB;
constexpr size_t WS_ACT = 77 * MiB;
constexpr size_t WS_KN = 165 * MiB;
constexpr size_t WS_VT = 181 * MiB;
constexpr size_t WS_REC = 197 * MiB;
constexpr size_t WS_WGU = 197 * MiB, WS_WDN = 208 * MiB;
constexpr size_t WS_KVT = 245 * MiB;
constexpr size_t WS_END = 254 * MiB;

constexpr int LDS_BYTES = 131072 + 1024;

__device__ __forceinline__ int sgpr_opaque(int v) { asm volatile("" : "+s"(v)); return v; }
__device__ __forceinline__ int tid_opaque() { int t = __builtin_amdgcn_workitem_id_x(); asm volatile("" : "+v"(t)); return t; }
__device__ __forceinline__ unsigned cvt_pk_bf16(float lo, float hi) { unsigned r; asm volatile("v_cvt_pk_bf16_f32 %0, %1, %2" : "=v"(r) : "v"(lo), "v"(hi)); return r; }
__device__ __forceinline__ bf16_t f2bf(float f) { return (bf16_t)(cvt_pk_bf16(f, 0.f) & 0xffffu); }
__device__ __forceinline__ float bf2f(bf16_t v) { return __uint_as_float(((unsigned)v) << 16); }
__device__ __forceinline__ float bflo(unsigned u) { return __uint_as_float(u << 16); }
__device__ __forceinline__ float bfhi(unsigned u) { return __uint_as_float(u & 0xffff0000u); }
__device__ __forceinline__ float sigmoidf_(float x) { return __builtin_amdgcn_rcpf(1.f + __expf(-x)); }
template <int CTRL> __device__ __forceinline__ float dpp_mov(float x) { return __builtin_bit_cast(float, __builtin_amdgcn_mov_dpp(__builtin_bit_cast(int, x), CTRL, 0xf, 0xf, true)); }
__device__ __forceinline__ float allreduce16(float x) {
    x += dpp_mov<0xB1>(x); x += dpp_mov<0x4E>(x); x += dpp_mov<0x141>(x); x += dpp_mov<0x140>(x); return x;
}
__device__ __forceinline__ float wave_sum(float v) { v = allreduce16(v); v += __shfl_xor(v, 16); v += __shfl_xor(v, 32); return v; }
__device__ __forceinline__ int crow(int r, int hi) { return (r & 3) + 8 * (r >> 2) + 4 * hi; }
#define MFMA32(a, b, c) __builtin_amdgcn_mfma_f32_32x32x16_bf16((a), (b), (c), 0, 0, 0)

namespace pg8 {
#define PG8_LAS __attribute__((address_space(3)))
constexpr int BM = 256, BK = 64, HALF = 128, HTB = HALF * BK * 2, STAGE_BYTES = 8 * HTB, NXCD = 8, WGM = 8;
__host__ __device__ __forceinline__ int lds_byte(int r, int c) { const int st = (r >> 4) * 2 + (c >> 5), rr = r & 15, cc = c & 31, ob = rr * 64 + cc * 2; return st * 1024 + (ob ^ (((ob >> 9) & 1) << 5)); }
__host__ __device__ __forceinline__ void stage_rc(int b, int& R, int& C) { const int st = b / 1024, sb = b % 1024, swz = sb ^ (((sb >> 9) & 1) << 5); R = (st >> 1) * 16 + swz / 64; C = (st & 1) * 32 + (swz % 64) / 2; }
__host__ __device__ __forceinline__ int perm32(int rho) { const int n = rho >> 4, i = rho & 15; return 8 * (i >> 2) + 4 * n + (i & 3); }
struct Unit { int pm, pn; };
struct Gemm { const bf16_t* A; const bf16_t* Bt; int M, N, K; };
struct StaticOrder {
    int nM, nN, nwg, G, c;
    __host__ __device__ void init(int M, int N, int G_, int c_) { nM = M / BM; nN = N / BM; nwg = nM * nN; G = G_; c = c_; }
    __host__ __device__ bool next(int i, Unit& u) const {
        const long L = (long)i * G + c; if (L >= nwg) return false;
        int wgid = (int)L; { const int q = nwg / NXCD, r = nwg % NXCD, xcd = wgid % NXCD, off = wgid / NXCD; wgid = (xcd < r ? xcd * (q + 1) : r * (q + 1) + (xcd - r) * q) + off; }
        const int nig = WGM * nN, gid = wgid / nig, fm = gid * WGM, gsz = (nM - fm) < WGM ? (nM - fm) : WGM;
        u.pm = fm + ((wgid % nig) % gsz); u.pn = (wgid % nig) / gsz; return true;
    }
    __device__ __forceinline__ void a_ready(const Unit&) const {}
    __device__ __forceinline__ void done(const Unit&) const {}
};

template <class Epi, class Sched, bool ALIGN_EPI = false, bool SP2 = false>
__device__ __forceinline__ void gemm_phase(PG8_LAS unsigned char* lds, const Gemm g, const Sched& S, const Epi& E) {
    const int tid = tid_opaque(), wid = __builtin_amdgcn_readfirstlane(tid >> 6), lane = tid & 63, wr = wid >> 2, wc = wid & 3, fr = lane & 15, fq = lane >> 4;
    const int K = g.K, nt = K / BK;
    unsigned voffA[2], voffB[2];
#pragma unroll
    for (int i = 0; i < 2; ++i) { int R, C; stage_rc(tid * 16 + i * 8192, R, C); const int Rb = Epi::PERM ? ((R & ~31) + perm32(R & 31)) : R;
        voffA[i] = (unsigned)(R * K + C) * 2u; voffB[i] = (unsigned)(Rb * K + C) * 2u; }
    const size_t kstep = (size_t)(BK * 2);
    const size_t hstep = (size_t)HALF * K * 2;
    const size_t tstep = 2 * hstep;
    const unsigned ldsw = (unsigned)wid * 1024u;
    const int aoff = lds_byte(wr * 64 + fr, fq * 8), boff = lds_byte(wc * 32 + fr, fq * 8);
#define PG8_SA(b, h) (((b) * 2 + (h)) * HTB)
#define PG8_SB(b, h) ((4 + (b) * 2 + (h)) * HTB)
#define PG8_STAGE(bufoff, gbase, voff) do { _Pragma("unroll") for (int _i = 0; _i < 2; ++_i) \
        __builtin_amdgcn_global_load_lds((const unsigned*)((const char*)(gbase) + (voff)[_i]), (PG8_LAS unsigned*)(lds + (bufoff) + ldsw + _i * 8192), 16, 0, 0); } while (0)
#define PG8_LDA(dst, b, h) do { _Pragma("unroll") for (int m = 0; m < 4; ++m) _Pragma("unroll") for (int k = 0; k < 2; ++k) dst[m][k] = *(const PG8_LAS bf16x8*)(lds + PG8_SA(b, h) + aoff + m * 2048 + k * 1024); } while (0)
#define PG8_LDB(dst, b, h) do { _Pragma("unroll") for (int n = 0; n < 2; ++n) _Pragma("unroll") for (int k = 0; k < 2; ++k) dst[n][k] = *(const PG8_LAS bf16x8*)(lds + PG8_SB(b, h) + boff + n * 2048 + k * 1024); } while (0)
#define PG8_MMA(ai, bj, At, Bt) do { __builtin_amdgcn_s_setprio(1); _Pragma("unroll") for (int m = 0; m < 4; ++m) _Pragma("unroll") for (int n = 0; n < 2; ++n) _Pragma("unroll") for (int k = 0; k < 2; ++k) \
        acc[ai][bj][m][n] = __builtin_amdgcn_mfma_f32_16x16x32_bf16(Bt[n][k], At[m][k], acc[ai][bj][m][n], 0, 0, 0); __builtin_amdgcn_s_setprio(0); } while (0)
#define PG8_WAIT_V(n) asm volatile("s_waitcnt vmcnt(" #n ")" ::: "memory")
#define PG8_WAIT_L(n) asm volatile("s_waitcnt lgkmcnt(" #n ")" ::: "memory")
#define PG8_BAR __builtin_amdgcn_s_barrier()
#define PG8_SCHED __builtin_amdgcn_sched_barrier(0)
    Unit cur, nxt; int ui = 0;
    if (!S.next(0, cur)) return;
    f32x4 acc[2][2][4][2];
#pragma unroll
    for (int a = 0; a < 2; ++a)
#pragma unroll
        for (int b = 0; b < 2; ++b)
#pragma unroll
            for (int m = 0; m < 4; ++m)
#pragma unroll
                for (int n = 0; n < 2; ++n) acc[a][b][m][n] = (f32x4){0.f, 0.f, 0.f, 0.f};
    bf16x8 At[4][2], B0[2][2], B1[2][2];
    const char* cA = (const char*)g.A + (size_t)cur.pm * tstep; const char* cB = (const char*)g.Bt + (size_t)cur.pn * tstep;
    S.a_ready(cur);
    if constexpr (SP2) {
        PG8_STAGE(PG8_SB(0, 0), cB, voffB); PG8_STAGE(PG8_SB(0, 1), cB + hstep, voffB); PG8_STAGE(PG8_SA(0, 0), cA, voffA); PG8_STAGE(PG8_SA(0, 1), cA + hstep, voffA);
        if (wr == 1) PG8_BAR;
        PG8_WAIT_V(2); PG8_BAR;
        PG8_STAGE(PG8_SB(1, 0), cB + kstep, voffB); PG8_STAGE(PG8_SA(1, 0), cA + kstep, voffA); PG8_STAGE(PG8_SB(1, 1), cB + hstep + kstep, voffB);
        PG8_WAIT_V(6); PG8_BAR;
    } else {
        PG8_STAGE(PG8_SB(0, 0), cB, voffB); PG8_STAGE(PG8_SA(0, 0), cA, voffA); PG8_STAGE(PG8_SB(0, 1), cB + hstep, voffB); PG8_STAGE(PG8_SA(0, 1), cA + hstep, voffA);
        if (wr == 1) PG8_BAR;
        PG8_WAIT_V(4); PG8_BAR;
        PG8_STAGE(PG8_SB(1, 0), cB + kstep, voffB); PG8_STAGE(PG8_SA(1, 0), cA + kstep, voffA); PG8_STAGE(PG8_SB(1, 1), cB + hstep + kstep, voffB);
        PG8_WAIT_V(6); PG8_BAR;
    }
    for (;;) {
        const bool has_next = S.next(ui + 1, nxt);
        const char* nA = has_next ? (const char*)g.A + (size_t)nxt.pm * tstep : cA; const char* nB = has_next ? (const char*)g.Bt + (size_t)nxt.pn * tstep : cB;
        for (int t = 0; t < nt; t += 2) {
            const bool last = (t == nt - 2);
            const char* a1 = cA + (size_t)(t + 1) * kstep;
            const char* a2 = last ? nA : cA + (size_t)(t + 2) * kstep; const char* b2 = last ? nB : cB + (size_t)(t + 2) * kstep;
            const char* a3 = a2 + kstep; const char* b3 = b2 + kstep;
            if (last && has_next) S.a_ready(nxt);
            if constexpr (SP2) {
            PG8_LDB(B0, 0, 0); PG8_LDB(B1, 0, 1); PG8_SCHED; PG8_LDA(At, 0, 0); PG8_STAGE(PG8_SA(1, 1), a1 + hstep, voffA);
            PG8_WAIT_V(8); PG8_WAIT_L(0); PG8_BAR; PG8_MMA(0, 0, At, B0); PG8_MMA(0, 1, At, B1); PG8_BAR; PG8_SCHED;
            PG8_LDA(At, 0, 1); PG8_STAGE(PG8_SB(0, 0), b2, voffB); PG8_STAGE(PG8_SB(0, 1), b2 + hstep, voffB); PG8_STAGE(PG8_SA(0, 0), a2, voffA);
            PG8_WAIT_V(8); PG8_WAIT_L(0); PG8_BAR; PG8_MMA(1, 0, At, B0); PG8_MMA(1, 1, At, B1); PG8_BAR; PG8_SCHED;
            PG8_LDB(B0, 1, 0); PG8_LDB(B1, 1, 1); PG8_SCHED; PG8_LDA(At, 1, 0); PG8_STAGE(PG8_SA(0, 1), a2 + hstep, voffA);
            PG8_WAIT_V(8); PG8_WAIT_L(0); PG8_BAR; PG8_MMA(0, 0, At, B0); PG8_MMA(0, 1, At, B1); PG8_BAR; PG8_SCHED;
            PG8_LDA(At, 1, 1); PG8_STAGE(PG8_SB(1, 0), b3, voffB); PG8_STAGE(PG8_SB(1, 1), b3 + hstep, voffB); PG8_STAGE(PG8_SA(1, 0), a3, voffA);
            PG8_WAIT_V(8); PG8_WAIT_L(0); PG8_BAR; PG8_MMA(1, 0, At, B0); PG8_MMA(1, 1, At, B1); PG8_BAR; PG8_SCHED;
            } else {
            PG8_LDB(B0, 0, 0); PG8_SCHED; PG8_LDA(At, 0, 0); PG8_STAGE(PG8_SA(1, 1), a1 + hstep, voffA);
            PG8_WAIT_L(8); PG8_BAR; PG8_WAIT_L(0); PG8_MMA(0, 0, At, B0); PG8_BAR; PG8_SCHED;
            PG8_LDB(B1, 0, 1); PG8_STAGE(PG8_SB(0, 0), b2, voffB);
            PG8_BAR; PG8_WAIT_L(0); PG8_MMA(0, 1, At, B1); PG8_BAR;
            PG8_LDA(At, 0, 1); PG8_STAGE(PG8_SA(0, 0), a2, voffA);
            PG8_BAR; PG8_WAIT_L(0); PG8_MMA(1, 0, At, B0); PG8_BAR; PG8_SCHED;
            PG8_STAGE(PG8_SB(0, 1), b2 + hstep, voffB);
            PG8_WAIT_V(6); PG8_BAR; PG8_MMA(1, 1, At, B1); PG8_BAR;
            PG8_LDB(B0, 1, 0); PG8_SCHED; PG8_LDA(At, 1, 0); PG8_STAGE(PG8_SA(0, 1), a2 + hstep, voffA);
            PG8_WAIT_L(8); PG8_BAR; PG8_WAIT_L(0); PG8_MMA(0, 0, At, B0); PG8_BAR; PG8_SCHED;
            PG8_LDB(B1, 1, 1); PG8_STAGE(PG8_SB(1, 0), b3, voffB);
            PG8_BAR; PG8_WAIT_L(0); PG8_MMA(0, 1, At, B1); PG8_BAR;
            PG8_LDA(At, 1, 1); PG8_STAGE(PG8_SA(1, 0), a3, voffA);
            PG8_BAR; PG8_WAIT_L(0); PG8_MMA(1, 0, At, B0); PG8_BAR; PG8_SCHED;
            PG8_STAGE(PG8_SB(1, 1), b3 + hstep, voffB);
            PG8_WAIT_V(6); PG8_BAR; PG8_MMA(1, 1, At, B1); PG8_BAR;
            }
        }
        if constexpr (ALIGN_EPI) { if (wr == 0) PG8_BAR; }
        E(acc, cur, wr, wc, fr, fq); S.done(cur);
        if (!has_next) break;
#pragma unroll
        for (int a = 0; a < 2; ++a)
#pragma unroll
            for (int b = 0; b < 2; ++b)
#pragma unroll
                for (int m = 0; m < 4; ++m)
#pragma unroll
                    for (int n = 0; n < 2; ++n) acc[a][b][m][n] = (f32x4){0.f, 0.f, 0.f, 0.f};
        cur = nxt; cA = nA; cB = nB; ++ui;
        if constexpr (ALIGN_EPI) { if (wr == 1) PG8_BAR; }
    }
    PG8_WAIT_V(0);
    if constexpr (!ALIGN_EPI) { if (wr == 0) PG8_BAR; }
    PG8_BAR;
#undef PG8_SA
#undef PG8_SB
#undef PG8_STAGE
#undef PG8_LDA
#undef PG8_LDB
#undef PG8_MMA
#undef PG8_WAIT_V
#undef PG8_WAIT_L
#undef PG8_BAR
#undef PG8_SCHED
}

__device__ __forceinline__ u32x4 pack8(const f32x4 v0, const f32x4 v1) { u32x4 w; w.x = cvt_pk_bf16(v0[0], v0[1]); w.y = cvt_pk_bf16(v0[2], v0[3]); w.z = cvt_pk_bf16(v1[0], v1[1]); w.w = cvt_pk_bf16(v1[2], v1[3]); return w; }

struct EpiProj {
    static constexpr bool PERM = true;
    bf16_t *pa, *pb, *pc;
    __device__ __forceinline__ void operator()(const f32x4 (&acc)[2][2][4][2], const Unit& u, int wr, int wc, int fr, int fq) const {
        bf16_t* base; int ldc, colt;
        if (u.pn < 4) { base = pa; ldc = 1024; colt = u.pn * 256; } else if (u.pn < 8) { base = pb; ldc = 1024; colt = (u.pn - 4) * 256; } else { base = pc; ldc = 768; colt = (u.pn - 8) * 256; }
        const int row0 = u.pm * BM + wr * 64 + fr, col0 = colt + wc * 32 + 8 * fq;
#pragma unroll
        for (int ai = 0; ai < 2; ++ai)
#pragma unroll
            for (int m = 0; m < 4; ++m) { bf16_t* rowp = base + (size_t)(row0 + ai * HALF + m * 16) * ldc + col0;
#pragma unroll
                for (int bj = 0; bj < 2; ++bj) *(u32x4*)(rowp + bj * HALF) = pack8(acc[ai][bj][m][0], acc[ai][bj][m][1]); }
    }
};
struct EpiPlain {
    static constexpr bool PERM = true;
    bf16_t* O; int ldc;
    __device__ __forceinline__ void operator()(const f32x4 (&acc)[2][2][4][2], const Unit& u, int wr, int wc, int fr, int fq) const {
        const int row0 = u.pm * BM + wr * 64 + fr, col0 = u.pn * BM + wc * 32 + 8 * fq;
#pragma unroll
        for (int ai = 0; ai < 2; ++ai)
#pragma unroll
            for (int m = 0; m < 4; ++m) { bf16_t* rowp = O + (size_t)(row0 + ai * HALF + m * 16) * ldc + col0;
#pragma unroll
                for (int bj = 0; bj < 2; ++bj) *(u32x4*)(rowp + bj * HALF) = pack8(acc[ai][bj][m][0], acc[ai][bj][m][1]); }
    }
};
struct EpiRes {
    static constexpr bool PERM = false;
    const float* base; float* out;
    __device__ __forceinline__ void operator()(const f32x4 (&acc)[2][2][4][2], const Unit& u, int wr, int wc, int fr, int fq) const {
        const int row0 = u.pm * BM + wr * 64 + fr, col0 = u.pn * BM + wc * 32 + 4 * fq;
#pragma unroll
        for (int ai = 0; ai < 2; ++ai)
#pragma unroll
            for (int m = 0; m < 4; ++m) { const size_t off = (size_t)(row0 + ai * HALF + m * 16) * 1024 + col0;
#pragma unroll
                for (int bj = 0; bj < 2; ++bj)
#pragma unroll
                    for (int n = 0; n < 2; ++n) { const f32x4 bs = *(const f32x4*)(base + off + bj * HALF + n * 16); *(f32x4*)(out + off + bj * HALF + n * 16) = bs + acc[ai][bj][m][n]; } }
    }
};
struct EpiSwiGLU {
    static constexpr bool PERM = true;
    bf16_t* act;
    __device__ __forceinline__ void operator()(const f32x4 (&acc)[2][2][4][2], const Unit& u, int wr, int wc, int fr, int fq) const {
        const int row0 = u.pm * BM + wr * 64 + fr, col0 = u.pn * 128 + wc * 32 + 8 * fq;
#pragma unroll
        for (int ai = 0; ai < 2; ++ai)
#pragma unroll
            for (int m = 0; m < 4; ++m) { f32x4 o[2];
#pragma unroll
                for (int n = 0; n < 2; ++n)
#pragma unroll
                    for (int i = 0; i < 4; ++i) { const float gt = acc[ai][0][m][n][i], up = acc[ai][1][m][n][i]; o[n][i] = gt * up * __builtin_amdgcn_rcpf(1.f + __expf(-gt)); }
                *(u32x4*)(act + (size_t)(row0 + ai * HALF + m * 16) * D_FF + col0) = pack8(o[0], o[1]); }
    }
};
}

struct Params { const void* in[27]; float* out; unsigned char* ws; };
enum { I_X = 0, I_POS, I_ATTN_NORM, I_W_IN, I_W_OUT, I_MU, I_W0, I_W2, I_A0, I_A2, I_G2, I_KK, I_KA, I_RK, I_GNW, I_GNB, I_V0, I_V1, I_V2,
       I_QNORM, I_KVNORM, I_WQUP, I_WKVUP, I_FFN_NORM, I_WGU, I_WDN, I_FINAL };

__device__ __forceinline__ void transpose_item(const float* W, int K, int N, bf16_t* WT, int mode, LAS float* scr, int item, int lane) {
    const int nblk = N / 32, kb = item / nblk, nb = item % nblk, k0 = 64 * kb, n0 = 32 * nb;
    int d0 = n0;
    if (mode == 1) d0 = (n0 < 896) ? n0 : n0 + 128;
    else if (mode == 2) { const int j = (n0 < D_FF) ? n0 : n0 - D_FF; d0 = 256 * (j >> 7) + (j & 127) + ((n0 < D_FF) ? 0 : 128); }
    float wv[32];
#pragma unroll
    for (int i = 0; i < 32; ++i) wv[i] = W[(size_t)(k0 + 2 * i + (lane >> 5)) * N + n0 + (lane & 31)];
#pragma unroll
    for (int i = 0; i < 32; ++i) scr[(2 * i + (lane >> 5)) * 33 + (lane & 31)] = wv[i];
    asm volatile("s_waitcnt lgkmcnt(0)" ::: "memory");
    const int c = lane & 7;
#pragma unroll
    for (int j = 0; j < 4; ++j) { const int n = (lane >> 3) + 8 * j; const LAS float* s = scr + (8 * c) * 33 + n;
        u32x4 o; o.x = cvt_pk_bf16(s[0 * 33], s[1 * 33]); o.y = cvt_pk_bf16(s[2 * 33], s[3 * 33]); o.z = cvt_pk_bf16(s[4 * 33], s[5 * 33]); o.w = cvt_pk_bf16(s[6 * 33], s[7 * 33]);
        *(u32x4*)(WT + (size_t)(d0 + n) * K + k0 + 8 * c) = o; }
    asm volatile("s_waitcnt lgkmcnt(0)" ::: "memory");
}

__device__ __forceinline__ void rms_rows2_bf16(const float* __restrict__ x0row, const float* __restrict__ x1row, const float* __restrict__ g, bf16_t* __restrict__ o0row, bf16_t* __restrict__ o1row, int lane) {
    const f32x4* xa = (const f32x4*)x0row + lane; const f32x4* xb = (const f32x4*)x1row + lane; const f32x4* gr = (const f32x4*)g + lane;
    f32x4 va[4], vb[4]; float sa = 0.f, sb = 0.f;
#pragma unroll
    for (int j = 0; j < 4; ++j) { va[j] = xa[64 * j]; vb[j] = xb[64 * j]; }
#pragma unroll
    for (int j = 0; j < 4; ++j) { sa += (va[j].x * va[j].x + va[j].y * va[j].y) + (va[j].z * va[j].z + va[j].w * va[j].w); sb += (vb[j].x * vb[j].x + vb[j].y * vb[j].y) + (vb[j].z * vb[j].z + vb[j].w * vb[j].w); }
    const float ra = rsqrtf(wave_sum(sa) * (1.f / 1024.f) + NORM_EPS), rb = rsqrtf(wave_sum(sb) * (1.f / 1024.f) + NORM_EPS);
    u32x2* oa = (u32x2*)o0row + lane; u32x2* ob = (u32x2*)o1row + lane;
#pragma unroll
    for (int j = 0; j < 4; ++j) { const f32x4 gg = gr[64 * j]; u32x2 w;
        w.x = cvt_pk_bf16(va[j].x * ra * gg.x, va[j].y * ra * gg.y); w.y = cvt_pk_bf16(va[j].z * ra * gg.z, va[j].w * ra * gg.w); oa[64 * j] = w;
        w.x = cvt_pk_bf16(vb[j].x * rb * gg.x, vb[j].y * rb * gg.y); w.y = cvt_pk_bf16(vb[j].z * rb * gg.z, vb[j].w * rb * gg.w); ob[64 * j] = w; }
}
__device__ __forceinline__ void rms_row_bf16(const float* xrow, const float* g, bf16_t* orow, int lane) {
    const f32x4* xr = (const f32x4*)xrow + lane; const f32x4* gr = (const f32x4*)g + lane;
    f32x4 v[4]; float s = 0.f;
#pragma unroll
    for (int j = 0; j < 4; ++j) { v[j] = xr[64 * j]; s += (v[j].x * v[j].x + v[j].y * v[j].y) + (v[j].z * v[j].z + v[j].w * v[j].w); }
    const float rstd = rsqrtf(wave_sum(s) * (1.f / 1024.f) + NORM_EPS);
    u32x2* o8 = (u32x2*)orow + lane;
#pragma unroll
    for (int j = 0; j < 4; ++j) { const f32x4 gg = gr[64 * j]; u32x2 w; w.x = cvt_pk_bf16(v[j].x * rstd * gg.x, v[j].y * rstd * gg.y); w.y = cvt_pk_bf16(v[j].z * rstd * gg.z, v[j].w * rstd * gg.w); o8[64 * j] = w; }
}

constexpr int KROW = 104, VROW = 72;
constexpr int ATT_KB = 64 * KROW * 2, ATT_VB = 64 * VROW * 2;
constexpr int ATT_SCR = 2 * (ATT_KB + ATT_VB);

__device__ __forceinline__ void att_unit(LAS unsigned char* lds, int b, int h, int qb, const bf16_t* __restrict__ q, const bf16_t* __restrict__ kvb, const bf16_t* __restrict__ kr,
                                         const float* __restrict__ cosM, const float* __restrict__ sinM, bf16_t* __restrict__ mix) {
    const int tid = tid_opaque(), lane = tid & 63, w = tid >> 6, r32 = lane & 31, hi = lane >> 5;
    LAS float* scr = (LAS float*)(lds + ATT_SCR) + w * 32;
    const int qrow = qb * 256 + w * 32 + r32; const size_t tok = (size_t)b * SEQ + qrow;
    bf16x8 qf[6];
    {
        const bf16_t* qp = q + tok * 768 + h * 96 + hi * 8;
#pragma unroll
        for (int d0 = 0; d0 < 4; ++d0) qf[d0] = *(const bf16x8*)(qp + d0 * 16);
        const u32x4 x1 = *(const u32x4*)(qp + 64), x2 = *(const u32x4*)(qp + 80);
        const f32x4 c0 = *(const f32x4*)(cosM + tok * 16 + hi * 8), c1 = *(const f32x4*)(cosM + tok * 16 + hi * 8 + 4);
        const f32x4 s0 = *(const f32x4*)(sinM + tok * 16 + hi * 8), s1 = *(const f32x4*)(sinM + tok * 16 + hi * 8 + 4);
        float a[8], bb[8], cs[8] = {c0.x, c0.y, c0.z, c0.w, c1.x, c1.y, c1.z, c1.w}, sn[8] = {s0.x, s0.y, s0.z, s0.w, s1.x, s1.y, s1.z, s1.w};
#pragma unroll
        for (int j = 0; j < 4; ++j) { a[2 * j] = bflo(x1[j]); a[2 * j + 1] = bfhi(x1[j]); bb[2 * j] = bflo(x2[j]); bb[2 * j + 1] = bfhi(x2[j]); }
        u32x4 o1, o2;
#pragma unroll
        for (int j = 0; j < 4; ++j) {
            o1[j] = cvt_pk_bf16(a[2 * j] * cs[2 * j] - bb[2 * j] * sn[2 * j], a[2 * j + 1] * cs[2 * j + 1] - bb[2 * j + 1] * sn[2 * j + 1]);
            o2[j] = cvt_pk_bf16(bb[2 * j] * cs[2 * j] + a[2 * j] * sn[2 * j], bb[2 * j + 1] * cs[2 * j + 1] + a[2 * j + 1] * sn[2 * j + 1]); }
        qf[4] = __builtin_bit_cast(bf16x8, o1); qf[5] = __builtin_bit_cast(bf16x8, o2);
    }
    const int k_key = tid >> 3, k_ch = tid & 7;
    const int r_key = (tid & 255) >> 2, r_ch = tid & 3;
    const bf16_t* kn_src = kvb + ((size_t)b * SEQ + k_key) * 1024 + h * 128 + k_ch * 8;
    const bf16_t* kr_src = kr + ((size_t)b * SEQ + r_key) * 32 + r_ch * 8;
    const int kn_dst = (k_key * KROW + k_ch * 8) * 2, kr_dst = (r_key * KROW + 64 + r_ch * 8) * 2, vt_dst = (k_ch * 8 * VROW + k_key) * 2;
#define ATT_VWRITE(bufoff, gv) do { LAS bf16_t* vd_ = (LAS bf16_t*)(lds + 2 * ATT_KB + (bufoff) + vt_dst); _Pragma("unroll") for (int j_ = 0; j_ < 4; ++j_) { \
        vd_[(2 * j_) * VROW] = (bf16_t)((gv)[j_] & 0xffffu); vd_[(2 * j_ + 1) * VROW] = (bf16_t)((gv)[j_] >> 16); } } while (0)
    const int ntiles = 4 * qb + 4;
    u32x4 gk, gr, gv;
    gk = *(const u32x4*)kn_src; gv = *(const u32x4*)(kn_src + 64); if (tid < 256) gr = *(const u32x4*)kr_src;
    *(LAS u32x4*)(lds + kn_dst) = gk; ATT_VWRITE(0, gv); if (tid < 256) *(LAS u32x4*)(lds + kr_dst) = gr;
    __syncthreads();
    f32x16 o0, o1;
#pragma unroll
    for (int r = 0; r < 16; ++r) { o0[r] = 0.f; o1[r] = 0.f; }
    float mrow = -1e30f, lrow = 0.f;
    const float SC = 0.10206207261596577f * 1.4426950408889634f;
    const int wq0 = qb * 256 + w * 32;
    for (int kt = 0; kt < ntiles; ++kt) {
        const int cur = kt & 1;
        if (kt + 1 < ntiles) { const size_t ko = (size_t)(kt + 1) * 64; gk = *(const u32x4*)(kn_src + ko * 1024); gv = *(const u32x4*)(kn_src + ko * 1024 + 64); if (tid < 256) gr = *(const u32x4*)(kr_src + ko * 32); }
        const int k0 = kt * 64;
        if (k0 <= wq0 + 31) {
            const LAS unsigned char* Kb = lds + cur * ATT_KB; const LAS unsigned char* Vb = lds + 2 * ATT_KB + cur * ATT_VB;
            f32x16 p0, p1;
#pragma unroll
            for (int r = 0; r < 16; ++r) { p0[r] = 0.f; p1[r] = 0.f; }
#pragma unroll
            for (int d0 = 0; d0 < 6; ++d0) {
                const bf16x8 k0f = *(const LAS bf16x8*)(Kb + (r32 * KROW + d0 * 16 + hi * 8) * 2);
                const bf16x8 k1f = *(const LAS bf16x8*)(Kb + ((32 + r32) * KROW + d0 * 16 + hi * 8) * 2);
                p0 = MFMA32(k0f, qf[d0], p0); p1 = MFMA32(k1f, qf[d0], p1);
            }
            const bool need_mask = (k0 + 63 > wq0);
            float mx = -1e30f;
            if (need_mask) {
#pragma unroll
                for (int r = 0; r < 16; ++r) { const int key = k0 + crow(r, hi); if (key > qrow) p0[r] = -1e30f; if (key + 32 > qrow) p1[r] = -1e30f; }
            }
#pragma unroll
            for (int r = 0; r < 16; ++r) mx = fmaxf(mx, fmaxf(p0[r], p1[r]));
            mx = fmaxf(mx, __shfl_xor(mx, 32)) * SC;
            const bool grew = __any(mx > mrow + 8.f);
            const float mnew = grew ? fmaxf(mrow, mx) : mrow;
            const float alpha = __builtin_amdgcn_exp2f(mrow - mnew); mrow = mnew;
            float ls = 0.f;
#pragma unroll
            for (int r = 0; r < 16; ++r) { p0[r] = __builtin_amdgcn_exp2f(__builtin_fmaf(p0[r], SC, -mnew)); p1[r] = __builtin_amdgcn_exp2f(__builtin_fmaf(p1[r], SC, -mnew)); ls += p0[r] + p1[r]; }
            lrow = lrow * alpha + ls;
            if (grew) {
                if (hi == 0) scr[r32] = alpha;
                asm volatile("s_waitcnt lgkmcnt(0)" ::: "memory");
#pragma unroll
                for (int i = 0; i < 4; ++i) { const f32x4 al = *(const LAS f32x4*)(scr + 8 * i + 4 * hi);
#pragma unroll
                    for (int j = 0; j < 4; ++j) { o0[4 * i + j] *= al[j]; o1[4 * i + j] *= al[j]; } }
                asm volatile("s_waitcnt lgkmcnt(0)" ::: "memory");
            }
#pragma unroll
            for (int s = 0; s < 4; ++s) {
                u32x4 pw;
#pragma unroll
                for (int j = 0; j < 4; ++j) pw[j] = (s < 2) ? cvt_pk_bf16(p0[8 * (s & 1) + 2 * j], p0[8 * (s & 1) + 2 * j + 1]) : cvt_pk_bf16(p1[8 * (s & 1) + 2 * j], p1[8 * (s & 1) + 2 * j + 1]);
                const bf16x8 pa = __builtin_bit_cast(bf16x8, pw);
#pragma unroll
                for (int dvh = 0; dvh < 2; ++dvh) {
                    const LAS unsigned char* vp = Vb + ((dvh * 32 + r32) * VROW + 16 * s + 4 * hi) * 2;
                    const u32x2 lo = *(const LAS u32x2*)vp, hh = *(const LAS u32x2*)(vp + 16);
                    u32x4 vv; vv.x = lo.x; vv.y = lo.y; vv.z = hh.x; vv.w = hh.y;
                    if (dvh == 0) o0 = MFMA32(pa, __builtin_bit_cast(bf16x8, vv), o0); else o1 = MFMA32(pa, __builtin_bit_cast(bf16x8, vv), o1);
                }
            }
        }
        if (kt + 1 < ntiles) { const int nx = cur ^ 1; *(LAS u32x4*)(lds + nx * ATT_KB + kn_dst) = gk; ATT_VWRITE(nx * ATT_VB, gv); if (tid < 256) *(LAS u32x4*)(lds + nx * ATT_KB + kr_dst) = gr; }
        __syncthreads();
    }
    float lt = lrow + __shfl_xor(lrow, 32);
    if (hi == 0) scr[r32] = 1.f / lt;
    asm volatile("s_waitcnt lgkmcnt(0)" ::: "memory");
#pragma unroll
    for (int i = 0; i < 4; ++i) { const f32x4 il = *(const LAS f32x4*)(scr + 8 * i + 4 * hi);
#pragma unroll
        for (int j = 0; j < 4; ++j) { const int r = 4 * i + j; const size_t orow = (size_t)b * SEQ + qb * 256 + w * 32 + crow(r, hi);
            mix[orow * 1024 + 512 + h * 64 + r32] = f2bf(o0[r] * il[j]); mix[orow * 1024 + 512 + h * 64 + 32 + r32] = f2bf(o1[r] * il[j]); } }
    asm volatile("s_waitcnt lgkmcnt(0)" ::: "memory");
}

__device__ __forceinline__ void ret_unit(LAS unsigned char* lds, int b, int h, int jb, const bf16_t* __restrict__ pb, const float* __restrict__ cosR, const float* __restrict__ sinR,
                                         const bf16_t* __restrict__ rprev, float* __restrict__ yb) {
    const int tid = tid_opaque(), lane = tid & 63, w = tid >> 6, r32 = lane & 31, hi = lane >> 5;
    const float lg2 = log2f(1.f - exp2f(-5.f - (float)h));
    const int qrow = jb * 256 + w * 32 + r32; const size_t tok = (size_t)b * SEQ + qrow;
    const int chunk = qrow >> 7;
    bf16x8 qf[4], qx[4];
    {
        const bf16_t* qp = pb + tok * 1024 + h * 64 + hi * 8;
        const float qdec = exp2f(lg2 * (float)((qrow & 127) + 1));
#pragma unroll
        for (int d0 = 0; d0 < 2; ++d0) {
            const u32x4 x1 = *(const u32x4*)(qp + d0 * 16), x2 = *(const u32x4*)(qp + d0 * 16 + 32);
            const float* cp = cosR + tok * 32 + d0 * 16 + hi * 8; const float* sp = sinR + tok * 32 + d0 * 16 + hi * 8;
            const f32x4 c0 = *(const f32x4*)cp, c1 = *(const f32x4*)(cp + 4), s0 = *(const f32x4*)sp, s1 = *(const f32x4*)(sp + 4);
            const float cs[8] = {c0.x, c0.y, c0.z, c0.w, c1.x, c1.y, c1.z, c1.w}, sn[8] = {s0.x, s0.y, s0.z, s0.w, s1.x, s1.y, s1.z, s1.w};
            u32x4 o1, o2, y1, y2;
#pragma unroll
            for (int j = 0; j < 4; ++j) {
                const float a0 = bflo(x1[j]), a1 = bfhi(x1[j]), b0 = bflo(x2[j]), b1 = bfhi(x2[j]);
                const float r0 = a0 * cs[2 * j] - b0 * sn[2 * j], r1 = a1 * cs[2 * j + 1] - b1 * sn[2 * j + 1];
                const float t0 = b0 * cs[2 * j] + a0 * sn[2 * j], t1 = b1 * cs[2 * j + 1] + a1 * sn[2 * j + 1];
                o1[j] = cvt_pk_bf16(r0, r1); o2[j] = cvt_pk_bf16(t0, t1); y1[j] = cvt_pk_bf16(r0 * qdec, r1 * qdec); y2[j] = cvt_pk_bf16(t0 * qdec, t1 * qdec); }
            qf[d0] = __builtin_bit_cast(bf16x8, o1); qf[d0 + 2] = __builtin_bit_cast(bf16x8, o2); qx[d0] = __builtin_bit_cast(bf16x8, y1); qx[d0 + 2] = __builtin_bit_cast(bf16x8, y2);
        }
    }
    f32x16 o0, o1;
#pragma unroll
    for (int r = 0; r < 16; ++r) { o0[r] = 0.f; o1[r] = 0.f; }
    {
        const bf16_t* rp = rprev + ((size_t)((b * 4 + h) * 32 + chunk)) * 4096;
#pragma unroll
        for (int d0 = 0; d0 < 4; ++d0) {
            const bf16x8 r0 = *(const bf16x8*)(rp + (size_t)r32 * 64 + d0 * 16 + hi * 8), r1 = *(const bf16x8*)(rp + (size_t)(32 + r32) * 64 + d0 * 16 + hi * 8);
            o0 = MFMA32(qx[d0], r0, o0); o1 = MFMA32(qx[d0], r1, o1);
        }
    }
    const int l_key = (tid & 255) >> 2, l_c = tid & 3;
    for (int kt = 0; kt < 4; ++kt) {
        const int k0 = jb * 256 + kt * 64;
        __syncthreads();
        if (tid < 256) {
            const size_t kt_tok = (size_t)b * SEQ + k0 + l_key; const bf16_t* kp = pb + kt_tok * 1024 + 256 + h * 64 + l_c * 8;
            const u32x4 x1 = *(const u32x4*)kp, x2 = *(const u32x4*)(kp + 32);
            const float* cp = cosR + kt_tok * 32 + l_c * 8; const float* sp = sinR + kt_tok * 32 + l_c * 8;
            const f32x4 c0 = *(const f32x4*)cp, c1 = *(const f32x4*)(cp + 4), s0 = *(const f32x4*)sp, s1 = *(const f32x4*)(sp + 4);
            const float cs[8] = {c0.x, c0.y, c0.z, c0.w, c1.x, c1.y, c1.z, c1.w}, sn[8] = {s0.x, s0.y, s0.z, s0.w, s1.x, s1.y, s1.z, s1.w};
            u32x4 o1v, o2v;
#pragma unroll
            for (int j = 0; j < 4; ++j) {
                const float a0 = bflo(x1[j]), a1 = bfhi(x1[j]), b0 = bflo(x2[j]), b1 = bfhi(x2[j]);
                o1v[j] = cvt_pk_bf16((a0 * cs[2 * j] - b0 * sn[2 * j]) * 0.125f, (a1 * cs[2 * j + 1] - b1 * sn[2 * j + 1]) * 0.125f);
                o2v[j] = cvt_pk_bf16((b0 * cs[2 * j] + a0 * sn[2 * j]) * 0.125f, (b1 * cs[2 * j + 1] + a1 * sn[2 * j + 1]) * 0.125f); }
            *(LAS u32x4*)(lds + (l_key * KROW + l_c * 8) * 2) = o1v; *(LAS u32x4*)(lds + (l_key * KROW + 32 + l_c * 8) * 2) = o2v;
        } else {
            const size_t vt_tok = (size_t)b * SEQ + k0 + l_key; const bf16_t* vp = pb + vt_tok * 1024 + 512 + h * 64 + l_c * 16;
            const u32x4 x1 = *(const u32x4*)vp, x2 = *(const u32x4*)(vp + 8);
            LAS bf16_t* vd = (LAS bf16_t*)(lds + 2 * ATT_KB) + l_key;
#pragma unroll
            for (int j = 0; j < 4; ++j) { vd[(l_c * 16 + 2 * j) * VROW] = (bf16_t)(x1[j] & 0xffffu); vd[(l_c * 16 + 2 * j + 1) * VROW] = (bf16_t)(x1[j] >> 16);
                                          vd[(l_c * 16 + 8 + 2 * j) * VROW] = (bf16_t)(x2[j] & 0xffffu); vd[(l_c * 16 + 8 + 2 * j + 1) * VROW] = (bf16_t)(x2[j] >> 16); }
        }
        __syncthreads();
        if ((k0 >> 7) == chunk && k0 <= jb * 256 + w * 32 + 31) {
            const LAS unsigned char* Kb = lds; const LAS unsigned char* Vb = lds + 2 * ATT_KB;
            f32x16 p0, p1;
#pragma unroll
            for (int r = 0; r < 16; ++r) { p0[r] = 0.f; p1[r] = 0.f; }
#pragma unroll
            for (int d0 = 0; d0 < 4; ++d0) {
                const bf16x8 k0f = *(const LAS bf16x8*)(Kb + (r32 * KROW + d0 * 16 + hi * 8) * 2);
                const bf16x8 k1f = *(const LAS bf16x8*)(Kb + ((32 + r32) * KROW + d0 * 16 + hi * 8) * 2);
                p0 = MFMA32(k0f, qf[d0], p0); p1 = MFMA32(k1f, qf[d0], p1);
            }
#pragma unroll
            for (int r = 0; r < 16; ++r) {
                const int df0 = qrow - (k0 + crow(r, hi)), df1 = df0 - 32;
                p0[r] = (df0 >= 0) ? p0[r] * __builtin_amdgcn_exp2f(lg2 * (float)df0) : 0.f;
                p1[r] = (df1 >= 0) ? p1[r] * __builtin_amdgcn_exp2f(lg2 * (float)df1) : 0.f;
            }
#pragma unroll
            for (int s = 0; s < 4; ++s) {
                u32x4 pw;
#pragma unroll
                for (int j = 0; j < 4; ++j) pw[j] = (s < 2) ? cvt_pk_bf16(p0[8 * (s & 1) + 2 * j], p0[8 * (s & 1) + 2 * j + 1]) : cvt_pk_bf16(p1[8 * (s & 1) + 2 * j], p1[8 * (s & 1) + 2 * j + 1]);
                const bf16x8 pa = __builtin_bit_cast(bf16x8, pw);
#pragma unroll
                for (int dvh = 0; dvh < 2; ++dvh) {
                    const LAS unsigned char* vp = Vb + ((dvh * 32 + r32) * VROW + 16 * s + 4 * hi) * 2;
                    const u32x2 lo = *(const LAS u32x2*)vp, hh = *(const LAS u32x2*)(vp + 16);
                    u32x4 vv; vv.x = lo.x; vv.y = lo.y; vv.z = hh.x; vv.w = hh.y;
                    if (dvh == 0) o0 = MFMA32(pa, __builtin_bit_cast(bf16x8, vv), o0); else o1 = MFMA32(pa, __builtin_bit_cast(bf16x8, vv), o1);
                }
            }
        }
    }
#pragma unroll
    for (int r = 0; r < 16; ++r) { const size_t orow = (size_t)b * SEQ + jb * 256 + w * 32 + crow(r, hi);
        yb[orow * 256 + h * 64 + r32] = o0[r]; yb[orow * 256 + h * 64 + 32 + r32] = o1[r]; }
}

__device__ __forceinline__ void ret_kv_unit(LAS unsigned char* lds, int bh, int ci, const bf16_t* __restrict__ pb, const float* __restrict__ cosR, const float* __restrict__ sinR, float* __restrict__ kvt) {
    const int tid = tid_opaque(); const int b = bh >> 2, h = bh & 3;
    LAS float* Ks = (LAS float*)lds;
    LAS float* Vs = Ks + 128 * 64;
    const float lg2 = log2f(1.f - exp2f(-5.f - (float)h));
    __syncthreads();
    {
        const int i = tid & 31; float x1[8], x2[8], cc[8], ss[8];
#pragma unroll
        for (int it = 0; it < 8; ++it) { const int t = (tid >> 5) + 16 * it; const size_t tok = (size_t)b * SEQ + ci * 128 + t;
            x1[it] = bf2f(pb[tok * 1024 + 256 + h * 64 + i]); x2[it] = bf2f(pb[tok * 1024 + 256 + h * 64 + 32 + i]); cc[it] = cosR[tok * 32 + i]; ss[it] = sinR[tok * 32 + i]; }
#pragma unroll
        for (int it = 0; it < 8; ++it) { const int t = (tid >> 5) + 16 * it; const float sc = 0.125f * exp2f(lg2 * (float)(127 - t));
            Ks[t * 64 + i] = (x1[it] * cc[it] - x2[it] * ss[it]) * sc; Ks[t * 64 + 32 + i] = (x2[it] * cc[it] + x1[it] * ss[it]) * sc; }
        u32x4 vr[2];
#pragma unroll
        for (int it = 0; it < 2; ++it) { const int ch = tid + 512 * it, t = ch >> 3, c8 = ch & 7; vr[it] = *(const u32x4*)(pb + ((size_t)b * SEQ + ci * 128 + t) * 1024 + 512 + h * 64 + c8 * 8); }
#pragma unroll
        for (int it = 0; it < 2; ++it) { const int ch = tid + 512 * it, t = ch >> 3, c8 = ch & 7; LAS float* d = Vs + t * 64 + c8 * 8;
            *(LAS f32x4*)d = (f32x4){bflo(vr[it].x), bfhi(vr[it].x), bflo(vr[it].y), bfhi(vr[it].y)}; *(LAS f32x4*)(d + 4) = (f32x4){bflo(vr[it].z), bfhi(vr[it].z), bflo(vr[it].w), bfhi(vr[it].w)}; }
    }
    __syncthreads();
    const int e = tid >> 3, d0 = (tid & 7) * 8;
    float acc[8];
#pragma unroll
    for (int j = 0; j < 8; ++j) acc[j] = 0.f;
    for (int t = 0; t < 128; ++t) {
        const float v = Vs[t * 64 + e]; const f32x4 ka = *(const LAS f32x4*)(Ks + t * 64 + d0), kb = *(const LAS f32x4*)(Ks + t * 64 + d0 + 4);
        acc[0] += v * ka.x; acc[1] += v * ka.y; acc[2] += v * ka.z; acc[3] += v * ka.w; acc[4] += v * kb.x; acc[5] += v * kb.y; acc[6] += v * kb.z; acc[7] += v * kb.w;
    }
    float* o = kvt + ((size_t)(bh * 32 + ci)) * 4096 + e * 64 + d0;
    *(f32x4*)o = (f32x4){acc[0], acc[1], acc[2], acc[3]}; *(f32x4*)(o + 4) = (f32x4){acc[4], acc[5], acc[6], acc[7]};
}

struct PrepW { bf16x8 Bw[2], Ba[2], Bv[2], Bg[2][2], Bv1[2]; };
__device__ __forceinline__ bf16x8 pack_col8(const float* W, int ld, int k0, int n) {
    float t[8];
#pragma unroll
    for (int j = 0; j < 8; ++j) t[j] = W[(size_t)(k0 + j) * ld + n];
    u32x4 o; o.x = cvt_pk_bf16(t[0], t[1]); o.y = cvt_pk_bf16(t[2], t[3]); o.z = cvt_pk_bf16(t[4], t[5]); o.w = cvt_pk_bf16(t[6], t[7]);
    return __builtin_bit_cast(bf16x8, o);
}
__device__ __forceinline__ bf16x8 pack_f8(const f32x4 a, const f32x4 b) {
    u32x4 o; o.x = cvt_pk_bf16(a.x, a.y); o.y = cvt_pk_bf16(a.z, a.w); o.z = cvt_pk_bf16(b.x, b.y); o.w = cvt_pk_bf16(b.z, b.w);
    return __builtin_bit_cast(bf16x8, o);
}
#define MFMA16(a, b, c) __builtin_amdgcn_mfma_f32_16x16x32_bf16((a), (b), (c), 0, 0, 0)
__device__ __forceinline__ void prep_fetch_rows(unsigned (&raw)[17], const bf16_t* __restrict__ pa, int t0, int c2) {
    raw[0] = ((t0 & (SEQ - 1)) == 0) ? 0u : *(const unsigned*)(pa + (size_t)(t0 - 1) * 1024 + c2);
#pragma unroll
    for (int t = 0; t < 16; ++t) raw[t + 1] = *(const unsigned*)(pa + (size_t)(t0 + t) * 1024 + c2);
}
constexpr int PSW = 900;
struct PrepC { float mu0, mu1, w0c, a0c, kkc, kac, rkc, v0c; };
__device__ __forceinline__ void rwkv_prep_tile(LAS unsigned char* lds, int tile, int next_tile, unsigned (&raw)[17], const PrepC& PC, int layer, const Params& P, int z, const PrepW& W, const bf16_t* __restrict__ pa, unsigned char* __restrict__ rec,
                                               bf16_t* __restrict__ vbuf, bf16_t* __restrict__ gbuf, bf16_t* __restrict__ vfirst, float* __restrict__ bs, float* __restrict__ cs) {
    const int tid = tid_opaque(), lane = tid & 63;
    LAS float* PS = (LAS float*)lds;
    LAS float* VV = PS + 16 * PSW;
    const float* mu = (const float*)P.in[I_MU + z] + layer * RW_IN;
    const float* w0 = (const float*)P.in[I_W0 + z] + layer * 256; const float* w2 = (const float*)P.in[I_W2 + z] + layer * 32 * 256;
    const float* a0 = (const float*)P.in[I_A0 + z] + layer * 256; const float* a2 = (const float*)P.in[I_A2 + z] + layer * 32 * 256;
    const float* g2 = (const float*)P.in[I_G2 + z] + layer * 64 * 256;
    const float* k_k = (const float*)P.in[I_KK + z] + layer * 256; const float* k_a = (const float*)P.in[I_KA + z] + layer * 256; const float* r_k = (const float*)P.in[I_RK + z] + layer * 256;
    const float* v0 = (const float*)P.in[I_V0 + z] + (layer > 0 ? (layer - 1) * 256 : 0);
    const float* v1 = (const float*)P.in[I_V1 + z] + (layer > 0 ? (layer - 1) * 256 * 32 : 0);
    const float* v2 = (const float*)P.in[I_V2 + z] + (layer > 0 ? (layer - 1) * 32 * 256 : 0);
    const int t0 = tile * 16;
    __syncthreads();
    if (tid < 448) {
        const int c2 = tid * 2; const float mu0 = PC.mu0, mu1 = PC.mu1;
#pragma unroll
        for (int t = 0; t < 16; ++t) {
            float x0 = bflo(raw[t + 1]), x1 = bfhi(raw[t + 1]); const float y0 = bflo(raw[t]), y1 = bfhi(raw[t]);
            x0 = x0 + (y0 - x0) * mu0; x1 = x1 + (y1 - x1) * mu1;
            if (c2 >= 768) { if (c2 < 800) { x0 = 2.f * sigmoidf_(2.f * x0) - 1.f; x1 = 2.f * sigmoidf_(2.f * x1) - 1.f; } else if (c2 >= 832) { x0 = sigmoidf_(x0); x1 = sigmoidf_(x1); } }
            *(LAS f32x2*)(PS + t * PSW + c2) = (f32x2){x0, x1};
        }
        if (next_tile >= 0) prep_fetch_rows(raw, pa, next_tile * 16, c2);
    }
    if (layer > 0) VV[tid] = 0.f;
    __syncthreads();
    const int wv = tid >> 6, l16 = lane & 15, lq = lane >> 4;
    LAS float* LR = VV + 512;
    const f32x4 zero4 = {0.f, 0.f, 0.f, 0.f};
    if (layer > 0) {
        const LAS float* ap = PS + l16 * PSW + 512 + 32 * wv + 8 * lq;
        const bf16x8 A = pack_f8(*(const LAS f32x4*)ap, *(const LAS f32x4*)(ap + 4));
#pragma unroll
        for (int nt = 0; nt < 2; ++nt) { const f32x4 d = MFMA16(A, W.Bv1[nt], zero4);
#pragma unroll
            for (int r = 0; r < 4; ++r) (void)__builtin_amdgcn_ds_faddf(VV + (4 * lq + r) * 32 + 16 * nt + l16, d[r], 0, 0, false); }
        __syncthreads();
    }
    {
        const LAS float* ap = PS + l16 * PSW + 768 + 8 * lq;
        const bf16x8 Aw = pack_f8(*(const LAS f32x4*)ap, *(const LAS f32x4*)(ap + 4)), Aa = pack_f8(*(const LAS f32x4*)(ap + 32), *(const LAS f32x4*)(ap + 36));
        const bf16x8 Ag0 = pack_f8(*(const LAS f32x4*)(ap + 64), *(const LAS f32x4*)(ap + 68)), Ag1 = pack_f8(*(const LAS f32x4*)(ap + 96), *(const LAS f32x4*)(ap + 100));
        bf16x8 Av = Aw;
        if (layer > 0) { const LAS float* vp = VV + l16 * 32 + 8 * lq; Av = pack_f8(*(const LAS f32x4*)vp, *(const LAS f32x4*)(vp + 4)); }
#pragma unroll
        for (int nt = 0; nt < 2; ++nt) {
            const f32x4 dw = MFMA16(Aw, W.Bw[nt], zero4), da = MFMA16(Aa, W.Ba[nt], zero4);
            f32x4 dg = MFMA16(Ag0, W.Bg[nt][0], zero4); dg = MFMA16(Ag1, W.Bg[nt][1], dg);
            f32x4 dv = zero4; if (layer > 0) dv = MFMA16(Av, W.Bv[nt], zero4);
            const int ch = 16 * (2 * wv + nt) + l16;
#pragma unroll
            for (int r = 0; r < 4; ++r) { LAS float* o = LR + (4 * lq + r) * 256 + ch; o[0] = dw[r]; o[4096] = da[r]; o[8192] = dg[r]; o[12288] = dv[r]; }
        }
    }
    __syncthreads();
    const int c = tid & 255, th = tid >> 8;
    float aw[8], aa[8], ag[8], av[8];
#pragma unroll
    for (int i = 0; i < 8; ++i) { const LAS float* o = LR + (th * 8 + i) * 256 + c; aw[i] = o[0]; aa[i] = o[4096]; ag[i] = o[8192]; av[i] = o[12288]; }
    const float w0c = PC.w0c, a0c = PC.a0c, kkc = PC.kkc, kac = PC.kac, rkc = PC.rkc, v0c = PC.v0c;
    const int head = c >> 6, kq = (c & 63) >> 2, e = c & 3;
    float kk_[8], b_[8], kp_[8], dec_[8], r_[8], v_[8], a_[8], q_[8];
#pragma unroll
    for (int i = 0; i < 8; ++i) {
        const int t = th * 8 + i; const size_t tok = (size_t)t0 + t;
        const float r = PS[t * PSW + c], k = PS[t * PSW + 256 + c]; float v = PS[t * PSW + 512 + c];
        dec_[i] = __expf(-0.6065306597126334f * sigmoidf_(w0c + aw[i]));
        const float a = sigmoidf_(a0c + aa[i]);
        if (layer > 0) { const float vf = bf2f(vfirst[tok * 256 + c]); v = v + (vf - v) * sigmoidf_(v0c + av[i]); }
        else vfirst[tok * 256 + c] = f2bf(v);
        r_[i] = r; v_[i] = v; a_[i] = a; kk_[i] = k * kkc; kp_[i] = k * (1.f + (a - 1.f) * kac);
        q_[i] = kk_[i] * kk_[i];
    }
#pragma unroll
    for (int i = 0; i < 8; ++i) q_[i] = wave_sum(q_[i]);
#pragma unroll
    for (int i = 0; i < 8; ++i) { kk_[i] *= rsqrtf(fmaxf(q_[i], 1e-24f)); b_[i] = kk_[i] * a_[i]; q_[i] = r_[i] * kp_[i] * rkc; }
#pragma unroll
    for (int i = 0; i < 8; ++i) q_[i] = wave_sum(q_[i]);
    float d1_[4], d2_[4];
#pragma unroll
    for (int j = 0; j < 4; ++j) { d1_[j] = b_[2 * j] * kk_[2 * j + 1]; d2_[j] = kp_[2 * j] * kk_[2 * j + 1]; }
#pragma unroll
    for (int j = 0; j < 4; ++j) { d1_[j] = wave_sum(d1_[j]); d2_[j] = wave_sum(d2_[j]); }
#pragma unroll
    for (int i = 0; i < 8; ++i) {
        const int t = th * 8 + i; const size_t tok = (size_t)t0 + t;
        const size_t ri = tok * 256 + c;
        ((float*)rec)[ri] = dec_[i]; ((bf16_t*)(rec + 16 * MiB))[ri] = f2bf(r_[i]); ((bf16_t*)(rec + 24 * MiB))[ri] = f2bf(kp_[i]); ((bf16_t*)(rec + 40 * MiB))[ri] = f2bf(b_[i]);
        if ((i & 1) == 0) ((bf16_t*)(rec + 32 * MiB))[ri] = f2bf(-kk_[i]);
        else {
            ((bf16_t*)(rec + 32 * MiB))[ri] = f2bf(kk_[i - 1] * d1_[i >> 1] - dec_[i - 1] * kk_[i]);
            if (lane == 0) cs[tok * 4 + head] = -d2_[i >> 1];
        }
        vbuf[tok * 256 + c] = f2bf(v_[i]); gbuf[tok * 256 + c] = f2bf(ag[i]);
        if (lane == 0) bs[tok * 4 + head] = q_[i];
    }
}

constexpr int SC_TC = 32;
constexpr int SC_REC_F = SC_TC * 16 * 20;
constexpr int SC_V_F = SC_TC * 20;
__device__ __forceinline__ void scan_load_chunk(LAS float* recb, LAS float* vb, const unsigned char* __restrict__ rec, const bf16_t* __restrict__ vbuf, const float* __restrict__ cs, size_t tok0, int h, int v0, int lt) {
#pragma unroll
    for (int it = 0; it < 2; ++it) {
        const int p = lt + it * 256, step = p >> 4, kq = p & 15;
        const size_t ri = (tok0 + step) * 256 + h * 64 + 4 * kq;
        const f32x4 wv = *(const f32x4*)((const float*)rec + ri);
        const u32x2 rr = *(const u32x2*)((const bf16_t*)(rec + 16 * MiB) + ri), kk2 = *(const u32x2*)((const bf16_t*)(rec + 24 * MiB) + ri);
        const u32x2 nn = *(const u32x2*)((const bf16_t*)(rec + 32 * MiB) + ri), bb = *(const u32x2*)((const bf16_t*)(rec + 40 * MiB) + ri);
        const u32x4 a = {rr.x, rr.y, kk2.x, kk2.y}, bq = {nn.x, nn.y, bb.x, bb.y};
        LAS float* d = recb + (step * 16 + kq) * 20;
        *(LAS f32x4*)d = wv;
        *(LAS f32x4*)(d + 4) = (f32x4){bflo(a.x), bfhi(a.x), bflo(a.y), bfhi(a.y)};
        *(LAS f32x4*)(d + 8) = (f32x4){bflo(a.z), bfhi(a.z), bflo(a.w), bfhi(a.w)};
        *(LAS f32x4*)(d + 12) = (f32x4){bflo(bq.x), bfhi(bq.x), bflo(bq.y), bfhi(bq.y)};
        *(LAS f32x4*)(d + 16) = (f32x4){bflo(bq.z), bfhi(bq.z), bflo(bq.w), bfhi(bq.w)};
    }
    if (lt < 128) { const int step = lt >> 2, qd = lt & 3;
        const u32x2 x = *(const u32x2*)(vbuf + (tok0 + step) * 256 + h * 64 + v0 + 4 * qd);
        *(LAS f32x4*)(vb + step * 20 + 4 * qd) = (f32x4){bflo(x.x), bfhi(x.x), bflo(x.y), bfhi(x.y)}; }
    else if (lt < 128 + SC_TC) { const int step = lt - 128; vb[step * 20 + 16] = cs[(tok0 + step) * 4 + h]; }
}
__device__ __forceinline__ void rwkv_scan_block(LAS unsigned char* lds, int blk, const unsigned char* __restrict__ rec, const bf16_t* __restrict__ vbuf, const float* __restrict__ cs, float* __restrict__ ya) {
    const int tid = tid_opaque(), lane = tid & 63, w = tid >> 6;
    const int bh = blk >> 2, b = bh >> 2, h = bh & 3, v0 = (blk & 3) * 16;
    LAS float* RECB = (LAS float*)lds;
    LAS float* VB = RECB + 2 * SC_REC_F;
    const size_t tokb = (size_t)b * SEQ;
    const int rowl = lane >> 4, kq = lane & 15, row = v0 + 4 * (w & 3) + rowl;
    f32x2 Sa = {0.f, 0.f}, Sb = {0.f, 0.f}; float ykeep = 0.f;
    if (w < 4) __builtin_amdgcn_s_setprio(3);
    __syncthreads();
    if (w >= 4) scan_load_chunk(RECB, VB, rec, vbuf, cs, tokb, h, v0, tid - 256);
    for (int c = 0; c < SEQ / SC_TC; ++c) {
        __syncthreads();
        const int buf = c & 1;
        if (w >= 4) { if (c + 1 < SEQ / SC_TC) scan_load_chunk(RECB + (buf ^ 1) * SC_REC_F, VB + (buf ^ 1) * SC_V_F, rec, vbuf, cs, tokb + (size_t)(c + 1) * SC_TC, h, v0, tid - 256); }
        else {
            const LAS float* rb = RECB + buf * SC_REC_F + kq * 20; const LAS float* vb = VB + buf * SC_V_F;
            float* yo = ya + (tokb + (size_t)c * SC_TC + kq) * 256 + h * 64 + row;
#define SC_LD(P, st) do { const LAS float* R_ = rb + (st) * 320; P##w = *(const LAS f32x4*)R_; P##r = *(const LAS f32x4*)(R_ + 4); P##k = *(const LAS f32x4*)(R_ + 8); \
                          P##n = *(const LAS f32x4*)(R_ + 12); P##b = *(const LAS f32x4*)(R_ + 16); P##v = vb[(st) * 20 + 4 * w + rowl]; } while (0)
#define LO2(q_) ((f32x2){(q_).x, (q_).y})
#define HI2(q_) ((f32x2){(q_).z, (q_).w})
            f32x4 Aw, Ar, Ak, An, Ab, Bw, Br, Bk, Bn, Bb, Cw, Cr, Ck, Cn, Cb, Dw, Dr, Dk, Dn, Db; float Av, Bv, Cv, Dv, Bc, Dc;
            SC_LD(A, 0); SC_LD(B, 1); Bc = vb[1 * 20 + 16];
#pragma unroll
            for (int st = 0; st < SC_TC; st += 4) {
                if (st + 2 < SC_TC) { SC_LD(C, st + 2); SC_LD(D, st + 3); Dc = vb[(st + 3) * 20 + 16]; }
#define SC_PAIR(E, O, Oc, S0) do { \
                f32x2 d0 = Sa * LO2(E##n); d0 = Sb * HI2(E##n) + d0; f32x2 d1 = Sa * LO2(O##n); d1 = Sb * HI2(O##n) + d1; \
                const f32x2 ve = {E##v, E##v}, vo = {O##v, O##v}; \
                f32x2 ta = ve * LO2(E##k), tb = ve * HI2(E##k); ta = Sa * LO2(E##w) + ta; tb = Sb * HI2(E##w) + tb; \
                const float sa0 = allreduce16(d0.x + d0.y); const float sa1 = allreduce16(d1.x + d1.y) + E##v * Oc; \
                const f32x2 s0 = {sa0, sa0}, s1 = {sa1, sa1}; \
                Sa = s0 * LO2(E##b) + ta; Sb = s0 * HI2(E##b) + tb; \
                f32x2 e0 = Sa * LO2(E##r); e0 = Sb * HI2(E##r) + e0; \
                f32x2 ua = vo * LO2(O##k), ub = vo * HI2(O##k); ua = Sa * LO2(O##w) + ua; ub = Sb * HI2(O##w) + ub; \
                Sa = s1 * LO2(O##b) + ua; Sb = s1 * HI2(O##b) + ub; \
                f32x2 e1 = Sa * LO2(O##r); e1 = Sb * HI2(O##r) + e1; \
                Y0 = e0.x + e0.y; Y1 = e1.x + e1.y; } while (0)
                float yp0, yp1, yp2, yp3;
#define Y0 yp0
#define Y1 yp1
                SC_PAIR(A, B, Bc, st);
#undef Y0
#undef Y1
                if (st + 4 < SC_TC) { SC_LD(A, st + 4); SC_LD(B, st + 5); Bc = vb[(st + 5) * 20 + 16]; }
#define Y0 yp2
#define Y1 yp3
                SC_PAIR(C, D, Dc, st + 2);
#undef Y0
#undef Y1
                {
                    const unsigned long long b0 = 0xAAAAAAAAAAAAAAAAull, b1 = 0xCCCCCCCCCCCCCCCCull;
                    float s01, x01, s23, x23;
                    asm volatile("v_cndmask_b32_e64 %0, %1, %2, %3" : "=v"(s01) : "v"(yp0), "v"(yp1), "s"(b0));
                    asm volatile("v_cndmask_b32_e64 %0, %1, %2, %3" : "=v"(x01) : "v"(yp1), "v"(yp0), "s"(b0));
                    asm volatile("v_cndmask_b32_e64 %0, %1, %2, %3" : "=v"(s23) : "v"(yp2), "v"(yp3), "s"(b0));
                    asm volatile("v_cndmask_b32_e64 %0, %1, %2, %3" : "=v"(x23) : "v"(yp3), "v"(yp2), "s"(b0));
                    const float a01 = s01 + dpp_mov<0xB1>(x01), a23 = s23 + dpp_mov<0xB1>(x23);
                    float sq, xq;
                    asm volatile("v_cndmask_b32_e64 %0, %1, %2, %3" : "=v"(sq) : "v"(a01), "v"(a23), "s"(b1));
                    asm volatile("v_cndmask_b32_e64 %0, %1, %2, %3" : "=v"(xq) : "v"(a23), "v"(a01), "s"(b1));
                    float yq = sq + dpp_mov<0x4E>(xq);
                    yq += dpp_mov<0x128>(yq); yq += dpp_mov<0x124>(yq);
                    const unsigned long long mk = 0x000F000F000F000Full << (st & 15);
                    asm volatile("v_cndmask_b32_e64 %0, %0, %1, %2" : "+v"(ykeep) : "v"(yq), "s"(mk));
                }
                if ((st & 15) == 12) yo[(size_t)(st - 12) * 256] = ykeep;
            }
#undef SC_PAIR
#undef SC_LD
#undef LO2
#undef HI2
        }
    }
    __builtin_amdgcn_s_setprio(0);
}

#define XB_TMO      128
#define XB_XCNT(j)  (256  + 64 * (j))
#define XB_XSUB(j)  (1280 + 64 * (j))
#define XB_XGEN(j)  (2304 + 64 * (j))
#define XB_TOP      3328
#define XB_TOPGEN   3392
#define XB_SPIN_CAP (1u << 20)
__device__ __forceinline__ unsigned xb_ld(unsigned* p)              { return __hip_atomic_load(p, __ATOMIC_RELAXED, __HIP_MEMORY_SCOPE_AGENT); }
__device__ __forceinline__ unsigned xb_add(unsigned* p, unsigned v) { return __hip_atomic_fetch_add(p, v, __ATOMIC_RELAXED, __HIP_MEMORY_SCOPE_AGENT); }
__device__ __forceinline__ unsigned xb_xcc_id() { return (unsigned)__builtin_amdgcn_s_getreg((3 << 11) | 20) & 0xFu; }
#define XB_SPIN(cond, bar) do { unsigned _sp = 0; while (cond) { __builtin_amdgcn_s_sleep(1); \
    if ((++_sp & 255u) == 0u) { if (xb_ld(&(bar)[XB_TMO])) break; if (_sp > XB_SPIN_CAP) { atomicAdd(&(bar)[XB_TMO], 1u); break; } } } } while (0)
struct XcdBarrier { unsigned* bar; unsigned x; volatile LAS unsigned* st; };
__device__ __forceinline__ XcdBarrier xcd_barrier_post(unsigned* bar, volatile LAS unsigned* st) {
    XcdBarrier b; b.bar = bar; b.x = xb_xcc_id(); b.st = st;
    if (__builtin_amdgcn_workitem_id_x() == 0) (void)xb_add(&bar[XB_XCNT(b.x)], 1u);
    return b;
}
__device__ __forceinline__ void xcd_barrier_complete(unsigned* bar, unsigned x, unsigned& nloc, unsigned& nx) {
    const unsigned G = gridDim.x * gridDim.y * gridDim.z;
    unsigned sum, cnt, mine, sp = 0u;
    for (;;) {
        sum = 0u; cnt = 0u; mine = 0u;
#pragma unroll
        for (unsigned j = 0; j < 16; ++j) { const unsigned c = xb_ld(&bar[XB_XCNT(j)]); sum += c; cnt += (c > 0u) ? 1u : 0u; mine = (j == x) ? c : mine; }
        if (sum == G) break;
        __builtin_amdgcn_s_sleep(1);
        if ((++sp & 255u) == 0u) { if (xb_ld(&bar[XB_TMO])) break; if (sp > XB_SPIN_CAP) { atomicAdd(&bar[XB_TMO], 1u); break; } }
    }
    nloc = mine > 0u ? mine : 1u; nx = cnt > 0u ? cnt : 1u;
}
__device__ __forceinline__ void xcd_barrier(const XcdBarrier& b, const unsigned k) {
    asm volatile("s_waitcnt vmcnt(0)" ::: "memory");
    __syncthreads();
    if (__builtin_amdgcn_workitem_id_x() == 0) {
        unsigned* bar = b.bar;
        __builtin_amdgcn_s_waitcnt(0);
        unsigned nloc = b.st[0], nx = b.st[1];
        if (nloc == 0u) { xcd_barrier_complete(bar, b.x, nloc, nx); b.st[0] = nloc; b.st[1] = nx; }
        const unsigned old = xb_add(&bar[XB_XSUB(b.x)], 1u);
        const unsigned gen = old / nloc;
        if (old + 1u == (gen + 1u) * nloc) {
            __builtin_amdgcn_fence(__ATOMIC_RELEASE, "agent");
            asm volatile("s_waitcnt vmcnt(0)" ::: "memory");
            const unsigned og = xb_add(&bar[XB_TOP], 1u);
            const unsigned tg = og / nx;
            if (og + 1u == (tg + 1u) * nx) xb_add(&bar[XB_TOPGEN], 1u);
            else XB_SPIN(xb_ld(&bar[XB_TOPGEN]) == tg, bar);
            __builtin_amdgcn_fence(__ATOMIC_ACQUIRE, "agent");
            asm volatile("s_waitcnt vmcnt(0)" ::: "memory");
        } else {
            XB_SPIN(xb_ld(&bar[XB_TOPGEN]) < k, bar);
            __builtin_amdgcn_fence(__ATOMIC_ACQUIRE, "agent");
            asm volatile("s_waitcnt vmcnt(0)" ::: "memory");
        }
    }
    __syncthreads();
}


#define PIN(i) ((const float*)P.in[(i) + z])
constexpr int NPH = 9;
template <int PH> __device__ __forceinline__ void run_phase(const Params& P, LAS unsigned char* lds) {
        int z; asm volatile("s_mov_b32 %0, 0" : "=s"(z));
        unsigned char* ws = P.ws + z;
        constexpr int layer = PH / NPH, k = PH - layer * NPH;
        const int tid = tid_opaque(), lane = tid & 63, wave = __builtin_amdgcn_readfirstlane(tid >> 6), G = sgpr_opaque(gridDim.x), blk = sgpr_opaque(blockIdx.x);
        const int gw = blk * 8 + wave, NGW = G * 8;
        float* hbuf = P.out + z;
        bf16_t* XN = (bf16_t*)(ws + WS_X);
        if constexpr (PH == NPH * DEPTH) {
            const float* g = PIN(I_FINAL);
            const f32x4* gr = (const f32x4*)g + lane;
            f32x4 gg[4];
#pragma unroll
            for (int j = 0; j < 4; ++j) gg[j] = gr[64 * j];
            for (int m = gw; m < T; m += 4 * NGW) {
                f32x4 v[4][4]; float rs[4];
#pragma unroll
                for (int r = 0; r < 4; ++r)
#pragma unroll
                    for (int j = 0; j < 4; ++j) v[r][j] = ((const f32x4*)(hbuf + (size_t)(m + r * NGW) * 1024) + lane)[64 * j];
#pragma unroll
                for (int r = 0; r < 4; ++r) { float s2 = 0.f;
#pragma unroll
                    for (int j = 0; j < 4; ++j) s2 += (v[r][j].x * v[r][j].x + v[r][j].y * v[r][j].y) + (v[r][j].z * v[r][j].z + v[r][j].w * v[r][j].w);
                    rs[r] = s2; }
#pragma unroll
                for (int r = 0; r < 4; ++r) rs[r] = rsqrtf(wave_sum(rs[r]) * (1.f / 1024.f) + NORM_EPS);
#pragma unroll
                for (int r = 0; r < 4; ++r)
#pragma unroll
                    for (int j = 0; j < 4; ++j) ((f32x4*)(hbuf + (size_t)(m + r * NGW) * 1024) + lane)[64 * j] = v[r][j] * rs[r] * gg[j];
            }
            return;
        } else if constexpr (k == 0) {
            const float* hin = (layer == 0) ? PIN(I_X) : hbuf;
            LAS float* tscr = (LAS float*)(lds + wave * 16384);
            bf16_t* Win_t = (bf16_t*)(ws + WS_WIN); bf16_t* Wq_t = (bf16_t*)(ws + WS_WQ); bf16_t* Wkv_t = (bf16_t*)(ws + WS_WKV); bf16_t* Wo_t = (bf16_t*)(ws + WS_WO);
            const float* Win = PIN(I_W_IN) + (size_t)layer * DM * IN_DIM;
            const float* Wq = PIN(I_WQUP) + (size_t)layer * 384 * 768;
            const float* Wkv = PIN(I_WKVUP) + (size_t)layer * 256 * 1024;
            const float* Wo = PIN(I_W_OUT) + (size_t)layer * 1024 * 1024;
            constexpr int IT_IN = 16 * 81, IT_Q = 6 * 24, IT_KV = 4 * 32, IT_O = 16 * 32;
            if (layer == 0) for (int it = gw; it < IT_IN + IT_Q + IT_KV + IT_O; it += NGW) {
                int r = it;
                if (r < IT_IN) { transpose_item(Win, 1024, IN_DIM, Win_t, 1, tscr, r, lane); continue; } r -= IT_IN;
                if (r < IT_Q) { transpose_item(Wq, 384, 768, Wq_t, 0, tscr, r, lane); continue; } r -= IT_Q;
                if (r < IT_KV) { transpose_item(Wkv, 256, 1024, Wkv_t, 0, tscr, r, lane); continue; } r -= IT_KV;
                transpose_item(Wo, 1024, 1024, Wo_t, 0, tscr, r, lane);
            }
            for (int i = blk * 512 + tid; i < 224 * 128; i += G * 512) { const int rr = i >> 7, cc = i & 127; const int row = (rr < 128) ? 896 + rr : 2720 + (rr - 128);
                *(u32x4*)(Win_t + (size_t)row * 1024 + cc * 8) = (u32x4){0u, 0u, 0u, 0u}; }
            if (layer == 0) {
                const int* pos = (const int*)P.in[I_POS + z];
                float* cosR = (float*)(ws + WS_COSR); float* sinR = (float*)(ws + WS_SINR); float* cosM = (float*)(ws + WS_COSM); float* sinM = (float*)(ws + WS_SINM);
                for (int i = blk * 512 + tid; i < T * 32; i += G * 512) { const int tok = i >> 5, f = i & 31;
                    const float inv = exp2f(-(float)f * (1.f / 32.f) * 13.287712379549449f); const float ang = (float)pos[tok] * inv;
                    double rev = (double)ang * 0.15915494309189535; rev -= floor(rev); const float a = (float)(rev * 6.283185307179586);
                    cosR[i] = __cosf(a); sinR[i] = __sinf(a); }
                for (int i = blk * 512 + tid; i < T * 16; i += G * 512) { const int tok = i >> 4, f = i & 15;
                    const float inv = exp2f(-(float)f * (1.f / 16.f) * 13.287712379549449f); const float ang = (float)pos[tok] * inv;
                    double rev = (double)ang * 0.15915494309189535; rev -= floor(rev); const float a = (float)(rev * 6.283185307179586);
                    cosM[i] = __cosf(a); sinM[i] = __sinf(a); }
            }
            const float* g = PIN(I_ATTN_NORM) + layer * 1024;
            for (int m = gw; m < T; m += 2 * NGW) rms_rows2_bf16(hin + (size_t)m * 1024, hin + (size_t)(m + NGW) * 1024, g, XN + (size_t)m * 1024, XN + (size_t)(m + NGW) * 1024, lane);
        } else if constexpr (k == 1) {
            pg8::Gemm g{XN, (bf16_t*)(ws + WS_WIN), T, NPROJ, 1024}; pg8::StaticOrder S; S.init(T, NPROJ, G, blk);
            pg8::EpiProj E{(bf16_t*)(ws + WS_PA), (bf16_t*)(ws + WS_PB), (bf16_t*)(ws + WS_PC)};
            pg8::gemm_phase<pg8::EpiProj, pg8::StaticOrder, true, true>(lds, g, S, E);
        } else if constexpr (k == 2) {
            bf16_t* pa = (bf16_t*)(ws + WS_PA); bf16_t* pb = (bf16_t*)(ws + WS_PB); bf16_t* pc = (bf16_t*)(ws + WS_PC);
            float* cosR = (float*)(ws + WS_COSR); float* sinR = (float*)(ws + WS_SINR); float* cosM = (float*)(ws + WS_COSM); float* sinM = (float*)(ws + WS_SINM);
            PrepW W;
            {
                const int l16 = lane & 15, lq = lane >> 4;
                const float* w2 = PIN(I_W2) + layer * 32 * 256; const float* a2 = PIN(I_A2) + layer * 32 * 256; const float* g2 = PIN(I_G2) + layer * 64 * 256;
                const float* v1 = PIN(I_V1) + (layer > 0 ? (layer - 1) * 256 * 32 : 0); const float* v2 = PIN(I_V2) + (layer > 0 ? (layer - 1) * 32 * 256 : 0);
#pragma unroll
                for (int nt = 0; nt < 2; ++nt) { const int n = 16 * (2 * wave + nt) + l16;
                    W.Bw[nt] = pack_col8(w2, 256, 8 * lq, n); W.Ba[nt] = pack_col8(a2, 256, 8 * lq, n);
                    W.Bg[nt][0] = pack_col8(g2, 256, 8 * lq, n); W.Bg[nt][1] = pack_col8(g2, 256, 32 + 8 * lq, n);
                    W.Bv[nt] = pack_col8(v2, 256, 8 * lq, n); W.Bv1[nt] = pack_col8(v1, 32, 32 * wave + 8 * lq, 16 * nt + l16); }
            }
            unsigned raw[17];
            if (tid < 448 && blk < T / 16) prep_fetch_rows(raw, pa, blk * 16, tid * 2);
            PrepC PC;
            { const int cc = tid & 255, c2 = (tid < 448) ? tid * 2 : 0;
              const float* mu = PIN(I_MU) + layer * RW_IN;
              PC.mu0 = mu[c2]; PC.mu1 = mu[c2 + 1]; PC.w0c = (PIN(I_W0) + layer * 256)[cc]; PC.a0c = (PIN(I_A0) + layer * 256)[cc]; PC.kkc = (PIN(I_KK) + layer * 256)[cc];
              PC.kac = (PIN(I_KA) + layer * 256)[cc]; PC.rkc = (PIN(I_RK) + layer * 256)[cc]; PC.v0c = (layer > 0) ? (PIN(I_V0) + (layer - 1) * 256)[cc] : 0.f; }
            for (int tile = blk; tile < T / 16; tile += G) rwkv_prep_tile(lds, tile, (tile + G < T / 16) ? tile + G : -1, raw, PC, layer, P, z, W, pa, ws + WS_REC, (bf16_t*)(ws + WS_VBUF), (bf16_t*)(ws + WS_GBUF), (bf16_t*)(ws + WS_VFIRST), (float*)(ws + WS_BS), (float*)(ws + WS_BS + 512 * 1024));
            for (int u = blk; u < 512; u += G) ret_kv_unit(lds, u >> 5, u & 31, pb, cosR, sinR, (float*)(ws + WS_KVT));
        } else if constexpr (k == 3) {
            LAS unsigned* misc = (LAS unsigned*)(lds + 131072);
            unsigned* ctl = (unsigned*)(ws + WS_CTL);
            float* cosR = (float*)(ws + WS_COSR); float* sinR = (float*)(ws + WS_SINR); float* cosM = (float*)(ws + WS_COSM); float* sinM = (float*)(ws + WS_SINM);
            unsigned* sbar = ctl + 64 * (8 + layer);
            const int NB = G - 64;
            if (blk < 64) {
                rwkv_scan_block(lds, blk, ws + WS_REC, (bf16_t*)(ws + WS_VBUF), (const float*)(ws + WS_BS + 512 * 1024), (float*)(ws + WS_YA));
                if (tid == 0) { unsigned sp = 0; while (xb_ld(sbar) < (unsigned)NB) { __builtin_amdgcn_s_sleep(4); if (++sp > (1u << 22)) break; }
                    __builtin_amdgcn_fence(__ATOMIC_ACQUIRE, "agent"); asm volatile("s_waitcnt vmcnt(0)" ::: "memory"); }
                __syncthreads();
            } else {
                const int cb = blk - 64;
                {
                    const int gwn = cb * 8 + wave, NGWn = NB * 8;
                    bf16_t* pc = (bf16_t*)(ws + WS_PC);
            bf16_t* qn = (bf16_t*)(ws + WS_QN); bf16_t* kvn = (bf16_t*)(ws + WS_KVN); bf16_t* kr = (bf16_t*)(ws + WS_KR);
            const float* qg = PIN(I_QNORM) + layer * 384; const float* kg = PIN(I_KVNORM) + layer * 256;
            float qgv[6], kgv[4];
#pragma unroll
            for (int j = 0; j < 6; ++j) qgv[j] = qg[lane + 64 * j];
#pragma unroll
            for (int j = 0; j < 4; ++j) kgv[j] = kg[lane + 64 * j];
            for (int m0 = gwn; m0 < T; m0 += 2 * NGWn) {
                float xq[2][6], xk[2][4], x1[2], x2[2], cc[2], sn[2];
#pragma unroll
                for (int u = 0; u < 2; ++u) { const int m = (m0 + u * NGWn < T) ? m0 + u * NGWn : T - 1; const bf16_t* row = pc + (size_t)m * 768;
#pragma unroll
                    for (int j = 0; j < 6; ++j) xq[u][j] = bf2f(row[lane + 64 * j]);
#pragma unroll
                    for (int j = 0; j < 4; ++j) xk[u][j] = bf2f(row[384 + lane + 64 * j]);
                    x1[u] = bf2f(row[640 + (lane & 15)]); x2[u] = bf2f(row[656 + (lane & 15)]); cc[u] = cosM[(size_t)m * 16 + (lane & 15)]; sn[u] = sinM[(size_t)m * 16 + (lane & 15)]; }
#pragma unroll
                for (int u = 0; u < 2; ++u) { const int m = m0 + u * NGWn; if (m >= T) continue;
                    float sq = 0.f, sk = 0.f;
#pragma unroll
                    for (int j = 0; j < 6; ++j) sq += xq[u][j] * xq[u][j];
#pragma unroll
                    for (int j = 0; j < 4; ++j) sk += xk[u][j] * xk[u][j];
                    const float rq = rsqrtf(wave_sum(sq) * (1.f / 384.f) + NORM_EPS), rk = rsqrtf(wave_sum(sk) * (1.f / 256.f) + NORM_EPS);
#pragma unroll
                    for (int j = 0; j < 6; ++j) qn[(size_t)m * 384 + lane + 64 * j] = f2bf(xq[u][j] * rq * qgv[j]);
#pragma unroll
                    for (int j = 0; j < 4; ++j) kvn[(size_t)m * 256 + lane + 64 * j] = f2bf(xk[u][j] * rk * kgv[j]);
                    if (lane < 16) { kr[(size_t)m * 32 + lane] = f2bf(x1[u] * cc[u] - x2[u] * sn[u]); kr[(size_t)m * 32 + 16 + lane] = f2bf(x2[u] * cc[u] + x1[u] * sn[u]); }
                }
            }
                    unsigned* sbar0 = ctl + 64 * (12 + layer);
                    asm volatile("s_waitcnt vmcnt(0)" ::: "memory");
                    __syncthreads();
                    if (tid == 0) {
                        __builtin_amdgcn_fence(__ATOMIC_RELEASE, "agent"); asm volatile("s_waitcnt vmcnt(0)" ::: "memory");
                        xb_add(sbar0, 1u);
                        unsigned sp = 0; while (xb_ld(sbar0) < (unsigned)NB) { __builtin_amdgcn_s_sleep(4); if (++sp > (1u << 22)) break; }
                        __builtin_amdgcn_fence(__ATOMIC_ACQUIRE, "agent"); asm volatile("s_waitcnt vmcnt(0)" ::: "memory");
                    }
                    __syncthreads();
                }
                bf16_t* rprev = (bf16_t*)(ws + WS_RPREV); const float* kvt = (const float*)(ws + WS_KVT);
                for (int i = cb * 512 + tid; i < 16 * 4096; i += NB * 512) { const int bh = i >> 12, el = i & 4095; const int h = bh & 3;
                    const float cd = exp2f(128.f * log2f(1.f - exp2f(-5.f - (float)h)));
                    float R = 0.f;
#pragma unroll 8
                    for (int ci = 0; ci < 32; ++ci) { rprev[((size_t)(bh * 32 + ci)) * 4096 + el] = f2bf(R); R = R * cd + kvt[((size_t)(bh * 32 + ci)) * 4096 + el]; } }
                __syncthreads();
                { pg8::Gemm g{(bf16_t*)(ws + WS_QN), (bf16_t*)(ws + WS_WQ), T, 768, 384}; pg8::StaticOrder S; S.init(T, 768, NB, cb); pg8::EpiPlain E{(bf16_t*)(ws + WS_PC), 768};
                  pg8::gemm_phase<pg8::EpiPlain, pg8::StaticOrder, true, true>(lds, g, S, E); }
                { pg8::Gemm g{(bf16_t*)(ws + WS_KVN), (bf16_t*)(ws + WS_WKV), T, 1024, 256}; pg8::StaticOrder S; S.init(T, 1024, NB, cb); pg8::EpiPlain E{(bf16_t*)(ws + WS_KN), 1024};
                  pg8::gemm_phase<pg8::EpiPlain, pg8::StaticOrder, true, true>(lds, g, S, E); }
                asm volatile("s_waitcnt vmcnt(0)" ::: "memory");
                __syncthreads();
                if (tid == 0) {
                    __builtin_amdgcn_fence(__ATOMIC_RELEASE, "agent"); asm volatile("s_waitcnt vmcnt(0)" ::: "memory");
                    xb_add(sbar, 1u);
                    unsigned sp = 0; while (xb_ld(sbar) < (unsigned)NB) { __builtin_amdgcn_s_sleep(4); if (++sp > (1u << 22)) break; }
                    __builtin_amdgcn_fence(__ATOMIC_ACQUIRE, "agent"); asm volatile("s_waitcnt vmcnt(0)" ::: "memory");
                }
                __syncthreads();
            }
            unsigned* qctr = ctl + 64 * (1 + layer);
            for (;;) {
                __syncthreads();
                if (tid == 0) misc[0] = atomicAdd(qctr, 1u);
                __syncthreads();
                const int u = (int)misc[0];
                if (u >= 768) break;
                if (u < 512) { const int qb = 15 - (u >> 5), bh = u & 31; att_unit(lds, bh >> 3, bh & 7, qb, (bf16_t*)(ws + WS_PC), (bf16_t*)(ws + WS_KN), (bf16_t*)(ws + WS_KR), cosM, sinM, XN); }
                else { const int v = u - 512; const int bh = v & 15, jb = v >> 4; ret_unit(lds, bh >> 2, bh & 3, jb, (bf16_t*)(ws + WS_PB), cosR, sinR, (bf16_t*)(ws + WS_RPREV), (float*)(ws + WS_YB)); }
            }
        } else if constexpr (k == 4) {
            LAS float* tscr = (LAS float*)(lds + wave * 16384);
            const float* __restrict__ ya = (const float*)(ws + WS_YA); const float* __restrict__ yb = (const float*)(ws + WS_YB); const float* __restrict__ bs = (const float*)(ws + WS_BS);
            const bf16_t* __restrict__ vbuf = (const bf16_t*)(ws + WS_VBUF); const bf16_t* __restrict__ gbuf = (const bf16_t*)(ws + WS_GBUF); const bf16_t* __restrict__ pb = (const bf16_t*)(ws + WS_PB);
            const float* __restrict__ gnw = PIN(I_GNW) + layer * 256; const float* __restrict__ gnb = PIN(I_GNB) + layer * 256;
            bf16_t* __restrict__ XNw = XN;
            const f32x4 gw4 = *(const f32x4*)(gnw + 4 * lane), gb4 = *(const f32x4*)(gnb + 4 * lane);
#pragma unroll 4
            for (int m = gw; m < T; m += NGW) {
                const int c = 4 * lane, head = lane >> 4;
                const f32x4 y = *(const f32x4*)(ya + (size_t)m * 256 + c);
                const float mean = allreduce16((y.x + y.y) + (y.z + y.w)) * (1.f / 64.f);
                const f32x4 d = y - mean;
                const float var = allreduce16((d.x * d.x + d.y * d.y) + (d.z * d.z + d.w * d.w)) * (1.f / 64.f);
                const float rs = rsqrtf(var + 64e-5f);
                const u32x2 vv = *(const u32x2*)(vbuf + (size_t)m * 256 + c), gg = *(const u32x2*)(gbuf + (size_t)m * 256 + c);
                const float bsc = bs[(size_t)m * 4 + head];
                const float o0 = (d.x * rs * gw4.x + gb4.x + bsc * bflo(vv.x)) * bflo(gg.x), o1 = (d.y * rs * gw4.y + gb4.y + bsc * bfhi(vv.x)) * bfhi(gg.x);
                const float o2 = (d.z * rs * gw4.z + gb4.z + bsc * bflo(vv.y)) * bflo(gg.y), o3 = (d.w * rs * gw4.w + gb4.w + bsc * bfhi(vv.y)) * bfhi(gg.y);
                u32x2 w; w.x = cvt_pk_bf16(o0, o1); w.y = cvt_pk_bf16(o2, o3);
                *(u32x2*)(XNw + (size_t)m * 1024 + c) = w;
                const f32x4 zz = *(const f32x4*)(yb + (size_t)m * 256 + c);
                const float ms = allreduce16((zz.x * zz.x + zz.y * zz.y) + (zz.z * zz.z + zz.w * zz.w)) * (1.f / 64.f);
                const float rz = rsqrtf(ms + NORM_EPS);
                const u32x2 gt = *(const u32x2*)(pb + (size_t)m * 1024 + 768 + c);
                const float g0 = bflo(gt.x), g1 = bfhi(gt.x), g2v = bflo(gt.y), g3 = bfhi(gt.y);
                u32x2 w2; w2.x = cvt_pk_bf16(zz.x * rz * g0 * sigmoidf_(g0), zz.y * rz * g1 * sigmoidf_(g1)); w2.y = cvt_pk_bf16(zz.z * rz * g2v * sigmoidf_(g2v), zz.w * rz * g3 * sigmoidf_(g3));
                *(u32x2*)(XNw + (size_t)m * 1024 + 256 + c) = w2;
            }
            const float* Wgu = PIN(I_WGU) + (size_t)layer * 1024 * 2 * D_FF; const float* Wdn = PIN(I_WDN) + (size_t)layer * D_FF * 1024;
            bf16_t* Wgu_t = (bf16_t*)(ws + WS_WGU); bf16_t* Wdn_t = (bf16_t*)(ws + WS_WDN);
            constexpr int IT_GU = 16 * 176, IT_DN = 44 * 32;
            for (int it = gw; it < IT_GU + IT_DN; it += NGW) {
                if (it < IT_GU) transpose_item(Wgu, 1024, 2 * D_FF, Wgu_t, 2, tscr, it, lane);
                else transpose_item(Wdn, D_FF, 1024, Wdn_t, 0, tscr, it - IT_GU, lane);
            }
        } else if constexpr (k == 5) {
            const float* hin = (layer == 0) ? PIN(I_X) : hbuf;
            pg8::Gemm g{XN, (bf16_t*)(ws + WS_WO), T, 1024, 1024}; pg8::StaticOrder S; S.init(T, 1024, G, blk); pg8::EpiRes E{hin, hbuf};
            pg8::gemm_phase<pg8::EpiRes, pg8::StaticOrder, true, true>(lds, g, S, E);
        } else if constexpr (k == 6) {
            const float* g = PIN(I_FFN_NORM) + layer * 1024;
            for (int m = gw; m < T; m += 2 * NGW) rms_rows2_bf16(hbuf + (size_t)m * 1024, hbuf + (size_t)(m + NGW) * 1024, g, XN + (size_t)m * 1024, XN + (size_t)(m + NGW) * 1024, lane);
            if constexpr (layer + 1 < DEPTH) {
                LAS float* tscr = (LAS float*)(lds + wave * 16384);
                const float* Win = PIN(I_W_IN) + (size_t)(layer + 1) * DM * IN_DIM; const float* Wq = PIN(I_WQUP) + (size_t)(layer + 1) * 384 * 768;
                const float* Wkv = PIN(I_WKVUP) + (size_t)(layer + 1) * 256 * 1024; const float* Wo = PIN(I_W_OUT) + (size_t)(layer + 1) * 1024 * 1024;
                constexpr int IT_IN = 16 * 81, IT_Q = 6 * 24, IT_KV = 4 * 32, IT_O = 16 * 32;
                for (int it = gw; it < IT_IN + IT_Q + IT_KV + IT_O; it += NGW) {
                    int r = it;
                    if (r < IT_IN) { transpose_item(Win, 1024, IN_DIM, (bf16_t*)(ws + WS_WIN), 1, tscr, r, lane); continue; } r -= IT_IN;
                    if (r < IT_Q) { transpose_item(Wq, 384, 768, (bf16_t*)(ws + WS_WQ), 0, tscr, r, lane); continue; } r -= IT_Q;
                    if (r < IT_KV) { transpose_item(Wkv, 256, 1024, (bf16_t*)(ws + WS_WKV), 0, tscr, r, lane); continue; } r -= IT_KV;
                    transpose_item(Wo, 1024, 1024, (bf16_t*)(ws + WS_WO), 0, tscr, r, lane);
                }
            }
        } else if constexpr (k == 7) {
            pg8::Gemm g{XN, (bf16_t*)(ws + WS_WGU), T, 2 * D_FF, 1024}; pg8::StaticOrder S; S.init(T, 2 * D_FF, G, blk); pg8::EpiSwiGLU E{(bf16_t*)(ws + WS_ACT)};
            pg8::gemm_phase<pg8::EpiSwiGLU, pg8::StaticOrder, true, true>(lds, g, S, E);
        } else {
            pg8::Gemm g{(bf16_t*)(ws + WS_ACT), (bf16_t*)(ws + WS_WDN), T, 1024, D_FF}; pg8::StaticOrder S; S.init(T, 1024, G, blk); pg8::EpiRes E{hbuf, hbuf};
            pg8::gemm_phase<pg8::EpiRes, pg8::StaticOrder, true, true>(lds, g, S, E);
        }
}

template <int PH> __device__ __forceinline__ void run_all(const Params& P, LAS unsigned char* lds, cg::grid_group& grid, const XcdBarrier& bar) {
    run_phase<PH>(P, lds);
    if constexpr (PH < NPH * DEPTH) {
        xcd_barrier(bar, (unsigned)PH + 1u);
        run_all<PH + 1>(P, lds, grid, bar);
    }
}
__global__ void __launch_bounds__(512) hymba_fwd(Params P) {
    extern __shared__ __attribute__((aligned(16))) unsigned char lds_raw[];
    LAS unsigned char* lds = (LAS unsigned char*)lds_raw;
    cg::grid_group grid = cg::this_grid();
    LAS unsigned* misc = (LAS unsigned*)(lds + 131072);
    if (__builtin_amdgcn_workitem_id_x() < 32) misc[__builtin_amdgcn_workitem_id_x()] = 0u;
    __syncthreads();
    if (P.ws == nullptr) grid.sync();
    const XcdBarrier bar = xcd_barrier_post((unsigned*)(P.ws + WS_CTL) + 4096, (volatile LAS unsigned*)(misc + 8));
    run_all<0>(P, lds, grid, bar);
}
extern "C" void kernel_launch(void* const* d_in, const int* in_sizes, int n_in, void* d_out, int out_size, void* d_ws, size_t ws_size, hipStream_t stream) {
    static int grid = 0;
    if (grid == 0) {
        if (n_in != 27 || out_size != T * DM || ws_size < WS_END) { fprintf(stderr, "kernel_launch: unexpected shapes (n_in %d, out %d, ws %zu)\n", n_in, out_size, ws_size); grid = -1; return; }
        int dev = 0, cus = 0, per_cu = 0;
        (void)hipGetDevice(&dev); (void)hipDeviceGetAttribute(&cus, hipDeviceAttributeMultiprocessorCount, dev);
        if (hipFuncSetAttribute((const void*)hymba_fwd, hipFuncAttributeMaxDynamicSharedMemorySize, LDS_BYTES) != hipSuccess) { fprintf(stderr, "kernel_launch: hipFuncSetAttribute failed\n"); grid = -1; return; }
        if (hipOccupancyMaxActiveBlocksPerMultiprocessor(&per_cu, (const void*)hymba_fwd, 512, LDS_BYTES) != hipSuccess || per_cu < 1) { fprintf(stderr, "kernel_launch: occupancy query failed (%d)\n", per_cu); grid = -1; return; }
        (void)hipGetLastError();
        grid = cus;
        if (grid < 64) { fprintf(stderr, "kernel_launch: needs >= 64 CUs\n"); grid = -1; return; }
    }
    if (grid < 0) return;
    (void)hipMemsetAsync((char*)d_ws + WS_CTL, 0, 1 * MiB, stream);
    Params p{};
    for (int i = 0; i < 27; ++i) p.in[i] = d_in[i];
    p.out = (float*)d_out; p.ws = (unsigned char*)d_ws;
    void* args[] = {&p};
    hipError_t e = hipLaunchCooperativeKernel((const void*)hymba_fwd, dim3(grid), dim3(512), args, LDS_BYTES, stream);
    if (e != hipSuccess) fprintf(stderr, "kernel_launch: cooperative launch failed: %s (grid %d)\n", hipGetErrorString(e), grid);
}
```

```cpp
#include <hip/hip_runtime.h>
#include <hip/hip_cooperative_groups.h>
#include <cstdio>
#include <cstdint>
namespace cg = cooperative_groups;

#define LAS __attribute__((address_space(3)))
typedef unsigned short bf16_t;
typedef short bf16x8 __attribute__((ext_vector_type(8)));
typedef float f32x2 __attribute__((ext_vector_type(2)));
typedef float f32x4 __attribute__((ext_vector_type(4)));
typedef float f32x16 __attribute__((ext_vector_type(16)));
typedef unsigned u32x4 __attribute__((ext_vector_type(4)));
typedef unsigned u32x2 __attribute__((ext_vector_type(2)));

constexpr int BATCH = 4, SEQ = 4096, T = BATCH * SEQ, DM = 1024, DEPTH = 2;
constexpr int RW_IN = 896, IN_DIM = 2592, D_FF = 2816;
constexpr int NPROJ = 2816;
constexpr float NORM_EPS = 1e-6f;

constexpr size_t MiB = 1u << 20;
constexpr size_t WS_CTL = 0;
constexpr size_t WS_COSR = 1 * MiB, WS_SINR = 3 * MiB, WS_COSM = 5 * MiB, WS_SINM = 6 * MiB;
constexpr size_t WS_BS = 7 * MiB;
constexpr size_t WS_RPREV = 8 * MiB;
constexpr size_t WS_WIN = 12 * MiB;
constexpr size_t WS_WQ = WS_WIN + 5632 * 1024;
constexpr size_t WS_WKV = WS_WQ + 768 * 384 * 2;
constexpr size_t WS_WO = WS_WKV + 1024 * 256 * 2;
constexpr size_t WS_VFIRST = 21 * MiB;
constexpr size_t WS_VBUF = 29 * MiB;
constexpr size_t WS_GBUF = 37 * MiB;
constexpr size_t WS_X = 45 * MiB;
constexpr size_t WS_QN = WS_X, WS_KVN = WS_X + 12 * MiB;
constexpr size_t WS_KR = 253 * MiB;
constexpr size_t WS_PA = 77 * MiB;
constexpr size_t WS_YA = WS_PA, WS_YB = WS_PA + 16 * MiB;
constexpr size_t WS_PB = 109 * MiB;
constexpr size_t WS_PC = 141 * MiB;
constexpr size_t WS_ACT = 77 * MiB;
constexpr size_t WS_KN = 165 * MiB;
constexpr size_t WS_VT = 181 * MiB;
constexpr size_t WS_REC = 197 * MiB;
constexpr size_t WS_WGU = 197 * MiB, WS_WDN = 208 * MiB;
constexpr size_t WS_KVT = 245 * MiB;
constexpr size_t WS_END = 254 * MiB;

constexpr int LDS_BYTES = 131072 + 1024;

__device__ __forceinline__ int sgpr_opaque(int v) { asm volatile("" : "+s"(v)); return v; }
__device__ __forceinline__ int tid_opaque() { int t = __builtin_amdgcn_workitem_id_x(); asm volatile("" : "+v"(t)); return t; }
__device__ __forceinline__ unsigned cvt_pk_bf16(float lo, float hi) { unsigned r; asm volatile("v_cvt_pk_bf16_f32 %0, %1, %2" : "=v"(r) : "v"(lo), "v"(hi)); return r; }
__device__ __forceinline__ bf16_t f2bf(float f) { return (bf16_t)(cvt_pk_bf16(f, 0.f) & 0xffffu); }
__device__ __forceinline__ float bf2f(bf16_t v) { return __uint_as_float(((unsigned)v) << 16); }
__device__ __forceinline__ float bflo(unsigned u) { return __uint_as_float(u << 16); }
__device__ __forceinline__ float bfhi(unsigned u) { return __uint_as_float(u & 0xffff0000u); }
__device__ __forceinline__ float sigmoidf_(float x) { return __builtin_amdgcn_rcpf(1.f + __expf(-x)); }
template <int CTRL> __device__ __forceinline__ float dpp_mov(float x) { return __builtin_bit_cast(float, __builtin_amdgcn_mov_dpp(__builtin_bit_cast(int, x), CTRL, 0xf, 0xf, true)); }
__device__ __forceinline__ float allreduce16(float x) {
    x += dpp_mov<0xB1>(x); x += dpp_mov<0x4E>(x); x += dpp_mov<0x141>(x); x += dpp_mov<0x140>(x); return x;
}
__device__ __forceinline__ float wave_sum(float v) { v = allreduce16(v); v += __shfl_xor(v, 16); v += __shfl_xor(v, 32); return v; }
__device__ __forceinline__ int crow(int r, int hi) { return (r & 3) + 8 * (r >> 2) + 4 * hi; }
#define MFMA32(a, b, c) __builtin_amdgcn_mfma_f32_32x32x16_bf16((a), (b), (c), 0, 0, 0)

namespace pg8 {
#define PG8_LAS __attribute__((address_space(3)))
constexpr int BM = 256, BK = 64, HALF = 128, HTB = HALF * BK * 2, STAGE_BYTES = 8 * HTB, NXCD = 8, WGM = 8;
__host__ __device__ __forceinline__ int lds_byte(int r, int c) { const int st = (r >> 4) * 2 + (c >> 5), rr = r & 15, cc = c & 31, ob = rr * 64 + cc * 2; return st * 1024 + (ob ^ (((ob >> 9) & 1) << 5)); }
__host__ __device__ __forceinline__ void stage_rc(int b, int& R, int& C) { const int st = b / 1024, sb = b % 1024, swz = sb ^ (((sb >> 9) & 1) << 5); R = (st >> 1) * 16 + swz / 64; C = (st & 1) * 32 + (swz % 64) / 2; }
__host__ __device__ __forceinline__ int perm32(int rho) { const int n = rho >> 4, i = rho & 15; return 8 * (i >> 2) + 4 * n + (i & 3); }
struct Unit { int pm, pn; };
struct Gemm { const bf16_t* A; const bf16_t* Bt; int M, N, K; };
struct StaticOrder {
    int nM, nN, nwg, G, c;
    __host__ __device__ void init(int M, int N, int G_, int c_) { nM = M / BM; nN = N / BM; nwg = nM * nN; G = G_; c = c_; }
    __host__ __device__ bool next(int i, Unit& u) const {
        const long L = (long)i * G + c; if (L >= nwg) return false;
        int wgid = (int)L; { const int q = nwg / NXCD, r = nwg % NXCD, xcd = wgid % NXCD, off = wgid / NXCD; wgid = (xcd < r ? xcd * (q + 1) : r * (q + 1) + (xcd - r) * q) + off; }
        const int nig = WGM * nN, gid = wgid / nig, fm = gid * WGM, gsz = (nM - fm) < WGM ? (nM - fm) : WGM;
        u.pm = fm + ((wgid % nig) % gsz); u.pn = (wgid % nig) / gsz; return true;
    }
    __device__ __forceinline__ void a_ready(const Unit&) const {}
    __device__ __forceinline__ void done(const Unit&) const {}
};

template <class Epi, class Sched, bool ALIGN_EPI = false, bool SP2 = false>
__device__ __forceinline__ void gemm_phase(PG8_LAS unsigned char* lds, const Gemm g, const Sched& S, const Epi& E) {
    const int tid = tid_opaque(), wid = __builtin_amdgcn_readfirstlane(tid >> 6), lane = tid & 63, wr = wid >> 2, wc = wid & 3, fr = lane & 15, fq = lane >> 4;
    const int K = g.K, nt = K / BK;
    unsigned voffA[2], voffB[2];
#pragma unroll
    for (int i = 0; i < 2; ++i) { int R, C; stage_rc(tid * 16 + i * 8192, R, C); const int Rb = Epi::PERM ? ((R & ~31) + perm32(R & 31)) : R;
        voffA[i] = (unsigned)(R * K + C) * 2u; voffB[i] = (unsigned)(Rb * K + C) * 2u; }
    const size_t kstep = (size_t)(BK * 2);
    const size_t hstep = (size_t)HALF * K * 2;
    const size_t tstep = 2 * hstep;
    const unsigned ldsw = (unsigned)wid * 1024u;
    const int aoff = lds_byte(wr * 64 + fr, fq * 8), boff = lds_byte(wc * 32 + fr, fq * 8);
#define PG8_SA(b, h) (((b) * 2 + (h)) * HTB)
#define PG8_SB(b, h) ((4 + (b) * 2 + (h)) * HTB)
#define PG8_STAGE(bufoff, gbase, voff) do { _Pragma("unroll") for (int _i = 0; _i < 2; ++_i) \
        __builtin_amdgcn_global_load_lds((const unsigned*)((const char*)(gbase) + (voff)[_i]), (PG8_LAS unsigned*)(lds + (bufoff) + ldsw + _i * 8192), 16, 0, 0); } while (0)
#define PG8_LDA(dst, b, h) do { _Pragma("unroll") for (int m = 0; m < 4; ++m) _Pragma("unroll") for (int k = 0; k < 2; ++k) dst[m][k] = *(const PG8_LAS bf16x8*)(lds + PG8_SA(b, h) + aoff + m * 2048 + k * 1024); } while (0)
#define PG8_LDB(dst, b, h) do { _Pragma("unroll") for (int n = 0; n < 2; ++n) _Pragma("unroll") for (int k = 0; k < 2; ++k) dst[n][k] = *(const PG8_LAS bf16x8*)(lds + PG8_SB(b, h) + boff + n * 2048 + k * 1024); } while (0)
#define PG8_MMA(ai, bj, At, Bt) do { __builtin_amdgcn_s_setprio(1); _Pragma("unroll") for (int m = 0; m < 4; ++m) _Pragma("unroll") for (int n = 0; n < 2; ++n) _Pragma("unroll") for (int k = 0; k < 2; ++k) \
        acc[ai][bj][m][n] = __builtin_amdgcn_mfma_f32_16x16x32_bf16(Bt[n][k], At[m][k], acc[ai][bj][m][n], 0, 0, 0); __builtin_amdgcn_s_setprio(0); } while (0)
#define PG8_WAIT_V(n) asm volatile("s_waitcnt vmcnt(" #n ")" ::: "memory")
#define PG8_WAIT_L(n) asm volatile("s_waitcnt lgkmcnt(" #n ")" ::: "memory")
#define PG8_BAR __builtin_amdgcn_s_barrier()
#define PG8_SCHED __builtin_amdgcn_sched_barrier(0)
    Unit cur, nxt; int ui = 0;
    if (!S.next(0, cur)) return;
    f32x4 acc[2][2][4][2];
#pragma unroll
    for (int a = 0; a < 2; ++a)
#pragma unroll
        for (int b = 0; b < 2; ++b)
#pragma unroll
            for (int m = 0; m < 4; ++m)
#pragma unroll
                for (int n = 0; n < 2; ++n) acc[a][b][m][n] = (f32x4){0.f, 0.f, 0.f, 0.f};
    bf16x8 At[4][2], B0[2][2], B1[2][2];
    const char* cA = (const char*)g.A + (size_t)cur.pm * tstep; const char* cB = (const char*)g.Bt + (size_t)cur.pn * tstep;
    S.a_ready(cur);
    if constexpr (SP2) {
        PG8_STAGE(PG8_SB(0, 0), cB, voffB); PG8_STAGE(PG8_SB(0, 1), cB + hstep, voffB); PG8_STAGE(PG8_SA(0, 0), cA, voffA); PG8_STAGE(PG8_SA(0, 1), cA + hstep, voffA);
        if (wr == 1) PG8_BAR;
        PG8_WAIT_V(2); PG8_BAR;
        PG8_STAGE(PG8_SB(1, 0), cB + kstep, voffB); PG8_STAGE(PG8_SA(1, 0), cA + kstep, voffA); PG8_STAGE(PG8_SB(1, 1), cB + hstep + kstep, voffB);
        PG8_WAIT_V(6); PG8_BAR;
    } else {
        PG8_STAGE(PG8_SB(0, 0), cB, voffB); PG8_STAGE(PG8_SA(0, 0), cA, voffA); PG8_STAGE(PG8_SB(0, 1), cB + hstep, voffB); PG8_STAGE(PG8_SA(0, 1), cA + hstep, voffA);
        if (wr == 1) PG8_BAR;
        PG8_WAIT_V(4); PG8_BAR;
        PG8_STAGE(PG8_SB(1, 0), cB + kstep, voffB); PG8_STAGE(PG8_SA(1, 0), cA + kstep, voffA); PG8_STAGE(PG8_SB(1, 1), cB + hstep + kstep, voffB);
        PG8_WAIT_V(6); PG8_BAR;
    }
    for (;;) {
        const bool has_next = S.next(ui + 1, nxt);
        const char* nA = has_next ? (const char*)g.A + (size_t)nxt.pm * tstep : cA; const char* nB = has_next ? (const char*)g.Bt + (size_t)nxt.pn * tstep : cB;
        for (int t = 0; t < nt; t += 2) {
            const bool last = (t == nt - 2);
            const char* a1 = cA + (size_t)(t + 1) * kstep;
            const char* a2 = last ? nA : cA + (size_t)(t + 2) * kstep; const char* b2 = last ? nB : cB + (size_t)(t + 2) * kstep;
            const char* a3 = a2 + kstep; const char* b3 = b2 + kstep;
            if (last && has_next) S.a_ready(nxt);
            if constexpr (SP2) {
            PG8_LDB(B0, 0, 0); PG8_LDB(B1, 0, 1); PG8_SCHED; PG8_LDA(At, 0, 0); PG8_STAGE(PG8_SA(1, 1), a1 + hstep, voffA);
            PG8_WAIT_V(8); PG8_WAIT_L(0); PG8_BAR; PG8_MMA(0, 0, At, B0); PG8_MMA(0, 1, At, B1); PG8_BAR; PG8_SCHED;
            PG8_LDA(At, 0, 1); PG8_STAGE(PG8_SB(0, 0), b2, voffB); PG8_STAGE(PG8_SB(0, 1), b2 + hstep, voffB); PG8_STAGE(PG8_SA(0, 0), a2, voffA);
            PG8_WAIT_V(8); PG8_WAIT_L(0); PG8_BAR; PG8_MMA(1, 0, At, B0); PG8_MMA(1, 1, At, B1); PG8_BAR; PG8_SCHED;
            PG8_LDB(B0, 1, 0); PG8_LDB(B1, 1, 1); PG8_SCHED; PG8_LDA(At, 1, 0); PG8_STAGE(PG8_SA(0, 1), a2 + hstep, voffA);
            PG8_WAIT_V(8); PG8_WAIT_L(0); PG8_BAR; PG8_MMA(0, 0, At, B0); PG8_MMA(0, 1, At, B1); PG8_BAR; PG8_SCHED;
            PG8_LDA(At, 1, 1); PG8_STAGE(PG8_SB(1, 0), b3, voffB); PG8_STAGE(PG8_SB(1, 1), b3 + hstep, voffB); PG8_STAGE(PG8_SA(1, 0), a3, voffA);
            PG8_WAIT_V(8); PG8_WAIT_L(0); PG8_BAR; PG8_MMA(1, 0, At, B0); PG8_MMA(1, 1, At, B1); PG8_BAR; PG8_SCHED;
            } else {
            PG8_LDB(B0, 0, 0); PG8_SCHED; PG8_LDA(At, 0, 0); PG8_STAGE(PG8_SA(1, 1), a1 + hstep, voffA);
            PG8_WAIT_L(8); PG8_BAR; PG8_WAIT_L(0); PG8_MMA(0, 0, At, B0); PG8_BAR; PG8_SCHED;
            PG8_LDB(B1, 0, 1); PG8_STAGE(PG8_SB(0, 0), b2, voffB);
            PG8_BAR; PG8_WAIT_L(0); PG8_MMA(0, 1, At, B1); PG8_BAR;
            PG8_LDA(At, 0, 1); PG8_STAGE(PG8_SA(0, 0), a2, voffA);
            PG8_BAR; PG8_WAIT_L(0); PG8_MMA(1, 0, At, B0); PG8_BAR; PG8_SCHED;
            PG8_STAGE(PG8_SB(0, 1), b2 + hstep, voffB);
            PG8_WAIT_V(6); PG8_BAR; PG8_MMA(1, 1, At, B1); PG8_BAR;
            PG8_LDB(B0, 1, 0); PG8_SCHED; PG8_LDA(At, 1, 0); PG8_STAGE(PG8_SA(0, 1), a2 + hstep, voffA);
            PG8_WAIT_L(8); PG8_BAR; PG8_WAIT_L(0); PG8_MMA(0, 0, At, B0); PG8_BAR; PG8_SCHED;
            PG8_LDB(B1, 1, 1); PG8_STAGE(PG8_SB(1, 0), b3, voffB);
            PG8_BAR; PG8_WAIT_L(0); PG8_MMA(0, 1, At, B1); PG8_BAR;
            PG8_LDA(At, 1, 1); PG8_STAGE(PG8_SA(1, 0), a3, voffA);
            PG8_BAR; PG8_WAIT_L(0); PG8_MMA(1, 0, At, B0); PG8_BAR; PG8_SCHED;
            PG8_STAGE(PG8_SB(1, 1), b3 + hstep, voffB);
            PG8_WAIT_V(6); PG8_BAR; PG8_MMA(1, 1, At, B1); PG8_BAR;
            }
        }
        if constexpr (ALIGN_EPI) { if (wr == 0) PG8_BAR; }
        E(acc, cur, wr, wc, fr, fq); S.done(cur);
        if (!has_next) break;
#pragma unroll
        for (int a = 0; a < 2; ++a)
#pragma unroll
            for (int b = 0; b < 2; ++b)
#pragma unroll
                for (int m = 0; m < 4; ++m)
#pragma unroll
                    for (int n = 0; n < 2; ++n) acc[a][b][m][n] = (f32x4){0.f, 0.f, 0.f, 0.f};
        cur = nxt; cA = nA; cB = nB; ++ui;
        if constexpr (ALIGN_EPI) { if (wr == 1) PG8_BAR; }
    }
    PG8_WAIT_V(0);
    if constexpr (!ALIGN_EPI) { if (wr == 0) PG8_BAR; }
    PG8_BAR;
#undef PG8_SA
#undef PG8_SB
#undef PG8_STAGE
#undef PG8_LDA
#undef PG8_LDB
#undef PG8_MMA
#undef PG8_WAIT_V
#undef PG8_WAIT_L
#undef PG8_BAR
#undef PG8_SCHED
}

__device__ __forceinline__ u32x4 pack8(const f32x4 v0, const f32x4 v1) { u32x4 w; w.x = cvt_pk_bf16(v0[0], v0[1]); w.y = cvt_pk_bf16(v0[2], v0[3]); w.z = cvt_pk_bf16(v1[0], v1[1]); w.w = cvt_pk_bf16(v1[2], v1[3]); return w; }

struct EpiProj {
    static constexpr bool PERM = true;
    bf16_t *pa, *pb, *pc;
    __device__ __forceinline__ void operator()(const f32x4 (&acc)[2][2][4][2], const Unit& u, int wr, int wc, int fr, int fq) const {
        bf16_t* base; int ldc, colt;
        if (u.pn < 4) { base = pa; ldc = 1024; colt = u.pn * 256; } else if (u.pn < 8) { base = pb; ldc = 1024; colt = (u.pn - 4) * 256; } else { base = pc; ldc = 768; colt = (u.pn - 8) * 256; }
        const int row0 = u.pm * BM + wr * 64 + fr, col0 = colt + wc * 32 + 8 * fq;
#pragma unroll
        for (int ai = 0; ai < 2; ++ai)
#pragma unroll
            for (int m = 0; m < 4; ++m) { bf16_t* rowp = base + (size_t)(row0 + ai * HALF + m * 16) * ldc + col0;
#pragma unroll
                for (int bj = 0; bj < 2; ++bj) *(u32x4*)(rowp + bj * HALF) = pack8(acc[ai][bj][m][0], acc[ai][bj][m][1]); }
    }
};
struct EpiPlain {
    static constexpr bool PERM = true;
    bf16_t* O; int ldc;
    __device__ __forceinline__ void operator()(const f32x4 (&acc)[2][2][4][2], const Unit& u, int wr, int wc, int fr, int fq) const {
        const int row0 = u.pm * BM + wr * 64 + fr, col0 = u.pn * BM + wc * 32 + 8 * fq;
#pragma unroll
        for (int ai = 0; ai < 2; ++ai)
#pragma unroll
            for (int m = 0; m < 4; ++m) { bf16_t* rowp = O + (size_t)(row0 + ai * HALF + m * 16) * ldc + col0;
#pragma unroll
                for (int bj = 0; bj < 2; ++bj) *(u32x4*)(rowp + bj * HALF) = pack8(acc[ai][bj][m][0], acc[ai][bj][m][1]); }
    }
};
struct EpiRes {
    static constexpr bool PERM = false;
    const float* base; float* out;
    __device__ __forceinline__ void operator()(const f32x4 (&acc)[2][2][4][2], const Unit& u, int wr, int wc, int fr, int fq) const {
        const int row0 = u.pm * BM + wr * 64 + fr, col0 = u.pn * BM + wc * 32 + 4 * fq;
#pragma unroll
        for (int ai = 0; ai < 2; ++ai)
#pragma unroll
            for (int m = 0; m < 4; ++m) { const size_t off = (size_t)(row0 + ai * HALF + m * 16) * 1024 + col0;
#pragma unroll
                for (int bj = 0; bj < 2; ++bj)
#pragma unroll
                    for (int n = 0; n < 2; ++n) { const f32x4 bs = *(const f32x4*)(base + off + bj * HALF + n * 16); *(f32x4*)(out + off + bj * HALF + n * 16) = bs + acc[ai][bj][m][n]; } }
    }
};
struct EpiSwiGLU {
    static constexpr bool PERM = true;
    bf16_t* act;
    __device__ __forceinline__ void operator()(const f32x4 (&acc)[2][2][4][2], const Unit& u, int wr, int wc, int fr, int fq) const {
        const int row0 = u.pm * BM + wr * 64 + fr, col0 = u.pn * 128 + wc * 32 + 8 * fq;
#pragma unroll
        for (int ai = 0; ai < 2; ++ai)
#pragma unroll
            for (int m = 0; m < 4; ++m) { f32x4 o[2];
#pragma unroll
                for (int n = 0; n < 2; ++n)
#pragma unroll
                    for (int i = 0; i < 4; ++i) { const float gt = acc[ai][0][m][n][i], up = acc[ai][1][m][n][i]; o[n][i] = gt * up * __builtin_amdgcn_rcpf(1.f + __expf(-gt)); }
                *(u32x4*)(act + (size_t)(row0 + ai * HALF + m * 16) * D_FF + col0) = pack8(o[0], o[1]); }
    }
};
}

struct Params { const void* in[27]; float* out; unsigned char* ws; };
enum { I_X = 0, I_POS, I_ATTN_NORM, I_W_IN, I_W_OUT, I_MU, I_W0, I_W2, I_A0, I_A2, I_G2, I_KK, I_KA, I_RK, I_GNW, I_GNB, I_V0, I_V1, I_V2,
       I_QNORM, I_KVNORM, I_WQUP, I_WKVUP, I_FFN_NORM, I_WGU, I_WDN, I_FINAL };

__device__ __forceinline__ void transpose_item(const float* W, int K, int N, bf16_t* WT, int mode, LAS float* scr, int item, int lane) {
    const int nblk = N / 32, kb = item / nblk, nb = item % nblk, k0 = 64 * kb, n0 = 32 * nb;
    int d0 = n0;
    if (mode == 1) d0 = (n0 < 896) ? n0 : n0 + 128;
    else if (mode == 2) { const int j = (n0 < D_FF) ? n0 : n0 - D_FF; d0 = 256 * (j >> 7) + (j & 127) + ((n0 < D_FF) ? 0 : 128); }
    float wv[32];
#pragma unroll
    for (int i = 0; i < 32; ++i) wv[i] = W[(size_t)(k0 + 2 * i + (lane >> 5)) * N + n0 + (lane & 31)];
#pragma unroll
    for (int i = 0; i < 32; ++i) scr[(2 * i + (lane >> 5)) * 33 + (lane & 31)] = wv[i];
    asm volatile("s_waitcnt lgkmcnt(0)" ::: "memory");
    const int c = lane & 7;
#pragma unroll
    for (int j = 0; j < 4; ++j) { const int n = (lane >> 3) + 8 * j; const LAS float* s = scr + (8 * c) * 33 + n;
        u32x4 o; o.x = cvt_pk_bf16(s[0 * 33], s[1 * 33]); o.y = cvt_pk_bf16(s[2 * 33], s[3 * 33]); o.z = cvt_pk_bf16(s[4 * 33], s[5 * 33]); o.w = cvt_pk_bf16(s[6 * 33], s[7 * 33]);
        *(u32x4*)(WT + (size_t)(d0 + n) * K + k0 + 8 * c) = o; }
    asm volatile("s_waitcnt lgkmcnt(0)" ::: "memory");
}

__device__ __forceinline__ void rms_rows2_bf16(const float* __restrict__ x0row, const float* __restrict__ x1row, const float* __restrict__ g, bf16_t* __restrict__ o0row, bf16_t* __restrict__ o1row, int lane) {
    const f32x4* xa = (const f32x4*)x0row + lane; const f32x4* xb = (const f32x4*)x1row + lane; const f32x4* gr = (const f32x4*)g + lane;
    f32x4 va[4], vb[4]; float sa = 0.f, sb = 0.f;
#pragma unroll
    for (int j = 0; j < 4; ++j) { va[j] = xa[64 * j]; vb[j] = xb[64 * j]; }
#pragma unroll
    for (int j = 0; j < 4; ++j) { sa += (va[j].x * va[j].x + va[j].y * va[j].y) + (va[j].z * va[j].z + va[j].w * va[j].w); sb += (vb[j].x * vb[j].x + vb[j].y * vb[j].y) + (vb[j].z * vb[j].z + vb[j].w * vb[j].w); }
    const float ra = rsqrtf(wave_sum(sa) * (1.f / 1024.f) + NORM_EPS), rb = rsqrtf(wave_sum(sb) * (1.f / 1024.f) + NORM_EPS);
    u32x2* oa = (u32x2*)o0row + lane; u32x2* ob = (u32x2*)o1row + lane;
#pragma unroll
    for (int j = 0; j < 4; ++j) { const f32x4 gg = gr[64 * j]; u32x2 w;
        w.x = cvt_pk_bf16(va[j].x * ra * gg.x, va[j].y * ra * gg.y); w.y = cvt_pk_bf16(va[j].z * ra * gg.z, va[j].w * ra * gg.w); oa[64 * j] = w;
        w.x = cvt_pk_bf16(vb[j].x * rb * gg.x, vb[j].y * rb * gg.y); w.y = cvt_pk_bf16(vb[j].z * rb * gg.z, vb[j].w * rb * gg.w); ob[64 * j] = w; }
}
__device__ __forceinline__ void rms_row_bf16(const float* xrow, const float* g, bf16_t* orow, int lane) {
    const f32x4* xr = (const f32x4*)xrow + lane; const f32x4* gr = (const f32x4*)g + lane;
    f32x4 v[4]; float s = 0.f;
#pragma unroll
    for (int j = 0; j < 4; ++j) { v[j] = xr[64 * j]; s += (v[j].x * v[j].x + v[j].y * v[j].y) + (v[j].z * v[j].z + v[j].w * v[j].w); }
    const float rstd = rsqrtf(wave_sum(s) * (1.f / 1024.f) + NORM_EPS);
    u32x2* o8 = (u32x2*)orow + lane;
#pragma unroll
    for (int j = 0; j < 4; ++j) { const f32x4 gg = gr[64 * j]; u32x2 w; w.x = cvt_pk_bf16(v[j].x * rstd * gg.x, v[j].y * rstd * gg.y); w.y = cvt_pk_bf16(v[j].z * rstd * gg.z, v[j].w * rstd * gg.w); o8[64 * j] = w; }
}

constexpr int KROW = 104, VROW = 72;
constexpr int ATT_KB = 64 * KROW * 2, ATT_VB = 64 * VROW * 2;
constexpr int ATT_SCR = 2 * (ATT_KB + ATT_VB);

__device__ __forceinline__ void att_unit(LAS unsigned char* lds, int b, int h, int qb, const bf16_t* __restrict__ q, const bf16_t* __restrict__ kvb, const bf16_t* __restrict__ kr,
                                         const float* __restrict__ cosM, const float* __restrict__ sinM, bf16_t* __restrict__ mix) {
    const int tid = tid_opaque(), lane = tid & 63, w = tid >> 6, r32 = lane & 31, hi = lane >> 5;
    LAS float* scr = (LAS float*)(lds + ATT_SCR) + w * 32;
    const int qrow = qb * 256 + w * 32 + r32; const size_t tok = (size_t)b * SEQ + qrow;
    bf16x8 qf[6];
    {
        const bf16_t* qp = q + tok * 768 + h * 96 + hi * 8;
#pragma unroll
        for (int d0 = 0; d0 < 4; ++d0) qf[d0] = *(const bf16x8*)(qp + d0 * 16);
        const u32x4 x1 = *(const u32x4*)(qp + 64), x2 = *(const u32x4*)(qp + 80);
        const f32x4 c0 = *(const f32x4*)(cosM + tok * 16 + hi * 8), c1 = *(const f32x4*)(cosM + tok * 16 + hi * 8 + 4);
        const f32x4 s0 = *(const f32x4*)(sinM + tok * 16 + hi * 8), s1 = *(const f32x4*)(sinM + tok * 16 + hi * 8 + 4);
        float a[8], bb[8], cs[8] = {c0.x, c0.y, c0.z, c0.w, c1.x, c1.y, c1.z, c1.w}, sn[8] = {s0.x, s0.y, s0.z, s0.w, s1.x, s1.y, s1.z, s1.w};
#pragma unroll
        for (int j = 0; j < 4; ++j) { a[2 * j] = bflo(x1[j]); a[2 * j + 1] = bfhi(x1[j]); bb[2 * j] = bflo(x2[j]); bb[2 * j + 1] = bfhi(x2[j]); }
        u32x4 o1, o2;
#pragma unroll
        for (int j = 0; j < 4; ++j) {
            o1[j] = cvt_pk_bf16(a[2 * j] * cs[2 * j] - bb[2 * j] * sn[2 * j], a[2 * j + 1] * cs[2 * j + 1] - bb[2 * j + 1] * sn[2 * j + 1]);
            o2[j] = cvt_pk_bf16(bb[2 * j] * cs[2 * j] + a[2 * j] * sn[2 * j], bb[2 * j + 1] * cs[2 * j + 1] + a[2 * j + 1] * sn[2 * j + 1]); }
        qf[4] = __builtin_bit_cast(bf16x8, o1); qf[5] = __builtin_bit_cast(bf16x8, o2);
    }
    const int k_key = tid >> 3, k_ch = tid & 7;
    const int r_key = (tid & 255) >> 2, r_ch = tid & 3;
    const bf16_t* kn_src = kvb + ((size_t)b * SEQ + k_key) * 1024 + h * 128 + k_ch * 8;
    const bf16_t* kr_src = kr + ((size_t)b * SEQ + r_key) * 32 + r_ch * 8;
    const int kn_dst = (k_key * KROW + k_ch * 8) * 2, kr_dst = (r_key * KROW + 64 + r_ch * 8) * 2, vt_dst = (k_ch * 8 * VROW + k_key) * 2;
#define ATT_VWRITE(bufoff, gv) do { LAS bf16_t* vd_ = (LAS bf16_t*)(lds + 2 * ATT_KB + (bufoff) + vt_dst); _Pragma("unroll") for (int j_ = 0; j_ < 4; ++j_) { \
        vd_[(2 * j_) * VROW] = (bf16_t)((gv)[j_] & 0xffffu); vd_[(2 * j_ + 1) * VROW] = (bf16_t)((gv)[j_] >> 16); } } while (0)
    const int ntiles = 4 * qb + 4;
    u32x4 gk, gr, gv;
    gk = *(const u32x4*)kn_src; gv = *(const u32x4*)(kn_src + 64); if (tid < 256) gr = *(const u32x4*)kr_src;
    *(LAS u32x4*)(lds + kn_dst) = gk; ATT_VWRITE(0, gv); if (tid < 256) *(LAS u32x4*)(lds + kr_dst) = gr;
    __syncthreads();
    f32x16 o0, o1;
#pragma unroll
    for (int r = 0; r < 16; ++r) { o0[r] = 0.f; o1[r] = 0.f; }
    float mrow = -1e30f, lrow = 0.f;
    const float SC = 0.10206207261596577f * 1.4426950408889634f;
    const int wq0 = qb * 256 + w * 32;
    for (int kt = 0; kt < ntiles; ++kt) {
        const int cur = kt & 1;
        if (kt + 1 < ntiles) { const size_t ko = (size_t)(kt + 1) * 64; gk = *(const u32x4*)(kn_src + ko * 1024); gv = *(const u32x4*)(kn_src + ko * 1024 + 64); if (tid < 256) gr = *(const u32x4*)(kr_src + ko * 32); }
        const int k0 = kt * 64;
        if (k0 <= wq0 + 31) {
            const LAS unsigned char* Kb = lds + cur * ATT_KB; const LAS unsigned char* Vb = lds + 2 * ATT_KB + cur * ATT_VB;
            f32x16 p0, p1;
#pragma unroll
            for (int r = 0; r < 16; ++r) { p0[r] = 0.f; p1[r] = 0.f; }
#pragma unroll
            for (int d0 = 0; d0 < 6; ++d0) {
                const bf16x8 k0f = *(const LAS bf16x8*)(Kb + (r32 * KROW + d0 * 16 + hi * 8) * 2);
                const bf16x8 k1f = *(const LAS bf16x8*)(Kb + ((32 + r32) * KROW + d0 * 16 + hi * 8) * 2);
                p0 = MFMA32(k0f, qf[d0], p0); p1 = MFMA32(k1f, qf[d0], p1);
            }
            const bool need_mask = (k0 + 63 > wq0);
            float mx = -1e30f;
            if (need_mask) {
#pragma unroll
                for (int r = 0; r < 16; ++r) { const int key = k0 + crow(r, hi); if (key > qrow) p0[r] = -1e30f; if (key + 32 > qrow) p1[r] = -1e30f; }
            }
#pragma unroll
            for (int r = 0; r < 16; ++r) mx = fmaxf(mx, fmaxf(p0[r], p1[r]));
            mx = fmaxf(mx, __shfl_xor(mx, 32)) * SC;
            const bool grew = __any(mx > mrow + 8.f);
            const float mnew = grew ? fmaxf(mrow, mx) : mrow;
            const float alpha = __builtin_amdgcn_exp2f(mrow - mnew); mrow = mnew;
            float ls = 0.f;
#pragma unroll
            for (int r = 0; r < 16; ++r) { p0[r] = __builtin_amdgcn_exp2f(__builtin_fmaf(p0[r], SC, -mnew)); p1[r] = __builtin_amdgcn_exp2f(__builtin_fmaf(p1[r], SC, -mnew)); ls += p0[r] + p1[r]; }
            lrow = lrow * alpha + ls;
            if (grew) {
                if (hi == 0) scr[r32] = alpha;
                asm volatile("s_waitcnt lgkmcnt(0)" ::: "memory");
#pragma unroll
                for (int i = 0; i < 4; ++i) { const f32x4 al = *(const LAS f32x4*)(scr + 8 * i + 4 * hi);
#pragma unroll
                    for (int j = 0; j < 4; ++j) { o0[4 * i + j] *= al[j]; o1[4 * i + j] *= al[j]; } }
                asm volatile("s_waitcnt lgkmcnt(0)" ::: "memory");
            }
#pragma unroll
            for (int s = 0; s < 4; ++s) {
                u32x4 pw;
#pragma unroll
                for (int j = 0; j < 4; ++j) pw[j] = (s < 2) ? cvt_pk_bf16(p0[8 * (s & 1) + 2 * j], p0[8 * (s & 1) + 2 * j + 1]) : cvt_pk_bf16(p1[8 * (s & 1) + 2 * j], p1[8 * (s & 1) + 2 * j + 1]);
                const bf16x8 pa = __builtin_bit_cast(bf16x8, pw);
#pragma unroll
                for (int dvh = 0; dvh < 2; ++dvh) {
                    const LAS unsigned char* vp = Vb + ((dvh * 32 + r32) * VROW + 16 * s + 4 * hi) * 2;
                    const u32x2 lo = *(const LAS u32x2*)vp, hh = *(const LAS u32x2*)(vp + 16);
                    u32x4 vv; vv.x = lo.x; vv.y = lo.y; vv.z = hh.x; vv.w = hh.y;
                    if (dvh == 0) o0 = MFMA32(pa, __builtin_bit_cast(bf16x8, vv), o0); else o1 = MFMA32(pa, __builtin_bit_cast(bf16x8, vv), o1);
                }
            }
        }
        if (kt + 1 < ntiles) { const int nx = cur ^ 1; *(LAS u32x4*)(lds + nx * ATT_KB + kn_dst) = gk; ATT_VWRITE(nx * ATT_VB, gv); if (tid < 256) *(LAS u32x4*)(lds + nx * ATT_KB + kr_dst) = gr; }
        __syncthreads();
    }
    float lt = lrow + __shfl_xor(lrow, 32);
    if (hi == 0) scr[r32] = 1.f / lt;
    asm volatile("s_waitcnt lgkmcnt(0)" ::: "memory");
#pragma unroll
    for (int i = 0; i < 4; ++i) { const f32x4 il = *(const LAS f32x4*)(scr + 8 * i + 4 * hi);
#pragma unroll
        for (int j = 0; j < 4; ++j) { const int r = 4 * i + j; const size_t orow = (size_t)b * SEQ + qb * 256 + w * 32 + crow(r, hi);
            mix[orow * 1024 + 512 + h * 64 + r32] = f2bf(o0[r] * il[j]); mix[orow * 1024 + 512 + h * 64 + 32 + r32] = f2bf(o1[r] * il[j]); } }
    asm volatile("s_waitcnt lgkmcnt(0)" ::: "memory");
}

__device__ __forceinline__ void ret_unit(LAS unsigned char* lds, int b, int h, int jb, const bf16_t* __restrict__ pb, const float* __restrict__ cosR, const float* __restrict__ sinR,
                                         const bf16_t* __restrict__ rprev, float* __restrict__ yb) {
    const int tid = tid_opaque(), lane = tid & 63, w = tid >> 6, r32 = lane & 31, hi = lane >> 5;
    const float lg2 = log2f(1.f - exp2f(-5.f - (float)h));
    const int qrow = jb * 256 + w * 32 + r32; const size_t tok = (size_t)b * SEQ + qrow;
    const int chunk = qrow >> 7;
    bf16x8 qf[4], qx[4];
    {
        const bf16_t* qp = pb + tok * 1024 + h * 64 + hi * 8;
        const float qdec = exp2f(lg2 * (float)((qrow & 127) + 1));
#pragma unroll
        for (int d0 = 0; d0 < 2; ++d0) {
            const u32x4 x1 = *(const u32x4*)(qp + d0 * 16), x2 = *(const u32x4*)(qp + d0 * 16 + 32);
            const float* cp = cosR + tok * 32 + d0 * 16 + hi * 8; const float* sp = sinR + tok * 32 + d0 * 16 + hi * 8;
            const f32x4 c0 = *(const f32x4*)cp, c1 = *(const f32x4*)(cp + 4), s0 = *(const f32x4*)sp, s1 = *(const f32x4*)(sp + 4);
            const float cs[8] = {c0.x, c0.y, c0.z, c0.w, c1.x, c1.y, c1.z, c1.w}, sn[8] = {s0.x, s0.y, s0.z, s0.w, s1.x, s1.y, s1.z, s1.w};
            u32x4 o1, o2, y1, y2;
#pragma unroll
            for (int j = 0; j < 4; ++j) {
                const float a0 = bflo(x1[j]), a1 = bfhi(x1[j]), b0 = bflo(x2[j]), b1 = bfhi(x2[j]);
                const float r0 = a0 * cs[2 * j] - b0 * sn[2 * j], r1 = a1 * cs[2 * j + 1] - b1 * sn[2 * j + 1];
                const float t0 = b0 * cs[2 * j] + a0 * sn[2 * j], t1 = b1 * cs[2 * j + 1] + a1 * sn[2 * j + 1];
                o1[j] = cvt_pk_bf16(r0, r1); o2[j] = cvt_pk_bf16(t0, t1); y1[j] = cvt_pk_bf16(r0 * qdec, r1 * qdec); y2[j] = cvt_pk_bf16(t0 * qdec, t1 * qdec); }
            qf[d0] = __builtin_bit_cast(bf16x8, o1); qf[d0 + 2] = __builtin_bit_cast(bf16x8, o2); qx[d0] = __builtin_bit_cast(bf16x8, y1); qx[d0 + 2] = __builtin_bit_cast(bf16x8, y2);
        }
    }
    f32x16 o0, o1;
#pragma unroll
    for (int r = 0; r < 16; ++r) { o0[r] = 0.f; o1[r] = 0.f; }
    {
        const bf16_t* rp = rprev + ((size_t)((b * 4 + h) * 32 + chunk)) * 4096;
#pragma unroll
        for (int d0 = 0; d0 < 4; ++d0) {
            const bf16x8 r0 = *(const bf16x8*)(rp + (size_t)r32 * 64 + d0 * 16 + hi * 8), r1 = *(const bf16x8*)(rp + (size_t)(32 + r32) * 64 + d0 * 16 + hi * 8);
            o0 = MFMA32(qx[d0], r0, o0); o1 = MFMA32(qx[d0], r1, o1);
        }
    }
    const int l_key = (tid & 255) >> 2, l_c = tid & 3;
    for (int kt = 0; kt < 4; ++kt) {
        const int k0 = jb * 256 + kt * 64;
        __syncthreads();
        if (tid < 256) {
            const size_t kt_tok = (size_t)b * SEQ + k0 + l_key; const bf16_t* kp = pb + kt_tok * 1024 + 256 + h * 64 + l_c * 8;
            const u32x4 x1 = *(const u32x4*)kp, x2 = *(const u32x4*)(kp + 32);
            const float* cp = cosR + kt_tok * 32 + l_c * 8; const float* sp = sinR + kt_tok * 32 + l_c * 8;
            const f32x4 c0 = *(const f32x4*)cp, c1 = *(const f32x4*)(cp + 4), s0 = *(const f32x4*)sp, s1 = *(const f32x4*)(sp + 4);
            const float cs[8] = {c0.x, c0.y, c0.z, c0.w, c1.x, c1.y, c1.z, c1.w}, sn[8] = {s0.x, s0.y, s0.z, s0.w, s1.x, s1.y, s1.z, s1.w};
            u32x4 o1v, o2v;
#pragma unroll
            for (int j = 0; j < 4; ++j) {
                const float a0 = bflo(x1[j]), a1 = bfhi(x1[j]), b0 = bflo(x2[j]), b1 = bfhi(x2[j]);
                o1v[j] = cvt_pk_bf16((a0 * cs[2 * j] - b0 * sn[2 * j]) * 0.125f, (a1 * cs[2 * j + 1] - b1 * sn[2 * j + 1]) * 0.125f);
                o2v[j] = cvt_pk_bf16((b0 * cs[2 * j] + a0 * sn[2 * j]) * 0.125f, (b1 * cs[2 * j + 1] + a1 * sn[2 * j + 1]) * 0.125f); }
            *(LAS u32x4*)(lds + (l_key * KROW + l_c * 8) * 2) = o1v; *(LAS u32x4*)(lds + (l_key * KROW + 32 + l_c * 8) * 2) = o2v;
        } else {
            const size_t vt_tok = (size_t)b * SEQ + k0 + l_key; const bf16_t* vp = pb + vt_tok * 1024 + 512 + h * 64 + l_c * 16;
            const u32x4 x1 = *(const u32x4*)vp, x2 = *(const u32x4*)(vp + 8);
            LAS bf16_t* vd = (LAS bf16_t*)(lds + 2 * ATT_KB) + l_key;
#pragma unroll
            for (int j = 0; j < 4; ++j) { vd[(l_c * 16 + 2 * j) * VROW] = (bf16_t)(x1[j] & 0xffffu); vd[(l_c * 16 + 2 * j + 1) * VROW] = (bf16_t)(x1[j] >> 16);
                                          vd[(l_c * 16 + 8 + 2 * j) * VROW] = (bf16_t)(x2[j] & 0xffffu); vd[(l_c * 16 + 8 + 2 * j + 1) * VROW] = (bf16_t)(x2[j] >> 16); }
        }
        __syncthreads();
        if ((k0 >> 7) == chunk && k0 <= jb * 256 + w * 32 + 31) {
            const LAS unsigned char* Kb = lds; const LAS unsigned char* Vb = lds + 2 * ATT_KB;
            f32x16 p0, p1;
#pragma unroll
            for (int r = 0; r < 16; ++r) { p0[r] = 0.f; p1[r] = 0.f; }
#pragma unroll
            for (int d0 = 0; d0 < 4; ++d0) {
                const bf16x8 k0f = *(const LAS bf16x8*)(Kb + (r32 * KROW + d0 * 16 + hi * 8) * 2);
                const bf16x8 k1f = *(const LAS bf16x8*)(Kb + ((32 + r32) * KROW + d0 * 16 + hi * 8) * 2);
                p0 = MFMA32(k0f, qf[d0], p0); p1 = MFMA32(k1f, qf[d0], p1);
            }
#pragma unroll
            for (int r = 0; r < 16; ++r) {
                const int df0 = qrow - (k0 + crow(r, hi)), df1 = df0 - 32;
                p0[r] = (df0 >= 0) ? p0[r] * __builtin_amdgcn_exp2f(lg2 * (float)df0) : 0.f;
                p1[r] = (df1 >= 0) ? p1[r] * __builtin_amdgcn_exp2f(lg2 * (float)df1) : 0.f;
            }
#pragma unroll
            for (int s = 0; s < 4; ++s) {
                u32x4 pw;
#pragma unroll
                for (int j = 0; j < 4; ++j) pw[j] = (s < 2) ? cvt_pk_bf16(p0[8 * (s & 1) + 2 * j], p0[8 * (s & 1) + 2 * j + 1]) : cvt_pk_bf16(p1[8 * (s & 1) + 2 * j], p1[8 * (s & 1) + 2 * j + 1]);
                const bf16x8 pa = __builtin_bit_cast(bf16x8, pw);
#pragma unroll
                for (int dvh = 0; dvh < 2; ++dvh) {
                    const LAS unsigned char* vp = Vb + ((dvh * 32 + r32) * VROW + 16 * s + 4 * hi) * 2;
                    const u32x2 lo = *(const LAS u32x2*)vp, hh = *(const LAS u32x2*)(vp + 16);
                    u32x4 vv; vv.x = lo.x; vv.y = lo.y; vv.z = hh.x; vv.w = hh.y;
                    if (dvh == 0) o0 = MFMA32(pa, __builtin_bit_cast(bf16x8, vv), o0); else o1 = MFMA32(pa, __builtin_bit_cast(bf16x8, vv), o1);
                }
            }
        }
    }
#pragma unroll
    for (int r = 0; r < 16; ++r) { const size_t orow = (size_t)b * SEQ + jb * 256 + w * 32 + crow(r, hi);
        yb[orow * 256 + h * 64 + r32] = o0[r]; yb[orow * 256 + h * 64 + 32 + r32] = o1[r]; }
}

__device__ __forceinline__ void ret_kv_unit(LAS unsigned char* lds, int bh, int ci, const bf16_t* __restrict__ pb, const float* __restrict__ cosR, const float* __restrict__ sinR, float* __restrict__ kvt) {
    const int tid = tid_opaque(); const int b = bh >> 2, h = bh & 3;
    LAS float* Ks = (LAS float*)lds;
    LAS float* Vs = Ks + 128 * 64;
    const float lg2 = log2f(1.f - exp2f(-5.f - (float)h));
    __syncthreads();
    {
        const int i = tid & 31; float x1[8], x2[8], cc[8], ss[8];
#pragma unroll
        for (int it = 0; it < 8; ++it) { const int t = (tid >> 5) + 16 * it; const size_t tok = (size_t)b * SEQ + ci * 128 + t;
            x1[it] = bf2f(pb[tok * 1024 + 256 + h * 64 + i]); x2[it] = bf2f(pb[tok * 1024 + 256 + h * 64 + 32 + i]); cc[it] = cosR[tok * 32 + i]; ss[it] = sinR[tok * 32 + i]; }
#pragma unroll
        for (int it = 0; it < 8; ++it) { const int t = (tid >> 5) + 16 * it; const float sc = 0.125f * exp2f(lg2 * (float)(127 - t));
            Ks[t * 64 + i] = (x1[it] * cc[it] - x2[it] * ss[it]) * sc; Ks[t * 64 + 32 + i] = (x2[it] * cc[it] + x1[it] * ss[it]) * sc; }
        u32x4 vr[2];
#pragma unroll
        for (int it = 0; it < 2; ++it) { const int ch = tid + 512 * it, t = ch >> 3, c8 = ch & 7; vr[it] = *(const u32x4*)(pb + ((size_t)b * SEQ + ci * 128 + t) * 1024 + 512 + h * 64 + c8 * 8); }
#pragma unroll
        for (int it = 0; it < 2; ++it) { const int ch = tid + 512 * it, t = ch >> 3, c8 = ch & 7; LAS float* d = Vs + t * 64 + c8 * 8;
            *(LAS f32x4*)d = (f32x4){bflo(vr[it].x), bfhi(vr[it].x), bflo(vr[it].y), bfhi(vr[it].y)}; *(LAS f32x4*)(d + 4) = (f32x4){bflo(vr[it].z), bfhi(vr[it].z), bflo(vr[it].w), bfhi(vr[it].w)}; }
    }
    __syncthreads();
    const int e = tid >> 3, d0 = (tid & 7) * 8;
    float acc[8];
#pragma unroll
    for (int j = 0; j < 8; ++j) acc[j] = 0.f;
    for (int t = 0; t < 128; ++t) {
        const float v = Vs[t * 64 + e]; const f32x4 ka = *(const LAS f32x4*)(Ks + t * 64 + d0), kb = *(const LAS f32x4*)(Ks + t * 64 + d0 + 4);
        acc[0] += v * ka.x; acc[1] += v * ka.y; acc[2] += v * ka.z; acc[3] += v * ka.w; acc[4] += v * kb.x; acc[5] += v * kb.y; acc[6] += v * kb.z; acc[7] += v * kb.w;
    }
    float* o = kvt + ((size_t)(bh * 32 + ci)) * 4096 + e * 64 + d0;
    *(f32x4*)o = (f32x4){acc[0], acc[1], acc[2], acc[3]}; *(f32x4*)(o + 4) = (f32x4){acc[4], acc[5], acc[6], acc[7]};
}

struct PrepW { bf16x8 Bw[2], Ba[2], Bv[2], Bg[2][2], Bv1[2]; };
__device__ __forceinline__ bf16x8 pack_col8(const float* W, int ld, int k0, int n) {
    float t[8];
#pragma unroll
    for (int j = 0; j < 8; ++j) t[j] = W[(size_t)(k0 + j) * ld + n];
    u32x4 o; o.x = cvt_pk_bf16(t[0], t[1]); o.y = cvt_pk_bf16(t[2], t[3]); o.z = cvt_pk_bf16(t[4], t[5]); o.w = cvt_pk_bf16(t[6], t[7]);
    return __builtin_bit_cast(bf16x8, o);
}
__device__ __forceinline__ bf16x8 pack_f8(const f32x4 a, const f32x4 b) {
    u32x4 o; o.x = cvt_pk_bf16(a.x, a.y); o.y = cvt_pk_bf16(a.z, a.w); o.z = cvt_pk_bf16(b.x, b.y); o.w = cvt_pk_bf16(b.z, b.w);
    return __builtin_bit_cast(bf16x8, o);
}
#define MFMA16(a, b, c) __builtin_amdgcn_mfma_f32_16x16x32_bf16((a), (b), (c), 0, 0, 0)
__device__ __forceinline__ void prep_fetch_rows(unsigned (&raw)[17], const bf16_t* __restrict__ pa, int t0, int c2) {
    raw[0] = ((t0 & (SEQ - 1)) == 0) ? 0u : *(const unsigned*)(pa + (size_t)(t0 - 1) * 1024 + c2);
#pragma unroll
    for (int t = 0; t < 16; ++t) raw[t + 1] = *(const unsigned*)(pa + (size_t)(t0 + t) * 1024 + c2);
}
constexpr int PSW = 900;
struct PrepC { float mu0, mu1, w0c, a0c, kkc, kac, rkc, v0c; };
__device__ __forceinline__ void rwkv_prep_tile(LAS unsigned char* lds, int tile, int next_tile, unsigned (&raw)[17], const PrepC& PC, int layer, const Params& P, int z, const PrepW& W, const bf16_t* __restrict__ pa, unsigned char* __restrict__ rec,
                                               bf16_t* __restrict__ vbuf, bf16_t* __restrict__ gbuf, bf16_t* __restrict__ vfirst, float* __restrict__ bs, float* __restrict__ cs) {
    const int tid = tid_opaque(), lane = tid & 63;
    LAS float* PS = (LAS float*)lds;
    LAS float* VV = PS + 16 * PSW;
    const float* mu = (const float*)P.in[I_MU + z] + layer * RW_IN;
    const float* w0 = (const float*)P.in[I_W0 + z] + layer * 256; const float* w2 = (const float*)P.in[I_W2 + z] + layer * 32 * 256;
    const float* a0 = (const float*)P.in[I_A0 + z] + layer * 256; const float* a2 = (const float*)P.in[I_A2 + z] + layer * 32 * 256;
    const float* g2 = (const float*)P.in[I_G2 + z] + layer * 64 * 256;
    const float* k_k = (const float*)P.in[I_KK + z] + layer * 256; const float* k_a = (const float*)P.in[I_KA + z] + layer * 256; const float* r_k = (const float*)P.in[I_RK + z] + layer * 256;
    const float* v0 = (const float*)P.in[I_V0 + z] + (layer > 0 ? (layer - 1) * 256 : 0);
    const float* v1 = (const float*)P.in[I_V1 + z] + (layer > 0 ? (layer - 1) * 256 * 32 : 0);
    const float* v2 = (const float*)P.in[I_V2 + z] + (layer > 0 ? (layer - 1) * 32 * 256 : 0);
    const int t0 = tile * 16;
    __syncthreads();
    if (tid < 448) {
        const int c2 = tid * 2; const float mu0 = PC.mu0, mu1 = PC.mu1;
#pragma unroll
        for (int t = 0; t < 16; ++t) {
            float x0 = bflo(raw[t + 1]), x1 = bfhi(raw[t + 1]); const float y0 = bflo(raw[t]), y1 = bfhi(raw[t]);
            x0 = x0 + (y0 - x0) * mu0; x1 = x1 + (y1 - x1) * mu1;
            if (c2 >= 768) { if (c2 < 800) { x0 = 2.f * sigmoidf_(2.f * x0) - 1.f; x1 = 2.f * sigmoidf_(2.f * x1) - 1.f; } else if (c2 >= 832) { x0 = sigmoidf_(x0); x1 = sigmoidf_(x1); } }
            *(LAS f32x2*)(PS + t * PSW + c2) = (f32x2){x0, x1};
        }
        if (next_tile >= 0) prep_fetch_rows(raw, pa, next_tile * 16, c2);
    }
    if (layer > 0) VV[tid] = 0.f;
    __syncthreads();
    const int wv = tid >> 6, l16 = lane & 15, lq = lane >> 4;
    LAS float* LR = VV + 512;
    const f32x4 zero4 = {0.f, 0.f, 0.f, 0.f};
    if (layer > 0) {
        const LAS float* ap = PS + l16 * PSW + 512 + 32 * wv + 8 * lq;
        const bf16x8 A = pack_f8(*(const LAS f32x4*)ap, *(const LAS f32x4*)(ap + 4));
#pragma unroll
        for (int nt = 0; nt < 2; ++nt) { const f32x4 d = MFMA16(A, W.Bv1[nt], zero4);
#pragma unroll
            for (int r = 0; r < 4; ++r) (void)__builtin_amdgcn_ds_faddf(VV + (4 * lq + r) * 32 + 16 * nt + l16, d[r], 0, 0, false); }
        __syncthreads();
    }
    {
        const LAS float* ap = PS + l16 * PSW + 768 + 8 * lq;
        const bf16x8 Aw = pack_f8(*(const LAS f32x4*)ap, *(const LAS f32x4*)(ap + 4)), Aa = pack_f8(*(const LAS f32x4*)(ap + 32), *(const LAS f32x4*)(ap + 36));
        const bf16x8 Ag0 = pack_f8(*(const LAS f32x4*)(ap + 64), *(const LAS f32x4*)(ap + 68)), Ag1 = pack_f8(*(const LAS f32x4*)(ap + 96), *(const LAS f32x4*)(ap + 100));
        bf16x8 Av = Aw;
        if (layer > 0) { const LAS float* vp = VV + l16 * 32 + 8 * lq; Av = pack_f8(*(const LAS f32x4*)vp, *(const LAS f32x4*)(vp + 4)); }
#pragma unroll
        for (int nt = 0; nt < 2; ++nt) {
            const f32x4 dw = MFMA16(Aw, W.Bw[nt], zero4), da = MFMA16(Aa, W.Ba[nt], zero4);
            f32x4 dg = MFMA16(Ag0, W.Bg[nt][0], zero4); dg = MFMA16(Ag1, W.Bg[nt][1], dg);
            f32x4 dv = zero4; if (layer > 0) dv = MFMA16(Av, W.Bv[nt], zero4);
            const int ch = 16 * (2 * wv + nt) + l16;
#pragma unroll
            for (int r = 0; r < 4; ++r) { LAS float* o = LR + (4 * lq + r) * 256 + ch; o[0] = dw[r]; o[4096] = da[r]; o[8192] = dg[r]; o[12288] = dv[r]; }
        }
    }
    __syncthreads();
    const int c = tid & 255, th = tid >> 8;
    float aw[8], aa[8], ag[8], av[8];
#pragma unroll
    for (int i = 0; i < 8; ++i) { const LAS float* o = LR + (th * 8 + i) * 256 + c; aw[i] = o[0]; aa[i] = o[4096]; ag[i] = o[8192]; av[i] = o[12288]; }
    const float w0c = PC.w0c, a0c = PC.a0c, kkc = PC.kkc, kac = PC.kac, rkc = PC.rkc, v0c = PC.v0c;
    const int head = c >> 6, kq = (c & 63) >> 2, e = c & 3;
    float kk_[8], b_[8], kp_[8], dec_[8], r_[8], v_[8], a_[8], q_[8];
#pragma unroll
    for (int i = 0; i < 8; ++i) {
        const int t = th * 8 + i; const size_t tok = (size_t)t0 + t;
        const float r = PS[t * PSW + c], k = PS[t * PSW + 256 + c]; float v = PS[t * PSW + 512 + c];
        dec_[i] = __expf(-0.6065306597126334f * sigmoidf_(w0c + aw[i]));
        const float a = sigmoidf_(a0c + aa[i]);
        if (layer > 0) { const float vf = bf2f(vfirst[tok * 256 + c]); v = v + (vf - v) * sigmoidf_(v0c + av[i]); }
        else vfirst[tok * 256 + c] = f2bf(v);
        r_[i] = r; v_[i] = v; a_[i] = a; kk_[i] = k * kkc; kp_[i] = k * (1.f + (a - 1.f) * kac);
        q_[i] = kk_[i] * kk_[i];
    }
#pragma unroll
    for (int i = 0; i < 8; ++i) q_[i] = wave_sum(q_[i]);
#pragma unroll
    for (int i = 0; i < 8; ++i) { kk_[i] *= rsqrtf(fmaxf(q_[i], 1e-24f)); b_[i] = kk_[i] * a_[i]; q_[i] = r_[i] * kp_[i] * rkc; }
#pragma unroll
    for (int i = 0; i < 8; ++i) q_[i] = wave_sum(q_[i]);
    float d1_[4], d2_[4];
#pragma unroll
    for (int j = 0; j < 4; ++j) { d1_[j] = b_[2 * j] * kk_[2 * j + 1]; d2_[j] = kp_[2 * j] * kk_[2 * j + 1]; }
#pragma unroll
    for (int j = 0; j < 4; ++j) { d1_[j] = wave_sum(d1_[j]); d2_[j] = wave_sum(d2_[j]); }
#pragma unroll
    for (int i = 0; i < 8; ++i) {
        const int t = th * 8 + i; const size_t tok = (size_t)t0 + t;
        const size_t ri = tok * 256 + c;
        ((float*)rec)[ri] = dec_[i]; ((bf16_t*)(rec + 16 * MiB))[ri] = f2bf(r_[i]); ((bf16_t*)(rec + 24 * MiB))[ri] = f2bf(kp_[i]); ((bf16_t*)(rec + 40 * MiB))[ri] = f2bf(b_[i]);
        if ((i & 1) == 0) ((bf16_t*)(rec + 32 * MiB))[ri] = f2bf(-kk_[i]);
        else {
            ((bf16_t*)(rec + 32 * MiB))[ri] = f2bf(kk_[i - 1] * d1_[i >> 1] - dec_[i - 1] * kk_[i]);
            if (lane == 0) cs[tok * 4 + head] = -d2_[i >> 1];
        }
        vbuf[tok * 256 + c] = f2bf(v_[i]); gbuf[tok * 256 + c] = f2bf(ag[i]);
        if (lane == 0) bs[tok * 4 + head] = q_[i];
    }
}

constexpr int SC_TC = 32;
constexpr int SC_REC_F = SC_TC * 16 * 20;
constexpr int SC_V_F = SC_TC * 20;
__device__ __forceinline__ void scan_load_chunk(LAS float* recb, LAS float* vb, const unsigned char* __restrict__ rec, const bf16_t* __restrict__ vbuf, const float* __restrict__ cs, size_t tok0, int h, int v0, int lt) {
#pragma unroll
    for (int it = 0; it < 2; ++it) {
        const int p = lt + it * 256, step = p >> 4, kq = p & 15;
        const size_t ri = (tok0 + step) * 256 + h * 64 + 4 * kq;
        const f32x4 wv = *(const f32x4*)((const float*)rec + ri);
        const u32x2 rr = *(const u32x2*)((const bf16_t*)(rec + 16 * MiB) + ri), kk2 = *(const u32x2*)((const bf16_t*)(rec + 24 * MiB) + ri);
        const u32x2 nn = *(const u32x2*)((const bf16_t*)(rec + 32 * MiB) + ri), bb = *(const u32x2*)((const bf16_t*)(rec + 40 * MiB) + ri);
        const u32x4 a = {rr.x, rr.y, kk2.x, kk2.y}, bq = {nn.x, nn.y, bb.x, bb.y};
        LAS float* d = recb + (step * 16 + kq) * 20;
        *(LAS f32x4*)d = wv;
        *(LAS f32x4*)(d + 4) = (f32x4){bflo(a.x), bfhi(a.x), bflo(a.y), bfhi(a.y)};
        *(LAS f32x4*)(d + 8) = (f32x4){bflo(a.z), bfhi(a.z), bflo(a.w), bfhi(a.w)};
        *(LAS f32x4*)(d + 12) = (f32x4){bflo(bq.x), bfhi(bq.x), bflo(bq.y), bfhi(bq.y)};
        *(LAS f32x4*)(d + 16) = (f32x4){bflo(bq.z), bfhi(bq.z), bflo(bq.w), bfhi(bq.w)};
    }
    if (lt < 128) { const int step = lt >> 2, qd = lt & 3;
        const u32x2 x = *(const u32x2*)(vbuf + (tok0 + step) * 256 + h * 64 + v0 + 4 * qd);
        *(LAS f32x4*)(vb + step * 20 + 4 * qd) = (f32x4){bflo(x.x), bfhi(x.x), bflo(x.y), bfhi(x.y)}; }
    else if (lt < 128 + SC_TC) { const int step = lt - 128; vb[step * 20 + 16] = cs[(tok0 + step) * 4 + h]; }
}
__device__ __forceinline__ void rwkv_scan_block(LAS unsigned char* lds, int blk, const unsigned char* __restrict__ rec, const bf16_t* __restrict__ vbuf, const float* __restrict__ cs, float* __restrict__ ya) {
    const int tid = tid_opaque(), lane = tid & 63, w = tid >> 6;
    const int bh = blk >> 2, b = bh >> 2, h = bh & 3, v0 = (blk & 3) * 16;
    LAS float* RECB = (LAS float*)lds;
    LAS float* VB = RECB + 2 * SC_REC_F;
    const size_t tokb = (size_t)b * SEQ;
    const int rowl = lane >> 4, kq = lane & 15, row = v0 + 4 * (w & 3) + rowl;
    f32x2 Sa = {0.f, 0.f}, Sb = {0.f, 0.f}; float ykeep = 0.f;
    if (w < 4) __builtin_amdgcn_s_setprio(3);
    __syncthreads();
    if (w >= 4) scan_load_chunk(RECB, VB, rec, vbuf, cs, tokb, h, v0, tid - 256);
    for (int c = 0; c < SEQ / SC_TC; ++c) {
        __syncthreads();
        const int buf = c & 1;
        if (w >= 4) { if (c + 1 < SEQ / SC_TC) scan_load_chunk(RECB + (buf ^ 1) * SC_REC_F, VB + (buf ^ 1) * SC_V_F, rec, vbuf, cs, tokb + (size_t)(c + 1) * SC_TC, h, v0, tid - 256); }
        else {
            const LAS float* rb = RECB + buf * SC_REC_F + kq * 20; const LAS float* vb = VB + buf * SC_V_F;
            float* yo = ya + (tokb + (size_t)c * SC_TC + kq) * 256 + h * 64 + row;
#define SC_LD(P, st) do { const LAS float* R_ = rb + (st) * 320; P##w = *(const LAS f32x4*)R_; P##r = *(const LAS f32x4*)(R_ + 4); P##k = *(const LAS f32x4*)(R_ + 8); \
                          P##n = *(const LAS f32x4*)(R_ + 12); P##b = *(const LAS f32x4*)(R_ + 16); P##v = vb[(st) * 20 + 4 * w + rowl]; } while (0)
#define LO2(q_) ((f32x2){(q_).x, (q_).y})
#define HI2(q_) ((f32x2){(q_).z, (q_).w})
            f32x4 Aw, Ar, Ak, An, Ab, Bw, Br, Bk, Bn, Bb, Cw, Cr, Ck, Cn, Cb, Dw, Dr, Dk, Dn, Db; float Av, Bv, Cv, Dv, Bc, Dc;
            SC_LD(A, 0); SC_LD(B, 1); Bc = vb[1 * 20 + 16];
#pragma unroll
            for (int st = 0; st < SC_TC; st += 4) {
                if (st + 2 < SC_TC) { SC_LD(C, st + 2); SC_LD(D, st + 3); Dc = vb[(st + 3) * 20 + 16]; }
#define SC_PAIR(E, O, Oc, S0) do { \
                f32x2 d0 = Sa * LO2(E##n); d0 = Sb * HI2(E##n) + d0; f32x2 d1 = Sa * LO2(O##n); d1 = Sb * HI2(O##n) + d1; \
                const f32x2 ve = {E##v, E##v}, vo = {O##v, O##v}; \
                f32x2 ta = ve * LO2(E##k), tb = ve * HI2(E##k); ta = Sa * LO2(E##w) + ta; tb = Sb * HI2(E##w) + tb; \
                const float sa0 = allreduce16(d0.x + d0.y); const float sa1 = allreduce16(d1.x + d1.y) + E##v * Oc; \
                const f32x2 s0 = {sa0, sa0}, s1 = {sa1, sa1}; \
                Sa = s0 * LO2(E##b) + ta; Sb = s0 * HI2(E##b) + tb; \
                f32x2 e0 = Sa * LO2(E##r); e0 = Sb * HI2(E##r) + e0; \
                f32x2 ua = vo * LO2(O##k), ub = vo * HI2(O##k); ua = Sa * LO2(O##w) + ua; ub = Sb * HI2(O##w) + ub; \
                Sa = s1 * LO2(O##b) + ua; Sb = s1 * HI2(O##b) + ub; \
                f32x2 e1 = Sa * LO2(O##r); e1 = Sb * HI2(O##r) + e1; \
                Y0 = e0.x + e0.y; Y1 = e1.x + e1.y; } while (0)
                float yp0, yp1, yp2, yp3;
#define Y0 yp0
#define Y1 yp1
                SC_PAIR(A, B, Bc, st);
#undef Y0
#undef Y1
                if (st + 4 < SC_TC) { SC_LD(A, st + 4); SC_LD(B, st + 5); Bc = vb[(st + 5) * 20 + 16]; }
#define Y0 yp2
#define Y1 yp3
                SC_PAIR(C, D, Dc, st + 2);
#undef Y0
#undef Y1
                {
                    const unsigned long long b0 = 0xAAAAAAAAAAAAAAAAull, b1 = 0xCCCCCCCCCCCCCCCCull;
                    float s01, x01, s23, x23;
                    asm volatile("v_cndmask_b32_e64 %0, %1, %2, %3" : "=v"(s01) : "v"(yp0), "v"(yp1), "s"(b0));
                    asm volatile("v_cndmask_b32_e64 %0, %1, %2, %3" : "=v"(x01) : "v"(yp1), "v"(yp0), "s"(b0));
                    asm volatile("v_cndmask_b32_e64 %0, %1, %2, %3" : "=v"(s23) : "v"(yp2), "v"(yp3), "s"(b0));
                    asm volatile("v_cndmask_b32_e64 %0, %1, %2, %3" : "=v"(x23) : "v"(yp3), "v"(yp2), "s"(b0));
                    const float a01 = s01 + dpp_mov<0xB1>(x01), a23 = s23 + dpp_mov<0xB1>(x23);
                    float sq, xq;
                    asm volatile("v_cndmask_b32_e64 %0, %1, %2, %3" : "=v"(sq) : "v"(a01), "v"(a23), "s"(b1));
                    asm volatile("v_cndmask_b32_e64 %0, %1, %2, %3" : "=v"(xq) : "v"(a23), "v"(a01), "s"(b1));
                    float yq = sq + dpp_mov<0x4E>(xq);
                    yq += dpp_mov<0x128>(yq); yq += dpp_mov<0x124>(yq);
                    const unsigned long long mk = 0x000F000F000F000Full << (st & 15);
                    asm volatile("v_cndmask_b32_e64 %0, %0, %1, %2" : "+v"(ykeep) : "v"(yq), "s"(mk));
                }
                if ((st & 15) == 12) yo[(size_t)(st - 12) * 256] = ykeep;
            }
#undef SC_PAIR
#undef SC_LD
#undef LO2
#undef HI2
        }
    }
    __builtin_amdgcn_s_setprio(0);
}

#define XB_TMO      128
#define XB_XCNT(j)  (256  + 64 * (j))
#define XB_XSUB(j)  (1280 + 64 * (j))
#define XB_XGEN(j)  (2304 + 64 * (j))
#define XB_TOP      3328
#define XB_TOPGEN   3392
#define XB_SPIN_CAP (1u << 20)
__device__ __forceinline__ unsigned xb_ld(unsigned* p)              { return __hip_atomic_load(p, __ATOMIC_RELAXED, __HIP_MEMORY_SCOPE_AGENT); }
__device__ __forceinline__ unsigned xb_add(unsigned* p, unsigned v) { return __hip_atomic_fetch_add(p, v, __ATOMIC_RELAXED, __HIP_MEMORY_SCOPE_AGENT); }
__device__ __forceinline__ unsigned xb_xcc_id() { return (unsigned)__builtin_amdgcn_s_getreg((3 << 11) | 20) & 0xFu; }
#define XB_SPIN(cond, bar) do { unsigned _sp = 0; while (cond) { __builtin_amdgcn_s_sleep(1); \
    if ((++_sp & 255u) == 0u) { if (xb_ld(&(bar)[XB_TMO])) break; if (_sp > XB_SPIN_CAP) { atomicAdd(&(bar)[XB_TMO], 1u); break; } } } } while (0)
struct XcdBarrier { unsigned* bar; unsigned x; volatile LAS unsigned* st; };
__device__ __forceinline__ XcdBarrier xcd_barrier_post(unsigned* bar, volatile LAS unsigned* st) {
    XcdBarrier b; b.bar = bar; b.x = xb_xcc_id(); b.st = st;
    if (__builtin_amdgcn_workitem_id_x() == 0) (void)xb_add(&bar[XB_XCNT(b.x)], 1u);
    return b;
}
__device__ __forceinline__ void xcd_barrier_complete(unsigned* bar, unsigned x, unsigned& nloc, unsigned& nx) {
    const unsigned G = gridDim.x * gridDim.y * gridDim.z;
    unsigned sum, cnt, mine, sp = 0u;
    for (;;) {
        sum = 0u; cnt = 0u; mine = 0u;
#pragma unroll
        for (unsigned j = 0; j < 16; ++j) { const unsigned c = xb_ld(&bar[XB_XCNT(j)]); sum += c; cnt += (c > 0u) ? 1u : 0u; mine = (j == x) ? c : mine; }
        if (sum == G) break;
        __builtin_amdgcn_s_sleep(1);
        if ((++sp & 255u) == 0u) { if (xb_ld(&bar[XB_TMO])) break; if (sp > XB_SPIN_CAP) { atomicAdd(&bar[XB_TMO], 1u); break; } }
    }
    nloc = mine > 0u ? mine : 1u; nx = cnt > 0u ? cnt : 1u;
}
__device__ __forceinline__ void xcd_barrier(const XcdBarrier& b, const unsigned k) {
    asm volatile("s_waitcnt vmcnt(0)" ::: "memory");
    __syncthreads();
    if (__builtin_amdgcn_workitem_id_x() == 0) {
        unsigned* bar = b.bar;
        __builtin_amdgcn_s_waitcnt(0);
        unsigned nloc = b.st[0], nx = b.st[1];
        if (nloc == 0u) { xcd_barrier_complete(bar, b.x, nloc, nx); b.st[0] = nloc; b.st[1] = nx; }
        const unsigned old = xb_add(&bar[XB_XSUB(b.x)], 1u);
        const unsigned gen = old / nloc;
        if (old + 1u == (gen + 1u) * nloc) {
            __builtin_amdgcn_fence(__ATOMIC_RELEASE, "agent");
            asm volatile("s_waitcnt vmcnt(0)" ::: "memory");
            const unsigned og = xb_add(&bar[XB_TOP], 1u);
            const unsigned tg = og / nx;
            if (og + 1u == (tg + 1u) * nx) xb_add(&bar[XB_TOPGEN], 1u);
            else XB_SPIN(xb_ld(&bar[XB_TOPGEN]) == tg, bar);
            __builtin_amdgcn_fence(__ATOMIC_ACQUIRE, "agent");
            asm volatile("s_waitcnt vmcnt(0)" ::: "memory");
        } else {
            XB_SPIN(xb_ld(&bar[XB_TOPGEN]) < k, bar);
            __builtin_amdgcn_fence(__ATOMIC_ACQUIRE, "agent");
            asm volatile("s_waitcnt vmcnt(0)" ::: "memory");
        }
    }
    __syncthreads();
}


#define PIN(i) ((const float*)P.in[(i) + z])
constexpr int NPH = 9;
template <int PH> __device__ __forceinline__ void run_phase(const Params& P, LAS unsigned char* lds) {
        int z; asm volatile("s_mov_b32 %0, 0" : "=s"(z));
        unsigned char* ws = P.ws + z;
        constexpr int layer = PH / NPH, k = PH - layer * NPH;
        const int tid = tid_opaque(), lane = tid & 63, wave = __builtin_amdgcn_readfirstlane(tid >> 6), G = sgpr_opaque(gridDim.x), blk = sgpr_opaque(blockIdx.x);
        const int gw = blk * 8 + wave, NGW = G * 8;
        float* hbuf = P.out + z;
        bf16_t* XN = (bf16_t*)(ws + WS_X);
        if constexpr (PH == NPH * DEPTH) {
            const float* g = PIN(I_FINAL);
            const f32x4* gr = (const f32x4*)g + lane;
            f32x4 gg[4];
#pragma unroll
            for (int j = 0; j < 4; ++j) gg[j] = gr[64 * j];
            for (int m = gw; m < T; m += 4 * NGW) {
                f32x4 v[4][4]; float rs[4];
#pragma unroll
                for (int r = 0; r < 4; ++r)
#pragma unroll
                    for (int j = 0; j < 4; ++j) v[r][j] = ((const f32x4*)(hbuf + (size_t)(m + r * NGW) * 1024) + lane)[64 * j];
#pragma unroll
                for (int r = 0; r < 4; ++r) { float s2 = 0.f;
#pragma unroll
                    for (int j = 0; j < 4; ++j) s2 += (v[r][j].x * v[r][j].x + v[r][j].y * v[r][j].y) + (v[r][j].z * v[r][j].z + v[r][j].w * v[r][j].w);
                    rs[r] = s2; }
#pragma unroll
                for (int r = 0; r < 4; ++r) rs[r] = rsqrtf(wave_sum(rs[r]) * (1.f / 1024.f) + NORM_EPS);
#pragma unroll
                for (int r = 0; r < 4; ++r)
#pragma unroll
                    for (int j = 0; j < 4; ++j) ((f32x4*)(hbuf + (size_t)(m + r * NGW) * 1024) + lane)[64 * j] = v[r][j] * rs[r] * gg[j];
            }
            return;
        } else if constexpr (k == 0) {
            const float* hin = (layer == 0) ? PIN(I_X) : hbuf;
            LAS float* tscr = (LAS float*)(lds + wave * 16384);
            bf16_t* Win_t = (bf16_t*)(ws + WS_WIN); bf16_t* Wq_t = (bf16_t*)(ws + WS_WQ); bf16_t* Wkv_t = (bf16_t*)(ws + WS_WKV); bf16_t* Wo_t = (bf16_t*)(ws + WS_WO);
            const float* Win = PIN(I_W_IN) + (size_t)layer * DM * IN_DIM;
            const float* Wq = PIN(I_WQUP) + (size_t)layer * 384 * 768;
            const float* Wkv = PIN(I_WKVUP) + (size_t)layer * 256 * 1024;
            const float* Wo = PIN(I_W_OUT) + (size_t)layer * 1024 * 1024;
            constexpr int IT_IN = 16 * 81, IT_Q = 6 * 24, IT_KV = 4 * 32, IT_O = 16 * 32;
            if (layer == 0) for (int it = gw; it < IT_IN + IT_Q + IT_KV + IT_O; it += NGW) {
                int r = it;
                if (r < IT_IN) { transpose_item(Win, 1024, IN_DIM, Win_t, 1, tscr, r, lane); continue; } r -= IT_IN;
                if (r < IT_Q) { transpose_item(Wq, 384, 768, Wq_t, 0, tscr, r, lane); continue; } r -= IT_Q;
                if (r < IT_KV) { transpose_item(Wkv, 256, 1024, Wkv_t, 0, tscr, r, lane); continue; } r -= IT_KV;
                transpose_item(Wo, 1024, 1024, Wo_t, 0, tscr, r, lane);
            }
            for (int i = blk * 512 + tid; i < 224 * 128; i += G * 512) { const int rr = i >> 7, cc = i & 127; const int row = (rr < 128) ? 896 + rr : 2720 + (rr - 128);
                *(u32x4*)(Win_t + (size_t)row * 1024 + cc * 8) = (u32x4){0u, 0u, 0u, 0u}; }
            if (layer == 0) {
                const int* pos = (const int*)P.in[I_POS + z];
                float* cosR = (float*)(ws + WS_COSR); float* sinR = (float*)(ws + WS_SINR); float* cosM = (float*)(ws + WS_COSM); float* sinM = (float*)(ws + WS_SINM);
                for (int i = blk * 512 + tid; i < T * 32; i += G * 512) { const int tok = i >> 5, f = i & 31;
                    const float inv = exp2f(-(float)f * (1.f / 32.f) * 13.287712379549449f); const float ang = (float)pos[tok] * inv;
                    double rev = (double)ang * 0.15915494309189535; rev -= floor(rev); const float a = (float)(rev * 6.283185307179586);
                    cosR[i] = __cosf(a); sinR[i] = __sinf(a); }
                for (int i = blk * 512 + tid; i < T * 16; i += G * 512) { const int tok = i >> 4, f = i & 15;
                    const float inv = exp2f(-(float)f * (1.f / 16.f) * 13.287712379549449f); const float ang = (float)pos[tok] * inv;
                    double rev = (double)ang * 0.15915494309189535; rev -= floor(rev); const float a = (float)(rev * 6.283185307179586);
                    cosM[i] = __cosf(a); sinM[i] = __sinf(a); }
            }
            const float* g = PIN(I_ATTN_NORM) + layer * 1024;
            for (int m = gw; m < T; m += 2 * NGW) rms_rows2_bf16(hin + (size_t)m * 1024, hin + (size_t)(m + NGW) * 1024, g, XN + (size_t)m * 1024, XN + (size_t)(m + NGW) * 1024, lane);
        } else if constexpr (k == 1) {
            pg8::Gemm g{XN, (bf16_t*)(ws + WS_WIN), T, NPROJ, 1024}; pg8::StaticOrder S; S.init(T, NPROJ, G, blk);
            pg8::EpiProj E{(bf16_t*)(ws + WS_PA), (bf16_t*)(ws + WS_PB), (bf16_t*)(ws + WS_PC)};
            pg8::gemm_phase<pg8::EpiProj, pg8::StaticOrder, true, true>(lds, g, S, E);
        } else if constexpr (k == 2) {
            bf16_t* pa = (bf16_t*)(ws + WS_PA); bf16_t* pb = (bf16_t*)(ws + WS_PB); bf16_t* pc = (bf16_t*)(ws + WS_PC);
            float* cosR = (float*)(ws + WS_COSR); float* sinR = (float*)(ws + WS_SINR); float* cosM = (float*)(ws + WS_COSM); float* sinM = (float*)(ws + WS_SINM);
            PrepW W;
            {
                const int l16 = lane & 15, lq = lane >> 4;
                const float* w2 = PIN(I_W2) + layer * 32 * 256; const float* a2 = PIN(I_A2) + layer * 32 * 256; const float* g2 = PIN(I_G2) + layer * 64 * 256;
                const float* v1 = PIN(I_V1) + (layer > 0 ? (layer - 1) * 256 * 32 : 0); const float* v2 = PIN(I_V2) + (layer > 0 ? (layer - 1) * 32 * 256 : 0);
#pragma unroll
                for (int nt = 0; nt < 2; ++nt) { const int n = 16 * (2 * wave + nt) + l16;
                    W.Bw[nt] = pack_col8(w2, 256, 8 * lq, n); W.Ba[nt] = pack_col8(a2, 256, 8 * lq, n);
                    W.Bg[nt][0] = pack_col8(g2, 256, 8 * lq, n); W.Bg[nt][1] = pack_col8(g2, 256, 32 + 8 * lq, n);
                    W.Bv[nt] = pack_col8(v2, 256, 8 * lq, n); W.Bv1[nt] = pack_col8(v1, 32, 32 * wave + 8 * lq, 16 * nt + l16); }
            }
            unsigned raw[17];
            if (tid < 448 && blk < T / 16) prep_fetch_rows(raw, pa, blk * 16, tid * 2);
            PrepC PC;
            { const int cc = tid & 255, c2 = (tid < 448) ? tid * 2 : 0;
              const float* mu = PIN(I_MU) + layer * RW_IN;
              PC.mu0 = mu[c2]; PC.mu1 = mu[c2 + 1]; PC.w0c = (PIN(I_W0) + layer * 256)[cc]; PC.a0c = (PIN(I_A0) + layer * 256)[cc]; PC.kkc = (PIN(I_KK) + layer * 256)[cc];
              PC.kac = (PIN(I_KA) + layer * 256)[cc]; PC.rkc = (PIN(I_RK) + layer * 256)[cc]; PC.v0c = (layer > 0) ? (PIN(I_V0) + (layer - 1) * 256)[cc] : 0.f; }
            for (int tile = blk; tile < T / 16; tile += G) rwkv_prep_tile(lds, tile, (tile + G < T / 16) ? tile + G : -1, raw, PC, layer, P, z, W, pa, ws + WS_REC, (bf16_t*)(ws + WS_VBUF), (bf16_t*)(ws + WS_GBUF), (bf16_t*)(ws + WS_VFIRST), (float*)(ws + WS_BS), (float*)(ws + WS_BS + 512 * 1024));
            for (int u = blk; u < 512; u += G) ret_kv_unit(lds, u >> 5, u & 31, pb, cosR, sinR, (float*)(ws + WS_KVT));
        } else if constexpr (k == 3) {
            LAS unsigned* misc = (LAS unsigned*)(lds + 131072);
            unsigned* ctl = (unsigned*)(ws + WS_CTL);
            float* cosR = (float*)(ws + WS_COSR); float* sinR = (float*)(ws + WS_SINR); float* cosM = (float*)(ws + WS_COSM); float* sinM = (float*)(ws + WS_SINM);
            unsigned* sbar = ctl + 64 * (8 + layer);
            const int NB = G - 64;
            if (blk < 64) {
                rwkv_scan_block(lds, blk, ws + WS_REC, (bf16_t*)(ws + WS_VBUF), (const float*)(ws + WS_BS + 512 * 1024), (float*)(ws + WS_YA));
                if (tid == 0) { unsigned sp = 0; while (xb_ld(sbar) < (unsigned)NB) { __builtin_amdgcn_s_sleep(4); if (++sp > (1u << 22)) break; }
                    __builtin_amdgcn_fence(__ATOMIC_ACQUIRE, "agent"); asm volatile("s_waitcnt vmcnt(0)" ::: "memory"); }
                __syncthreads();
            } else {
                const int cb = blk - 64;
                {
                    const int gwn = cb * 8 + wave, NGWn = NB * 8;
                    bf16_t* pc = (bf16_t*)(ws + WS_PC);
            bf16_t* qn = (bf16_t*)(ws + WS_QN); bf16_t* kvn = (bf16_t*)(ws + WS_KVN); bf16_t* kr = (bf16_t*)(ws + WS_KR);
            const float* qg = PIN(I_QNORM) + layer * 384; const float* kg = PIN(I_KVNORM) + layer * 256;
            const int lq_ = (lane < 48) ? lane : 0, lk_ = lane & 31, lr_ = lane & 1;
            const f32x4 qg0 = *(const f32x4*)(qg + 8 * lq_), qg1 = *(const f32x4*)(qg + 8 * lq_ + 4), kg0 = *(const f32x4*)(kg + 8 * lk_), kg1 = *(const f32x4*)(kg + 8 * lk_ + 4);
            for (int m0 = gwn; m0 < T; m0 += 2 * NGWn) {
                u32x4 rq_[2], rk_[2], r1_[2], r2_[2]; f32x4 cA[2], cB[2], sA[2], sB[2];
#pragma unroll
                for (int u = 0; u < 2; ++u) { const int m = (m0 + u * NGWn < T) ? m0 + u * NGWn : T - 1; const bf16_t* row = pc + (size_t)m * 768;
                    rq_[u] = *(const u32x4*)(row + 8 * lq_); rk_[u] = *(const u32x4*)(row + 384 + 8 * lk_);
                    r1_[u] = *(const u32x4*)(row + 640 + 8 * lr_); r2_[u] = *(const u32x4*)(row + 656 + 8 * lr_);
                    cA[u] = *(const f32x4*)(cosM + (size_t)m * 16 + 8 * lr_); cB[u] = *(const f32x4*)(cosM + (size_t)m * 16 + 8 * lr_ + 4);
                    sA[u] = *(const f32x4*)(sinM + (size_t)m * 16 + 8 * lr_); sB[u] = *(const f32x4*)(sinM + (size_t)m * 16 + 8 * lr_ + 4); }
#pragma unroll
                for (int u = 0; u < 2; ++u) { const int m = m0 + u * NGWn; if (m >= T) continue;
                    float q8[8], k8[8];
#pragma unroll
                    for (int j = 0; j < 4; ++j) { q8[2 * j] = bflo(rq_[u][j]); q8[2 * j + 1] = bfhi(rq_[u][j]); k8[2 * j] = bflo(rk_[u][j]); k8[2 * j + 1] = bfhi(rk_[u][j]); }
                    float sq = 0.f, sk = 0.f;
#pragma unroll
                    for (int j = 0; j < 8; ++j) { sq += q8[j] * q8[j]; sk += k8[j] * k8[j]; }
                    if (lane >= 48) sq = 0.f;
                    if (lane >= 32) sk = 0.f;
                    const float rq = rsqrtf(wave_sum(sq) * (1.f / 384.f) + NORM_EPS), rk = rsqrtf(wave_sum(sk) * (1.f / 256.f) + NORM_EPS);
                    if (lane < 48) { u32x4 o; o.x = cvt_pk_bf16(q8[0] * rq * qg0.x, q8[1] * rq * qg0.y); o.y = cvt_pk_bf16(q8[2] * rq * qg0.z, q8[3] * rq * qg0.w);
                        o.z = cvt_pk_bf16(q8[4] * rq * qg1.x, q8[5] * rq * qg1.y); o.w = cvt_pk_bf16(q8[6] * rq * qg1.z, q8[7] * rq * qg1.w); *(u32x4*)(qn + (size_t)m * 384 + 8 * lane) = o; }
                    if (lane < 32) { u32x4 o; o.x = cvt_pk_bf16(k8[0] * rk * kg0.x, k8[1] * rk * kg0.y); o.y = cvt_pk_bf16(k8[2] * rk * kg0.z, k8[3] * rk * kg0.w);
                        o.z = cvt_pk_bf16(k8[4] * rk * kg1.x, k8[5] * rk * kg1.y); o.w = cvt_pk_bf16(k8[6] * rk * kg1.z, k8[7] * rk * kg1.w); *(u32x4*)(kvn + (size_t)m * 256 + 8 * lane) = o; }
                    if (lane < 2) { const float cs8[8] = {cA[u].x, cA[u].y, cA[u].z, cA[u].w, cB[u].x, cB[u].y, cB[u].z, cB[u].w}, sn8[8] = {sA[u].x, sA[u].y, sA[u].z, sA[u].w, sB[u].x, sB[u].y, sB[u].z, sB[u].w};
                        u32x4 o1, o2;
#pragma unroll
                        for (int j = 0; j < 4; ++j) { const float a0 = bflo(r1_[u][j]), a1 = bfhi(r1_[u][j]), b0 = bflo(r2_[u][j]), b1 = bfhi(r2_[u][j]);
                            o1[j] = cvt_pk_bf16(a0 * cs8[2 * j] - b0 * sn8[2 * j], a1 * cs8[2 * j + 1] - b1 * sn8[2 * j + 1]); o2[j] = cvt_pk_bf16(b0 * cs8[2 * j] + a0 * sn8[2 * j], b1 * cs8[2 * j + 1] + a1 * sn8[2 * j + 1]); }
                        *(u32x4*)(kr + (size_t)m * 32 + 8 * lane) = o1; *(u32x4*)(kr + (size_t)m * 32 + 16 + 8 * lane) = o2; }
                }
            }
                    unsigned* sbar0 = ctl + 64 * (12 + layer);
                    asm volatile("s_waitcnt vmcnt(0)" ::: "memory");
                    __syncthreads();
                    if (tid == 0) {
                        __builtin_amdgcn_fence(__ATOMIC_RELEASE, "agent"); asm volatile("s_waitcnt vmcnt(0)" ::: "memory");
                        xb_add(sbar0, 1u);
                        unsigned sp = 0; while (xb_ld(sbar0) < (unsigned)NB) { __builtin_amdgcn_s_sleep(4); if (++sp > (1u << 22)) break; }
                        __builtin_amdgcn_fence(__ATOMIC_ACQUIRE, "agent"); asm volatile("s_waitcnt vmcnt(0)" ::: "memory");
                    }
                    __syncthreads();
                }
                bf16_t* rprev = (bf16_t*)(ws + WS_RPREV); const float* kvt = (const float*)(ws + WS_KVT);
                for (int i = cb * 512 + tid; i < 16 * 4096; i += NB * 512) { const int bh = i >> 12, el = i & 4095; const int h = bh & 3;
                    const float cd = exp2f(128.f * log2f(1.f - exp2f(-5.f - (float)h)));
                    float R = 0.f;
#pragma unroll 8
                    for (int ci = 0; ci < 32; ++ci) { rprev[((size_t)(bh * 32 + ci)) * 4096 + el] = f2bf(R); R = R * cd + kvt[((size_t)(bh * 32 + ci)) * 4096 + el]; } }
                __syncthreads();
                { pg8::Gemm g{(bf16_t*)(ws + WS_QN), (bf16_t*)(ws + WS_WQ), T, 768, 384}; pg8::StaticOrder S; S.init(T, 768, NB, cb); pg8::EpiPlain E{(bf16_t*)(ws + WS_PC), 768};
                  pg8::gemm_phase<pg8::EpiPlain, pg8::StaticOrder, true, true>(lds, g, S, E); }
                { pg8::Gemm g{(bf16_t*)(ws + WS_KVN), (bf16_t*)(ws + WS_WKV), T, 1024, 256}; pg8::StaticOrder S; S.init(T, 1024, NB, cb); pg8::EpiPlain E{(bf16_t*)(ws + WS_KN), 1024};
                  pg8::gemm_phase<pg8::EpiPlain, pg8::StaticOrder, true, true>(lds, g, S, E); }
                asm volatile("s_waitcnt vmcnt(0)" ::: "memory");
                __syncthreads();
                if (tid == 0) {
                    __builtin_amdgcn_fence(__ATOMIC_RELEASE, "agent"); asm volatile("s_waitcnt vmcnt(0)" ::: "memory");
                    xb_add(sbar, 1u);
                    unsigned sp = 0; while (xb_ld(sbar) < (unsigned)NB) { __builtin_amdgcn_s_sleep(4); if (++sp > (1u << 22)) break; }
                    __builtin_amdgcn_fence(__ATOMIC_ACQUIRE, "agent"); asm volatile("s_waitcnt vmcnt(0)" ::: "memory");
                }
                __syncthreads();
            }
            unsigned* qctr = ctl + 64 * (1 + layer);
            for (;;) {
                __syncthreads();
                if (tid == 0) misc[0] = atomicAdd(qctr, 1u);
                __syncthreads();
                const int u = (int)misc[0];
                if (u >= 768) break;
                if (u < 512) { const int qb = 15 - (u >> 5), bh = u & 31; att_unit(lds, bh >> 3, bh & 7, qb, (bf16_t*)(ws + WS_PC), (bf16_t*)(ws + WS_KN), (bf16_t*)(ws + WS_KR), cosM, sinM, XN); }
                else { const int v = u - 512; const int bh = v & 15, jb = v >> 4; ret_unit(lds, bh >> 2, bh & 3, jb, (bf16_t*)(ws + WS_PB), cosR, sinR, (bf16_t*)(ws + WS_RPREV), (float*)(ws + WS_YB)); }
            }
        } else if constexpr (k == 4) {
            LAS float* tscr = (LAS float*)(lds + wave * 16384);
            const float* __restrict__ ya = (const float*)(ws + WS_YA); const float* __restrict__ yb = (const float*)(ws + WS_YB); const float* __restrict__ bs = (const float*)(ws + WS_BS);
            const bf16_t* __restrict__ vbuf = (const bf16_t*)(ws + WS_VBUF); const bf16_t* __restrict__ gbuf = (const bf16_t*)(ws + WS_GBUF); const bf16_t* __restrict__ pb = (const bf16_t*)(ws + WS_PB);
            const float* __restrict__ gnw = PIN(I_GNW) + layer * 256; const float* __restrict__ gnb = PIN(I_GNB) + layer * 256;
            bf16_t* __restrict__ XNw = XN;
            const f32x4 gw4 = *(const f32x4*)(gnw + 4 * lane), gb4 = *(const f32x4*)(gnb + 4 * lane);
#pragma unroll 4
            for (int m = gw; m < T; m += NGW) {
                const int c = 4 * lane, head = lane >> 4;
                const f32x4 y = *(const f32x4*)(ya + (size_t)m * 256 + c);
                const float mean = allreduce16((y.x + y.y) + (y.z + y.w)) * (1.f / 64.f);
                const f32x4 d = y - mean;
                const float var = allreduce16((d.x * d.x + d.y * d.y) + (d.z * d.z + d.w * d.w)) * (1.f / 64.f);
                const float rs = rsqrtf(var + 64e-5f);
                const u32x2 vv = *(const u32x2*)(vbuf + (size_t)m * 256 + c), gg = *(const u32x2*)(gbuf + (size_t)m * 256 + c);
                const float bsc = bs[(size_t)m * 4 + head];
                const float o0 = (d.x * rs * gw4.x + gb4.x + bsc * bflo(vv.x)) * bflo(gg.x), o1 = (d.y * rs * gw4.y + gb4.y + bsc * bfhi(vv.x)) * bfhi(gg.x);
                const float o2 = (d.z * rs * gw4.z + gb4.z + bsc * bflo(vv.y)) * bflo(gg.y), o3 = (d.w * rs * gw4.w + gb4.w + bsc * bfhi(vv.y)) * bfhi(gg.y);
                u32x2 w; w.x = cvt_pk_bf16(o0, o1); w.y = cvt_pk_bf16(o2, o3);
                *(u32x2*)(XNw + (size_t)m * 1024 + c) = w;
                const f32x4 zz = *(const f32x4*)(yb + (size_t)m * 256 + c);
                const float ms = allreduce16((zz.x * zz.x + zz.y * zz.y) + (zz.z * zz.z + zz.w * zz.w)) * (1.f / 64.f);
                const float rz = rsqrtf(ms + NORM_EPS);
                const u32x2 gt = *(const u32x2*)(pb + (size_t)m * 1024 + 768 + c);
                const float g0 = bflo(gt.x), g1 = bfhi(gt.x), g2v = bflo(gt.y), g3 = bfhi(gt.y);
                u32x2 w2; w2.x = cvt_pk_bf16(zz.x * rz * g0 * sigmoidf_(g0), zz.y * rz * g1 * sigmoidf_(g1)); w2.y = cvt_pk_bf16(zz.z * rz * g2v * sigmoidf_(g2v), zz.w * rz * g3 * sigmoidf_(g3));
                *(u32x2*)(XNw + (size_t)m * 1024 + 256 + c) = w2;
            }
            const float* Wgu = PIN(I_WGU) + (size_t)layer * 1024 * 2 * D_FF; const float* Wdn = PIN(I_WDN) + (size_t)layer * D_FF * 1024;
            bf16_t* Wgu_t = (bf16_t*)(ws + WS_WGU); bf16_t* Wdn_t = (bf16_t*)(ws + WS_WDN);
            constexpr int IT_GU = 16 * 176, IT_DN = 44 * 32;
            for (int it = gw; it < IT_GU + IT_DN; it += NGW) {
                if (it < IT_GU) transpose_item(Wgu, 1024, 2 * D_FF, Wgu_t, 2, tscr, it, lane);
                else transpose_item(Wdn, D_FF, 1024, Wdn_t, 0, tscr, it - IT_GU, lane);
            }
        } else if constexpr (k == 5) {
            const float* hin = (layer == 0) ? PIN(I_X) : hbuf;
            pg8::Gemm g{XN, (bf16_t*)(ws + WS_WO), T, 1024, 1024}; pg8::StaticOrder S; S.init(T, 1024, G, blk); pg8::EpiRes E{hin, hbuf};
            pg8::gemm_phase<pg8::EpiRes, pg8::StaticOrder, true, true>(lds, g, S, E);
        } else if constexpr (k == 6) {
            const float* g = PIN(I_FFN_NORM) + layer * 1024;
            for (int m = gw; m < T; m += 2 * NGW) rms_rows2_bf16(hbuf + (size_t)m * 1024, hbuf + (size_t)(m + NGW) * 1024, g, XN + (size_t)m * 1024, XN + (size_t)(m + NGW) * 1024, lane);
            if constexpr (layer + 1 < DEPTH) {
                LAS float* tscr = (LAS float*)(lds + wave * 16384);
                const float* Win = PIN(I_W_IN) + (size_t)(layer + 1) * DM * IN_DIM; const float* Wq = PIN(I_WQUP) + (size_t)(layer + 1) * 384 * 768;
                const float* Wkv = PIN(I_WKVUP) + (size_t)(layer + 1) * 256 * 1024; const float* Wo = PIN(I_W_OUT) + (size_t)(layer + 1) * 1024 * 1024;
                constexpr int IT_IN = 16 * 81, IT_Q = 6 * 24, IT_KV = 4 * 32, IT_O = 16 * 32;
                for (int it = gw; it < IT_IN + IT_Q + IT_KV + IT_O; it += NGW) {
                    int r = it;
                    if (r < IT_IN) { transpose_item(Win, 1024, IN_DIM, (bf16_t*)(ws + WS_WIN), 1, tscr, r, lane); continue; } r -= IT_IN;
                    if (r < IT_Q) { transpose_item(Wq, 384, 768, (bf16_t*)(ws + WS_WQ), 0, tscr, r, lane); continue; } r -= IT_Q;
                    if (r < IT_KV) { transpose_item(Wkv, 256, 1024, (bf16_t*)(ws + WS_WKV), 0, tscr, r, lane); continue; } r -= IT_KV;
                    transpose_item(Wo, 1024, 1024, (bf16_t*)(ws + WS_WO), 0, tscr, r, lane);
                }
            }
        } else if constexpr (k == 7) {
            pg8::Gemm g{XN, (bf16_t*)(ws + WS_WGU), T, 2 * D_FF, 1024}; pg8::StaticOrder S; S.init(T, 2 * D_FF, G, blk); pg8::EpiSwiGLU E{(bf16_t*)(ws + WS_ACT)};
            pg8::gemm_phase<pg8::EpiSwiGLU, pg8::StaticOrder, true, true>(lds, g, S, E);
        } else {
            pg8::Gemm g{(bf16_t*)(ws + WS_ACT), (bf16_t*)(ws + WS_WDN), T, 1024, D_FF}; pg8::StaticOrder S; S.init(T, 1024, G, blk); pg8::EpiRes E{hbuf, hbuf};
            pg8::gemm_phase<pg8::EpiRes, pg8::StaticOrder, true, true>(lds, g, S, E);
        }
}

template <int PH> __device__ __forceinline__ void run_all(const Params& P, LAS unsigned char* lds, cg::grid_group& grid, const XcdBarrier& bar) {
    run_phase<PH>(P, lds);
    if constexpr (PH < NPH * DEPTH) {
        xcd_barrier(bar, (unsigned)PH + 1u);
        run_all<PH + 1>(P, lds, grid, bar);
    }
}
__global__ void __launch_bounds__(512) hymba_fwd(Params P) {
    extern __shared__ __attribute__((aligned(16))) unsigned char lds_raw[];
    LAS unsigned char* lds = (LAS unsigned char*)lds_raw;
    cg::grid_group grid = cg::this_grid();
    LAS unsigned* misc = (LAS unsigned*)(lds + 131072);
    if (__builtin_amdgcn_workitem_id_x() < 32) misc[__builtin_amdgcn_workitem_id_x()] = 0u;
    __syncthreads();
    if (P.ws == nullptr) grid.sync();
    const XcdBarrier bar = xcd_barrier_post((unsigned*)(P.ws + WS_CTL) + 4096, (volatile LAS unsigned*)(misc + 8));
    run_all<0>(P, lds, grid, bar);
}
extern "C" void kernel_launch(void* const* d_in, const int* in_sizes, int n_in, void* d_out, int out_size, void* d_ws, size_t ws_size, hipStream_t stream) {
    static int grid = 0;
    if (grid == 0) {
        if (n_in != 27 || out_size != T * DM || ws_size < WS_END) { fprintf(stderr, "kernel_launch: unexpected shapes (n_in %d, out %d, ws %zu)\n", n_in, out_size, ws_size); grid = -1; return; }
        int dev = 0, cus = 0, per_cu = 0;
        (void)hipGetDevice(&dev); (void)hipDeviceGetAttribute(&cus, hipDeviceAttributeMultiprocessorCount, dev);
        if (hipFuncSetAttribute((const void*)hymba_fwd, hipFuncAttributeMaxDynamicSharedMemorySize, LDS_BYTES) != hipSuccess) { fprintf(stderr, "kernel_launch: hipFuncSetAttribute failed\n"); grid = -1; return; }
        if (hipOccupancyMaxActiveBlocksPerMultiprocessor(&per_cu, (const void*)hymba_fwd, 512, LDS_BYTES) != hipSuccess || per_cu < 1) { fprintf(stderr, "kernel_launch: occupancy query failed (%d)\n", per_cu); grid = -1; return; }
        (void)hipGetLastError();
        grid = cus;
        if (grid < 64) { fprintf(stderr, "kernel_launch: needs >= 64 CUs\n"); grid = -1; return; }
    }
    if (grid < 0) return;
    (void)hipMemsetAsync((char*)d_ws + WS_CTL, 0, 1 * MiB, stream);
    Params p{};
    for (int i = 0; i < 27; ++i) p.in[i] = d_in[i];
    p.out = (float*)d_out; p.ws = (unsigned char*)d_ws;
    void* args[] = {&p};
    hipError_t e = hipLaunchCooperativeKernel((const void*)hymba_fwd, dim3(grid), dim3(512), args, LDS_BYTES, stream);
    if (e != hipSuccess) fprintf(stderr, "kernel_launch: cooperative launch failed: %s (grid %d)\n", hipGetErrorString(e), grid);
}
```

```cpp
#include <hip/hip_runtime.h>
#include <hip/hip_cooperative_groups.h>
#include <cstdio>
#include <cstdint>
namespace cg = cooperative_groups;

#define LAS __attribute__((address_space(3)))
typedef unsigned short bf16_t;
typedef short bf16x8 __attribute__((ext_vector_type(8)));
typedef float f32x2 __attribute__((ext_vector_type(2)));
typedef float f32x4 __attribute__((ext_vector_type(4)));
typedef float f32x16 __attribute__((ext_vector_type(16)));
typedef unsigned u32x4 __attribute__((ext_vector_type(4)));
typedef unsigned u32x2 __attribute__((ext_vector_type(2)));

constexpr int BATCH = 4, SEQ = 4096, T = BATCH * SEQ, DM = 1024, DEPTH = 2;
constexpr int RW_IN = 896, IN_DIM = 2592, D_FF = 2816;
constexpr int NPROJ = 2816;
constexpr float NORM_EPS = 1e-6f;

constexpr size_t MiB = 1u << 20;
constexpr size_t WS_CTL = 0;
constexpr size_t WS_COSR = 1 * MiB, WS_SINR = 3 * MiB, WS_COSM = 5 * MiB, WS_SINM = 6 * MiB;
constexpr size_t WS_BS = 7 * MiB;
constexpr size_t WS_RPREV = 8 * MiB;
constexpr size_t WS_WIN = 12 * MiB;
constexpr size_t WS_WQ = WS_WIN + 5632 * 1024;
constexpr size_t WS_WKV = WS_WQ + 768 * 384 * 2;
constexpr size_t WS_WO = WS_WKV + 1024 * 256 * 2;
constexpr size_t WS_VFIRST = 21 * MiB;
constexpr size_t WS_VBUF = 29 * MiB;
constexpr size_t WS_GBUF = 37 * MiB;
constexpr size_t WS_X = 45 * MiB;
constexpr size_t WS_QN = WS_X, WS_KVN = WS_X + 12 * MiB;
constexpr size_t WS_KR = 253 * MiB;
constexpr size_t WS_PA = 77 * MiB;
constexpr size_t WS_YA = WS_PA, WS_YB = WS_PA + 16 * MiB;
constexpr size_t WS_PB = 109 * MiB;
constexpr size_t WS_PC = 141 * MiB;
constexpr size_t WS_ACT = 77 * MiB;
constexpr size_t WS_KN = 165 * MiB;
constexpr size_t WS_VT = 181 * MiB;
constexpr size_t WS_REC = 197 * MiB;
constexpr size_t WS_WGU = 197 * MiB, WS_WDN = 208 * MiB;
constexpr size_t WS_KVT = 245 * MiB;
constexpr size_t WS_END = 254 * MiB;

constexpr int LDS_BYTES = 131072 + 1024;

__device__ __forceinline__ int sgpr_opaque(int v) { asm volatile("" : "+s"(v)); return v; }
__device__ __forceinline__ int tid_opaque() { int t = __builtin_amdgcn_workitem_id_x(); asm volatile("" : "+v"(t)); return t; }
__device__ __forceinline__ unsigned cvt_pk_bf16(float lo, float hi) { unsigned r; asm volatile("v_cvt_pk_bf16_f32 %0, %1, %2" : "=v"(r) : "v"(lo), "v"(hi)); return r; }
__device__ __forceinline__ bf16_t f2bf(float f) { return (bf16_t)(cvt_pk_bf16(f, 0.f) & 0xffffu); }
__device__ __forceinline__ float bf2f(bf16_t v) { return __uint_as_float(((unsigned)v) << 16); }
__device__ __forceinline__ float bflo(unsigned u) { return __uint_as_float(u << 16); }
__device__ __forceinline__ float bfhi(unsigned u) { return __uint_as_float(u & 0xffff0000u); }
__device__ __forceinline__ float sigmoidf_(float x) { return __builtin_amdgcn_rcpf(1.f + __expf(-x)); }
template <int CTRL> __device__ __forceinline__ float dpp_mov(float x) { return __builtin_bit_cast(float, __builtin_amdgcn_mov_dpp(__builtin_bit_cast(int, x), CTRL, 0xf, 0xf, true)); }
__device__ __forceinline__ float allreduce16(float x) {
    x += dpp_mov<0xB1>(x); x += dpp_mov<0x4E>(x); x += dpp_mov<0x141>(x); x += dpp_mov<0x140>(x); return x;
}
__device__ __forceinline__ float wave_sum(float v) { v = allreduce16(v); v += __shfl_xor(v, 16); v += __shfl_xor(v, 32); return v; }
__device__ __forceinline__ int crow(int r, int hi) { return (r & 3) + 8 * (r >> 2) + 4 * hi; }
#define MFMA32(a, b, c) __builtin_amdgcn_mfma_f32_32x32x16_bf16((a), (b), (c), 0, 0, 0)

namespace pg8 {
#define PG8_LAS __attribute__((address_space(3)))
constexpr int BM = 256, BK = 64, HALF = 128, HTB = HALF * BK * 2, STAGE_BYTES = 8 * HTB, NXCD = 8, WGM = 8;
__host__ __device__ __forceinline__ int lds_byte(int r, int c) { const int st = (r >> 4) * 2 + (c >> 5), rr = r & 15, cc = c & 31, ob = rr * 64 + cc * 2; return st * 1024 + (ob ^ (((ob >> 9) & 1) << 5)); }
__host__ __device__ __forceinline__ void stage_rc(int b, int& R, int& C) { const int st = b / 1024, sb = b % 1024, swz = sb ^ (((sb >> 9) & 1) << 5); R = (st >> 1) * 16 + swz / 64; C = (st & 1) * 32 + (swz % 64) / 2; }
__host__ __device__ __forceinline__ int perm32(int rho) { const int n = rho >> 4, i = rho & 15; return 8 * (i >> 2) + 4 * n + (i & 3); }
struct Unit { int pm, pn; };
struct Gemm { const bf16_t* A; const bf16_t* Bt; int M, N, K; };
struct StaticOrder {
    int nM, nN, nwg, G, c;
    __host__ __device__ void init(int M, int N, int G_, int c_) { nM = M / BM; nN = N / BM; nwg = nM * nN; G = G_; c = c_; }
    __host__ __device__ bool next(int i, Unit& u) const {
        const long L = (long)i * G + c; if (L >= nwg) return false;
        int wgid = (int)L; { const int q = nwg / NXCD, r = nwg % NXCD, xcd = wgid % NXCD, off = wgid / NXCD; wgid = (xcd < r ? xcd * (q + 1) : r * (q + 1) + (xcd - r) * q) + off; }
        const int nig = WGM * nN, gid = wgid / nig, fm = gid * WGM, gsz = (nM - fm) < WGM ? (nM - fm) : WGM;
        u.pm = fm + ((wgid % nig) % gsz); u.pn = (wgid % nig) / gsz; return true;
    }
    __device__ __forceinline__ void a_ready(const Unit&) const {}
    __device__ __forceinline__ void done(const Unit&) const {}
};

template <class Epi, class Sched, bool ALIGN_EPI = false, bool SP2 = false>
__device__ __forceinline__ void gemm_phase(PG8_LAS unsigned char* lds, const Gemm g, const Sched& S, const Epi& E) {
    const int tid = tid_opaque(), wid = __builtin_amdgcn_readfirstlane(tid >> 6), lane = tid & 63, wr = wid >> 2, wc = wid & 3, fr = lane & 15, fq = lane >> 4;
    const int K = g.K, nt = K / BK;
    unsigned voffA[2], voffB[2];
#pragma unroll
    for (int i = 0; i < 2; ++i) { int R, C; stage_rc(tid * 16 + i * 8192, R, C); const int Rb = Epi::PERM ? ((R & ~31) + perm32(R & 31)) : R;
        voffA[i] = (unsigned)(R * K + C) * 2u; voffB[i] = (unsigned)(Rb * K + C) * 2u; }
    const size_t kstep = (size_t)(BK * 2);
    const size_t hstep = (size_t)HALF * K * 2;
    const size_t tstep = 2 * hstep;
    const unsigned ldsw = (unsigned)wid * 1024u;
    const int aoff = lds_byte(wr * 64 + fr, fq * 8), boff = lds_byte(wc * 32 + fr, fq * 8);
#define PG8_SA(b, h) (((b) * 2 + (h)) * HTB)
#define PG8_SB(b, h) ((4 + (b) * 2 + (h)) * HTB)
#define PG8_STAGE(bufoff, gbase, voff) do { _Pragma("unroll") for (int _i = 0; _i < 2; ++_i) \
        __builtin_amdgcn_global_load_lds((const unsigned*)((const char*)(gbase) + (voff)[_i]), (PG8_LAS unsigned*)(lds + (bufoff) + ldsw + _i * 8192), 16, 0, 0); } while (0)
#define PG8_LDA(dst, b, h) do { _Pragma("unroll") for (int m = 0; m < 4; ++m) _Pragma("unroll") for (int k = 0; k < 2; ++k) dst[m][k] = *(const PG8_LAS bf16x8*)(lds + PG8_SA(b, h) + aoff + m * 2048 + k * 1024); } while (0)
#define PG8_LDB(dst, b, h) do { _Pragma("unroll") for (int n = 0; n < 2; ++n) _Pragma("unroll") for (int k = 0; k < 2; ++k) dst[n][k] = *(const PG8_LAS bf16x8*)(lds + PG8_SB(b, h) + boff + n * 2048 + k * 1024); } while (0)
#define PG8_MMA(ai, bj, At, Bt) do { __builtin_amdgcn_s_setprio(1); _Pragma("unroll") for (int m = 0; m < 4; ++m) _Pragma("unroll") for (int n = 0; n < 2; ++n) _Pragma("unroll") for (int k = 0; k < 2; ++k) \
        acc[ai][bj][m][n] = __builtin_amdgcn_mfma_f32_16x16x32_bf16(Bt[n][k], At[m][k], acc[ai][bj][m][n], 0, 0, 0); __builtin_amdgcn_s_setprio(0); } while (0)
#define PG8_WAIT_V(n) asm volatile("s_waitcnt vmcnt(" #n ")" ::: "memory")
#define PG8_WAIT_L(n) asm volatile("s_waitcnt lgkmcnt(" #n ")" ::: "memory")
#define PG8_BAR __builtin_amdgcn_s_barrier()
#define PG8_SCHED __builtin_amdgcn_sched_barrier(0)
    Unit cur, nxt; int ui = 0;
    if (!S.next(0, cur)) return;
    f32x4 acc[2][2][4][2];
#pragma unroll
    for (int a = 0; a < 2; ++a)
#pragma unroll
        for (int b = 0; b < 2; ++b)
#pragma unroll
            for (int m = 0; m < 4; ++m)
#pragma unroll
                for (int n = 0; n < 2; ++n) acc[a][b][m][n] = (f32x4){0.f, 0.f, 0.f, 0.f};
    bf16x8 At[4][2], B0[2][2], B1[2][2];
    const char* cA = (const char*)g.A + (size_t)cur.pm * tstep; const char* cB = (const char*)g.Bt + (size_t)cur.pn * tstep;
    S.a_ready(cur);
    if constexpr (SP2) {
        PG8_STAGE(PG8_SB(0, 0), cB, voffB); PG8_STAGE(PG8_SB(0, 1), cB + hstep, voffB); PG8_STAGE(PG8_SA(0, 0), cA, voffA); PG8_STAGE(PG8_SA(0, 1), cA + hstep, voffA);
        if (wr == 1) PG8_BAR;
        PG8_WAIT_V(2); PG8_BAR;
        PG8_STAGE(PG8_SB(1, 0), cB + kstep, voffB); PG8_STAGE(PG8_SA(1, 0), cA + kstep, voffA); PG8_STAGE(PG8_SB(1, 1), cB + hstep + kstep, voffB);
        PG8_WAIT_V(6); PG8_BAR;
    } else {
        PG8_STAGE(PG8_SB(0, 0), cB, voffB); PG8_STAGE(PG8_SA(0, 0), cA, voffA); PG8_STAGE(PG8_SB(0, 1), cB + hstep, voffB); PG8_STAGE(PG8_SA(0, 1), cA + hstep, voffA);
        if (wr == 1) PG8_BAR;
        PG8_WAIT_V(4); PG8_BAR;
        PG8_STAGE(PG8_SB(1, 0), cB + kstep, voffB); PG8_STAGE(PG8_SA(1, 0), cA + kstep, voffA); PG8_STAGE(PG8_SB(1, 1), cB + hstep + kstep, voffB);
        PG8_WAIT_V(6); PG8_BAR;
    }
    for (;;) {
        const bool has_next = S.next(ui + 1, nxt);
        const char* nA = has_next ? (const char*)g.A + (size_t)nxt.pm * tstep : cA; const char* nB = has_next ? (const char*)g.Bt + (size_t)nxt.pn * tstep : cB;
        for (int t = 0; t < nt; t += 2) {
            const bool last = (t == nt - 2);
            const char* a1 = cA + (size_t)(t + 1) * kstep;
            const char* a2 = last ? nA : cA + (size_t)(t + 2) * kstep; const char* b2 = last ? nB : cB + (size_t)(t + 2) * kstep;
            const char* a3 = a2 + kstep; const char* b3 = b2 + kstep;
            if (last && has_next) S.a_ready(nxt);
            if constexpr (SP2) {
            PG8_LDB(B0, 0, 0); PG8_LDB(B1, 0, 1); PG8_SCHED; PG8_LDA(At, 0, 0); PG8_STAGE(PG8_SA(1, 1), a1 + hstep, voffA);
            PG8_WAIT_V(8); PG8_WAIT_L(0); PG8_BAR; PG8_MMA(0, 0, At, B0); PG8_MMA(0, 1, At, B1); PG8_BAR; PG8_SCHED;
            PG8_LDA(At, 0, 1); PG8_STAGE(PG8_SB(0, 0), b2, voffB); PG8_STAGE(PG8_SB(0, 1), b2 + hstep, voffB); PG8_STAGE(PG8_SA(0, 0), a2, voffA);
            PG8_WAIT_V(8); PG8_WAIT_L(0); PG8_BAR; PG8_MMA(1, 0, At, B0); PG8_MMA(1, 1, At, B1); PG8_BAR; PG8_SCHED;
            PG8_LDB(B0, 1, 0); PG8_LDB(B1, 1, 1); PG8_SCHED; PG8_LDA(At, 1, 0); PG8_STAGE(PG8_SA(0, 1), a2 + hstep, voffA);
            PG8_WAIT_V(8); PG8_WAIT_L(0); PG8_BAR; PG8_MMA(0, 0, At, B0); PG8_MMA(0, 1, At, B1); PG8_BAR; PG8_SCHED;
            PG8_LDA(At, 1, 1); PG8_STAGE(PG8_SB(1, 0), b3, voffB); PG8_STAGE(PG8_SB(1, 1), b3 + hstep, voffB); PG8_STAGE(PG8_SA(1, 0), a3, voffA);
            PG8_WAIT_V(8); PG8_WAIT_L(0); PG8_BAR; PG8_MMA(1, 0, At, B0); PG8_MMA(1, 1, At, B1); PG8_BAR; PG8_SCHED;
            } else {
            PG8_LDB(B0, 0, 0); PG8_SCHED; PG8_LDA(At, 0, 0); PG8_STAGE(PG8_SA(1, 1), a1 + hstep, voffA);
            PG8_WAIT_L(8); PG8_BAR; PG8_WAIT_L(0); PG8_MMA(0, 0, At, B0); PG8_BAR; PG8_SCHED;
            PG8_LDB(B1, 0, 1); PG8_STAGE(PG8_SB(0, 0), b2, voffB);
            PG8_BAR; PG8_WAIT_L(0); PG8_MMA(0, 1, At, B1); PG8_BAR;
            PG8_LDA(At, 0, 1); PG8_STAGE(PG8_SA(0, 0), a2, voffA);
            PG8_BAR; PG8_WAIT_L(0); PG8_MMA(1, 0, At, B0); PG8_BAR; PG8_SCHED;
            PG8_STAGE(PG8_SB(0, 1), b2 + hstep, voffB);
            PG8_WAIT_V(6); PG8_BAR; PG8_MMA(1, 1, At, B1); PG8_BAR;
            PG8_LDB(B0, 1, 0); PG8_SCHED; PG8_LDA(At, 1, 0); PG8_STAGE(PG8_SA(0, 1), a2 + hstep, voffA);
            PG8_WAIT_L(8); PG8_BAR; PG8_WAIT_L(0); PG8_MMA(0, 0, At, B0); PG8_BAR; PG8_SCHED;
            PG8_LDB(B1, 1, 1); PG8_STAGE(PG8_SB(1, 0), b3, voffB);
            PG8_BAR; PG8_WAIT_L(0); PG8_MMA(0, 1, At, B1); PG8_BAR;
            PG8_LDA(At, 1, 1); PG8_STAGE(PG8_SA(1, 0), a3, voffA);
            PG8_BAR; PG8_WAIT_L(0); PG8_MMA(1, 0, At, B0); PG8_BAR; PG8_SCHED;
            PG8_STAGE(PG8_SB(1, 1), b3 + hstep, voffB);
            PG8_WAIT_V(6); PG8_BAR; PG8_MMA(1, 1, At, B1); PG8_BAR;
            }
        }
        if constexpr (ALIGN_EPI) { if (wr == 0) PG8_BAR; }
        E(acc, cur, wr, wc, fr, fq); S.done(cur);
        if (!has_next) break;
#pragma unroll
        for (int a = 0; a < 2; ++a)
#pragma unroll
            for (int b = 0; b < 2; ++b)
#pragma unroll
                for (int m = 0; m < 4; ++m)
#pragma unroll
                    for (int n = 0; n < 2; ++n) acc[a][b][m][n] = (f32x4){0.f, 0.f, 0.f, 0.f};
        cur = nxt; cA = nA; cB = nB; ++ui;
        if constexpr (ALIGN_EPI) { if (wr == 1) PG8_BAR; }
    }
    PG8_WAIT_V(0);
    if constexpr (!ALIGN_EPI) { if (wr == 0) PG8_BAR; }
    PG8_BAR;
#undef PG8_SA
#undef PG8_SB
#undef PG8_STAGE
#undef PG8_LDA
#undef PG8_LDB
#undef PG8_MMA
#undef PG8_WAIT_V
#undef PG8_WAIT_L
#undef PG8_BAR
#undef PG8_SCHED
}

__device__ __forceinline__ u32x4 pack8(const f32x4 v0, const f32x4 v1) { u32x4 w; w.x = cvt_pk_bf16(v0[0], v0[1]); w.y = cvt_pk_bf16(v0[2], v0[3]); w.z = cvt_pk_bf16(v1[0], v1[1]); w.w = cvt_pk_bf16(v1[2], v1[3]); return w; }

struct EpiProj {
    static constexpr bool PERM = true;
    bf16_t *pa, *pb, *pc;
    __device__ __forceinline__ void operator()(const f32x4 (&acc)[2][2][4][2], const Unit& u, int wr, int wc, int fr, int fq) const {
        bf16_t* base; int ldc, colt;
        if (u.pn < 4) { base = pa; ldc = 1024; colt = u.pn * 256; } else if (u.pn < 8) { base = pb; ldc = 1024; colt = (u.pn - 4) * 256; } else { base = pc; ldc = 768; colt = (u.pn - 8) * 256; }
        const int row0 = u.pm * BM + wr * 64 + fr, col0 = colt + wc * 32 + 8 * fq;
#pragma unroll
        for (int ai = 0; ai < 2; ++ai)
#pragma unroll
            for (int m = 0; m < 4; ++m) { bf16_t* rowp = base + (size_t)(row0 + ai * HALF + m * 16) * ldc + col0;
#pragma unroll
                for (int bj = 0; bj < 2; ++bj) *(u32x4*)(rowp + bj * HALF) = pack8(acc[ai][bj][m][0], acc[ai][bj][m][1]); }
    }
};
struct EpiPlain {
    static constexpr bool PERM = true;
    bf16_t* O; int ldc;
    __device__ __forceinline__ void operator()(const f32x4 (&acc)[2][2][4][2], const Unit& u, int wr, int wc, int fr, int fq) const {
        const int row0 = u.pm * BM + wr * 64 + fr, col0 = u.pn * BM + wc * 32 + 8 * fq;
#pragma unroll
        for (int ai = 0; ai < 2; ++ai)
#pragma unroll
            for (int m = 0; m < 4; ++m) { bf16_t* rowp = O + (size_t)(row0 + ai * HALF + m * 16) * ldc + col0;
#pragma unroll
                for (int bj = 0; bj < 2; ++bj) *(u32x4*)(rowp + bj * HALF) = pack8(acc[ai][bj][m][0], acc[ai][bj][m][1]); }
    }
};
struct EpiRes {
    static constexpr bool PERM = false;
    const float* base; float* out;
    __device__ __forceinline__ void operator()(const f32x4 (&acc)[2][2][4][2], const Unit& u, int wr, int wc, int fr, int fq) const {
        const int row0 = u.pm * BM + wr * 64 + fr, col0 = u.pn * BM + wc * 32 + 4 * fq;
#pragma unroll
        for (int ai = 0; ai < 2; ++ai)
#pragma unroll
            for (int m = 0; m < 4; ++m) { const size_t off = (size_t)(row0 + ai * HALF + m * 16) * 1024 + col0;
#pragma unroll
                for (int bj = 0; bj < 2; ++bj)
#pragma unroll
                    for (int n = 0; n < 2; ++n) { const f32x4 bs = *(const f32x4*)(base + off + bj * HALF + n * 16); *(f32x4*)(out + off + bj * HALF + n * 16) = bs + acc[ai][bj][m][n]; } }
    }
};
struct EpiSwiGLU {
    static constexpr bool PERM = true;
    bf16_t* act;
    __device__ __forceinline__ void operator()(const f32x4 (&acc)[2][2][4][2], const Unit& u, int wr, int wc, int fr, int fq) const {
        const int row0 = u.pm * BM + wr * 64 + fr, col0 = u.pn * 128 + wc * 32 + 8 * fq;
#pragma unroll
        for (int ai = 0; ai < 2; ++ai)
#pragma unroll
            for (int m = 0; m < 4; ++m) { f32x4 o[2];
#pragma unroll
                for (int n = 0; n < 2; ++n)
#pragma unroll
                    for (int i = 0; i < 4; ++i) { const float gt = acc[ai][0][m][n][i], up = acc[ai][1][m][n][i]; o[n][i] = gt * up * __builtin_amdgcn_rcpf(1.f + __expf(-gt)); }
                *(u32x4*)(act + (size_t)(row0 + ai * HALF + m * 16) * D_FF + col0) = pack8(o[0], o[1]); }
    }
};
}

struct Params { const void* in[27]; float* out; unsigned char* ws; };
enum { I_X = 0, I_POS, I_ATTN_NORM, I_W_IN, I_W_OUT, I_MU, I_W0, I_W2, I_A0, I_A2, I_G2, I_KK, I_KA, I_RK, I_GNW, I_GNB, I_V0, I_V1, I_V2,
       I_QNORM, I_KVNORM, I_WQUP, I_WKVUP, I_FFN_NORM, I_WGU, I_WDN, I_FINAL };

__device__ __forceinline__ void transpose_item(const float* W, int K, int N, bf16_t* WT, int mode, LAS float* scr, int item, int lane) {
    const int nblk = N / 32, kb = item / nblk, nb = item % nblk, k0 = 64 * kb, n0 = 32 * nb;
    int d0 = n0;
    if (mode == 1) d0 = (n0 < 896) ? n0 : n0 + 128;
    else if (mode == 2) { const int j = (n0 < D_FF) ? n0 : n0 - D_FF; d0 = 256 * (j >> 7) + (j & 127) + ((n0 < D_FF) ? 0 : 128); }
    float wv[32];
#pragma unroll
    for (int i = 0; i < 32; ++i) wv[i] = W[(size_t)(k0 + 2 * i + (lane >> 5)) * N + n0 + (lane & 31)];
#pragma unroll
    for (int i = 0; i < 32; ++i) scr[(2 * i + (lane >> 5)) * 33 + (lane & 31)] = wv[i];
    asm volatile("s_waitcnt lgkmcnt(0)" ::: "memory");
    const int c = lane & 7;
#pragma unroll
    for (int j = 0; j < 4; ++j) { const int n = (lane >> 3) + 8 * j; const LAS float* s = scr + (8 * c) * 33 + n;
        u32x4 o; o.x = cvt_pk_bf16(s[0 * 33], s[1 * 33]); o.y = cvt_pk_bf16(s[2 * 33], s[3 * 33]); o.z = cvt_pk_bf16(s[4 * 33], s[5 * 33]); o.w = cvt_pk_bf16(s[6 * 33], s[7 * 33]);
        *(u32x4*)(WT + (size_t)(d0 + n) * K + k0 + 8 * c) = o; }
    asm volatile("s_waitcnt lgkmcnt(0)" ::: "memory");
}

__device__ __forceinline__ void rms_rows2_bf16(const float* __restrict__ x0row, const float* __restrict__ x1row, const float* __restrict__ g, bf16_t* __restrict__ o0row, bf16_t* __restrict__ o1row, int lane) {
    const f32x4* xa = (const f32x4*)x0row + lane; const f32x4* xb = (const f32x4*)x1row + lane; const f32x4* gr = (const f32x4*)g + lane;
    f32x4 va[4], vb[4]; float sa = 0.f, sb = 0.f;
#pragma unroll
    for (int j = 0; j < 4; ++j) { va[j] = xa[64 * j]; vb[j] = xb[64 * j]; }
#pragma unroll
    for (int j = 0; j < 4; ++j) { sa += (va[j].x * va[j].x + va[j].y * va[j].y) + (va[j].z * va[j].z + va[j].w * va[j].w); sb += (vb[j].x * vb[j].x + vb[j].y * vb[j].y) + (vb[j].z * vb[j].z + vb[j].w * vb[j].w); }
    const float ra = rsqrtf(wave_sum(sa) * (1.f / 1024.f) + NORM_EPS), rb = rsqrtf(wave_sum(sb) * (1.f / 1024.f) + NORM_EPS);
    u32x2* oa = (u32x2*)o0row + lane; u32x2* ob = (u32x2*)o1row + lane;
#pragma unroll
    for (int j = 0; j < 4; ++j) { const f32x4 gg = gr[64 * j]; u32x2 w;
        w.x = cvt_pk_bf16(va[j].x * ra * gg.x, va[j].y * ra * gg.y); w.y = cvt_pk_bf16(va[j].z * ra * gg.z, va[j].w * ra * gg.w); oa[64 * j] = w;
        w.x = cvt_pk_bf16(vb[j].x * rb * gg.x, vb[j].y * rb * gg.y); w.y = cvt_pk_bf16(vb[j].z * rb * gg.z, vb[j].w * rb * gg.w); ob[64 * j] = w; }
}
__device__ __forceinline__ void rms_row_bf16(const float* xrow, const float* g, bf16_t* orow, int lane) {
    const f32x4* xr = (const f32x4*)xrow + lane; const f32x4* gr = (const f32x4*)g + lane;
    f32x4 v[4]; float s = 0.f;
#pragma unroll
    for (int j = 0; j < 4; ++j) { v[j] = xr[64 * j]; s += (v[j].x * v[j].x + v[j].y * v[j].y) + (v[j].z * v[j].z + v[j].w * v[j].w); }
    const float rstd = rsqrtf(wave_sum(s) * (1.f / 1024.f) + NORM_EPS);
    u32x2* o8 = (u32x2*)orow + lane;
#pragma unroll
    for (int j = 0; j < 4; ++j) { const f32x4 gg = gr[64 * j]; u32x2 w; w.x = cvt_pk_bf16(v[j].x * rstd * gg.x, v[j].y * rstd * gg.y); w.y = cvt_pk_bf16(v[j].z * rstd * gg.z, v[j].w * rstd * gg.w); o8[64 * j] = w; }
}

constexpr int KROW = 104, VROW = 72;
constexpr int ATT_KB = 64 * KROW * 2, ATT_VB = 64 * VROW * 2;
constexpr int ATT_SCR = 2 * (ATT_KB + ATT_VB);

__device__ __forceinline__ void att_unit(LAS unsigned char* lds, int b, int h, int qb, const bf16_t* __restrict__ q, const bf16_t* __restrict__ kvb, const bf16_t* __restrict__ kr,
                                         const float* __restrict__ cosM, const float* __restrict__ sinM, bf16_t* __restrict__ mix) {
    const int tid = tid_opaque(), lane = tid & 63, w = tid >> 6, r32 = lane & 31, hi = lane >> 5;
    LAS float* scr = (LAS float*)(lds + ATT_SCR) + w * 32;
    const int qrow = qb * 256 + w * 32 + r32; const size_t tok = (size_t)b * SEQ + qrow;
    bf16x8 qf[6];
    {
        const bf16_t* qp = q + tok * 768 + h * 96 + hi * 8;
#pragma unroll
        for (int d0 = 0; d0 < 4; ++d0) qf[d0] = *(const bf16x8*)(qp + d0 * 16);
        const u32x4 x1 = *(const u32x4*)(qp + 64), x2 = *(const u32x4*)(qp + 80);
        const f32x4 c0 = *(const f32x4*)(cosM + tok * 16 + hi * 8), c1 = *(const f32x4*)(cosM + tok * 16 + hi * 8 + 4);
        const f32x4 s0 = *(const f32x4*)(sinM + tok * 16 + hi * 8), s1 = *(const f32x4*)(sinM + tok * 16 + hi * 8 + 4);
        float a[8], bb[8], cs[8] = {c0.x, c0.y, c0.z, c0.w, c1.x, c1.y, c1.z, c1.w}, sn[8] = {s0.x, s0.y, s0.z, s0.w, s1.x, s1.y, s1.z, s1.w};
#pragma unroll
        for (int j = 0; j < 4; ++j) { a[2 * j] = bflo(x1[j]); a[2 * j + 1] = bfhi(x1[j]); bb[2 * j] = bflo(x2[j]); bb[2 * j + 1] = bfhi(x2[j]); }
        u32x4 o1, o2;
#pragma unroll
        for (int j = 0; j < 4; ++j) {
            o1[j] = cvt_pk_bf16(a[2 * j] * cs[2 * j] - bb[2 * j] * sn[2 * j], a[2 * j + 1] * cs[2 * j + 1] - bb[2 * j + 1] * sn[2 * j + 1]);
            o2[j] = cvt_pk_bf16(bb[2 * j] * cs[2 * j] + a[2 * j] * sn[2 * j], bb[2 * j + 1] * cs[2 * j + 1] + a[2 * j + 1] * sn[2 * j + 1]); }
        qf[4] = __builtin_bit_cast(bf16x8, o1); qf[5] = __builtin_bit_cast(bf16x8, o2);
    }
    const int k_key = tid >> 3, k_ch = tid & 7;
    const int r_key = (tid & 255) >> 2, r_ch = tid & 3;
    const bf16_t* kn_src = kvb + ((size_t)b * SEQ + k_key) * 1024 + h * 128 + k_ch * 8;
    const bf16_t* kr_src = kr + ((size_t)b * SEQ + r_key) * 32 + r_ch * 8;
    const int kn_dst = (k_key * KROW + k_ch * 8) * 2, kr_dst = (r_key * KROW + 64 + r_ch * 8) * 2, vt_dst = (k_ch * 8 * VROW + k_key) * 2;
#define ATT_VWRITE(bufoff, gv) do { LAS bf16_t* vd_ = (LAS bf16_t*)(lds + 2 * ATT_KB + (bufoff) + vt_dst); _Pragma("unroll") for (int j_ = 0; j_ < 4; ++j_) { \
        vd_[(2 * j_) * VROW] = (bf16_t)((gv)[j_] & 0xffffu); vd_[(2 * j_ + 1) * VROW] = (bf16_t)((gv)[j_] >> 16); } } while (0)
    const int ntiles = 4 * qb + 4;
    u32x4 gk, gr, gv;
    gk = *(const u32x4*)kn_src; gv = *(const u32x4*)(kn_src + 64); if (tid < 256) gr = *(const u32x4*)kr_src;
    *(LAS u32x4*)(lds + kn_dst) = gk; ATT_VWRITE(0, gv); if (tid < 256) *(LAS u32x4*)(lds + kr_dst) = gr;
    __syncthreads();
    f32x16 o0, o1;
#pragma unroll
    for (int r = 0; r < 16; ++r) { o0[r] = 0.f; o1[r] = 0.f; }
    float mrow = -1e30f, lrow = 0.f;
    const float SC = 0.10206207261596577f * 1.4426950408889634f;
    const int wq0 = qb * 256 + w * 32;
    for (int kt = 0; kt < ntiles; ++kt) {
        const int cur = kt & 1;
        if (kt + 1 < ntiles) { const size_t ko = (size_t)(kt + 1) * 64; gk = *(const u32x4*)(kn_src + ko * 1024); gv = *(const u32x4*)(kn_src + ko * 1024 + 64); if (tid < 256) gr = *(const u32x4*)(kr_src + ko * 32); }
        const int k0 = kt * 64;
        if (k0 <= wq0 + 31) {
            const LAS unsigned char* Kb = lds + cur * ATT_KB; const LAS unsigned char* Vb = lds + 2 * ATT_KB + cur * ATT_VB;
            f32x16 p0, p1;
#pragma unroll
            for (int r = 0; r < 16; ++r) { p0[r] = 0.f; p1[r] = 0.f; }
#pragma unroll
            for (int d0 = 0; d0 < 6; ++d0) {
                const bf16x8 k0f = *(const LAS bf16x8*)(Kb + (r32 * KROW + d0 * 16 + hi * 8) * 2);
                const bf16x8 k1f = *(const LAS bf16x8*)(Kb + ((32 + r32) * KROW + d0 * 16 + hi * 8) * 2);
                p0 = MFMA32(k0f, qf[d0], p0); p1 = MFMA32(k1f, qf[d0], p1);
            }
            const bool need_mask = (k0 + 63 > wq0);
            float mx = -1e30f;
            if (need_mask) {
#pragma unroll
                for (int r = 0; r < 16; ++r) { const int key = k0 + crow(r, hi); if (key > qrow) p0[r] = -1e30f; if (key + 32 > qrow) p1[r] = -1e30f; }
            }
#pragma unroll
            for (int r = 0; r < 16; ++r) mx = fmaxf(mx, fmaxf(p0[r], p1[r]));
            mx = fmaxf(mx, __shfl_xor(mx, 32)) * SC;
            const bool grew = __any(mx > mrow + 8.f);
            const float mnew = grew ? fmaxf(mrow, mx) : mrow;
            const float alpha = __builtin_amdgcn_exp2f(mrow - mnew); mrow = mnew;
            float ls = 0.f;
#pragma unroll
            for (int r = 0; r < 16; ++r) { p0[r] = __builtin_amdgcn_exp2f(__builtin_fmaf(p0[r], SC, -mnew)); p1[r] = __builtin_amdgcn_exp2f(__builtin_fmaf(p1[r], SC, -mnew)); ls += p0[r] + p1[r]; }
            lrow = lrow * alpha + ls;
            if (grew) {
                if (hi == 0) scr[r32] = alpha;
                asm volatile("s_waitcnt lgkmcnt(0)" ::: "memory");
#pragma unroll
                for (int i = 0; i < 4; ++i) { const f32x4 al = *(const LAS f32x4*)(scr + 8 * i + 4 * hi);
#pragma unroll
                    for (int j = 0; j < 4; ++j) { o0[4 * i + j] *= al[j]; o1[4 * i + j] *= al[j]; } }
                asm volatile("s_waitcnt lgkmcnt(0)" ::: "memory");
            }
#pragma unroll
            for (int s = 0; s < 4; ++s) {
                u32x4 pw;
#pragma unroll
                for (int j = 0; j < 4; ++j) pw[j] = (s < 2) ? cvt_pk_bf16(p0[8 * (s & 1) + 2 * j], p0[8 * (s & 1) + 2 * j + 1]) : cvt_pk_bf16(p1[8 * (s & 1) + 2 * j], p1[8 * (s & 1) + 2 * j + 1]);
                const bf16x8 pa = __builtin_bit_cast(bf16x8, pw);
#pragma unroll
                for (int dvh = 0; dvh < 2; ++dvh) {
                    const LAS unsigned char* vp = Vb + ((dvh * 32 + r32) * VROW + 16 * s + 4 * hi) * 2;
                    const u32x2 lo = *(const LAS u32x2*)vp, hh = *(const LAS u32x2*)(vp + 16);
                    u32x4 vv; vv.x = lo.x; vv.y = lo.y; vv.z = hh.x; vv.w = hh.y;
                    if (dvh == 0) o0 = MFMA32(pa, __builtin_bit_cast(bf16x8, vv), o0); else o1 = MFMA32(pa, __builtin_bit_cast(bf16x8, vv), o1);
                }
            }
        }
        if (kt + 1 < ntiles) { const int nx = cur ^ 1; *(LAS u32x4*)(lds + nx * ATT_KB + kn_dst) = gk; ATT_VWRITE(nx * ATT_VB, gv); if (tid < 256) *(LAS u32x4*)(lds + nx * ATT_KB + kr_dst) = gr; }
        __syncthreads();
    }
    float lt = lrow + __shfl_xor(lrow, 32);
    if (hi == 0) scr[r32] = 1.f / lt;
    asm volatile("s_waitcnt lgkmcnt(0)" ::: "memory");
#pragma unroll
    for (int i = 0; i < 4; ++i) { const f32x4 il = *(const LAS f32x4*)(scr + 8 * i + 4 * hi);
#pragma unroll
        for (int j = 0; j < 4; ++j) { const int r = 4 * i + j; const size_t orow = (size_t)b * SEQ + qb * 256 + w * 32 + crow(r, hi);
            mix[orow * 1024 + 512 + h * 64 + r32] = f2bf(o0[r] * il[j]); mix[orow * 1024 + 512 + h * 64 + 32 + r32] = f2bf(o1[r] * il[j]); } }
    asm volatile("s_waitcnt lgkmcnt(0)" ::: "memory");
}

__device__ __forceinline__ void ret_unit(LAS unsigned char* lds, int b, int h, int jb, const bf16_t* __restrict__ pb, const float* __restrict__ cosR, const float* __restrict__ sinR,
                                         const bf16_t* __restrict__ rprev, float* __restrict__ yb) {
    const int tid = tid_opaque(), lane = tid & 63, w = tid >> 6, r32 = lane & 31, hi = lane >> 5;
    const float lg2 = log2f(1.f - exp2f(-5.f - (float)h));
    const int qrow = jb * 256 + w * 32 + r32; const size_t tok = (size_t)b * SEQ + qrow;
    const int chunk = qrow >> 7;
    bf16x8 qf[4], qx[4];
    {
        const bf16_t* qp = pb + tok * 1024 + h * 64 + hi * 8;
        const float qdec = exp2f(lg2 * (float)((qrow & 127) + 1));
#pragma unroll
        for (int d0 = 0; d0 < 2; ++d0) {
            const u32x4 x1 = *(const u32x4*)(qp + d0 * 16), x2 = *(const u32x4*)(qp + d0 * 16 + 32);
            const float* cp = cosR + tok * 32 + d0 * 16 + hi * 8; const float* sp = sinR + tok * 32 + d0 * 16 + hi * 8;
            const f32x4 c0 = *(const f32x4*)cp, c1 = *(const f32x4*)(cp + 4), s0 = *(const f32x4*)sp, s1 = *(const f32x4*)(sp + 4);
            const float cs[8] = {c0.x, c0.y, c0.z, c0.w, c1.x, c1.y, c1.z, c1.w}, sn[8] = {s0.x, s0.y, s0.z, s0.w, s1.x, s1.y, s1.z, s1.w};
            u32x4 o1, o2, y1, y2;
#pragma unroll
            for (int j = 0; j < 4; ++j) {
                const float a0 = bflo(x1[j]), a1 = bfhi(x1[j]), b0 = bflo(x2[j]), b1 = bfhi(x2[j]);
                const float r0 = a0 * cs[2 * j] - b0 * sn[2 * j], r1 = a1 * cs[2 * j + 1] - b1 * sn[2 * j + 1];
                const float t0 = b0 * cs[2 * j] + a0 * sn[2 * j], t1 = b1 * cs[2 * j + 1] + a1 * sn[2 * j + 1];
                o1[j] = cvt_pk_bf16(r0, r1); o2[j] = cvt_pk_bf16(t0, t1); y1[j] = cvt_pk_bf16(r0 * qdec, r1 * qdec); y2[j] = cvt_pk_bf16(t0 * qdec, t1 * qdec); }
            qf[d0] = __builtin_bit_cast(bf16x8, o1); qf[d0 + 2] = __builtin_bit_cast(bf16x8, o2); qx[d0] = __builtin_bit_cast(bf16x8, y1); qx[d0 + 2] = __builtin_bit_cast(bf16x8, y2);
        }
    }
    f32x16 o0, o1;
#pragma unroll
    for (int r = 0; r < 16; ++r) { o0[r] = 0.f; o1[r] = 0.f; }
    {
        const bf16_t* rp = rprev + ((size_t)((b * 4 + h) * 32 + chunk)) * 4096;
#pragma unroll
        for (int d0 = 0; d0 < 4; ++d0) {
            const bf16x8 r0 = *(const bf16x8*)(rp + (size_t)r32 * 64 + d0 * 16 + hi * 8), r1 = *(const bf16x8*)(rp + (size_t)(32 + r32) * 64 + d0 * 16 + hi * 8);
            o0 = MFMA32(qx[d0], r0, o0); o1 = MFMA32(qx[d0], r1, o1);
        }
    }
    const int l_key = (tid & 255) >> 2, l_c = tid & 3;
    for (int kt = 0; kt < 4; ++kt) {
        const int k0 = jb * 256 + kt * 64;
        __syncthreads();
        if (tid < 256) {
            const size_t kt_tok = (size_t)b * SEQ + k0 + l_key; const bf16_t* kp = pb + kt_tok * 1024 + 256 + h * 64 + l_c * 8;
            const u32x4 x1 = *(const u32x4*)kp, x2 = *(const u32x4*)(kp + 32);
            const float* cp = cosR + kt_tok * 32 + l_c * 8; const float* sp = sinR + kt_tok * 32 + l_c * 8;
            const f32x4 c0 = *(const f32x4*)cp, c1 = *(const f32x4*)(cp + 4), s0 = *(const f32x4*)sp, s1 = *(const f32x4*)(sp + 4);
            const float cs[8] = {c0.x, c0.y, c0.z, c0.w, c1.x, c1.y, c1.z, c1.w}, sn[8] = {s0.x, s0.y, s0.z, s0.w, s1.x, s1.y, s1.z, s1.w};
            u32x4 o1v, o2v;
#pragma unroll
            for (int j = 0; j < 4; ++j) {
                const float a0 = bflo(x1[j]), a1 = bfhi(x1[j]), b0 = bflo(x2[j]), b1 = bfhi(x2[j]);
                o1v[j] = cvt_pk_bf16((a0 * cs[2 * j] - b0 * sn[2 * j]) * 0.125f, (a1 * cs[2 * j + 1] - b1 * sn[2 * j + 1]) * 0.125f);
                o2v[j] = cvt_pk_bf16((b0 * cs[2 * j] + a0 * sn[2 * j]) * 0.125f, (b1 * cs[2 * j + 1] + a1 * sn[2 * j + 1]) * 0.125f); }
            *(LAS u32x4*)(lds + (l_key * KROW + l_c * 8) * 2) = o1v; *(LAS u32x4*)(lds + (l_key * KROW + 32 + l_c * 8) * 2) = o2v;
        } else {
            const size_t vt_tok = (size_t)b * SEQ + k0 + l_key; const bf16_t* vp = pb + vt_tok * 1024 + 512 + h * 64 + l_c * 16;
            const u32x4 x1 = *(const u32x4*)vp, x2 = *(const u32x4*)(vp + 8);
            LAS bf16_t* vd = (LAS bf16_t*)(lds + 2 * ATT_KB) + l_key;
#pragma unroll
            for (int j = 0; j < 4; ++j) { vd[(l_c * 16 + 2 * j) * VROW] = (bf16_t)(x1[j] & 0xffffu); vd[(l_c * 16 + 2 * j + 1) * VROW] = (bf16_t)(x1[j] >> 16);
                                          vd[(l_c * 16 + 8 + 2 * j) * VROW] = (bf16_t)(x2[j] & 0xffffu); vd[(l_c * 16 + 8 + 2 * j + 1) * VROW] = (bf16_t)(x2[j] >> 16); }
        }
        __syncthreads();
        if ((k0 >> 7) == chunk && k0 <= jb * 256 + w * 32 + 31) {
            const LAS unsigned char* Kb = lds; const LAS unsigned char* Vb = lds + 2 * ATT_KB;
            f32x16 p0, p1;
#pragma unroll
            for (int r = 0; r < 16; ++r) { p0[r] = 0.f; p1[r] = 0.f; }
#pragma unroll
            for (int d0 = 0; d0 < 4; ++d0) {
                const bf16x8 k0f = *(const LAS bf16x8*)(Kb + (r32 * KROW + d0 * 16 + hi * 8) * 2);
                const bf16x8 k1f = *(const LAS bf16x8*)(Kb + ((32 + r32) * KROW + d0 * 16 + hi * 8) * 2);
                p0 = MFMA32(k0f, qf[d0], p0); p1 = MFMA32(k1f, qf[d0], p1);
            }
#pragma unroll
            for (int r = 0; r < 16; ++r) {
                const int df0 = qrow - (k0 + crow(r, hi)), df1 = df0 - 32;
                p0[r] = (df0 >= 0) ? p0[r] * __builtin_amdgcn_exp2f(lg2 * (float)df0) : 0.f;
                p1[r] = (df1 >= 0) ? p1[r] * __builtin_amdgcn_exp2f(lg2 * (float)df1) : 0.f;
            }
#pragma unroll
            for (int s = 0; s < 4; ++s) {
                u32x4 pw;
#pragma unroll
                for (int j = 0; j < 4; ++j) pw[j] = (s < 2) ? cvt_pk_bf16(p0[8 * (s & 1) + 2 * j], p0[8 * (s & 1) + 2 * j + 1]) : cvt_pk_bf16(p1[8 * (s & 1) + 2 * j], p1[8 * (s & 1) + 2 * j + 1]);
                const bf16x8 pa = __builtin_bit_cast(bf16x8, pw);
#pragma unroll
                for (int dvh = 0; dvh < 2; ++dvh) {
                    const LAS unsigned char* vp = Vb + ((dvh * 32 + r32) * VROW + 16 * s + 4 * hi) * 2;
                    const u32x2 lo = *(const LAS u32x2*)vp, hh = *(const LAS u32x2*)(vp + 16);
                    u32x4 vv; vv.x = lo.x; vv.y = lo.y; vv.z = hh.x; vv.w = hh.y;
                    if (dvh == 0) o0 = MFMA32(pa, __builtin_bit_cast(bf16x8, vv), o0); else o1 = MFMA32(pa, __builtin_bit_cast(bf16x8, vv), o1);
                }
            }
        }
    }
#pragma unroll
    for (int r = 0; r < 16; ++r) { const size_t orow = (size_t)b * SEQ + jb * 256 + w * 32 + crow(r, hi);
        yb[orow * 256 + h * 64 + r32] = o0[r]; yb[orow * 256 + h * 64 + 32 + r32] = o1[r]; }
}

__device__ __forceinline__ void ret_kv_unit(LAS unsigned char* lds, int bh, int ci, const bf16_t* __restrict__ pb, const float* __restrict__ cosR, const float* __restrict__ sinR, float* __restrict__ kvt) {
    const int tid = tid_opaque(); const int b = bh >> 2, h = bh & 3;
    LAS float* Ks = (LAS float*)lds;
    LAS float* Vs = Ks + 128 * 64;
    const float lg2 = log2f(1.f - exp2f(-5.f - (float)h));
    __syncthreads();
    {
        const int i = tid & 31; float x1[8], x2[8], cc[8], ss[8];
#pragma unroll
        for (int it = 0; it < 8; ++it) { const int t = (tid >> 5) + 16 * it; const size_t tok = (size_t)b * SEQ + ci * 128 + t;
            x1[it] = bf2f(pb[tok * 1024 + 256 + h * 64 + i]); x2[it] = bf2f(pb[tok * 1024 + 256 + h * 64 + 32 + i]); cc[it] = cosR[tok * 32 + i]; ss[it] = sinR[tok * 32 + i]; }
#pragma unroll
        for (int it = 0; it < 8; ++it) { const int t = (tid >> 5) + 16 * it; const float sc = 0.125f * exp2f(lg2 * (float)(127 - t));
            Ks[t * 64 + i] = (x1[it] * cc[it] - x2[it] * ss[it]) * sc; Ks[t * 64 + 32 + i] = (x2[it] * cc[it] + x1[it] * ss[it]) * sc; }
        u32x4 vr[2];
#pragma unroll
        for (int it = 0; it < 2; ++it) { const int ch = tid + 512 * it, t = ch >> 3, c8 = ch & 7; vr[it] = *(const u32x4*)(pb + ((size_t)b * SEQ + ci * 128 + t) * 1024 + 512 + h * 64 + c8 * 8); }
#pragma unroll
        for (int it = 0; it < 2; ++it) { const int ch = tid + 512 * it, t = ch >> 3, c8 = ch & 7; LAS float* d = Vs + t * 64 + c8 * 8;
            *(LAS f32x4*)d = (f32x4){bflo(vr[it].x), bfhi(vr[it].x), bflo(vr[it].y), bfhi(vr[it].y)}; *(LAS f32x4*)(d + 4) = (f32x4){bflo(vr[it].z), bfhi(vr[it].z), bflo(vr[it].w), bfhi(vr[it].w)}; }
    }
    __syncthreads();
    const int e = tid >> 3, d0 = (tid & 7) * 8;
    float acc[8];
#pragma unroll
    for (int j = 0; j < 8; ++j) acc[j] = 0.f;
    for (int t = 0; t < 128; ++t) {
        const float v = Vs[t * 64 + e]; const f32x4 ka = *(const LAS f32x4*)(Ks + t * 64 + d0), kb = *(const LAS f32x4*)(Ks + t * 64 + d0 + 4);
        acc[0] += v * ka.x; acc[1] += v * ka.y; acc[2] += v * ka.z; acc[3] += v * ka.w; acc[4] += v * kb.x; acc[5] += v * kb.y; acc[6] += v * kb.z; acc[7] += v * kb.w;
    }
    float* o = kvt + ((size_t)(bh * 32 + ci)) * 4096 + e * 64 + d0;
    *(f32x4*)o = (f32x4){acc[0], acc[1], acc[2], acc[3]}; *(f32x4*)(o + 4) = (f32x4){acc[4], acc[5], acc[6], acc[7]};
}

struct PrepW { bf16x8 Bw[2], Ba[2], Bv[2], Bg[2][2], Bv1[2]; };
__device__ __forceinline__ bf16x8 pack_col8(const float* W, int ld, int k0, int n) {
    float t[8];
#pragma unroll
    for (int j = 0; j < 8; ++j) t[j] = W[(size_t)(k0 + j) * ld + n];
    u32x4 o; o.x = cvt_pk_bf16(t[0], t[1]); o.y = cvt_pk_bf16(t[2], t[3]); o.z = cvt_pk_bf16(t[4], t[5]); o.w = cvt_pk_bf16(t[6], t[7]);
    return __builtin_bit_cast(bf16x8, o);
}
__device__ __forceinline__ bf16x8 pack_f8(const f32x4 a, const f32x4 b) {
    u32x4 o; o.x = cvt_pk_bf16(a.x, a.y); o.y = cvt_pk_bf16(a.z, a.w); o.z = cvt_pk_bf16(b.x, b.y); o.w = cvt_pk_bf16(b.z, b.w);
    return __builtin_bit_cast(bf16x8, o);
}
#define MFMA16(a, b, c) __builtin_amdgcn_mfma_f32_16x16x32_bf16((a), (b), (c), 0, 0, 0)
__device__ __forceinline__ void prep_fetch_rows(unsigned (&raw)[17], const bf16_t* __restrict__ pa, int t0, int c2) {
    raw[0] = ((t0 & (SEQ - 1)) == 0) ? 0u : *(const unsigned*)(pa + (size_t)(t0 - 1) * 1024 + c2);
#pragma unroll
    for (int t = 0; t < 16; ++t) raw[t + 1] = *(const unsigned*)(pa + (size_t)(t0 + t) * 1024 + c2);
}
constexpr int PSW = 900;
struct PrepC { float mu0, mu1, w0c, a0c, kkc, kac, rkc, v0c; };
__device__ __forceinline__ void rwkv_prep_tile(LAS unsigned char* lds, int tile, int next_tile, unsigned (&raw)[17], const PrepC& PC, int layer, const Params& P, int z, const PrepW& W, const bf16_t* __restrict__ pa, unsigned char* __restrict__ rec,
                                               bf16_t* __restrict__ vbuf, bf16_t* __restrict__ gbuf, bf16_t* __restrict__ vfirst, float* __restrict__ bs, float* __restrict__ cs) {
    const int tid = tid_opaque(), lane = tid & 63;
    LAS float* PS = (LAS float*)lds;
    LAS float* VV = PS + 16 * PSW;
    const float* mu = (const float*)P.in[I_MU + z] + layer * RW_IN;
    const float* w0 = (const float*)P.in[I_W0 + z] + layer * 256; const float* w2 = (const float*)P.in[I_W2 + z] + layer * 32 * 256;
    const float* a0 = (const float*)P.in[I_A0 + z] + layer * 256; const float* a2 = (const float*)P.in[I_A2 + z] + layer * 32 * 256;
    const float* g2 = (const float*)P.in[I_G2 + z] + layer * 64 * 256;
    const float* k_k = (const float*)P.in[I_KK + z] + layer * 256; const float* k_a = (const float*)P.in[I_KA + z] + layer * 256; const float* r_k = (const float*)P.in[I_RK + z] + layer * 256;
    const float* v0 = (const float*)P.in[I_V0 + z] + (layer > 0 ? (layer - 1) * 256 : 0);
    const float* v1 = (const float*)P.in[I_V1 + z] + (layer > 0 ? (layer - 1) * 256 * 32 : 0);
    const float* v2 = (const float*)P.in[I_V2 + z] + (layer > 0 ? (layer - 1) * 32 * 256 : 0);
    const int t0 = tile * 16;
    __syncthreads();
    if (tid < 448) {
        const int c2 = tid * 2; const float mu0 = PC.mu0, mu1 = PC.mu1;
#pragma unroll
        for (int t = 0; t < 16; ++t) {
            float x0 = bflo(raw[t + 1]), x1 = bfhi(raw[t + 1]); const float y0 = bflo(raw[t]), y1 = bfhi(raw[t]);
            x0 = x0 + (y0 - x0) * mu0; x1 = x1 + (y1 - x1) * mu1;
            if (c2 >= 768) { if (c2 < 800) { x0 = 2.f * sigmoidf_(2.f * x0) - 1.f; x1 = 2.f * sigmoidf_(2.f * x1) - 1.f; } else if (c2 >= 832) { x0 = sigmoidf_(x0); x1 = sigmoidf_(x1); } }
            *(LAS f32x2*)(PS + t * PSW + c2) = (f32x2){x0, x1};
        }
        if (next_tile >= 0) prep_fetch_rows(raw, pa, next_tile * 16, c2);
    }
    if (layer > 0) VV[tid] = 0.f;
    __syncthreads();
    const int wv = tid >> 6, l16 = lane & 15, lq = lane >> 4;
    LAS float* LR = VV + 512;
    const f32x4 zero4 = {0.f, 0.f, 0.f, 0.f};
    if (layer > 0) {
        const LAS float* ap = PS + l16 * PSW + 512 + 32 * wv + 8 * lq;
        const bf16x8 A = pack_f8(*(const LAS f32x4*)ap, *(const LAS f32x4*)(ap + 4));
#pragma unroll
        for (int nt = 0; nt < 2; ++nt) { const f32x4 d = MFMA16(A, W.Bv1[nt], zero4);
#pragma unroll
            for (int r = 0; r < 4; ++r) (void)__builtin_amdgcn_ds_faddf(VV + (4 * lq + r) * 32 + 16 * nt + l16, d[r], 0, 0, false); }
        __syncthreads();
    }
    {
        const LAS float* ap = PS + l16 * PSW + 768 + 8 * lq;
        const bf16x8 Aw = pack_f8(*(const LAS f32x4*)ap, *(const LAS f32x4*)(ap + 4)), Aa = pack_f8(*(const LAS f32x4*)(ap + 32), *(const LAS f32x4*)(ap + 36));
        const bf16x8 Ag0 = pack_f8(*(const LAS f32x4*)(ap + 64), *(const LAS f32x4*)(ap + 68)), Ag1 = pack_f8(*(const LAS f32x4*)(ap + 96), *(const LAS f32x4*)(ap + 100));
        bf16x8 Av = Aw;
        if (layer > 0) { const LAS float* vp = VV + l16 * 32 + 8 * lq; Av = pack_f8(*(const LAS f32x4*)vp, *(const LAS f32x4*)(vp + 4)); }
#pragma unroll
        for (int nt = 0; nt < 2; ++nt) {
            const f32x4 dw = MFMA16(Aw, W.Bw[nt], zero4), da = MFMA16(Aa, W.Ba[nt], zero4);
            f32x4 dg = MFMA16(Ag0, W.Bg[nt][0], zero4); dg = MFMA16(Ag1, W.Bg[nt][1], dg);
            f32x4 dv = zero4; if (layer > 0) dv = MFMA16(Av, W.Bv[nt], zero4);
            const int ch = 16 * (2 * wv + nt) + l16;
#pragma unroll
            for (int r = 0; r < 4; ++r) { LAS float* o = LR + (4 * lq + r) * 256 + ch; o[0] = dw[r]; o[4096] = da[r]; o[8192] = dg[r]; o[12288] = dv[r]; }
        }
    }
    __syncthreads();
    const int c = tid & 255, th = tid >> 8;
    float aw[8], aa[8], ag[8], av[8];
#pragma unroll
    for (int i = 0; i < 8; ++i) { const LAS float* o = LR + (th * 8 + i) * 256 + c; aw[i] = o[0]; aa[i] = o[4096]; ag[i] = o[8192]; av[i] = o[12288]; }
    const float w0c = PC.w0c, a0c = PC.a0c, kkc = PC.kkc, kac = PC.kac, rkc = PC.rkc, v0c = PC.v0c;
    const int head = c >> 6, kq = (c & 63) >> 2, e = c & 3;
    float kk_[8], b_[8], kp_[8], dec_[8], r_[8], v_[8], a_[8], q_[8];
#pragma unroll
    for (int i = 0; i < 8; ++i) {
        const int t = th * 8 + i; const size_t tok = (size_t)t0 + t;
        const float r = PS[t * PSW + c], k = PS[t * PSW + 256 + c]; float v = PS[t * PSW + 512 + c];
        dec_[i] = __expf(-0.6065306597126334f * sigmoidf_(w0c + aw[i]));
        const float a = sigmoidf_(a0c + aa[i]);
        if (layer > 0) { const float vf = bf2f(vfirst[tok * 256 + c]); v = v + (vf - v) * sigmoidf_(v0c + av[i]); }
        else vfirst[tok * 256 + c] = f2bf(v);
        r_[i] = r; v_[i] = v; a_[i] = a; kk_[i] = k * kkc; kp_[i] = k * (1.f + (a - 1.f) * kac);
        q_[i] = kk_[i] * kk_[i];
    }
#pragma unroll
    for (int i = 0; i < 8; ++i) q_[i] = wave_sum(q_[i]);
#pragma unroll
    for (int i = 0; i < 8; ++i) { kk_[i] *= rsqrtf(fmaxf(q_[i], 1e-24f)); b_[i] = kk_[i] * a_[i]; q_[i] = r_[i] * kp_[i] * rkc; }
#pragma unroll
    for (int i = 0; i < 8; ++i) q_[i] = wave_sum(q_[i]);
    float d1_[4], d2_[4];
#pragma unroll
    for (int j = 0; j < 4; ++j) { d1_[j] = b_[2 * j] * kk_[2 * j + 1]; d2_[j] = kp_[2 * j] * kk_[2 * j + 1]; }
#pragma unroll
    for (int j = 0; j < 4; ++j) { d1_[j] = wave_sum(d1_[j]); d2_[j] = wave_sum(d2_[j]); }
#pragma unroll
    for (int i = 0; i < 8; ++i) {
        const int t = th * 8 + i; const size_t tok = (size_t)t0 + t;
        const size_t ri = tok * 256 + c;
        ((float*)rec)[ri] = dec_[i]; ((bf16_t*)(rec + 16 * MiB))[ri] = f2bf(r_[i]); ((bf16_t*)(rec + 24 * MiB))[ri] = f2bf(kp_[i]); ((bf16_t*)(rec + 40 * MiB))[ri] = f2bf(b_[i]);
        if ((i & 1) == 0) ((bf16_t*)(rec + 32 * MiB))[ri] = f2bf(-kk_[i]);
        else {
            ((bf16_t*)(rec + 32 * MiB))[ri] = f2bf(kk_[i - 1] * d1_[i >> 1] - dec_[i - 1] * kk_[i]);
            if (lane == 0) cs[tok * 4 + head] = -d2_[i >> 1];
        }
        vbuf[tok * 256 + c] = f2bf(v_[i]); gbuf[tok * 256 + c] = f2bf(ag[i]);
        if (lane == 0) bs[tok * 4 + head] = q_[i];
    }
}

constexpr int SC_TC = 32;
constexpr int SC_REC_F = SC_TC * 16 * 20;
constexpr int SC_V_F = SC_TC * 20;
__device__ __forceinline__ void scan_load_chunk(LAS float* recb, LAS float* vb, const unsigned char* __restrict__ rec, const bf16_t* __restrict__ vbuf, const float* __restrict__ cs, size_t tok0, int h, int v0, int lt) {
#pragma unroll
    for (int it = 0; it < 2; ++it) {
        const int p = lt + it * 256, step = p >> 4, kq = p & 15;
        const size_t ri = (tok0 + step) * 256 + h * 64 + 4 * kq;
        const f32x4 wv = *(const f32x4*)((const float*)rec + ri);
        const u32x2 rr = *(const u32x2*)((const bf16_t*)(rec + 16 * MiB) + ri), kk2 = *(const u32x2*)((const bf16_t*)(rec + 24 * MiB) + ri);
        const u32x2 nn = *(const u32x2*)((const bf16_t*)(rec + 32 * MiB) + ri), bb = *(const u32x2*)((const bf16_t*)(rec + 40 * MiB) + ri);
        const u32x4 a = {rr.x, rr.y, kk2.x, kk2.y}, bq = {nn.x, nn.y, bb.x, bb.y};
        LAS float* d = recb + (step * 16 + kq) * 20;
        *(LAS f32x4*)d = wv;
        *(LAS f32x4*)(d + 4) = (f32x4){bflo(a.x), bfhi(a.x), bflo(a.y), bfhi(a.y)};
        *(LAS f32x4*)(d + 8) = (f32x4){bflo(a.z), bfhi(a.z), bflo(a.w), bfhi(a.w)};
        *(LAS f32x4*)(d + 12) = (f32x4){bflo(bq.x), bfhi(bq.x), bflo(bq.y), bfhi(bq.y)};
        *(LAS f32x4*)(d + 16) = (f32x4){bflo(bq.z), bfhi(bq.z), bflo(bq.w), bfhi(bq.w)};
    }
    if (lt < 128) { const int step = lt >> 2, qd = lt & 3;
        const u32x2 x = *(const u32x2*)(vbuf + (tok0 + step) * 256 + h * 64 + v0 + 4 * qd);
        *(LAS f32x4*)(vb + step * 20 + 4 * qd) = (f32x4){bflo(x.x), bfhi(x.x), bflo(x.y), bfhi(x.y)}; }
    else if (lt < 128 + SC_TC) { const int step = lt - 128; vb[step * 20 + 16] = cs[(tok0 + step) * 4 + h]; }
}
__device__ __forceinline__ void rwkv_scan_block(LAS unsigned char* lds, int blk, const unsigned char* __restrict__ rec, const bf16_t* __restrict__ vbuf, const float* __restrict__ cs, float* __restrict__ ya) {
    const int tid = tid_opaque(), lane = tid & 63, w = tid >> 6;
    const int bh = blk >> 2, b = bh >> 2, h = bh & 3, v0 = (blk & 3) * 16;
    LAS float* RECB = (LAS float*)lds;
    LAS float* VB = RECB + 2 * SC_REC_F;
    const size_t tokb = (size_t)b * SEQ;
    const int rowl = lane >> 4, kq = lane & 15, row = v0 + 4 * (w & 3) + rowl;
    f32x2 Sa = {0.f, 0.f}, Sb = {0.f, 0.f}; float ykeep = 0.f;
    if (w < 4) __builtin_amdgcn_s_setprio(3);
    __syncthreads();
    if (w >= 4) scan_load_chunk(RECB, VB, rec, vbuf, cs, tokb, h, v0, tid - 256);
    for (int c = 0; c < SEQ / SC_TC; ++c) {
        __syncthreads();
        const int buf = c & 1;
        if (w >= 4) { if (c + 1 < SEQ / SC_TC) scan_load_chunk(RECB + (buf ^ 1) * SC_REC_F, VB + (buf ^ 1) * SC_V_F, rec, vbuf, cs, tokb + (size_t)(c + 1) * SC_TC, h, v0, tid - 256); }
        else {
            const LAS float* rb = RECB + buf * SC_REC_F + kq * 20; const LAS float* vb = VB + buf * SC_V_F;
            float* yo = ya + (tokb + (size_t)c * SC_TC + kq) * 256 + h * 64 + row;
#define SC_LD(P, st) do { const LAS float* R_ = rb + (st) * 320; P##w = *(const LAS f32x4*)R_; P##r = *(const LAS f32x4*)(R_ + 4); P##k = *(const LAS f32x4*)(R_ + 8); \
                          P##n = *(const LAS f32x4*)(R_ + 12); P##b = *(const LAS f32x4*)(R_ + 16); P##v = vb[(st) * 20 + 4 * w + rowl]; } while (0)
#define LO2(q_) ((f32x2){(q_).x, (q_).y})
#define HI2(q_) ((f32x2){(q_).z, (q_).w})
            f32x4 Aw, Ar, Ak, An, Ab, Bw, Br, Bk, Bn, Bb, Cw, Cr, Ck, Cn, Cb, Dw, Dr, Dk, Dn, Db; float Av, Bv, Cv, Dv, Bc, Dc;
            SC_LD(A, 0); SC_LD(B, 1); Bc = vb[1 * 20 + 16];
#pragma unroll
            for (int st = 0; st < SC_TC; st += 4) {
                if (st + 2 < SC_TC) { SC_LD(C, st + 2); SC_LD(D, st + 3); Dc = vb[(st + 3) * 20 + 16]; }
#define SC_PAIR(E, O, Oc, S0) do { \
                f32x2 d0 = Sa * LO2(E##n); d0 = Sb * HI2(E##n) + d0; f32x2 d1 = Sa * LO2(O##n); d1 = Sb * HI2(O##n) + d1; \
                const f32x2 ve = {E##v, E##v}, vo = {O##v, O##v}; \
                f32x2 ta = ve * LO2(E##k), tb = ve * HI2(E##k); ta = Sa * LO2(E##w) + ta; tb = Sb * HI2(E##w) + tb; \
                const float sa0 = allreduce16(d0.x + d0.y); const float sa1 = allreduce16(d1.x + d1.y) + E##v * Oc; \
                const f32x2 s0 = {sa0, sa0}, s1 = {sa1, sa1}; \
                Sa = s0 * LO2(E##b) + ta; Sb = s0 * HI2(E##b) + tb; \
                f32x2 e0 = Sa * LO2(E##r); e0 = Sb * HI2(E##r) + e0; \
                f32x2 ua = vo * LO2(O##k), ub = vo * HI2(O##k); ua = Sa * LO2(O##w) + ua; ub = Sb * HI2(O##w) + ub; \
                Sa = s1 * LO2(O##b) + ua; Sb = s1 * HI2(O##b) + ub; \
                f32x2 e1 = Sa * LO2(O##r); e1 = Sb * HI2(O##r) + e1; \
                Y0 = e0.x + e0.y; Y1 = e1.x + e1.y; } while (0)
                float yp0, yp1, yp2, yp3;
#define Y0 yp0
#define Y1 yp1
                SC_PAIR(A, B, Bc, st);
#undef Y0
#undef Y1
                if (st + 4 < SC_TC) { SC_LD(A, st + 4); SC_LD(B, st + 5); Bc = vb[(st + 5) * 20 + 16]; }
#define Y0 yp2
#define Y1 yp3
                SC_PAIR(C, D, Dc, st + 2);
#undef Y0
#undef Y1
                {
                    const unsigned long long b0 = 0xAAAAAAAAAAAAAAAAull, b1 = 0xCCCCCCCCCCCCCCCCull;
                    float s01, x01, s23, x23;
                    asm volatile("v_cndmask_b32_e64 %0, %1, %2, %3" : "=v"(s01) : "v"(yp0), "v"(yp1), "s"(b0));
                    asm volatile("v_cndmask_b32_e64 %0, %1, %2, %3" : "=v"(x01) : "v"(yp1), "v"(yp0), "s"(b0));
                    asm volatile("v_cndmask_b32_e64 %0, %1, %2, %3" : "=v"(s23) : "v"(yp2), "v"(yp3), "s"(b0));
                    asm volatile("v_cndmask_b32_e64 %0, %1, %2, %3" : "=v"(x23) : "v"(yp3), "v"(yp2), "s"(b0));
                    const float a01 = s01 + dpp_mov<0xB1>(x01), a23 = s23 + dpp_mov<0xB1>(x23);
                    float sq, xq;
                    asm volatile("v_cndmask_b32_e64 %0, %1, %2, %3" : "=v"(sq) : "v"(a01), "v"(a23), "s"(b1));
                    asm volatile("v_cndmask_b32_e64 %0, %1, %2, %3" : "=v"(xq) : "v"(a23), "v"(a01), "s"(b1));
                    float yq = sq + dpp_mov<0x4E>(xq);
                    yq += dpp_mov<0x128>(yq); yq += dpp_mov<0x124>(yq);
                    const unsigned long long mk = 0x000F000F000F000Full << (st & 15);
                    asm volatile("v_cndmask_b32_e64 %0, %0, %1, %2" : "+v"(ykeep) : "v"(yq), "s"(mk));
                }
                if ((st & 15) == 12) yo[(size_t)(st - 12) * 256] = ykeep;
            }
#undef SC_PAIR
#undef SC_LD
#undef LO2
#undef HI2
        }
    }
    __builtin_amdgcn_s_setprio(0);
}

#define XB_TMO      128
#define XB_XCNT(j)  (256  + 64 * (j))
#define XB_XSUB(j)  (1280 + 64 * (j))
#define XB_XGEN(j)  (2304 + 64 * (j))
#define XB_TOP      3328
#define XB_TOPGEN   3392
#define XB_SPIN_CAP (1u << 20)
__device__ __forceinline__ unsigned xb_ld(unsigned* p)              { return __hip_atomic_load(p, __ATOMIC_RELAXED, __HIP_MEMORY_SCOPE_AGENT); }
__device__ __forceinline__ unsigned xb_add(unsigned* p, unsigned v) { return __hip_atomic_fetch_add(p, v, __ATOMIC_RELAXED, __HIP_MEMORY_SCOPE_AGENT); }
__device__ __forceinline__ unsigned xb_xcc_id() { return (unsigned)__builtin_amdgcn_s_getreg((3 << 11) | 20) & 0xFu; }
#define XB_SPIN(cond, bar) do { unsigned _sp = 0; while (cond) { __builtin_amdgcn_s_sleep(1); \
    if ((++_sp & 255u) == 0u) { if (xb_ld(&(bar)[XB_TMO])) break; if (_sp > XB_SPIN_CAP) { atomicAdd(&(bar)[XB_TMO], 1u); break; } } } } while (0)
struct XcdBarrier { unsigned* bar; unsigned x; volatile LAS unsigned* st; };
__device__ __forceinline__ XcdBarrier xcd_barrier_post(unsigned* bar, volatile LAS unsigned* st) {
    XcdBarrier b; b.bar = bar; b.x = xb_xcc_id(); b.st = st;
    if (__builtin_amdgcn_workitem_id_x() == 0) (void)xb_add(&bar[XB_XCNT(b.x)], 1u);
    return b;
}
__device__ __forceinline__ void xcd_barrier_complete(unsigned* bar, unsigned x, unsigned& nloc, unsigned& nx) {
    const unsigned G = gridDim.x * gridDim.y * gridDim.z;
    unsigned sum, cnt, mine, sp = 0u;
    for (;;) {
        sum = 0u; cnt = 0u; mine = 0u;
#pragma unroll
        for (unsigned j = 0; j < 16; ++j) { const unsigned c = xb_ld(&bar[XB_XCNT(j)]); sum += c; cnt += (c > 0u) ? 1u : 0u; mine = (j == x) ? c : mine; }
        if (sum == G) break;
        __builtin_amdgcn_s_sleep(1);
        if ((++sp & 255u) == 0u) { if (xb_ld(&bar[XB_TMO])) break; if (sp > XB_SPIN_CAP) { atomicAdd(&bar[XB_TMO], 1u); break; } }
    }
    nloc = mine > 0u ? mine : 1u; nx = cnt > 0u ? cnt : 1u;
}
__device__ __forceinline__ void xcd_barrier(const XcdBarrier& b, const unsigned k) {
    asm volatile("s_waitcnt vmcnt(0)" ::: "memory");
    __syncthreads();
    if (__builtin_amdgcn_workitem_id_x() == 0) {
        unsigned* bar = b.bar;
        __builtin_amdgcn_s_waitcnt(0);
        unsigned nloc = b.st[0], nx = b.st[1];
        if (nloc == 0u) { xcd_barrier_complete(bar, b.x, nloc, nx); b.st[0] = nloc; b.st[1] = nx; }
        const unsigned old = xb_add(&bar[XB_XSUB(b.x)], 1u);
        const unsigned gen = old / nloc;
        if (old + 1u == (gen + 1u) * nloc) {
            __builtin_amdgcn_fence(__ATOMIC_RELEASE, "agent");
            asm volatile("s_waitcnt vmcnt(0)" ::: "memory");
            const unsigned og = xb_add(&bar[XB_TOP], 1u);
            const unsigned tg = og / nx;
            if (og + 1u == (tg + 1u) * nx) xb_add(&bar[XB_TOPGEN], 1u);
            else XB_SPIN(xb_ld(&bar[XB_TOPGEN]) == tg, bar);
            __builtin_amdgcn_fence(__ATOMIC_ACQUIRE, "agent");
            asm volatile("s_waitcnt vmcnt(0)" ::: "memory");
        } else {
            XB_SPIN(xb_ld(&bar[XB_TOPGEN]) < k, bar);
            __builtin_amdgcn_fence(__ATOMIC_ACQUIRE, "agent");
            asm volatile("s_waitcnt vmcnt(0)" ::: "memory");
        }
    }
    __syncthreads();
}


#define XB2_XCNT(j) (8192 + 64 * (j))
#define XB2_XSUB(j) (9216 + 64 * (j))
#define XB2_TOP     10240
#define XB2_TOPGEN  10304
__device__ __forceinline__ void sub_barrier_nonscan(unsigned* ctl, const unsigned k) {
    asm volatile("s_waitcnt vmcnt(0)" ::: "memory");
    __syncthreads();
    if (__builtin_amdgcn_workitem_id_x() == 0) {
        const unsigned x = xb_xcc_id();
        unsigned cnts[16];
#pragma unroll
        for (unsigned j = 0; j < 16; ++j) cnts[j] = xb_ld(&ctl[XB2_XCNT(j)]);
        unsigned nloc = 0u, nx = 0u;
#pragma unroll
        for (unsigned j = 0; j < 16; ++j) { nloc = (j == x) ? cnts[j] : nloc; nx += (cnts[j] > 0u) ? 1u : 0u; }
        nloc = nloc ? nloc : 1u; nx = nx ? nx : 1u;
        const unsigned old = xb_add(&ctl[XB2_XSUB(x)], 1u);
        if ((old + 1u) % nloc == 0u) {
            __builtin_amdgcn_fence(__ATOMIC_RELEASE, "agent"); asm volatile("s_waitcnt vmcnt(0)" ::: "memory");
            const unsigned og = xb_add(&ctl[XB2_TOP], 1u);
            if ((og + 1u) % nx == 0u) xb_add(&ctl[XB2_TOPGEN], 1u);
        }
        unsigned sp = 0; while (xb_ld(&ctl[XB2_TOPGEN]) < k) { __builtin_amdgcn_s_sleep(1); if (++sp > (1u << 22)) break; }
        __builtin_amdgcn_fence(__ATOMIC_ACQUIRE, "agent"); asm volatile("s_waitcnt vmcnt(0)" ::: "memory");
    }
    __syncthreads();
}
#define PIN(i) ((const float*)P.in[(i) + z])
constexpr int NPH = 9;
template <int PH> __device__ __forceinline__ void run_phase(const Params& P, LAS unsigned char* lds) {
        int z; asm volatile("s_mov_b32 %0, 0" : "=s"(z));
        unsigned char* ws = P.ws + z;
        constexpr int layer = PH / NPH, k = PH - layer * NPH;
        const int tid = tid_opaque(), lane = tid & 63, wave = __builtin_amdgcn_readfirstlane(tid >> 6), G = sgpr_opaque(gridDim.x), blk = sgpr_opaque(blockIdx.x);
        const int gw = blk * 8 + wave, NGW = G * 8;
        float* hbuf = P.out + z;
        bf16_t* XN = (bf16_t*)(ws + WS_X);
        if constexpr (PH == NPH * DEPTH) {
            const float* g = PIN(I_FINAL);
            const f32x4* gr = (const f32x4*)g + lane;
            f32x4 gg[4];
#pragma unroll
            for (int j = 0; j < 4; ++j) gg[j] = gr[64 * j];
            for (int m = gw; m < T; m += 4 * NGW) {
                f32x4 v[4][4]; float rs[4];
#pragma unroll
                for (int r = 0; r < 4; ++r)
#pragma unroll
                    for (int j = 0; j < 4; ++j) v[r][j] = ((const f32x4*)(hbuf + (size_t)(m + r * NGW) * 1024) + lane)[64 * j];
#pragma unroll
                for (int r = 0; r < 4; ++r) { float s2 = 0.f;
#pragma unroll
                    for (int j = 0; j < 4; ++j) s2 += (v[r][j].x * v[r][j].x + v[r][j].y * v[r][j].y) + (v[r][j].z * v[r][j].z + v[r][j].w * v[r][j].w);
                    rs[r] = s2; }
#pragma unroll
                for (int r = 0; r < 4; ++r) rs[r] = rsqrtf(wave_sum(rs[r]) * (1.f / 1024.f) + NORM_EPS);
#pragma unroll
                for (int r = 0; r < 4; ++r)
#pragma unroll
                    for (int j = 0; j < 4; ++j) ((f32x4*)(hbuf + (size_t)(m + r * NGW) * 1024) + lane)[64 * j] = v[r][j] * rs[r] * gg[j];
            }
            return;
        } else if constexpr (k == 0) {
            const float* hin = (layer == 0) ? PIN(I_X) : hbuf;
            LAS float* tscr = (LAS float*)(lds + wave * 16384);
            bf16_t* Win_t = (bf16_t*)(ws + WS_WIN); bf16_t* Wq_t = (bf16_t*)(ws + WS_WQ); bf16_t* Wkv_t = (bf16_t*)(ws + WS_WKV); bf16_t* Wo_t = (bf16_t*)(ws + WS_WO);
            const float* Win = PIN(I_W_IN) + (size_t)layer * DM * IN_DIM;
            const float* Wq = PIN(I_WQUP) + (size_t)layer * 384 * 768;
            const float* Wkv = PIN(I_WKVUP) + (size_t)layer * 256 * 1024;
            const float* Wo = PIN(I_W_OUT) + (size_t)layer * 1024 * 1024;
            constexpr int IT_IN = 16 * 81, IT_Q = 6 * 24, IT_KV = 4 * 32, IT_O = 16 * 32;
            if (layer == 0) for (int it = gw; it < IT_IN + IT_Q + IT_KV + IT_O; it += NGW) {
                int r = it;
                if (r < IT_IN) { transpose_item(Win, 1024, IN_DIM, Win_t, 1, tscr, r, lane); continue; } r -= IT_IN;
                if (r < IT_Q) { transpose_item(Wq, 384, 768, Wq_t, 0, tscr, r, lane); continue; } r -= IT_Q;
                if (r < IT_KV) { transpose_item(Wkv, 256, 1024, Wkv_t, 0, tscr, r, lane); continue; } r -= IT_KV;
                transpose_item(Wo, 1024, 1024, Wo_t, 0, tscr, r, lane);
            }
            for (int i = blk * 512 + tid; i < 224 * 128; i += G * 512) { const int rr = i >> 7, cc = i & 127; const int row = (rr < 128) ? 896 + rr : 2720 + (rr - 128);
                *(u32x4*)(Win_t + (size_t)row * 1024 + cc * 8) = (u32x4){0u, 0u, 0u, 0u}; }
            if (layer == 0) {
                const int* pos = (const int*)P.in[I_POS + z];
                float* cosR = (float*)(ws + WS_COSR); float* sinR = (float*)(ws + WS_SINR); float* cosM = (float*)(ws + WS_COSM); float* sinM = (float*)(ws + WS_SINM);
                for (int i = blk * 512 + tid; i < T * 32; i += G * 512) { const int tok = i >> 5, f = i & 31;
                    const float inv = exp2f(-(float)f * (1.f / 32.f) * 13.287712379549449f); const float ang = (float)pos[tok] * inv;
                    double rev = (double)ang * 0.15915494309189535; rev -= floor(rev); const float a = (float)(rev * 6.283185307179586);
                    cosR[i] = __cosf(a); sinR[i] = __sinf(a); }
                for (int i = blk * 512 + tid; i < T * 16; i += G * 512) { const int tok = i >> 4, f = i & 15;
                    const float inv = exp2f(-(float)f * (1.f / 16.f) * 13.287712379549449f); const float ang = (float)pos[tok] * inv;
                    double rev = (double)ang * 0.15915494309189535; rev -= floor(rev); const float a = (float)(rev * 6.283185307179586);
                    cosM[i] = __cosf(a); sinM[i] = __sinf(a); }
            }
            const float* g = PIN(I_ATTN_NORM) + layer * 1024;
            for (int m = gw; m < T; m += 2 * NGW) rms_rows2_bf16(hin + (size_t)m * 1024, hin + (size_t)(m + NGW) * 1024, g, XN + (size_t)m * 1024, XN + (size_t)(m + NGW) * 1024, lane);
        } else if constexpr (k == 1) {
            pg8::Gemm g{XN, (bf16_t*)(ws + WS_WIN), T, NPROJ, 1024}; pg8::StaticOrder S; S.init(T, NPROJ, G, blk);
            pg8::EpiProj E{(bf16_t*)(ws + WS_PA), (bf16_t*)(ws + WS_PB), (bf16_t*)(ws + WS_PC)};
            pg8::gemm_phase<pg8::EpiProj, pg8::StaticOrder, true, true>(lds, g, S, E);
        } else if constexpr (k == 2) {
            bf16_t* pa = (bf16_t*)(ws + WS_PA); bf16_t* pb = (bf16_t*)(ws + WS_PB); bf16_t* pc = (bf16_t*)(ws + WS_PC);
            float* cosR = (float*)(ws + WS_COSR); float* sinR = (float*)(ws + WS_SINR); float* cosM = (float*)(ws + WS_COSM); float* sinM = (float*)(ws + WS_SINM);
            PrepW W;
            {
                const int l16 = lane & 15, lq = lane >> 4;
                const float* w2 = PIN(I_W2) + layer * 32 * 256; const float* a2 = PIN(I_A2) + layer * 32 * 256; const float* g2 = PIN(I_G2) + layer * 64 * 256;
                const float* v1 = PIN(I_V1) + (layer > 0 ? (layer - 1) * 256 * 32 : 0); const float* v2 = PIN(I_V2) + (layer > 0 ? (layer - 1) * 32 * 256 : 0);
#pragma unroll
                for (int nt = 0; nt < 2; ++nt) { const int n = 16 * (2 * wave + nt) + l16;
                    W.Bw[nt] = pack_col8(w2, 256, 8 * lq, n); W.Ba[nt] = pack_col8(a2, 256, 8 * lq, n);
                    W.Bg[nt][0] = pack_col8(g2, 256, 8 * lq, n); W.Bg[nt][1] = pack_col8(g2, 256, 32 + 8 * lq, n);
                    W.Bv[nt] = pack_col8(v2, 256, 8 * lq, n); W.Bv1[nt] = pack_col8(v1, 32, 32 * wave + 8 * lq, 16 * nt + l16); }
            }
            unsigned raw[17];
            if (tid < 448 && blk < T / 16) prep_fetch_rows(raw, pa, blk * 16, tid * 2);
            PrepC PC;
            { const int cc = tid & 255, c2 = (tid < 448) ? tid * 2 : 0;
              const float* mu = PIN(I_MU) + layer * RW_IN;
              PC.mu0 = mu[c2]; PC.mu1 = mu[c2 + 1]; PC.w0c = (PIN(I_W0) + layer * 256)[cc]; PC.a0c = (PIN(I_A0) + layer * 256)[cc]; PC.kkc = (PIN(I_KK) + layer * 256)[cc];
              PC.kac = (PIN(I_KA) + layer * 256)[cc]; PC.rkc = (PIN(I_RK) + layer * 256)[cc]; PC.v0c = (layer > 0) ? (PIN(I_V0) + (layer - 1) * 256)[cc] : 0.f; }
            for (int tile = blk; tile < T / 16; tile += G) rwkv_prep_tile(lds, tile, (tile + G < T / 16) ? tile + G : -1, raw, PC, layer, P, z, W, pa, ws + WS_REC, (bf16_t*)(ws + WS_VBUF), (bf16_t*)(ws + WS_GBUF), (bf16_t*)(ws + WS_VFIRST), (float*)(ws + WS_BS), (float*)(ws + WS_BS + 512 * 1024));
            for (int u = blk; u < 512; u += G) ret_kv_unit(lds, u >> 5, u & 31, pb, cosR, sinR, (float*)(ws + WS_KVT));
        } else if constexpr (k == 3) {
            LAS unsigned* misc = (LAS unsigned*)(lds + 131072);
            unsigned* ctl = (unsigned*)(ws + WS_CTL);
            float* cosR = (float*)(ws + WS_COSR); float* sinR = (float*)(ws + WS_SINR); float* cosM = (float*)(ws + WS_COSM); float* sinM = (float*)(ws + WS_SINM);
            unsigned* sbar = ctl + 64 * (8 + layer);
            const int NB = G - 64;
            if (blk < 64) {
                rwkv_scan_block(lds, blk, ws + WS_REC, (bf16_t*)(ws + WS_VBUF), (const float*)(ws + WS_BS + 512 * 1024), (float*)(ws + WS_YA));
                if (tid == 0) { unsigned sp = 0; while (xb_ld((unsigned*)ctl + XB2_TOPGEN) < 2u * layer + 2u) { __builtin_amdgcn_s_sleep(4); if (++sp > (1u << 22)) break; }
                    __builtin_amdgcn_fence(__ATOMIC_ACQUIRE, "agent"); asm volatile("s_waitcnt vmcnt(0)" ::: "memory"); }
                __syncthreads();
            } else {
                const int cb = blk - 64;
                {
                    const int gwn = cb * 8 + wave, NGWn = NB * 8;
                    bf16_t* pc = (bf16_t*)(ws + WS_PC);
            bf16_t* qn = (bf16_t*)(ws + WS_QN); bf16_t* kvn = (bf16_t*)(ws + WS_KVN); bf16_t* kr = (bf16_t*)(ws + WS_KR);
            const float* qg = PIN(I_QNORM) + layer * 384; const float* kg = PIN(I_KVNORM) + layer * 256;
            const int lq_ = (lane < 48) ? lane : 0, lk_ = lane & 31, lr_ = lane & 1;
            const f32x4 qg0 = *(const f32x4*)(qg + 8 * lq_), qg1 = *(const f32x4*)(qg + 8 * lq_ + 4), kg0 = *(const f32x4*)(kg + 8 * lk_), kg1 = *(const f32x4*)(kg + 8 * lk_ + 4);
            for (int m0 = gwn; m0 < T; m0 += 2 * NGWn) {
                u32x4 rq_[2], rk_[2], r1_[2], r2_[2]; f32x4 cA[2], cB[2], sA[2], sB[2];
#pragma unroll
                for (int u = 0; u < 2; ++u) { const int m = (m0 + u * NGWn < T) ? m0 + u * NGWn : T - 1; const bf16_t* row = pc + (size_t)m * 768;
                    rq_[u] = *(const u32x4*)(row + 8 * lq_); rk_[u] = *(const u32x4*)(row + 384 + 8 * lk_);
                    r1_[u] = *(const u32x4*)(row + 640 + 8 * lr_); r2_[u] = *(const u32x4*)(row + 656 + 8 * lr_);
                    cA[u] = *(const f32x4*)(cosM + (size_t)m * 16 + 8 * lr_); cB[u] = *(const f32x4*)(cosM + (size_t)m * 16 + 8 * lr_ + 4);
                    sA[u] = *(const f32x4*)(sinM + (size_t)m * 16 + 8 * lr_); sB[u] = *(const f32x4*)(sinM + (size_t)m * 16 + 8 * lr_ + 4); }
#pragma unroll
                for (int u = 0; u < 2; ++u) { const int m = m0 + u * NGWn; if (m >= T) continue;
                    float q8[8], k8[8];
#pragma unroll
                    for (int j = 0; j < 4; ++j) { q8[2 * j] = bflo(rq_[u][j]); q8[2 * j + 1] = bfhi(rq_[u][j]); k8[2 * j] = bflo(rk_[u][j]); k8[2 * j + 1] = bfhi(rk_[u][j]); }
                    float sq = 0.f, sk = 0.f;
#pragma unroll
                    for (int j = 0; j < 8; ++j) { sq += q8[j] * q8[j]; sk += k8[j] * k8[j]; }
                    if (lane >= 48) sq = 0.f;
                    if (lane >= 32) sk = 0.f;
                    const float rq = rsqrtf(wave_sum(sq) * (1.f / 384.f) + NORM_EPS), rk = rsqrtf(wave_sum(sk) * (1.f / 256.f) + NORM_EPS);
                    if (lane < 48) { u32x4 o; o.x = cvt_pk_bf16(q8[0] * rq * qg0.x, q8[1] * rq * qg0.y); o.y = cvt_pk_bf16(q8[2] * rq * qg0.z, q8[3] * rq * qg0.w);
                        o.z = cvt_pk_bf16(q8[4] * rq * qg1.x, q8[5] * rq * qg1.y); o.w = cvt_pk_bf16(q8[6] * rq * qg1.z, q8[7] * rq * qg1.w); *(u32x4*)(qn + (size_t)m * 384 + 8 * lane) = o; }
                    if (lane < 32) { u32x4 o; o.x = cvt_pk_bf16(k8[0] * rk * kg0.x, k8[1] * rk * kg0.y); o.y = cvt_pk_bf16(k8[2] * rk * kg0.z, k8[3] * rk * kg0.w);
                        o.z = cvt_pk_bf16(k8[4] * rk * kg1.x, k8[5] * rk * kg1.y); o.w = cvt_pk_bf16(k8[6] * rk * kg1.z, k8[7] * rk * kg1.w); *(u32x4*)(kvn + (size_t)m * 256 + 8 * lane) = o; }
                    if (lane < 2) { const float cs8[8] = {cA[u].x, cA[u].y, cA[u].z, cA[u].w, cB[u].x, cB[u].y, cB[u].z, cB[u].w}, sn8[8] = {sA[u].x, sA[u].y, sA[u].z, sA[u].w, sB[u].x, sB[u].y, sB[u].z, sB[u].w};
                        u32x4 o1, o2;
#pragma unroll
                        for (int j = 0; j < 4; ++j) { const float a0 = bflo(r1_[u][j]), a1 = bfhi(r1_[u][j]), b0 = bflo(r2_[u][j]), b1 = bfhi(r2_[u][j]);
                            o1[j] = cvt_pk_bf16(a0 * cs8[2 * j] - b0 * sn8[2 * j], a1 * cs8[2 * j + 1] - b1 * sn8[2 * j + 1]); o2[j] = cvt_pk_bf16(b0 * cs8[2 * j] + a0 * sn8[2 * j], b1 * cs8[2 * j + 1] + a1 * sn8[2 * j + 1]); }
                        *(u32x4*)(kr + (size_t)m * 32 + 8 * lane) = o1; *(u32x4*)(kr + (size_t)m * 32 + 16 + 8 * lane) = o2; }
                }
            }
                    sub_barrier_nonscan((unsigned*)ctl, 2u * layer + 1u);
                }
                bf16_t* rprev = (bf16_t*)(ws + WS_RPREV); const float* kvt = (const float*)(ws + WS_KVT);
                for (int i = cb * 512 + tid; i < 16 * 4096; i += NB * 512) { const int bh = i >> 12, el = i & 4095; const int h = bh & 3;
                    const float cd = exp2f(128.f * log2f(1.f - exp2f(-5.f - (float)h)));
                    float R = 0.f;
#pragma unroll 8
                    for (int ci = 0; ci < 32; ++ci) { rprev[((size_t)(bh * 32 + ci)) * 4096 + el] = f2bf(R); R = R * cd + kvt[((size_t)(bh * 32 + ci)) * 4096 + el]; } }
                __syncthreads();
                { pg8::Gemm g{(bf16_t*)(ws + WS_QN), (bf16_t*)(ws + WS_WQ), T, 768, 384}; pg8::StaticOrder S; S.init(T, 768, NB, cb); pg8::EpiPlain E{(bf16_t*)(ws + WS_PC), 768};
                  pg8::gemm_phase<pg8::EpiPlain, pg8::StaticOrder, true, true>(lds, g, S, E); }
                { pg8::Gemm g{(bf16_t*)(ws + WS_KVN), (bf16_t*)(ws + WS_WKV), T, 1024, 256}; pg8::StaticOrder S; S.init(T, 1024, NB, cb); pg8::EpiPlain E{(bf16_t*)(ws + WS_KN), 1024};
                  pg8::gemm_phase<pg8::EpiPlain, pg8::StaticOrder, true, true>(lds, g, S, E); }
                sub_barrier_nonscan((unsigned*)ctl, 2u * layer + 2u);
            }
            unsigned* qctr = ctl + 64 * (1 + layer);
            for (;;) {
                __syncthreads();
                if (tid == 0) misc[0] = atomicAdd(qctr, 1u);
                __syncthreads();
                const int u = (int)misc[0];
                if (u >= 768) break;
                if (u < 512) { const int qb = 15 - (u >> 5), bh = u & 31; att_unit(lds, bh >> 3, bh & 7, qb, (bf16_t*)(ws + WS_PC), (bf16_t*)(ws + WS_KN), (bf16_t*)(ws + WS_KR), cosM, sinM, XN); }
                else { const int v = u - 512; const int bh = v & 15, jb = v >> 4; ret_unit(lds, bh >> 2, bh & 3, jb, (bf16_t*)(ws + WS_PB), cosR, sinR, (bf16_t*)(ws + WS_RPREV), (float*)(ws + WS_YB)); }
            }
        } else if constexpr (k == 4) {
            LAS float* tscr = (LAS float*)(lds + wave * 16384);
            const float* __restrict__ ya = (const float*)(ws + WS_YA); const float* __restrict__ yb = (const float*)(ws + WS_YB); const float* __restrict__ bs = (const float*)(ws + WS_BS);
            const bf16_t* __restrict__ vbuf = (const bf16_t*)(ws + WS_VBUF); const bf16_t* __restrict__ gbuf = (const bf16_t*)(ws + WS_GBUF); const bf16_t* __restrict__ pb = (const bf16_t*)(ws + WS_PB);
            const float* __restrict__ gnw = PIN(I_GNW) + layer * 256; const float* __restrict__ gnb = PIN(I_GNB) + layer * 256;
            bf16_t* __restrict__ XNw = XN;
            const f32x4 gw4 = *(const f32x4*)(gnw + 4 * lane), gb4 = *(const f32x4*)(gnb + 4 * lane);
#pragma unroll 4
            for (int m = gw; m < T; m += NGW) {
                const int c = 4 * lane, head = lane >> 4;
                const f32x4 y = *(const f32x4*)(ya + (size_t)m * 256 + c);
                const float mean = allreduce16((y.x + y.y) + (y.z + y.w)) * (1.f / 64.f);
                const f32x4 d = y - mean;
                const float var = allreduce16((d.x * d.x + d.y * d.y) + (d.z * d.z + d.w * d.w)) * (1.f / 64.f);
                const float rs = rsqrtf(var + 64e-5f);
                const u32x2 vv = *(const u32x2*)(vbuf + (size_t)m * 256 + c), gg = *(const u32x2*)(gbuf + (size_t)m * 256 + c);
                const float bsc = bs[(size_t)m * 4 + head];
                const float o0 = (d.x * rs * gw4.x + gb4.x + bsc * bflo(vv.x)) * bflo(gg.x), o1 = (d.y * rs * gw4.y + gb4.y + bsc * bfhi(vv.x)) * bfhi(gg.x);
                const float o2 = (d.z * rs * gw4.z + gb4.z + bsc * bflo(vv.y)) * bflo(gg.y), o3 = (d.w * rs * gw4.w + gb4.w + bsc * bfhi(vv.y)) * bfhi(gg.y);
                u32x2 w; w.x = cvt_pk_bf16(o0, o1); w.y = cvt_pk_bf16(o2, o3);
                *(u32x2*)(XNw + (size_t)m * 1024 + c) = w;
                const f32x4 zz = *(const f32x4*)(yb + (size_t)m * 256 + c);
                const float ms = allreduce16((zz.x * zz.x + zz.y * zz.y) + (zz.z * zz.z + zz.w * zz.w)) * (1.f / 64.f);
                const float rz = rsqrtf(ms + NORM_EPS);
                const u32x2 gt = *(const u32x2*)(pb + (size_t)m * 1024 + 768 + c);
                const float g0 = bflo(gt.x), g1 = bfhi(gt.x), g2v = bflo(gt.y), g3 = bfhi(gt.y);
                u32x2 w2; w2.x = cvt_pk_bf16(zz.x * rz * g0 * sigmoidf_(g0), zz.y * rz * g1 * sigmoidf_(g1)); w2.y = cvt_pk_bf16(zz.z * rz * g2v * sigmoidf_(g2v), zz.w * rz * g3 * sigmoidf_(g3));
                *(u32x2*)(XNw + (size_t)m * 1024 + 256 + c) = w2;
            }
            const float* Wgu = PIN(I_WGU) + (size_t)layer * 1024 * 2 * D_FF; const float* Wdn = PIN(I_WDN) + (size_t)layer * D_FF * 1024;
            bf16_t* Wgu_t = (bf16_t*)(ws + WS_WGU); bf16_t* Wdn_t = (bf16_t*)(ws + WS_WDN);
            constexpr int IT_GU = 16 * 176, IT_DN = 44 * 32;
            for (int it = gw; it < IT_GU + IT_DN; it += NGW) {
                if (it < IT_GU) transpose_item(Wgu, 1024, 2 * D_FF, Wgu_t, 2, tscr, it, lane);
                else transpose_item(Wdn, D_FF, 1024, Wdn_t, 0, tscr, it - IT_GU, lane);
            }
        } else if constexpr (k == 5) {
            const float* hin = (layer == 0) ? PIN(I_X) : hbuf;
            pg8::Gemm g{XN, (bf16_t*)(ws + WS_WO), T, 1024, 1024}; pg8::StaticOrder S; S.init(T, 1024, G, blk); pg8::EpiRes E{hin, hbuf};
            pg8::gemm_phase<pg8::EpiRes, pg8::StaticOrder, true, true>(lds, g, S, E);
        } else if constexpr (k == 6) {
            const float* g = PIN(I_FFN_NORM) + layer * 1024;
            for (int m = gw; m < T; m += 2 * NGW) rms_rows2_bf16(hbuf + (size_t)m * 1024, hbuf + (size_t)(m + NGW) * 1024, g, XN + (size_t)m * 1024, XN + (size_t)(m + NGW) * 1024, lane);
            if constexpr (layer + 1 < DEPTH) {
                LAS float* tscr = (LAS float*)(lds + wave * 16384);
                const float* Win = PIN(I_W_IN) + (size_t)(layer + 1) * DM * IN_DIM; const float* Wq = PIN(I_WQUP) + (size_t)(layer + 1) * 384 * 768;
                const float* Wkv = PIN(I_WKVUP) + (size_t)(layer + 1) * 256 * 1024; const float* Wo = PIN(I_W_OUT) + (size_t)(layer + 1) * 1024 * 1024;
                constexpr int IT_IN = 16 * 81, IT_Q = 6 * 24, IT_KV = 4 * 32, IT_O = 16 * 32;
                for (int it = gw; it < IT_IN + IT_Q + IT_KV + IT_O; it += NGW) {
                    int r = it;
                    if (r < IT_IN) { transpose_item(Win, 1024, IN_DIM, (bf16_t*)(ws + WS_WIN), 1, tscr, r, lane); continue; } r -= IT_IN;
                    if (r < IT_Q) { transpose_item(Wq, 384, 768, (bf16_t*)(ws + WS_WQ), 0, tscr, r, lane); continue; } r -= IT_Q;
                    if (r < IT_KV) { transpose_item(Wkv, 256, 1024, (bf16_t*)(ws + WS_WKV), 0, tscr, r, lane); continue; } r -= IT_KV;
                    transpose_item(Wo, 1024, 1024, (bf16_t*)(ws + WS_WO), 0, tscr, r, lane);
                }
            }
        } else if constexpr (k == 7) {
            pg8::Gemm g{XN, (bf16_t*)(ws + WS_WGU), T, 2 * D_FF, 1024}; pg8::StaticOrder S; S.init(T, 2 * D_FF, G, blk); pg8::EpiSwiGLU E{(bf16_t*)(ws + WS_ACT)};
            pg8::gemm_phase<pg8::EpiSwiGLU, pg8::StaticOrder, true, true>(lds, g, S, E);
        } else {
            pg8::Gemm g{(bf16_t*)(ws + WS_ACT), (bf16_t*)(ws + WS_WDN), T, 1024, D_FF}; pg8::StaticOrder S; S.init(T, 1024, G, blk); pg8::EpiRes E{hbuf, hbuf};
            pg8::gemm_phase<pg8::EpiRes, pg8::StaticOrder, true, true>(lds, g, S, E);
        }
}

template <int PH> __device__ __forceinline__ void run_all(const Params& P, LAS unsigned char* lds, cg::grid_group& grid, const XcdBarrier& bar) {
    run_phase<PH>(P, lds);
    if constexpr (PH < NPH * DEPTH) {
        xcd_barrier(bar, (unsigned)PH + 1u);
        run_all<PH + 1>(P, lds, grid, bar);
    }
}
__global__ void __launch_bounds__(512) hymba_fwd(Params P) {
    extern __shared__ __attribute__((aligned(16))) unsigned char lds_raw[];
    LAS unsigned char* lds = (LAS unsigned char*)lds_raw;
    cg::grid_group grid = cg::this_grid();
    LAS unsigned* misc = (LAS unsigned*)(lds + 131072);
    if (__builtin_amdgcn_workitem_id_x() < 32) misc[__builtin_amdgcn_workitem_id_x()] = 0u;
    __syncthreads();
    if (P.ws == nullptr) grid.sync();
    if (blockIdx.x >= 64 && __builtin_amdgcn_workitem_id_x() == 0) (void)xb_add((unsigned*)(P.ws + WS_CTL) + XB2_XCNT(xb_xcc_id()), 1u);
    const XcdBarrier bar = xcd_barrier_post((unsigned*)(P.ws + WS_CTL) + 4096, (volatile LAS unsigned*)(misc + 8));
    run_all<0>(P, lds, grid, bar);
}
extern "C" void kernel_launch(void* const* d_in, const int* in_sizes, int n_in, void* d_out, int out_size, void* d_ws, size_t ws_size, hipStream_t stream) {
    static int grid = 0;
    if (grid == 0) {
        if (n_in != 27 || out_size != T * DM || ws_size < WS_END) { fprintf(stderr, "kernel_launch: unexpected shapes (n_in %d, out %d, ws %zu)\n", n_in, out_size, ws_size); grid = -1; return; }
        int dev = 0, cus = 0, per_cu = 0;
        (void)hipGetDevice(&dev); (void)hipDeviceGetAttribute(&cus, hipDeviceAttributeMultiprocessorCount, dev);
        if (hipFuncSetAttribute((const void*)hymba_fwd, hipFuncAttributeMaxDynamicSharedMemorySize, LDS_BYTES) != hipSuccess) { fprintf(stderr, "kernel_launch: hipFuncSetAttribute failed\n"); grid = -1; return; }
        if (hipOccupancyMaxActiveBlocksPerMultiprocessor(&per_cu, (const void*)hymba_fwd, 512, LDS_BYTES) != hipSuccess || per_cu < 1) { fprintf(stderr, "kernel_launch: occupancy query failed (%d)\n", per_cu); grid = -1; return; }
        (void)hipGetLastError();
        grid = cus;
        if (grid < 64) { fprintf(stderr, "kernel_launch: needs >= 64 CUs\n"); grid = -1; return; }
    }
    if (grid < 0) return;
    (void)hipMemsetAsync((char*)d_ws + WS_CTL, 0, 1 * MiB, stream);
    Params p{};
    for (int i = 0; i < 27; ++i) p.in[i] = d_in[i];
    p.out = (float*)d_out; p.ws = (unsigned char*)d_ws;
    void* args[] = {&p};
    hipError_t e = hipLaunchCooperativeKernel((const void*)hymba_fwd, dim3(grid), dim3(512), args, LDS_BYTES, stream);
    if (e != hipSuccess) fprintf(stderr, "kernel_launch: cooperative launch failed: %s (grid %d)\n", hipGetErrorString(e), grid);
}
```

```cpp
#include <hip/hip_runtime.h>
#include <hip/hip_cooperative_groups.h>
#include <cstdio>
#include <cstdint>
namespace cg = cooperative_groups;

#define LAS __attribute__((address_space(3)))
typedef unsigned short bf16_t;
typedef short bf16x8 __attribute__((ext_vector_type(8)));
typedef float f32x2 __attribute__((ext_vector_type(2)));
typedef float f32x4 __attribute__((ext_vector_type(4)));
typedef float f32x16 __attribute__((ext_vector_type(16)));
typedef unsigned u32x4 __attribute__((ext_vector_type(4)));
typedef unsigned u32x2 __attribute__((ext_vector_type(2)));

constexpr int BATCH = 4, SEQ = 4096, T = BATCH * SEQ, DM = 1024, DEPTH = 2;
constexpr int RW_IN = 896, IN_DIM = 2592, D_FF = 2816;
constexpr int NPROJ = 2816;
constexpr float NORM_EPS = 1e-6f;

constexpr size_t MiB = 1u << 20;
constexpr size_t WS_CTL = 0;
constexpr size_t WS_COSR = 1 * MiB, WS_SINR = 3 * MiB, WS_COSM = 5 * MiB, WS_SINM = 6 * MiB;
constexpr size_t WS_BS = 7 * MiB;
constexpr size_t WS_RPREV = 8 * MiB;
constexpr size_t WS_WIN = 12 * MiB;
constexpr size_t WS_WQ = WS_WIN + 5632 * 1024;
constexpr size_t WS_WKV = WS_WQ + 768 * 384 * 2;
constexpr size_t WS_WO = WS_WKV + 1024 * 256 * 2;
constexpr size_t WS_VFIRST = 21 * MiB;
constexpr size_t WS_VBUF = 29 * MiB;
constexpr size_t WS_GBUF = 37 * MiB;
constexpr size_t WS_X = 45 * MiB;
constexpr size_t WS_QN = WS_X, WS_KVN = WS_X + 12 * MiB;
constexpr size_t WS_KR = 253 * MiB;
constexpr size_t WS_PA = 77 * MiB;
constexpr size_t WS_YA = WS_PA, WS_YB = WS_PA + 16 * MiB;
constexpr size_t WS_PB = 109 * MiB;
constexpr size_t WS_PC = 141 * MiB;
constexpr size_t WS_ACT = 77 * MiB;
constexpr size_t WS_KN = 165 * MiB;
constexpr size_t WS_VT = 181 * MiB;
constexpr size_t WS_REC = 197 * MiB;
constexpr size_t WS_WGU = 197 * MiB, WS_WDN = 208 * MiB;
constexpr size_t WS_KVT = 245 * MiB;
constexpr size_t WS_END = 254 * MiB;

constexpr int LDS_BYTES = 131072 + 1024;

__device__ __forceinline__ int sgpr_opaque(int v) { asm volatile("" : "+s"(v)); return v; }
__device__ __forceinline__ int tid_opaque() { int t = __builtin_amdgcn_workitem_id_x(); asm volatile("" : "+v"(t)); return t; }
__device__ __forceinline__ unsigned cvt_pk_bf16(float lo, float hi) { unsigned r; asm volatile("v_cvt_pk_bf16_f32 %0, %1, %2" : "=v"(r) : "v"(lo), "v"(hi)); return r; }
__device__ __forceinline__ bf16_t f2bf(float f) { return (bf16_t)(cvt_pk_bf16(f, 0.f) & 0xffffu); }
__device__ __forceinline__ float bf2f(bf16_t v) { return __uint_as_float(((unsigned)v) << 16); }
__device__ __forceinline__ float bflo(unsigned u) { return __uint_as_float(u << 16); }
__device__ __forceinline__ float bfhi(unsigned u) { return __uint_as_float(u & 0xffff0000u); }
__device__ __forceinline__ float sigmoidf_(float x) { return __builtin_amdgcn_rcpf(1.f + __expf(-x)); }
template <int CTRL> __device__ __forceinline__ float dpp_mov(float x) { return __builtin_bit_cast(float, __builtin_amdgcn_mov_dpp(__builtin_bit_cast(int, x), CTRL, 0xf, 0xf, true)); }
__device__ __forceinline__ float allreduce16(float x) {
    x += dpp_mov<0xB1>(x); x += dpp_mov<0x4E>(x); x += dpp_mov<0x141>(x); x += dpp_mov<0x140>(x); return x;
}
__device__ __forceinline__ float wave_sum(float v) { v = allreduce16(v); v += __shfl_xor(v, 16); v += __shfl_xor(v, 32); return v; }
__device__ __forceinline__ int crow(int r, int hi) { return (r & 3) + 8 * (r >> 2) + 4 * hi; }
#define MFMA32(a, b, c) __builtin_amdgcn_mfma_f32_32x32x16_bf16((a), (b), (c), 0, 0, 0)

namespace pg8 {
#define PG8_LAS __attribute__((address_space(3)))
constexpr int BM = 256, BK = 64, HALF = 128, HTB = HALF * BK * 2, STAGE_BYTES = 8 * HTB, NXCD = 8, WGM = 8;
__host__ __device__ __forceinline__ int lds_byte(int r, int c) { const int st = (r >> 4) * 2 + (c >> 5), rr = r & 15, cc = c & 31, ob = rr * 64 + cc * 2; return st * 1024 + (ob ^ (((ob >> 9) & 1) << 5)); }
__host__ __device__ __forceinline__ void stage_rc(int b, int& R, int& C) { const int st = b / 1024, sb = b % 1024, swz = sb ^ (((sb >> 9) & 1) << 5); R = (st >> 1) * 16 + swz / 64; C = (st & 1) * 32 + (swz % 64) / 2; }
__host__ __device__ __forceinline__ int perm32(int rho) { const int n = rho >> 4, i = rho & 15; return 8 * (i >> 2) + 4 * n + (i & 3); }
struct Unit { int pm, pn; };
struct Gemm { const bf16_t* A; const bf16_t* Bt; int M, N, K; };
struct StaticOrder {
    int nM, nN, nwg, G, c;
    __host__ __device__ void init(int M, int N, int G_, int c_) { nM = M / BM; nN = N / BM; nwg = nM * nN; G = G_; c = c_; }
    __host__ __device__ bool next(int i, Unit& u) const {
        const long L = (long)i * G + c; if (L >= nwg) return false;
        int wgid = (int)L; { const int q = nwg / NXCD, r = nwg % NXCD, xcd = wgid % NXCD, off = wgid / NXCD; wgid = (xcd < r ? xcd * (q + 1) : r * (q + 1) + (xcd - r) * q) + off; }
        const int nig = WGM * nN, gid = wgid / nig, fm = gid * WGM, gsz = (nM - fm) < WGM ? (nM - fm) : WGM;
        u.pm = fm + ((wgid % nig) % gsz); u.pn = (wgid % nig) / gsz; return true;
    }
    __device__ __forceinline__ void a_ready(const Unit&) const {}
    __device__ __forceinline__ void done(const Unit&) const {}
};

template <class Epi, class Sched, bool ALIGN_EPI = false, bool SP2 = false>
__device__ __forceinline__ void gemm_phase(PG8_LAS unsigned char* lds, const Gemm g, const Sched& S, const Epi& E) {
    const int tid = tid_opaque(), wid = __builtin_amdgcn_readfirstlane(tid >> 6), lane = tid & 63, wr = wid >> 2, wc = wid & 3, fr = lane & 15, fq = lane >> 4;
    const int K = g.K, nt = K / BK;
    unsigned voffA[2], voffB[2];
#pragma unroll
    for (int i = 0; i < 2; ++i) { int R, C; stage_rc(tid * 16 + i * 8192, R, C); const int Rb = Epi::PERM ? ((R & ~31) + perm32(R & 31)) : R;
        voffA[i] = (unsigned)(R * K + C) * 2u; voffB[i] = (unsigned)(Rb * K + C) * 2u; }
    const size_t kstep = (size_t)(BK * 2);
    const size_t hstep = (size_t)HALF * K * 2;
    const size_t tstep = 2 * hstep;
    const unsigned ldsw = (unsigned)wid * 1024u;
    const int aoff = lds_byte(wr * 64 + fr, fq * 8), boff = lds_byte(wc * 32 + fr, fq * 8);
#define PG8_SA(b, h) (((b) * 2 + (h)) * HTB)
#define PG8_SB(b, h) ((4 + (b) * 2 + (h)) * HTB)
#define PG8_STAGE(bufoff, gbase, voff) do { _Pragma("unroll") for (int _i = 0; _i < 2; ++_i) \
        __builtin_amdgcn_global_load_lds((const unsigned*)((const char*)(gbase) + (voff)[_i]), (PG8_LAS unsigned*)(lds + (bufoff) + ldsw + _i * 8192), 16, 0, 0); } while (0)
#define PG8_LDA(dst, b, h) do { _Pragma("unroll") for (int m = 0; m < 4; ++m) _Pragma("unroll") for (int k = 0; k < 2; ++k) dst[m][k] = *(const PG8_LAS bf16x8*)(lds + PG8_SA(b, h) + aoff + m * 2048 + k * 1024); } while (0)
#define PG8_LDB(dst, b, h) do { _Pragma("unroll") for (int n = 0; n < 2; ++n) _Pragma("unroll") for (int k = 0; k < 2; ++k) dst[n][k] = *(const PG8_LAS bf16x8*)(lds + PG8_SB(b, h) + boff + n * 2048 + k * 1024); } while (0)
#define PG8_MMA(ai, bj, At, Bt) do { __builtin_amdgcn_s_setprio(1); _Pragma("unroll") for (int m = 0; m < 4; ++m) _Pragma("unroll") for (int n = 0; n < 2; ++n) _Pragma("unroll") for (int k = 0; k < 2; ++k) \
        acc[ai][bj][m][n] = __builtin_amdgcn_mfma_f32_16x16x32_bf16(Bt[n][k], At[m][k], acc[ai][bj][m][n], 0, 0, 0); __builtin_amdgcn_s_setprio(0); } while (0)
#define PG8_WAIT_V(n) asm volatile("s_waitcnt vmcnt(" #n ")" ::: "memory")
#define PG8_WAIT_L(n) asm volatile("s_waitcnt lgkmcnt(" #n ")" ::: "memory")
#define PG8_BAR __builtin_amdgcn_s_barrier()
#define PG8_SCHED __builtin_amdgcn_sched_barrier(0)
    Unit cur, nxt; int ui = 0;
    if (!S.next(0, cur)) return;
    f32x4 acc[2][2][4][2];
#pragma unroll
    for (int a = 0; a < 2; ++a)
#pragma unroll
        for (int b = 0; b < 2; ++b)
#pragma unroll
            for (int m = 0; m < 4; ++m)
#pragma unroll
                for (int n = 0; n < 2; ++n) acc[a][b][m][n] = (f32x4){0.f, 0.f, 0.f, 0.f};
    bf16x8 At[4][2], B0[2][2], B1[2][2];
    const char* cA = (const char*)g.A + (size_t)cur.pm * tstep; const char* cB = (const char*)g.Bt + (size_t)cur.pn * tstep;
    S.a_ready(cur);
    if constexpr (SP2) {
        PG8_STAGE(PG8_SB(0, 0), cB, voffB); PG8_STAGE(PG8_SB(0, 1), cB + hstep, voffB); PG8_STAGE(PG8_SA(0, 0), cA, voffA); PG8_STAGE(PG8_SA(0, 1), cA + hstep, voffA);
        if (wr == 1) PG8_BAR;
        PG8_WAIT_V(2); PG8_BAR;
        PG8_STAGE(PG8_SB(1, 0), cB + kstep, voffB); PG8_STAGE(PG8_SA(1, 0), cA + kstep, voffA); PG8_STAGE(PG8_SB(1, 1), cB + hstep + kstep, voffB);
        PG8_WAIT_V(6); PG8_BAR;
    } else {
        PG8_STAGE(PG8_SB(0, 0), cB, voffB); PG8_STAGE(PG8_SA(0, 0), cA, voffA); PG8_STAGE(PG8_SB(0, 1), cB + hstep, voffB); PG8_STAGE(PG8_SA(0, 1), cA + hstep, voffA);
        if (wr == 1) PG8_BAR;
        PG8_WAIT_V(4); PG8_BAR;
        PG8_STAGE(PG8_SB(1, 0), cB + kstep, voffB); PG8_STAGE(PG8_SA(1, 0), cA + kstep, voffA); PG8_STAGE(PG8_SB(1, 1), cB + hstep + kstep, voffB);
        PG8_WAIT_V(6); PG8_BAR;
    }
    for (;;) {
        const bool has_next = S.next(ui + 1, nxt);
        const char* nA = has_next ? (const char*)g.A + (size_t)nxt.pm * tstep : cA; const char* nB = has_next ? (const char*)g.Bt + (size_t)nxt.pn * tstep : cB;
        for (int t = 0; t < nt; t += 2) {
            const bool last = (t == nt - 2);
            const char* a1 = cA + (size_t)(t + 1) * kstep;
            const char* a2 = last ? nA : cA + (size_t)(t + 2) * kstep; const char* b2 = last ? nB : cB + (size_t)(t + 2) * kstep;
            const char* a3 = a2 + kstep; const char* b3 = b2 + kstep;
            if (last && has_next) S.a_ready(nxt);
            if constexpr (SP2) {
            PG8_LDB(B0, 0, 0); PG8_LDB(B1, 0, 1); PG8_SCHED; PG8_LDA(At, 0, 0); PG8_STAGE(PG8_SA(1, 1), a1 + hstep, voffA);
            PG8_WAIT_V(8); PG8_WAIT_L(0); PG8_BAR; PG8_MMA(0, 0, At, B0); PG8_MMA(0, 1, At, B1); PG8_BAR; PG8_SCHED;
            PG8_LDA(At, 0, 1); PG8_STAGE(PG8_SB(0, 0), b2, voffB); PG8_STAGE(PG8_SB(0, 1), b2 + hstep, voffB); PG8_STAGE(PG8_SA(0, 0), a2, voffA);
            PG8_WAIT_V(8); PG8_WAIT_L(0); PG8_BAR; PG8_MMA(1, 0, At, B0); PG8_MMA(1, 1, At, B1); PG8_BAR; PG8_SCHED;
            PG8_LDB(B0, 1, 0); PG8_LDB(B1, 1, 1); PG8_SCHED; PG8_LDA(At, 1, 0); PG8_STAGE(PG8_SA(0, 1), a2 + hstep, voffA);
            PG8_WAIT_V(8); PG8_WAIT_L(0); PG8_BAR; PG8_MMA(0, 0, At, B0); PG8_MMA(0, 1, At, B1); PG8_BAR; PG8_SCHED;
            PG8_LDA(At, 1, 1); PG8_STAGE(PG8_SB(1, 0), b3, voffB); PG8_STAGE(PG8_SB(1, 1), b3 + hstep, voffB); PG8_STAGE(PG8_SA(1, 0), a3, voffA);
            PG8_WAIT_V(8); PG8_WAIT_L(0); PG8_BAR; PG8_MMA(1, 0, At, B0); PG8_MMA(1, 1, At, B1); PG8_BAR; PG8_SCHED;
            } else {
            PG8_LDB(B0, 0, 0); PG8_SCHED; PG8_LDA(At, 0, 0); PG8_STAGE(PG8_SA(1, 1), a1 + hstep, voffA);
            PG8_WAIT_L(8); PG8_BAR; PG8_WAIT_L(0); PG8_MMA(0, 0, At, B0); PG8_BAR; PG8_SCHED;
            PG8_LDB(B1, 0, 1); PG8_STAGE(PG8_SB(0, 0), b2, voffB);
            PG8_BAR; PG8_WAIT_L(0); PG8_MMA(0, 1, At, B1); PG8_BAR;
            PG8_LDA(At, 0, 1); PG8_STAGE(PG8_SA(0, 0), a2, voffA);
            PG8_BAR; PG8_WAIT_L(0); PG8_MMA(1, 0, At, B0); PG8_BAR; PG8_SCHED;
            PG8_STAGE(PG8_SB(0, 1), b2 + hstep, voffB);
            PG8_WAIT_V(6); PG8_BAR; PG8_MMA(1, 1, At, B1); PG8_BAR;
            PG8_LDB(B0, 1, 0); PG8_SCHED; PG8_LDA(At, 1, 0); PG8_STAGE(PG8_SA(0, 1), a2 + hstep, voffA);
            PG8_WAIT_L(8); PG8_BAR; PG8_WAIT_L(0); PG8_MMA(0, 0, At, B0); PG8_BAR; PG8_SCHED;
            PG8_LDB(B1, 1, 1); PG8_STAGE(PG8_SB(1, 0), b3, voffB);
            PG8_BAR; PG8_WAIT_L(0); PG8_MMA(0, 1, At, B1); PG8_BAR;
            PG8_LDA(At, 1, 1); PG8_STAGE(PG8_SA(1, 0), a3, voffA);
            PG8_BAR; PG8_WAIT_L(0); PG8_MMA(1, 0, At, B0); PG8_BAR; PG8_SCHED;
            PG8_STAGE(PG8_SB(1, 1), b3 + hstep, voffB);
            PG8_WAIT_V(6); PG8_BAR; PG8_MMA(1, 1, At, B1); PG8_BAR;
            }
        }
        if constexpr (ALIGN_EPI) { if (wr == 0) PG8_BAR; }
        E(acc, cur, wr, wc, fr, fq); S.done(cur);
        if (!has_next) break;
#pragma unroll
        for (int a = 0; a < 2; ++a)
#pragma unroll
            for (int b = 0; b < 2; ++b)
#pragma unroll
                for (int m = 0; m < 4; ++m)
#pragma unroll
                    for (int n = 0; n < 2; ++n) acc[a][b][m][n] = (f32x4){0.f, 0.f, 0.f, 0.f};
        cur = nxt; cA = nA; cB = nB; ++ui;
        if constexpr (ALIGN_EPI) { if (wr == 1) PG8_BAR; }
    }
    PG8_WAIT_V(0);
    if constexpr (!ALIGN_EPI) { if (wr == 0) PG8_BAR; }
    PG8_BAR;
#undef PG8_SA
#undef PG8_SB
#undef PG8_STAGE
#undef PG8_LDA
#undef PG8_LDB
#undef PG8_MMA
#undef PG8_WAIT_V
#undef PG8_WAIT_L
#undef PG8_BAR
#undef PG8_SCHED
}

__device__ __forceinline__ u32x4 pack8(const f32x4 v0, const f32x4 v1) { u32x4 w; w.x = cvt_pk_bf16(v0[0], v0[1]); w.y = cvt_pk_bf16(v0[2], v0[3]); w.z = cvt_pk_bf16(v1[0], v1[1]); w.w = cvt_pk_bf16(v1[2], v1[3]); return w; }

struct EpiProj {
    static constexpr bool PERM = true;
    bf16_t *pa, *pb, *pc;
    __device__ __forceinline__ void operator()(const f32x4 (&acc)[2][2][4][2], const Unit& u, int wr, int wc, int fr, int fq) const {
        bf16_t* base; int ldc, colt;
        if (u.pn < 4) { base = pa; ldc = 1024; colt = u.pn * 256; } else if (u.pn < 8) { base = pb; ldc = 1024; colt = (u.pn - 4) * 256; } else { base = pc; ldc = 768; colt = (u.pn - 8) * 256; }
        const int row0 = u.pm * BM + wr * 64 + fr, col0 = colt + wc * 32 + 8 * fq;
#pragma unroll
        for (int ai = 0; ai < 2; ++ai)
#pragma unroll
            for (int m = 0; m < 4; ++m) { bf16_t* rowp = base + (size_t)(row0 + ai * HALF + m * 16) * ldc + col0;
#pragma unroll
                for (int bj = 0; bj < 2; ++bj) *(u32x4*)(rowp + bj * HALF) = pack8(acc[ai][bj][m][0], acc[ai][bj][m][1]); }
    }
};
struct EpiPlain {
    static constexpr bool PERM = true;
    bf16_t* O; int ldc;
    __device__ __forceinline__ void operator()(const f32x4 (&acc)[2][2][4][2], const Unit& u, int wr, int wc, int fr, int fq) const {
        const int row0 = u.pm * BM + wr * 64 + fr, col0 = u.pn * BM + wc * 32 + 8 * fq;
#pragma unroll
        for (int ai = 0; ai < 2; ++ai)
#pragma unroll
            for (int m = 0; m < 4; ++m) { bf16_t* rowp = O + (size_t)(row0 + ai * HALF + m * 16) * ldc + col0;
#pragma unroll
                for (int bj = 0; bj < 2; ++bj) *(u32x4*)(rowp + bj * HALF) = pack8(acc[ai][bj][m][0], acc[ai][bj][m][1]); }
    }
};
struct EpiRes {
    static constexpr bool PERM = false;
    const float* base; float* out;
    __device__ __forceinline__ void operator()(const f32x4 (&acc)[2][2][4][2], const Unit& u, int wr, int wc, int fr, int fq) const {
        const int row0 = u.pm * BM + wr * 64 + fr, col0 = u.pn * BM + wc * 32 + 4 * fq;
#pragma unroll
        for (int ai = 0; ai < 2; ++ai)
#pragma unroll
            for (int m = 0; m < 4; ++m) { const size_t off = (size_t)(row0 + ai * HALF + m * 16) * 1024 + col0;
#pragma unroll
                for (int bj = 0; bj < 2; ++bj)
#pragma unroll
                    for (int n = 0; n < 2; ++n) { const f32x4 bs = *(const f32x4*)(base + off + bj * HALF + n * 16); *(f32x4*)(out + off + bj * HALF + n * 16) = bs + acc[ai][bj][m][n]; } }
    }
};
struct EpiSwiGLU {
    static constexpr bool PERM = true;
    bf16_t* act;
    __device__ __forceinline__ void operator()(const f32x4 (&acc)[2][2][4][2], const Unit& u, int wr, int wc, int fr, int fq) const {
        const int row0 = u.pm * BM + wr * 64 + fr, col0 = u.pn * 128 + wc * 32 + 8 * fq;
#pragma unroll
        for (int ai = 0; ai < 2; ++ai)
#pragma unroll
            for (int m = 0; m < 4; ++m) { f32x4 o[2];
#pragma unroll
                for (int n = 0; n < 2; ++n)
#pragma unroll
                    for (int i = 0; i < 4; ++i) { const float gt = acc[ai][0][m][n][i], up = acc[ai][1][m][n][i]; o[n][i] = gt * up * __builtin_amdgcn_rcpf(1.f + __expf(-gt)); }
                *(u32x4*)(act + (size_t)(row0 + ai * HALF + m * 16) * D_FF + col0) = pack8(o[0], o[1]); }
    }
};
}

struct Params { const void* in[27]; float* out; unsigned char* ws; };
enum { I_X = 0, I_POS, I_ATTN_NORM, I_W_IN, I_W_OUT, I_MU, I_W0, I_W2, I_A0, I_A2, I_G2, I_KK, I_KA, I_RK, I_GNW, I_GNB, I_V0, I_V1, I_V2,
       I_QNORM, I_KVNORM, I_WQUP, I_WKVUP, I_FFN_NORM, I_WGU, I_WDN, I_FINAL };

__device__ __forceinline__ void transpose_item(const float* W, int K, int N, bf16_t* WT, int mode, LAS float* scr, int item, int lane) {
    const int nblk = N / 32, kb = item / nblk, nb = item % nblk, k0 = 64 * kb, n0 = 32 * nb;
    int d0 = n0;
    if (mode == 1) d0 = (n0 < 896) ? n0 : n0 + 128;
    else if (mode == 2) { const int j = (n0 < D_FF) ? n0 : n0 - D_FF; d0 = 256 * (j >> 7) + (j & 127) + ((n0 < D_FF) ? 0 : 128); }
    float wv[32];
#pragma unroll
    for (int i = 0; i < 32; ++i) wv[i] = W[(size_t)(k0 + 2 * i + (lane >> 5)) * N + n0 + (lane & 31)];
#pragma unroll
    for (int i = 0; i < 32; ++i) scr[(2 * i + (lane >> 5)) * 33 + (lane & 31)] = wv[i];
    asm volatile("s_waitcnt lgkmcnt(0)" ::: "memory");
    const int c = lane & 7;
#pragma unroll
    for (int j = 0; j < 4; ++j) { const int n = (lane >> 3) + 8 * j; const LAS float* s = scr + (8 * c) * 33 + n;
        u32x4 o; o.x = cvt_pk_bf16(s[0 * 33], s[1 * 33]); o.y = cvt_pk_bf16(s[2 * 33], s[3 * 33]); o.z = cvt_pk_bf16(s[4 * 33], s[5 * 33]); o.w = cvt_pk_bf16(s[6 * 33], s[7 * 33]);
        *(u32x4*)(WT + (size_t)(d0 + n) * K + k0 + 8 * c) = o; }
    asm volatile("s_waitcnt lgkmcnt(0)" ::: "memory");
}

__device__ __forceinline__ void rms_rows2_bf16(const float* __restrict__ x0row, const float* __restrict__ x1row, const float* __restrict__ g, bf16_t* __restrict__ o0row, bf16_t* __restrict__ o1row, int lane) {
    const f32x4* xa = (const f32x4*)x0row + lane; const f32x4* xb = (const f32x4*)x1row + lane; const f32x4* gr = (const f32x4*)g + lane;
    f32x4 va[4], vb[4]; float sa = 0.f, sb = 0.f;
#pragma unroll
    for (int j = 0; j < 4; ++j) { va[j] = xa[64 * j]; vb[j] = xb[64 * j]; }
#pragma unroll
    for (int j = 0; j < 4; ++j) { sa += (va[j].x * va[j].x + va[j].y * va[j].y) + (va[j].z * va[j].z + va[j].w * va[j].w); sb += (vb[j].x * vb[j].x + vb[j].y * vb[j].y) + (vb[j].z * vb[j].z + vb[j].w * vb[j].w); }
    const float ra = rsqrtf(wave_sum(sa) * (1.f / 1024.f) + NORM_EPS), rb = rsqrtf(wave_sum(sb) * (1.f / 1024.f) + NORM_EPS);
    u32x2* oa = (u32x2*)o0row + lane; u32x2* ob = (u32x2*)o1row + lane;
#pragma unroll
    for (int j = 0; j < 4; ++j) { const f32x4 gg = gr[64 * j]; u32x2 w;
        w.x = cvt_pk_bf16(va[j].x * ra * gg.x, va[j].y * ra * gg.y); w.y = cvt_pk_bf16(va[j].z * ra * gg.z, va[j].w * ra * gg.w); oa[64 * j] = w;
        w.x = cvt_pk_bf16(vb[j].x * rb * gg.x, vb[j].y * rb * gg.y); w.y = cvt_pk_bf16(vb[j].z * rb * gg.z, vb[j].w * rb * gg.w); ob[64 * j] = w; }
}
__device__ __forceinline__ void rms_row_bf16(const float* xrow, const float* g, bf16_t* orow, int lane) {
    const f32x4* xr = (const f32x4*)xrow + lane; const f32x4* gr = (const f32x4*)g + lane;
    f32x4 v[4]; float s = 0.f;
#pragma unroll
    for (int j = 0; j < 4; ++j) { v[j] = xr[64 * j]; s += (v[j].x * v[j].x + v[j].y * v[j].y) + (v[j].z * v[j].z + v[j].w * v[j].w); }
    const float rstd = rsqrtf(wave_sum(s) * (1.f / 1024.f) + NORM_EPS);
    u32x2* o8 = (u32x2*)orow + lane;
#pragma unroll
    for (int j = 0; j < 4; ++j) { const f32x4 gg = gr[64 * j]; u32x2 w; w.x = cvt_pk_bf16(v[j].x * rstd * gg.x, v[j].y * rstd * gg.y); w.y = cvt_pk_bf16(v[j].z * rstd * gg.z, v[j].w * rstd * gg.w); o8[64 * j] = w; }
}

constexpr int KROW = 104, VROW = 72;
constexpr int ATT_KB = 64 * KROW * 2, ATT_VB = 64 * VROW * 2;
constexpr int ATT_SCR = 2 * (ATT_KB + ATT_VB);

__device__ __forceinline__ void att_unit(LAS unsigned char* lds, int b, int h, int qb, const bf16_t* __restrict__ q, const bf16_t* __restrict__ kvb, const bf16_t* __restrict__ kr,
                                         const float* __restrict__ cosM, const float* __restrict__ sinM, bf16_t* __restrict__ mix) {
    const int tid = tid_opaque(), lane = tid & 63, w = tid >> 6, r32 = lane & 31, hi = lane >> 5;
    LAS float* scr = (LAS float*)(lds + ATT_SCR) + w * 32;
    const int qrow = qb * 256 + w * 32 + r32; const size_t tok = (size_t)b * SEQ + qrow;
    bf16x8 qf[6];
    {
        const bf16_t* qp = q + tok * 768 + h * 96 + hi * 8;
#pragma unroll
        for (int d0 = 0; d0 < 4; ++d0) qf[d0] = *(const bf16x8*)(qp + d0 * 16);
        const u32x4 x1 = *(const u32x4*)(qp + 64), x2 = *(const u32x4*)(qp + 80);
        const f32x4 c0 = *(const f32x4*)(cosM + tok * 16 + hi * 8), c1 = *(const f32x4*)(cosM + tok * 16 + hi * 8 + 4);
        const f32x4 s0 = *(const f32x4*)(sinM + tok * 16 + hi * 8), s1 = *(const f32x4*)(sinM + tok * 16 + hi * 8 + 4);
        float a[8], bb[8], cs[8] = {c0.x, c0.y, c0.z, c0.w, c1.x, c1.y, c1.z, c1.w}, sn[8] = {s0.x, s0.y, s0.z, s0.w, s1.x, s1.y, s1.z, s1.w};
#pragma unroll
        for (int j = 0; j < 4; ++j) { a[2 * j] = bflo(x1[j]); a[2 * j + 1] = bfhi(x1[j]); bb[2 * j] = bflo(x2[j]); bb[2 * j + 1] = bfhi(x2[j]); }
        u32x4 o1, o2;
#pragma unroll
        for (int j = 0; j < 4; ++j) {
            o1[j] = cvt_pk_bf16(a[2 * j] * cs[2 * j] - bb[2 * j] * sn[2 * j], a[2 * j + 1] * cs[2 * j + 1] - bb[2 * j + 1] * sn[2 * j + 1]);
            o2[j] = cvt_pk_bf16(bb[2 * j] * cs[2 * j] + a[2 * j] * sn[2 * j], bb[2 * j + 1] * cs[2 * j + 1] + a[2 * j + 1] * sn[2 * j + 1]); }
        qf[4] = __builtin_bit_cast(bf16x8, o1); qf[5] = __builtin_bit_cast(bf16x8, o2);
    }
    const int k_key = tid >> 3, k_ch = tid & 7;
    const int r_key = (tid & 255) >> 2, r_ch = tid & 3;
    const bf16_t* kn_src = kvb + ((size_t)b * SEQ + k_key) * 1024 + h * 128 + k_ch * 8;
    const bf16_t* kr_src = kr + ((size_t)b * SEQ + r_key) * 32 + r_ch * 8;
    const int kn_dst = (k_key * KROW + k_ch * 8) * 2, kr_dst = (r_key * KROW + 64 + r_ch * 8) * 2, vt_dst = (k_ch * 8 * VROW + k_key) * 2;
#define ATT_VWRITE(bufoff, gv) do { LAS bf16_t* vd_ = (LAS bf16_t*)(lds + 2 * ATT_KB + (bufoff) + vt_dst); _Pragma("unroll") for (int j_ = 0; j_ < 4; ++j_) { \
        vd_[(2 * j_) * VROW] = (bf16_t)((gv)[j_] & 0xffffu); vd_[(2 * j_ + 1) * VROW] = (bf16_t)((gv)[j_] >> 16); } } while (0)
    const int ntiles = 4 * qb + 4;
    u32x4 gk, gr, gv;
    gk = *(const u32x4*)kn_src; gv = *(const u32x4*)(kn_src + 64); if (tid < 256) gr = *(const u32x4*)kr_src;
    *(LAS u32x4*)(lds + kn_dst) = gk; ATT_VWRITE(0, gv); if (tid < 256) *(LAS u32x4*)(lds + kr_dst) = gr;
    __syncthreads();
    f32x16 o0, o1;
#pragma unroll
    for (int r = 0; r < 16; ++r) { o0[r] = 0.f; o1[r] = 0.f; }
    float mrow = -1e30f, lrow = 0.f;
    const float SC = 0.10206207261596577f * 1.4426950408889634f;
    const int wq0 = qb * 256 + w * 32;
    for (int kt = 0; kt < ntiles; ++kt) {
        const int cur = kt & 1;
        if (kt + 1 < ntiles) { const size_t ko = (size_t)(kt + 1) * 64; gk = *(const u32x4*)(kn_src + ko * 1024); gv = *(const u32x4*)(kn_src + ko * 1024 + 64); if (tid < 256) gr = *(const u32x4*)(kr_src + ko * 32); }
        const int k0 = kt * 64;
        if (k0 <= wq0 + 31) {
            const LAS unsigned char* Kb = lds + cur * ATT_KB; const LAS unsigned char* Vb = lds + 2 * ATT_KB + cur * ATT_VB;
            f32x16 p0, p1;
#pragma unroll
            for (int r = 0; r < 16; ++r) { p0[r] = 0.f; p1[r] = 0.f; }
#pragma unroll
            for (int d0 = 0; d0 < 6; ++d0) {
                const bf16x8 k0f = *(const LAS bf16x8*)(Kb + (r32 * KROW + d0 * 16 + hi * 8) * 2);
                const bf16x8 k1f = *(const LAS bf16x8*)(Kb + ((32 + r32) * KROW + d0 * 16 + hi * 8) * 2);
                p0 = MFMA32(k0f, qf[d0], p0); p1 = MFMA32(k1f, qf[d0], p1);
            }
            const bool need_mask = (k0 + 63 > wq0);
            float mx = -1e30f;
            if (need_mask) {
#pragma unroll
                for (int r = 0; r < 16; ++r) { const int key = k0 + crow(r, hi); if (key > qrow) p0[r] = -1e30f; if (key + 32 > qrow) p1[r] = -1e30f; }
            }
#pragma unroll
            for (int r = 0; r < 16; ++r) mx = fmaxf(mx, fmaxf(p0[r], p1[r]));
            mx = fmaxf(mx, __shfl_xor(mx, 32)) * SC;
            const bool grew = __any(mx > mrow + 8.f);
            const float mnew = grew ? fmaxf(mrow, mx) : mrow;
            const float alpha = __builtin_amdgcn_exp2f(mrow - mnew); mrow = mnew;
            float ls = 0.f;
#pragma unroll
            for (int r = 0; r < 16; ++r) { p0[r] = __builtin_amdgcn_exp2f(__builtin_fmaf(p0[r], SC, -mnew)); p1[r] = __builtin_amdgcn_exp2f(__builtin_fmaf(p1[r], SC, -mnew)); ls += p0[r] + p1[r]; }
            lrow = lrow * alpha + ls;
            if (grew) {
                if (hi == 0) scr[r32] = alpha;
                asm volatile("s_waitcnt lgkmcnt(0)" ::: "memory");
#pragma unroll
                for (int i = 0; i < 4; ++i) { const f32x4 al = *(const LAS f32x4*)(scr + 8 * i + 4 * hi);
#pragma unroll
                    for (int j = 0; j < 4; ++j) { o0[4 * i + j] *= al[j]; o1[4 * i + j] *= al[j]; } }
                asm volatile("s_waitcnt lgkmcnt(0)" ::: "memory");
            }
#pragma unroll
            for (int s = 0; s < 4; ++s) {
                u32x4 pw;
#pragma unroll
                for (int j = 0; j < 4; ++j) pw[j] = (s < 2) ? cvt_pk_bf16(p0[8 * (s & 1) + 2 * j], p0[8 * (s & 1) + 2 * j + 1]) : cvt_pk_bf16(p1[8 * (s & 1) + 2 * j], p1[8 * (s & 1) + 2 * j + 1]);
                const bf16x8 pa = __builtin_bit_cast(bf16x8, pw);
#pragma unroll
                for (int dvh = 0; dvh < 2; ++dvh) {
                    const LAS unsigned char* vp = Vb + ((dvh * 32 + r32) * VROW + 16 * s + 4 * hi) * 2;
                    const u32x2 lo = *(const LAS u32x2*)vp, hh = *(const LAS u32x2*)(vp + 16);
                    u32x4 vv; vv.x = lo.x; vv.y = lo.y; vv.z = hh.x; vv.w = hh.y;
                    if (dvh == 0) o0 = MFMA32(pa, __builtin_bit_cast(bf16x8, vv), o0); else o1 = MFMA32(pa, __builtin_bit_cast(bf16x8, vv), o1);
                }
            }
        }
        if (kt + 1 < ntiles) { const int nx = cur ^ 1; *(LAS u32x4*)(lds + nx * ATT_KB + kn_dst) = gk; ATT_VWRITE(nx * ATT_VB, gv); if (tid < 256) *(LAS u32x4*)(lds + nx * ATT_KB + kr_dst) = gr; }
        __syncthreads();
    }
    float lt = lrow + __shfl_xor(lrow, 32);
    if (hi == 0) scr[r32] = 1.f / lt;
    asm volatile("s_waitcnt lgkmcnt(0)" ::: "memory");
#pragma unroll
    for (int i = 0; i < 4; ++i) { const f32x4 il = *(const LAS f32x4*)(scr + 8 * i + 4 * hi);
#pragma unroll
        for (int j = 0; j < 4; ++j) { const int r = 4 * i + j; const size_t orow = (size_t)b * SEQ + qb * 256 + w * 32 + crow(r, hi);
            mix[orow * 1024 + 512 + h * 64 + r32] = f2bf(o0[r] * il[j]); mix[orow * 1024 + 512 + h * 64 + 32 + r32] = f2bf(o1[r] * il[j]); } }
    asm volatile("s_waitcnt lgkmcnt(0)" ::: "memory");
}

__device__ __forceinline__ void ret_unit(LAS unsigned char* lds, int b, int h, int jb, const bf16_t* __restrict__ pb, const float* __restrict__ cosR, const float* __restrict__ sinR,
                                         const bf16_t* __restrict__ rprev, float* __restrict__ yb) {
    const int tid = tid_opaque(), lane = tid & 63, w = tid >> 6, r32 = lane & 31, hi = lane >> 5;
    const float lg2 = log2f(1.f - exp2f(-5.f - (float)h));
    const int qrow = jb * 256 + w * 32 + r32; const size_t tok = (size_t)b * SEQ + qrow;
    const int chunk = qrow >> 7;
    bf16x8 qf[4], qx[4];
    {
        const bf16_t* qp = pb + tok * 1024 + h * 64 + hi * 8;
        const float qdec = exp2f(lg2 * (float)((qrow & 127) + 1));
#pragma unroll
        for (int d0 = 0; d0 < 2; ++d0) {
            const u32x4 x1 = *(const u32x4*)(qp + d0 * 16), x2 = *(const u32x4*)(qp + d0 * 16 + 32);
            const float* cp = cosR + tok * 32 + d0 * 16 + hi * 8; const float* sp = sinR + tok * 32 + d0 * 16 + hi * 8;
            const f32x4 c0 = *(const f32x4*)cp, c1 = *(const f32x4*)(cp + 4), s0 = *(const f32x4*)sp, s1 = *(const f32x4*)(sp + 4);
            const float cs[8] = {c0.x, c0.y, c0.z, c0.w, c1.x, c1.y, c1.z, c1.w}, sn[8] = {s0.x, s0.y, s0.z, s0.w, s1.x, s1.y, s1.z, s1.w};
            u32x4 o1, o2, y1, y2;
#pragma unroll
            for (int j = 0; j < 4; ++j) {
                const float a0 = bflo(x1[j]), a1 = bfhi(x1[j]), b0 = bflo(x2[j]), b1 = bfhi(x2[j]);
                const float r0 = a0 * cs[2 * j] - b0 * sn[2 * j], r1 = a1 * cs[2 * j + 1] - b1 * sn[2 * j + 1];
                const float t0 = b0 * cs[2 * j] + a0 * sn[2 * j], t1 = b1 * cs[2 * j + 1] + a1 * sn[2 * j + 1];
                o1[j] = cvt_pk_bf16(r0, r1); o2[j] = cvt_pk_bf16(t0, t1); y1[j] = cvt_pk_bf16(r0 * qdec, r1 * qdec); y2[j] = cvt_pk_bf16(t0 * qdec, t1 * qdec); }
            qf[d0] = __builtin_bit_cast(bf16x8, o1); qf[d0 + 2] = __builtin_bit_cast(bf16x8, o2); qx[d0] = __builtin_bit_cast(bf16x8, y1); qx[d0 + 2] = __builtin_bit_cast(bf16x8, y2);
        }
    }
    f32x16 o0, o1;
#pragma unroll
    for (int r = 0; r < 16; ++r) { o0[r] = 0.f; o1[r] = 0.f; }
    {
        const bf16_t* rp = rprev + ((size_t)((b * 4 + h) * 32 + chunk)) * 4096;
#pragma unroll
        for (int d0 = 0; d0 < 4; ++d0) {
            const bf16x8 r0 = *(const bf16x8*)(rp + (size_t)r32 * 64 + d0 * 16 + hi * 8), r1 = *(const bf16x8*)(rp + (size_t)(32 + r32) * 64 + d0 * 16 + hi * 8);
            o0 = MFMA32(qx[d0], r0, o0); o1 = MFMA32(qx[d0], r1, o1);
        }
    }
    const int l_key = (tid & 255) >> 2, l_c = tid & 3;
    for (int kt = 0; kt < 4; ++kt) {
        const int k0 = jb * 256 + kt * 64;
        __syncthreads();
        if (tid < 256) {
            const size_t kt_tok = (size_t)b * SEQ + k0 + l_key; const bf16_t* kp = pb + kt_tok * 1024 + 256 + h * 64 + l_c * 8;
            const u32x4 x1 = *(const u32x4*)kp, x2 = *(const u32x4*)(kp + 32);
            const float* cp = cosR + kt_tok * 32 + l_c * 8; const float* sp = sinR + kt_tok * 32 + l_c * 8;
            const f32x4 c0 = *(const f32x4*)cp, c1 = *(const f32x4*)(cp + 4), s0 = *(const f32x4*)sp, s1 = *(const f32x4*)(sp + 4);
            const float cs[8] = {c0.x, c0.y, c0.z, c0.w, c1.x, c1.y, c1.z, c1.w}, sn[8] = {s0.x, s0.y, s0.z, s0.w, s1.x, s1.y, s1.z, s1.w};
            u32x4 o1v, o2v;
#pragma unroll
            for (int j = 0; j < 4; ++j) {
                const float a0 = bflo(x1[j]), a1 = bfhi(x1[j]), b0 = bflo(x2[j]), b1 = bfhi(x2[j]);
                o1v[j] = cvt_pk_bf16((a0 * cs[2 * j] - b0 * sn[2 * j]) * 0.125f, (a1 * cs[2 * j + 1] - b1 * sn[2 * j + 1]) * 0.125f);
                o2v[j] = cvt_pk_bf16((b0 * cs[2 * j] + a0 * sn[2 * j]) * 0.125f, (b1 * cs[2 * j + 1] + a1 * sn[2 * j + 1]) * 0.125f); }
            *(LAS u32x4*)(lds + (l_key * KROW + l_c * 8) * 2) = o1v; *(LAS u32x4*)(lds + (l_key * KROW + 32 + l_c * 8) * 2) = o2v;
        } else {
            const size_t vt_tok = (size_t)b * SEQ + k0 + l_key; const bf16_t* vp = pb + vt_tok * 1024 + 512 + h * 64 + l_c * 16;
            const u32x4 x1 = *(const u32x4*)vp, x2 = *(const u32x4*)(vp + 8);
            LAS bf16_t* vd = (LAS bf16_t*)(lds + 2 * ATT_KB) + l_key;
#pragma unroll
            for (int j = 0; j < 4; ++j) { vd[(l_c * 16 + 2 * j) * VROW] = (bf16_t)(x1[j] & 0xffffu); vd[(l_c * 16 + 2 * j + 1) * VROW] = (bf16_t)(x1[j] >> 16);
                                          vd[(l_c * 16 + 8 + 2 * j) * VROW] = (bf16_t)(x2[j] & 0xffffu); vd[(l_c * 16 + 8 + 2 * j + 1) * VROW] = (bf16_t)(x2[j] >> 16); }
        }
        __syncthreads();
        if ((k0 >> 7) == chunk && k0 <= jb * 256 + w * 32 + 31) {
            const LAS unsigned char* Kb = lds; const LAS unsigned char* Vb = lds + 2 * ATT_KB;
            f32x16 p0, p1;
#pragma unroll
            for (int r = 0; r < 16; ++r) { p0[r] = 0.f; p1[r] = 0.f; }
#pragma unroll
            for (int d0 = 0; d0 < 4; ++d0) {
                const bf16x8 k0f = *(const LAS bf16x8*)(Kb + (r32 * KROW + d0 * 16 + hi * 8) * 2);
                const bf16x8 k1f = *(const LAS bf16x8*)(Kb + ((32 + r32) * KROW + d0 * 16 + hi * 8) * 2);
                p0 = MFMA32(k0f, qf[d0], p0); p1 = MFMA32(k1f, qf[d0], p1);
            }
#pragma unroll
            for (int r = 0; r < 16; ++r) {
                const int df0 = qrow - (k0 + crow(r, hi)), df1 = df0 - 32;
                p0[r] = (df0 >= 0) ? p0[r] * __builtin_amdgcn_exp2f(lg2 * (float)df0) : 0.f;
                p1[r] = (df1 >= 0) ? p1[r] * __builtin_amdgcn_exp2f(lg2 * (float)df1) : 0.f;
            }
#pragma unroll
            for (int s = 0; s < 4; ++s) {
                u32x4 pw;
#pragma unroll
                for (int j = 0; j < 4; ++j) pw[j] = (s < 2) ? cvt_pk_bf16(p0[8 * (s & 1) + 2 * j], p0[8 * (s & 1) + 2 * j + 1]) : cvt_pk_bf16(p1[8 * (s & 1) + 2 * j], p1[8 * (s & 1) + 2 * j + 1]);
                const bf16x8 pa = __builtin_bit_cast(bf16x8, pw);
#pragma unroll
                for (int dvh = 0; dvh < 2; ++dvh) {
                    const LAS unsigned char* vp = Vb + ((dvh * 32 + r32) * VROW + 16 * s + 4 * hi) * 2;
                    const u32x2 lo = *(const LAS u32x2*)vp, hh = *(const LAS u32x2*)(vp + 16);
                    u32x4 vv; vv.x = lo.x; vv.y = lo.y; vv.z = hh.x; vv.w = hh.y;
                    if (dvh == 0) o0 = MFMA32(pa, __builtin_bit_cast(bf16x8, vv), o0); else o1 = MFMA32(pa, __builtin_bit_cast(bf16x8, vv), o1);
                }
            }
        }
    }
#pragma unroll
    for (int r = 0; r < 16; ++r) { const size_t orow = (size_t)b * SEQ + jb * 256 + w * 32 + crow(r, hi);
        yb[orow * 256 + h * 64 + r32] = o0[r]; yb[orow * 256 + h * 64 + 32 + r32] = o1[r]; }
}

__device__ __forceinline__ void ret_kv_unit(LAS unsigned char* lds, int bh, int ci, const bf16_t* __restrict__ pb, const float* __restrict__ cosR, const float* __restrict__ sinR, float* __restrict__ kvt) {
    const int tid = tid_opaque(); const int b = bh >> 2, h = bh & 3;
    LAS float* Ks = (LAS float*)lds;
    LAS float* Vs = Ks + 128 * 64;
    const float lg2 = log2f(1.f - exp2f(-5.f - (float)h));
    __syncthreads();
    {
        const int i = tid & 31; float x1[8], x2[8], cc[8], ss[8];
#pragma unroll
        for (int it = 0; it < 8; ++it) { const int t = (tid >> 5) + 16 * it; const size_t tok = (size_t)b * SEQ + ci * 128 + t;
            x1[it] = bf2f(pb[tok * 1024 + 256 + h * 64 + i]); x2[it] = bf2f(pb[tok * 1024 + 256 + h * 64 + 32 + i]); cc[it] = cosR[tok * 32 + i]; ss[it] = sinR[tok * 32 + i]; }
#pragma unroll
        for (int it = 0; it < 8; ++it) { const int t = (tid >> 5) + 16 * it; const float sc = 0.125f * exp2f(lg2 * (float)(127 - t));
            Ks[t * 64 + i] = (x1[it] * cc[it] - x2[it] * ss[it]) * sc; Ks[t * 64 + 32 + i] = (x2[it] * cc[it] + x1[it] * ss[it]) * sc; }
        u32x4 vr[2];
#pragma unroll
        for (int it = 0; it < 2; ++it) { const int ch = tid + 512 * it, t = ch >> 3, c8 = ch & 7; vr[it] = *(const u32x4*)(pb + ((size_t)b * SEQ + ci * 128 + t) * 1024 + 512 + h * 64 + c8 * 8); }
#pragma unroll
        for (int it = 0; it < 2; ++it) { const int ch = tid + 512 * it, t = ch >> 3, c8 = ch & 7; LAS float* d = Vs + t * 64 + c8 * 8;
            *(LAS f32x4*)d = (f32x4){bflo(vr[it].x), bfhi(vr[it].x), bflo(vr[it].y), bfhi(vr[it].y)}; *(LAS f32x4*)(d + 4) = (f32x4){bflo(vr[it].z), bfhi(vr[it].z), bflo(vr[it].w), bfhi(vr[it].w)}; }
    }
    __syncthreads();
    const int e = tid >> 3, d0 = (tid & 7) * 8;
    float acc[8];
#pragma unroll
    for (int j = 0; j < 8; ++j) acc[j] = 0.f;
    for (int t = 0; t < 128; ++t) {
        const float v = Vs[t * 64 + e]; const f32x4 ka = *(const LAS f32x4*)(Ks + t * 64 + d0), kb = *(const LAS f32x4*)(Ks + t * 64 + d0 + 4);
        acc[0] += v * ka.x; acc[1] += v * ka.y; acc[2] += v * ka.z; acc[3] += v * ka.w; acc[4] += v * kb.x; acc[5] += v * kb.y; acc[6] += v * kb.z; acc[7] += v * kb.w;
    }
    float* o = kvt + ((size_t)(bh * 32 + ci)) * 4096 + e * 64 + d0;
    *(f32x4*)o = (f32x4){acc[0], acc[1], acc[2], acc[3]}; *(f32x4*)(o + 4) = (f32x4){acc[4], acc[5], acc[6], acc[7]};
}

struct PrepW { bf16x8 Bw[2], Ba[2], Bv[2], Bg[2][2], Bv1[2]; };
__device__ __forceinline__ bf16x8 pack_col8(const float* W, int ld, int k0, int n) {
    float t[8];
#pragma unroll
    for (int j = 0; j < 8; ++j) t[j] = W[(size_t)(k0 + j) * ld + n];
    u32x4 o; o.x = cvt_pk_bf16(t[0], t[1]); o.y = cvt_pk_bf16(t[2], t[3]); o.z = cvt_pk_bf16(t[4], t[5]); o.w = cvt_pk_bf16(t[6], t[7]);
    return __builtin_bit_cast(bf16x8, o);
}
__device__ __forceinline__ bf16x8 pack_f8(const f32x4 a, const f32x4 b) {
    u32x4 o; o.x = cvt_pk_bf16(a.x, a.y); o.y = cvt_pk_bf16(a.z, a.w); o.z = cvt_pk_bf16(b.x, b.y); o.w = cvt_pk_bf16(b.z, b.w);
    return __builtin_bit_cast(bf16x8, o);
}
#define MFMA16(a, b, c) __builtin_amdgcn_mfma_f32_16x16x32_bf16((a), (b), (c), 0, 0, 0)
__device__ __forceinline__ void prep_fetch_rows(unsigned (&raw)[17], const bf16_t* __restrict__ pa, int t0, int c2) {
    raw[0] = ((t0 & (SEQ - 1)) == 0) ? 0u : *(const unsigned*)(pa + (size_t)(t0 - 1) * 1024 + c2);
#pragma unroll
    for (int t = 0; t < 16; ++t) raw[t + 1] = *(const unsigned*)(pa + (size_t)(t0 + t) * 1024 + c2);
}
constexpr int PSW = 900;
struct PrepC { float mu0, mu1, w0c, a0c, kkc, kac, rkc, v0c; };
__device__ __forceinline__ void rwkv_prep_tile(LAS unsigned char* lds, int tile, int next_tile, unsigned (&raw)[17], const PrepC& PC, int layer, const Params& P, int z, const PrepW& W, const bf16_t* __restrict__ pa, unsigned char* __restrict__ rec,
                                               bf16_t* __restrict__ vbuf, bf16_t* __restrict__ gbuf, bf16_t* __restrict__ vfirst, float* __restrict__ bs, float* __restrict__ cs) {
    const int tid = tid_opaque(), lane = tid & 63;
    LAS float* PS = (LAS float*)lds;
    LAS float* VV = PS + 16 * PSW;
    const float* mu = (const float*)P.in[I_MU + z] + layer * RW_IN;
    const float* w0 = (const float*)P.in[I_W0 + z] + layer * 256; const float* w2 = (const float*)P.in[I_W2 + z] + layer * 32 * 256;
    const float* a0 = (const float*)P.in[I_A0 + z] + layer * 256; const float* a2 = (const float*)P.in[I_A2 + z] + layer * 32 * 256;
    const float* g2 = (const float*)P.in[I_G2 + z] + layer * 64 * 256;
    const float* k_k = (const float*)P.in[I_KK + z] + layer * 256; const float* k_a = (const float*)P.in[I_KA + z] + layer * 256; const float* r_k = (const float*)P.in[I_RK + z] + layer * 256;
    const float* v0 = (const float*)P.in[I_V0 + z] + (layer > 0 ? (layer - 1) * 256 : 0);
    const float* v1 = (const float*)P.in[I_V1 + z] + (layer > 0 ? (layer - 1) * 256 * 32 : 0);
    const float* v2 = (const float*)P.in[I_V2 + z] + (layer > 0 ? (layer - 1) * 32 * 256 : 0);
    const int t0 = tile * 16;
    __syncthreads();
    if (tid < 448) {
        const int c2 = tid * 2; const float mu0 = PC.mu0, mu1 = PC.mu1;
#pragma unroll
        for (int t = 0; t < 16; ++t) {
            float x0 = bflo(raw[t + 1]), x1 = bfhi(raw[t + 1]); const float y0 = bflo(raw[t]), y1 = bfhi(raw[t]);
            x0 = x0 + (y0 - x0) * mu0; x1 = x1 + (y1 - x1) * mu1;
            if (c2 >= 768) { if (c2 < 800) { x0 = 2.f * sigmoidf_(2.f * x0) - 1.f; x1 = 2.f * sigmoidf_(2.f * x1) - 1.f; } else if (c2 >= 832) { x0 = sigmoidf_(x0); x1 = sigmoidf_(x1); } }
            *(LAS f32x2*)(PS + t * PSW + c2) = (f32x2){x0, x1};
        }
        if (next_tile >= 0) prep_fetch_rows(raw, pa, next_tile * 16, c2);
    }
    if (layer > 0) VV[tid] = 0.f;
    __syncthreads();
    const int wv = tid >> 6, l16 = lane & 15, lq = lane >> 4;
    LAS float* LR = VV + 512;
    const f32x4 zero4 = {0.f, 0.f, 0.f, 0.f};
    if (layer > 0) {
        const LAS float* ap = PS + l16 * PSW + 512 + 32 * wv + 8 * lq;
        const bf16x8 A = pack_f8(*(const LAS f32x4*)ap, *(const LAS f32x4*)(ap + 4));
#pragma unroll
        for (int nt = 0; nt < 2; ++nt) { const f32x4 d = MFMA16(A, W.Bv1[nt], zero4);
#pragma unroll
            for (int r = 0; r < 4; ++r) (void)__builtin_amdgcn_ds_faddf(VV + (4 * lq + r) * 32 + 16 * nt + l16, d[r], 0, 0, false); }
        __syncthreads();
    }
    {
        const LAS float* ap = PS + l16 * PSW + 768 + 8 * lq;
        const bf16x8 Aw = pack_f8(*(const LAS f32x4*)ap, *(const LAS f32x4*)(ap + 4)), Aa = pack_f8(*(const LAS f32x4*)(ap + 32), *(const LAS f32x4*)(ap + 36));
        const bf16x8 Ag0 = pack_f8(*(const LAS f32x4*)(ap + 64), *(const LAS f32x4*)(ap + 68)), Ag1 = pack_f8(*(const LAS f32x4*)(ap + 96), *(const LAS f32x4*)(ap + 100));
        bf16x8 Av = Aw;
        if (layer > 0) { const LAS float* vp = VV + l16 * 32 + 8 * lq; Av = pack_f8(*(const LAS f32x4*)vp, *(const LAS f32x4*)(vp + 4)); }
#pragma unroll
        for (int nt = 0; nt < 2; ++nt) {
            const f32x4 dw = MFMA16(Aw, W.Bw[nt], zero4), da = MFMA16(Aa, W.Ba[nt], zero4);
            f32x4 dg = MFMA16(Ag0, W.Bg[nt][0], zero4); dg = MFMA16(Ag1, W.Bg[nt][1], dg);
            f32x4 dv = zero4; if (layer > 0) dv = MFMA16(Av, W.Bv[nt], zero4);
            const int ch = 16 * (2 * wv + nt) + l16;
#pragma unroll
            for (int r = 0; r < 4; ++r) { LAS float* o = LR + (4 * lq + r) * 256 + ch; o[0] = dw[r]; o[4096] = da[r]; o[8192] = dg[r]; o[12288] = dv[r]; }
        }
    }
    __syncthreads();
    const int c = tid & 255, th = tid >> 8;
    float aw[8], aa[8], ag[8], av[8];
#pragma unroll
    for (int i = 0; i < 8; ++i) { const LAS float* o = LR + (th * 8 + i) * 256 + c; aw[i] = o[0]; aa[i] = o[4096]; ag[i] = o[8192]; av[i] = o[12288]; }
    const float w0c = PC.w0c, a0c = PC.a0c, kkc = PC.kkc, kac = PC.kac, rkc = PC.rkc, v0c = PC.v0c;
    const int head = c >> 6, kq = (c & 63) >> 2, e = c & 3;
    float kk_[8], b_[8], kp_[8], dec_[8], r_[8], v_[8], a_[8], q_[8];
#pragma unroll
    for (int i = 0; i < 8; ++i) {
        const int t = th * 8 + i; const size_t tok = (size_t)t0 + t;
        const float r = PS[t * PSW + c], k = PS[t * PSW + 256 + c]; float v = PS[t * PSW + 512 + c];
        dec_[i] = __expf(-0.6065306597126334f * sigmoidf_(w0c + aw[i]));
        const float a = sigmoidf_(a0c + aa[i]);
        if (layer > 0) { const float vf = bf2f(vfirst[tok * 256 + c]); v = v + (vf - v) * sigmoidf_(v0c + av[i]); }
        else vfirst[tok * 256 + c] = f2bf(v);
        r_[i] = r; v_[i] = v; a_[i] = a; kk_[i] = k * kkc; kp_[i] = k * (1.f + (a - 1.f) * kac);
        q_[i] = kk_[i] * kk_[i];
    }
#pragma unroll
    for (int i = 0; i < 8; ++i) q_[i] = wave_sum(q_[i]);
#pragma unroll
    for (int i = 0; i < 8; ++i) { kk_[i] *= rsqrtf(fmaxf(q_[i], 1e-24f)); b_[i] = kk_[i] * a_[i]; q_[i] = r_[i] * kp_[i] * rkc; }
#pragma unroll
    for (int i = 0; i < 8; ++i) q_[i] = wave_sum(q_[i]);
    float d1_[4], d2_[4];
#pragma unroll
    for (int j = 0; j < 4; ++j) { d1_[j] = b_[2 * j] * kk_[2 * j + 1]; d2_[j] = kp_[2 * j] * kk_[2 * j + 1]; }
#pragma unroll
    for (int j = 0; j < 4; ++j) { d1_[j] = wave_sum(d1_[j]); d2_[j] = wave_sum(d2_[j]); }
#pragma unroll
    for (int i = 0; i < 8; ++i) {
        const int t = th * 8 + i; const size_t tok = (size_t)t0 + t;
        const size_t ri = tok * 256 + c;
        ((float*)rec)[ri] = dec_[i]; ((bf16_t*)(rec + 16 * MiB))[ri] = f2bf(r_[i]); ((bf16_t*)(rec + 24 * MiB))[ri] = f2bf(kp_[i]); ((bf16_t*)(rec + 40 * MiB))[ri] = f2bf(b_[i]);
        if ((i & 1) == 0) ((bf16_t*)(rec + 32 * MiB))[ri] = f2bf(-kk_[i]);
        else {
            ((bf16_t*)(rec + 32 * MiB))[ri] = f2bf(kk_[i - 1] * d1_[i >> 1] - dec_[i - 1] * kk_[i]);
            if (lane == 0) cs[tok * 4 + head] = -d2_[i >> 1];
        }
        vbuf[tok * 256 + c] = f2bf(v_[i]); gbuf[tok * 256 + c] = f2bf(ag[i]);
        if (lane == 0) bs[tok * 4 + head] = q_[i];
    }
}

constexpr int SC_TC = 32;
constexpr int SC_REC_F = SC_TC * 16 * 20;
constexpr int SC_V_F = SC_TC * 20;
__device__ __forceinline__ void scan_load_chunk(LAS float* recb, LAS float* vb, const unsigned char* __restrict__ rec, const bf16_t* __restrict__ vbuf, const float* __restrict__ cs, size_t tok0, int h, int v0, int lt) {
#pragma unroll
    for (int it = 0; it < 2; ++it) {
        const int p = lt + it * 256, step = p >> 4, kq = p & 15;
        const size_t ri = (tok0 + step) * 256 + h * 64 + 4 * kq;
        const f32x4 wv = *(const f32x4*)((const float*)rec + ri);
        const u32x2 rr = *(const u32x2*)((const bf16_t*)(rec + 16 * MiB) + ri), kk2 = *(const u32x2*)((const bf16_t*)(rec + 24 * MiB) + ri);
        const u32x2 nn = *(const u32x2*)((const bf16_t*)(rec + 32 * MiB) + ri), bb = *(const u32x2*)((const bf16_t*)(rec + 40 * MiB) + ri);
        const u32x4 a = {rr.x, rr.y, kk2.x, kk2.y}, bq = {nn.x, nn.y, bb.x, bb.y};
        LAS float* d = recb + (step * 16 + kq) * 20;
        *(LAS f32x4*)d = wv;
        *(LAS f32x4*)(d + 4) = (f32x4){bflo(a.x), bfhi(a.x), bflo(a.y), bfhi(a.y)};
        *(LAS f32x4*)(d + 8) = (f32x4){bflo(a.z), bfhi(a.z), bflo(a.w), bfhi(a.w)};
        *(LAS f32x4*)(d + 12) = (f32x4){bflo(bq.x), bfhi(bq.x), bflo(bq.y), bfhi(bq.y)};
        *(LAS f32x4*)(d + 16) = (f32x4){bflo(bq.z), bfhi(bq.z), bflo(bq.w), bfhi(bq.w)};
    }
    if (lt < 128) { const int step = lt >> 2, qd = lt & 3;
        const u32x2 x = *(const u32x2*)(vbuf + (tok0 + step) * 256 + h * 64 + v0 + 4 * qd);
        *(LAS f32x4*)(vb + step * 20 + 4 * qd) = (f32x4){bflo(x.x), bfhi(x.x), bflo(x.y), bfhi(x.y)}; }
    else if (lt < 128 + SC_TC) { const int step = lt - 128; vb[step * 20 + 16] = cs[(tok0 + step) * 4 + h]; }
}
__device__ __forceinline__ void rwkv_scan_block(LAS unsigned char* lds, int blk, const unsigned char* __restrict__ rec, const bf16_t* __restrict__ vbuf, const float* __restrict__ cs, float* __restrict__ ya) {
    const int tid = tid_opaque(), lane = tid & 63, w = tid >> 6;
    const int bh = blk >> 2, b = bh >> 2, h = bh & 3, v0 = (blk & 3) * 16;
    LAS float* RECB = (LAS float*)lds;
    LAS float* VB = RECB + 2 * SC_REC_F;
    const size_t tokb = (size_t)b * SEQ;
    const int rowl = lane >> 4, kq = lane & 15, row = v0 + 4 * (w & 3) + rowl;
    f32x2 Sa = {0.f, 0.f}, Sb = {0.f, 0.f}; float ykeep = 0.f;
    if (w < 4) __builtin_amdgcn_s_setprio(3);
    __syncthreads();
    if (w >= 4) scan_load_chunk(RECB, VB, rec, vbuf, cs, tokb, h, v0, tid - 256);
    for (int c = 0; c < SEQ / SC_TC; ++c) {
        __syncthreads();
        const int buf = c & 1;
        if (w >= 4) { if (c + 1 < SEQ / SC_TC) scan_load_chunk(RECB + (buf ^ 1) * SC_REC_F, VB + (buf ^ 1) * SC_V_F, rec, vbuf, cs, tokb + (size_t)(c + 1) * SC_TC, h, v0, tid - 256); }
        else {
            const LAS float* rb = RECB + buf * SC_REC_F + kq * 20; const LAS float* vb = VB + buf * SC_V_F;
            float* yo = ya + (tokb + (size_t)c * SC_TC + kq) * 256 + h * 64 + row;
#define SC_LD(P, st) do { const LAS float* R_ = rb + (st) * 320; P##w = *(const LAS f32x4*)R_; P##r = *(const LAS f32x4*)(R_ + 4); P##k = *(const LAS f32x4*)(R_ + 8); \
                          P##n = *(const LAS f32x4*)(R_ + 12); P##b = *(const LAS f32x4*)(R_ + 16); P##v = vb[(st) * 20 + 4 * w + rowl]; } while (0)
#define LO2(q_) ((f32x2){(q_).x, (q_).y})
#define HI2(q_) ((f32x2){(q_).z, (q_).w})
            f32x4 Aw, Ar, Ak, An, Ab, Bw, Br, Bk, Bn, Bb, Cw, Cr, Ck, Cn, Cb, Dw, Dr, Dk, Dn, Db; float Av, Bv, Cv, Dv, Bc, Dc;
            SC_LD(A, 0); SC_LD(B, 1); Bc = vb[1 * 20 + 16];
#pragma unroll
            for (int st = 0; st < SC_TC; st += 4) {
                if (st + 2 < SC_TC) { SC_LD(C, st + 2); SC_LD(D, st + 3); Dc = vb[(st + 3) * 20 + 16]; }
#define SC_PAIR(E, O, Oc, S0) do { \
                f32x2 d0 = Sa * LO2(E##n); d0 = Sb * HI2(E##n) + d0; f32x2 d1 = Sa * LO2(O##n); d1 = Sb * HI2(O##n) + d1; \
                const f32x2 ve = {E##v, E##v}, vo = {O##v, O##v}; \
                f32x2 ta = ve * LO2(E##k), tb = ve * HI2(E##k); ta = Sa * LO2(E##w) + ta; tb = Sb * HI2(E##w) + tb; \
                const float sa0 = allreduce16(d0.x + d0.y); const float sa1 = allreduce16(d1.x + d1.y) + E##v * Oc; \
                const f32x2 s0 = {sa0, sa0}, s1 = {sa1, sa1}; \
                Sa = s0 * LO2(E##b) + ta; Sb = s0 * HI2(E##b) + tb; \
                f32x2 e0 = Sa * LO2(E##r); e0 = Sb * HI2(E##r) + e0; \
                f32x2 ua = vo * LO2(O##k), ub = vo * HI2(O##k); ua = Sa * LO2(O##w) + ua; ub = Sb * HI2(O##w) + ub; \
                Sa = s1 * LO2(O##b) + ua; Sb = s1 * HI2(O##b) + ub; \
                f32x2 e1 = Sa * LO2(O##r); e1 = Sb * HI2(O##r) + e1; \
                Y0 = e0.x + e0.y; Y1 = e1.x + e1.y; } while (0)
                float yp0, yp1, yp2, yp3;
#define Y0 yp0
#define Y1 yp1
                SC_PAIR(A, B, Bc, st);
#undef Y0
#undef Y1
                if (st + 4 < SC_TC) { SC_LD(A, st + 4); SC_LD(B, st + 5); Bc = vb[(st + 5) * 20 + 16]; }
#define Y0 yp2
#define Y1 yp3
                SC_PAIR(C, D, Dc, st + 2);
#undef Y0
#undef Y1
                {
                    const unsigned long long b0 = 0xAAAAAAAAAAAAAAAAull, b1 = 0xCCCCCCCCCCCCCCCCull;
                    float s01, x01, s23, x23;
                    asm volatile("v_cndmask_b32_e64 %0, %1, %2, %3" : "=v"(s01) : "v"(yp0), "v"(yp1), "s"(b0));
                    asm volatile("v_cndmask_b32_e64 %0, %1, %2, %3" : "=v"(x01) : "v"(yp1), "v"(yp0), "s"(b0));
                    asm volatile("v_cndmask_b32_e64 %0, %1, %2, %3" : "=v"(s23) : "v"(yp2), "v"(yp3), "s"(b0));
                    asm volatile("v_cndmask_b32_e64 %0, %1, %2, %3" : "=v"(x23) : "v"(yp3), "v"(yp2), "s"(b0));
                    const float a01 = s01 + dpp_mov<0xB1>(x01), a23 = s23 + dpp_mov<0xB1>(x23);
                    float sq, xq;
                    asm volatile("v_cndmask_b32_e64 %0, %1, %2, %3" : "=v"(sq) : "v"(a01), "v"(a23), "s"(b1));
                    asm volatile("v_cndmask_b32_e64 %0, %1, %2, %3" : "=v"(xq) : "v"(a23), "v"(a01), "s"(b1));
                    float yq = sq + dpp_mov<0x4E>(xq);
                    yq += dpp_mov<0x128>(yq); yq += dpp_mov<0x124>(yq);
                    const unsigned long long mk = 0x000F000F000F000Full << (st & 15);
                    asm volatile("v_cndmask_b32_e64 %0, %0, %1, %2" : "+v"(ykeep) : "v"(yq), "s"(mk));
                }
                if ((st & 15) == 12) yo[(size_t)(st - 12) * 256] = ykeep;
            }
#undef SC_PAIR
#undef SC_LD
#undef LO2
#undef HI2
        }
    }
    __builtin_amdgcn_s_setprio(0);
}

#define XB_TMO      128
#define XB_XCNT(j)  (256  + 64 * (j))
#define XB_XSUB(j)  (1280 + 64 * (j))
#define XB_XGEN(j)  (2304 + 64 * (j))
#define XB_TOP      3328
#define XB_TOPGEN   3392
#define XB_SPIN_CAP (1u << 20)
__device__ __forceinline__ unsigned xb_ld(unsigned* p)              { return __hip_atomic_load(p, __ATOMIC_RELAXED, __HIP_MEMORY_SCOPE_AGENT); }
__device__ __forceinline__ unsigned xb_add(unsigned* p, unsigned v) { return __hip_atomic_fetch_add(p, v, __ATOMIC_RELAXED, __HIP_MEMORY_SCOPE_AGENT); }
__device__ __forceinline__ unsigned xb_xcc_id() { return (unsigned)__builtin_amdgcn_s_getreg((3 << 11) | 20) & 0xFu; }
#define XB_SPIN(cond, bar) do { unsigned _sp = 0; while (cond) { __builtin_amdgcn_s_sleep(1); \
    if ((++_sp & 255u) == 0u) { if (xb_ld(&(bar)[XB_TMO])) break; if (_sp > XB_SPIN_CAP) { atomicAdd(&(bar)[XB_TMO], 1u); break; } } } } while (0)
struct XcdBarrier { unsigned* bar; unsigned x; volatile LAS unsigned* st; };
__device__ __forceinline__ XcdBarrier xcd_barrier_post(unsigned* bar, volatile LAS unsigned* st) {
    XcdBarrier b; b.bar = bar; b.x = xb_xcc_id(); b.st = st;
    if (__builtin_amdgcn_workitem_id_x() == 0) (void)xb_add(&bar[XB_XCNT(b.x)], 1u);
    return b;
}
__device__ __forceinline__ void xcd_barrier_complete(unsigned* bar, unsigned x, unsigned& nloc, unsigned& nx) {
    const unsigned G = gridDim.x * gridDim.y * gridDim.z;
    unsigned sum, cnt, mine, sp = 0u;
    for (;;) {
        sum = 0u; cnt = 0u; mine = 0u;
#pragma unroll
        for (unsigned j = 0; j < 16; ++j) { const unsigned c = xb_ld(&bar[XB_XCNT(j)]); sum += c; cnt += (c > 0u) ? 1u : 0u; mine = (j == x) ? c : mine; }
        if (sum == G) break;
        __builtin_amdgcn_s_sleep(1);
        if ((++sp & 255u) == 0u) { if (xb_ld(&bar[XB_TMO])) break; if (sp > XB_SPIN_CAP) { atomicAdd(&bar[XB_TMO], 1u); break; } }
    }
    nloc = mine > 0u ? mine : 1u; nx = cnt > 0u ? cnt : 1u;
}
__device__ __forceinline__ void xcd_barrier(const XcdBarrier& b, const unsigned k) {
    asm volatile("s_waitcnt vmcnt(0)" ::: "memory");
    __syncthreads();
    if (__builtin_amdgcn_workitem_id_x() == 0) {
        unsigned* bar = b.bar;
        __builtin_amdgcn_s_waitcnt(0);
        unsigned nloc = b.st[0], nx = b.st[1];
        if (nloc == 0u) { xcd_barrier_complete(bar, b.x, nloc, nx); b.st[0] = nloc; b.st[1] = nx; }
        const unsigned old = xb_add(&bar[XB_XSUB(b.x)], 1u);
        const unsigned gen = old / nloc;
        if (old + 1u == (gen + 1u) * nloc) {
            __builtin_amdgcn_fence(__ATOMIC_RELEASE, "agent");
            asm volatile("s_waitcnt vmcnt(0)" ::: "memory");
            const unsigned og = xb_add(&bar[XB_TOP], 1u);
            const unsigned tg = og / nx;
            if (og + 1u == (tg + 1u) * nx) xb_add(&bar[XB_TOPGEN], 1u);
            else XB_SPIN(xb_ld(&bar[XB_TOPGEN]) == tg, bar);
            __builtin_amdgcn_fence(__ATOMIC_ACQUIRE, "agent");
            asm volatile("s_waitcnt vmcnt(0)" ::: "memory");
        } else {
            XB_SPIN(xb_ld(&bar[XB_TOPGEN]) < k, bar);
            __builtin_amdgcn_fence(__ATOMIC_ACQUIRE, "agent");
            asm volatile("s_waitcnt vmcnt(0)" ::: "memory");
        }
    }
    __syncthreads();
}


#define XB2_XCNT(j) (8192 + 64 * (j))
#define XB2_XSUB(j) (9216 + 64 * (j))
#define XB2_TOP     10240
#define XB2_TOPGEN  10304
__device__ __forceinline__ void sub_barrier_nonscan(unsigned* ctl, volatile LAS unsigned* st2, const unsigned k) {
    asm volatile("s_waitcnt vmcnt(0)" ::: "memory");
    __syncthreads();
    if (__builtin_amdgcn_workitem_id_x() == 0) {
        const unsigned x = xb_xcc_id();
        unsigned nloc = st2[0], nx = st2[1];
        if (nloc == 0u) {
            unsigned cnts[16];
#pragma unroll
            for (unsigned j = 0; j < 16; ++j) cnts[j] = xb_ld(&ctl[XB2_XCNT(j)]);
#pragma unroll
            for (unsigned j = 0; j < 16; ++j) { nloc = (j == x) ? cnts[j] : nloc; nx += (cnts[j] > 0u) ? 1u : 0u; }
            nloc = nloc ? nloc : 1u; nx = nx ? nx : 1u; st2[0] = nloc; st2[1] = nx;
        }
        const unsigned old = xb_add(&ctl[XB2_XSUB(x)], 1u);
        if ((old + 1u) % nloc == 0u) {
            __builtin_amdgcn_fence(__ATOMIC_RELEASE, "agent"); asm volatile("s_waitcnt vmcnt(0)" ::: "memory");
            const unsigned og = xb_add(&ctl[XB2_TOP], 1u);
            if ((og + 1u) % nx == 0u) xb_add(&ctl[XB2_TOPGEN], 1u);
        }
        unsigned sp = 0; while (xb_ld(&ctl[XB2_TOPGEN]) < k) { __builtin_amdgcn_s_sleep(1); if (++sp > (1u << 22)) break; }
        __builtin_amdgcn_fence(__ATOMIC_ACQUIRE, "agent"); asm volatile("s_waitcnt vmcnt(0)" ::: "memory");
    }
    __syncthreads();
}
#define PIN(i) ((const float*)P.in[(i) + z])
constexpr int NPH = 9;
template <int PH> __device__ __forceinline__ void run_phase(const Params& P, LAS unsigned char* lds) {
        int z; asm volatile("s_mov_b32 %0, 0" : "=s"(z));
        unsigned char* ws = P.ws + z;
        constexpr int layer = PH / NPH, k = PH - layer * NPH;
        const int tid = tid_opaque(), lane = tid & 63, wave = __builtin_amdgcn_readfirstlane(tid >> 6), G = sgpr_opaque(gridDim.x), blk = sgpr_opaque(blockIdx.x);
        const int gw = blk * 8 + wave, NGW = G * 8;
        float* hbuf = P.out + z;
        bf16_t* XN = (bf16_t*)(ws + WS_X);
        if constexpr (PH == NPH * DEPTH) {
            const float* g = PIN(I_FINAL);
            const f32x4* gr = (const f32x4*)g + lane;
            f32x4 gg[4];
#pragma unroll
            for (int j = 0; j < 4; ++j) gg[j] = gr[64 * j];
            for (int m = gw; m < T; m += 4 * NGW) {
                f32x4 v[4][4]; float rs[4];
#pragma unroll
                for (int r = 0; r < 4; ++r)
#pragma unroll
                    for (int j = 0; j < 4; ++j) v[r][j] = ((const f32x4*)(hbuf + (size_t)(m + r * NGW) * 1024) + lane)[64 * j];
#pragma unroll
                for (int r = 0; r < 4; ++r) { float s2 = 0.f;
#pragma unroll
                    for (int j = 0; j < 4; ++j) s2 += (v[r][j].x * v[r][j].x + v[r][j].y * v[r][j].y) + (v[r][j].z * v[r][j].z + v[r][j].w * v[r][j].w);
                    rs[r] = s2; }
#pragma unroll
                for (int r = 0; r < 4; ++r) rs[r] = rsqrtf(wave_sum(rs[r]) * (1.f / 1024.f) + NORM_EPS);
#pragma unroll
                for (int r = 0; r < 4; ++r)
#pragma unroll
                    for (int j = 0; j < 4; ++j) ((f32x4*)(hbuf + (size_t)(m + r * NGW) * 1024) + lane)[64 * j] = v[r][j] * rs[r] * gg[j];
            }
            return;
        } else if constexpr (k == 0) {
            const float* hin = (layer == 0) ? PIN(I_X) : hbuf;
            LAS float* tscr = (LAS float*)(lds + wave * 16384);
            bf16_t* Win_t = (bf16_t*)(ws + WS_WIN); bf16_t* Wq_t = (bf16_t*)(ws + WS_WQ); bf16_t* Wkv_t = (bf16_t*)(ws + WS_WKV); bf16_t* Wo_t = (bf16_t*)(ws + WS_WO);
            const float* Win = PIN(I_W_IN) + (size_t)layer * DM * IN_DIM;
            const float* Wq = PIN(I_WQUP) + (size_t)layer * 384 * 768;
            const float* Wkv = PIN(I_WKVUP) + (size_t)layer * 256 * 1024;
            const float* Wo = PIN(I_W_OUT) + (size_t)layer * 1024 * 1024;
            constexpr int IT_IN = 16 * 81, IT_Q = 6 * 24, IT_KV = 4 * 32, IT_O = 16 * 32;
            if (layer == 0) for (int it = gw; it < IT_IN + IT_Q + IT_KV + IT_O; it += NGW) {
                int r = it;
                if (r < IT_IN) { transpose_item(Win, 1024, IN_DIM, Win_t, 1, tscr, r, lane); continue; } r -= IT_IN;
                if (r < IT_Q) { transpose_item(Wq, 384, 768, Wq_t, 0, tscr, r, lane); continue; } r -= IT_Q;
                if (r < IT_KV) { transpose_item(Wkv, 256, 1024, Wkv_t, 0, tscr, r, lane); continue; } r -= IT_KV;
                transpose_item(Wo, 1024, 1024, Wo_t, 0, tscr, r, lane);
            }
            for (int i = blk * 512 + tid; i < 224 * 128; i += G * 512) { const int rr = i >> 7, cc = i & 127; const int row = (rr < 128) ? 896 + rr : 2720 + (rr - 128);
                *(u32x4*)(Win_t + (size_t)row * 1024 + cc * 8) = (u32x4){0u, 0u, 0u, 0u}; }
            if (layer == 0) {
                const int* pos = (const int*)P.in[I_POS + z];
                float* cosR = (float*)(ws + WS_COSR); float* sinR = (float*)(ws + WS_SINR); float* cosM = (float*)(ws + WS_COSM); float* sinM = (float*)(ws + WS_SINM);
                for (int i = blk * 512 + tid; i < T * 32; i += G * 512) { const int tok = i >> 5, f = i & 31;
                    const float inv = exp2f(-(float)f * (1.f / 32.f) * 13.287712379549449f); const float ang = (float)pos[tok] * inv;
                    double rev = (double)ang * 0.15915494309189535; rev -= floor(rev); const float a = (float)(rev * 6.283185307179586);
                    cosR[i] = __cosf(a); sinR[i] = __sinf(a); }
                for (int i = blk * 512 + tid; i < T * 16; i += G * 512) { const int tok = i >> 4, f = i & 15;
                    const float inv = exp2f(-(float)f * (1.f / 16.f) * 13.287712379549449f); const float ang = (float)pos[tok] * inv;
                    double rev = (double)ang * 0.15915494309189535; rev -= floor(rev); const float a = (float)(rev * 6.283185307179586);
                    cosM[i] = __cosf(a); sinM[i] = __sinf(a); }
            }
            const float* g = PIN(I_ATTN_NORM) + layer * 1024;
            for (int m = gw; m < T; m += 2 * NGW) rms_rows2_bf16(hin + (size_t)m * 1024, hin + (size_t)(m + NGW) * 1024, g, XN + (size_t)m * 1024, XN + (size_t)(m + NGW) * 1024, lane);
        } else if constexpr (k == 1) {
            pg8::Gemm g{XN, (bf16_t*)(ws + WS_WIN), T, NPROJ, 1024}; pg8::StaticOrder S; S.init(T, NPROJ, G, blk);
            pg8::EpiProj E{(bf16_t*)(ws + WS_PA), (bf16_t*)(ws + WS_PB), (bf16_t*)(ws + WS_PC)};
            pg8::gemm_phase<pg8::EpiProj, pg8::StaticOrder, true, true>(lds, g, S, E);
        } else if constexpr (k == 2) {
            bf16_t* pa = (bf16_t*)(ws + WS_PA); bf16_t* pb = (bf16_t*)(ws + WS_PB); bf16_t* pc = (bf16_t*)(ws + WS_PC);
            float* cosR = (float*)(ws + WS_COSR); float* sinR = (float*)(ws + WS_SINR); float* cosM = (float*)(ws + WS_COSM); float* sinM = (float*)(ws + WS_SINM);
            PrepW W;
            {
                const int l16 = lane & 15, lq = lane >> 4;
                const float* w2 = PIN(I_W2) + layer * 32 * 256; const float* a2 = PIN(I_A2) + layer * 32 * 256; const float* g2 = PIN(I_G2) + layer * 64 * 256;
                const float* v1 = PIN(I_V1) + (layer > 0 ? (layer - 1) * 256 * 32 : 0); const float* v2 = PIN(I_V2) + (layer > 0 ? (layer - 1) * 32 * 256 : 0);
#pragma unroll
                for (int nt = 0; nt < 2; ++nt) { const int n = 16 * (2 * wave + nt) + l16;
                    W.Bw[nt] = pack_col8(w2, 256, 8 * lq, n); W.Ba[nt] = pack_col8(a2, 256, 8 * lq, n);
                    W.Bg[nt][0] = pack_col8(g2, 256, 8 * lq, n); W.Bg[nt][1] = pack_col8(g2, 256, 32 + 8 * lq, n);
                    W.Bv[nt] = pack_col8(v2, 256, 8 * lq, n); W.Bv1[nt] = pack_col8(v1, 32, 32 * wave + 8 * lq, 16 * nt + l16); }
            }
            unsigned raw[17];
            if (tid < 448 && blk < T / 16) prep_fetch_rows(raw, pa, blk * 16, tid * 2);
            PrepC PC;
            { const int cc = tid & 255, c2 = (tid < 448) ? tid * 2 : 0;
              const float* mu = PIN(I_MU) + layer * RW_IN;
              PC.mu0 = mu[c2]; PC.mu1 = mu[c2 + 1]; PC.w0c = (PIN(I_W0) + layer * 256)[cc]; PC.a0c = (PIN(I_A0) + layer * 256)[cc]; PC.kkc = (PIN(I_KK) + layer * 256)[cc];
              PC.kac = (PIN(I_KA) + layer * 256)[cc]; PC.rkc = (PIN(I_RK) + layer * 256)[cc]; PC.v0c = (layer > 0) ? (PIN(I_V0) + (layer - 1) * 256)[cc] : 0.f; }
            for (int tile = blk; tile < T / 16; tile += G) rwkv_prep_tile(lds, tile, (tile + G < T / 16) ? tile + G : -1, raw, PC, layer, P, z, W, pa, ws + WS_REC, (bf16_t*)(ws + WS_VBUF), (bf16_t*)(ws + WS_GBUF), (bf16_t*)(ws + WS_VFIRST), (float*)(ws + WS_BS), (float*)(ws + WS_BS + 512 * 1024));
            for (int u = blk; u < 512; u += G) ret_kv_unit(lds, u >> 5, u & 31, pb, cosR, sinR, (float*)(ws + WS_KVT));
        } else if constexpr (k == 3) {
            LAS unsigned* misc = (LAS unsigned*)(lds + 131072);
            unsigned* ctl = (unsigned*)(ws + WS_CTL);
            float* cosR = (float*)(ws + WS_COSR); float* sinR = (float*)(ws + WS_SINR); float* cosM = (float*)(ws + WS_COSM); float* sinM = (float*)(ws + WS_SINM);
            unsigned* sbar = ctl + 64 * (8 + layer);
            const int NB = G - 64;
            if (blk < 64) {
                rwkv_scan_block(lds, blk, ws + WS_REC, (bf16_t*)(ws + WS_VBUF), (const float*)(ws + WS_BS + 512 * 1024), (float*)(ws + WS_YA));
                if (tid == 0) { unsigned sp = 0; while (xb_ld((unsigned*)ctl + XB2_TOPGEN) < 2u * layer + 2u) { __builtin_amdgcn_s_sleep(4); if (++sp > (1u << 22)) break; }
                    __builtin_amdgcn_fence(__ATOMIC_ACQUIRE, "agent"); asm volatile("s_waitcnt vmcnt(0)" ::: "memory"); }
                __syncthreads();
            } else {
                const int cb = blk - 64;
                {
                    const int gwn = cb * 8 + wave, NGWn = NB * 8;
                    bf16_t* pc = (bf16_t*)(ws + WS_PC);
            bf16_t* qn = (bf16_t*)(ws + WS_QN); bf16_t* kvn = (bf16_t*)(ws + WS_KVN); bf16_t* kr = (bf16_t*)(ws + WS_KR);
            const float* qg = PIN(I_QNORM) + layer * 384; const float* kg = PIN(I_KVNORM) + layer * 256;
            const int lq_ = (lane < 48) ? lane : 0, lk_ = lane & 31, lr_ = lane & 1;
            const f32x4 qg0 = *(const f32x4*)(qg + 8 * lq_), qg1 = *(const f32x4*)(qg + 8 * lq_ + 4), kg0 = *(const f32x4*)(kg + 8 * lk_), kg1 = *(const f32x4*)(kg + 8 * lk_ + 4);
            for (int m0 = gwn; m0 < T; m0 += 2 * NGWn) {
                u32x4 rq_[2], rk_[2], r1_[2], r2_[2]; f32x4 cA[2], cB[2], sA[2], sB[2];
#pragma unroll
                for (int u = 0; u < 2; ++u) { const int m = (m0 + u * NGWn < T) ? m0 + u * NGWn : T - 1; const bf16_t* row = pc + (size_t)m * 768;
                    rq_[u] = *(const u32x4*)(row + 8 * lq_); rk_[u] = *(const u32x4*)(row + 384 + 8 * lk_);
                    r1_[u] = *(const u32x4*)(row + 640 + 8 * lr_); r2_[u] = *(const u32x4*)(row + 656 + 8 * lr_);
                    cA[u] = *(const f32x4*)(cosM + (size_t)m * 16 + 8 * lr_); cB[u] = *(const f32x4*)(cosM + (size_t)m * 16 + 8 * lr_ + 4);
                    sA[u] = *(const f32x4*)(sinM + (size_t)m * 16 + 8 * lr_); sB[u] = *(const f32x4*)(sinM + (size_t)m * 16 + 8 * lr_ + 4); }
#pragma unroll
                for (int u = 0; u < 2; ++u) { const int m = m0 + u * NGWn; if (m >= T) continue;
                    float q8[8], k8[8];
#pragma unroll
                    for (int j = 0; j < 4; ++j) { q8[2 * j] = bflo(rq_[u][j]); q8[2 * j + 1] = bfhi(rq_[u][j]); k8[2 * j] = bflo(rk_[u][j]); k8[2 * j + 1] = bfhi(rk_[u][j]); }
                    float sq = 0.f, sk = 0.f;
#pragma unroll
                    for (int j = 0; j < 8; ++j) { sq += q8[j] * q8[j]; sk += k8[j] * k8[j]; }
                    if (lane >= 48) sq = 0.f;
                    if (lane >= 32) sk = 0.f;
                    const float rq = rsqrtf(wave_sum(sq) * (1.f / 384.f) + NORM_EPS), rk = rsqrtf(wave_sum(sk) * (1.f / 256.f) + NORM_EPS);
                    if (lane < 48) { u32x4 o; o.x = cvt_pk_bf16(q8[0] * rq * qg0.x, q8[1] * rq * qg0.y); o.y = cvt_pk_bf16(q8[2] * rq * qg0.z, q8[3] * rq * qg0.w);
                        o.z = cvt_pk_bf16(q8[4] * rq * qg1.x, q8[5] * rq * qg1.y); o.w = cvt_pk_bf16(q8[6] * rq * qg1.z, q8[7] * rq * qg1.w); *(u32x4*)(qn + (size_t)m * 384 + 8 * lane) = o; }
                    if (lane < 32) { u32x4 o; o.x = cvt_pk_bf16(k8[0] * rk * kg0.x, k8[1] * rk * kg0.y); o.y = cvt_pk_bf16(k8[2] * rk * kg0.z, k8[3] * rk * kg0.w);
                        o.z = cvt_pk_bf16(k8[4] * rk * kg1.x, k8[5] * rk * kg1.y); o.w = cvt_pk_bf16(k8[6] * rk * kg1.z, k8[7] * rk * kg1.w); *(u32x4*)(kvn + (size_t)m * 256 + 8 * lane) = o; }
                    if (lane < 2) { const float cs8[8] = {cA[u].x, cA[u].y, cA[u].z, cA[u].w, cB[u].x, cB[u].y, cB[u].z, cB[u].w}, sn8[8] = {sA[u].x, sA[u].y, sA[u].z, sA[u].w, sB[u].x, sB[u].y, sB[u].z, sB[u].w};
                        u32x4 o1, o2;
#pragma unroll
                        for (int j = 0; j < 4; ++j) { const float a0 = bflo(r1_[u][j]), a1 = bfhi(r1_[u][j]), b0 = bflo(r2_[u][j]), b1 = bfhi(r2_[u][j]);
                            o1[j] = cvt_pk_bf16(a0 * cs8[2 * j] - b0 * sn8[2 * j], a1 * cs8[2 * j + 1] - b1 * sn8[2 * j + 1]); o2[j] = cvt_pk_bf16(b0 * cs8[2 * j] + a0 * sn8[2 * j], b1 * cs8[2 * j + 1] + a1 * sn8[2 * j + 1]); }
                        *(u32x4*)(kr + (size_t)m * 32 + 8 * lane) = o1; *(u32x4*)(kr + (size_t)m * 32 + 16 + 8 * lane) = o2; }
                }
            }
                    sub_barrier_nonscan((unsigned*)ctl, (volatile LAS unsigned*)(misc + 12), 2u * layer + 1u);
                }
                bf16_t* rprev = (bf16_t*)(ws + WS_RPREV); const float* kvt = (const float*)(ws + WS_KVT);
                for (int i = cb * 512 + tid; i < 16 * 4096; i += NB * 512) { const int bh = i >> 12, el = i & 4095; const int h = bh & 3;
                    const float cd = exp2f(128.f * log2f(1.f - exp2f(-5.f - (float)h)));
                    float R = 0.f;
#pragma unroll 8
                    for (int ci = 0; ci < 32; ++ci) { rprev[((size_t)(bh * 32 + ci)) * 4096 + el] = f2bf(R); R = R * cd + kvt[((size_t)(bh * 32 + ci)) * 4096 + el]; } }
                __syncthreads();
                { pg8::Gemm g{(bf16_t*)(ws + WS_QN), (bf16_t*)(ws + WS_WQ), T, 768, 384}; pg8::StaticOrder S; S.init(T, 768, NB, cb); pg8::EpiPlain E{(bf16_t*)(ws + WS_PC), 768};
                  pg8::gemm_phase<pg8::EpiPlain, pg8::StaticOrder, true, true>(lds, g, S, E); }
                { pg8::Gemm g{(bf16_t*)(ws + WS_KVN), (bf16_t*)(ws + WS_WKV), T, 1024, 256}; pg8::StaticOrder S; S.init(T, 1024, NB, cb); pg8::EpiPlain E{(bf16_t*)(ws + WS_KN), 1024};
                  pg8::gemm_phase<pg8::EpiPlain, pg8::StaticOrder, true, true>(lds, g, S, E); }
                sub_barrier_nonscan((unsigned*)ctl, (volatile LAS unsigned*)(misc + 12), 2u * layer + 2u);
            }
            unsigned* qctr = ctl + 64 * (1 + layer);
            for (;;) {
                __syncthreads();
                if (tid == 0) misc[0] = atomicAdd(qctr, 1u);
                __syncthreads();
                const int u = (int)misc[0];
                if (u >= 768) break;
                if (u < 512) { const int qb = 15 - (u >> 5), bh = u & 31; att_unit(lds, bh >> 3, bh & 7, qb, (bf16_t*)(ws + WS_PC), (bf16_t*)(ws + WS_KN), (bf16_t*)(ws + WS_KR), cosM, sinM, XN); }
                else { const int v = u - 512; const int bh = v & 15, jb = v >> 4; ret_unit(lds, bh >> 2, bh & 3, jb, (bf16_t*)(ws + WS_PB), cosR, sinR, (bf16_t*)(ws + WS_RPREV), (float*)(ws + WS_YB)); }
            }
        } else if constexpr (k == 4) {
            LAS float* tscr = (LAS float*)(lds + wave * 16384);
            const float* __restrict__ ya = (const float*)(ws + WS_YA); const float* __restrict__ yb = (const float*)(ws + WS_YB); const float* __restrict__ bs = (const float*)(ws + WS_BS);
            const bf16_t* __restrict__ vbuf = (const bf16_t*)(ws + WS_VBUF); const bf16_t* __restrict__ gbuf = (const bf16_t*)(ws + WS_GBUF); const bf16_t* __restrict__ pb = (const bf16_t*)(ws + WS_PB);
            const float* __restrict__ gnw = PIN(I_GNW) + layer * 256; const float* __restrict__ gnb = PIN(I_GNB) + layer * 256;
            bf16_t* __restrict__ XNw = XN;
            const f32x4 gw4 = *(const f32x4*)(gnw + 4 * lane), gb4 = *(const f32x4*)(gnb + 4 * lane);
#pragma unroll 4
            for (int m = gw; m < T; m += NGW) {
                const int c = 4 * lane, head = lane >> 4;
                const f32x4 y = *(const f32x4*)(ya + (size_t)m * 256 + c);
                const float mean = allreduce16((y.x + y.y) + (y.z + y.w)) * (1.f / 64.f);
                const f32x4 d = y - mean;
                const float var = allreduce16((d.x * d.x + d.y * d.y) + (d.z * d.z + d.w * d.w)) * (1.f / 64.f);
                const float rs = rsqrtf(var + 64e-5f);
                const u32x2 vv = *(const u32x2*)(vbuf + (size_t)m * 256 + c), gg = *(const u32x2*)(gbuf + (size_t)m * 256 + c);
                const float bsc = bs[(size_t)m * 4 + head];
                const float o0 = (d.x * rs * gw4.x + gb4.x + bsc * bflo(vv.x)) * bflo(gg.x), o1 = (d.y * rs * gw4.y + gb4.y + bsc * bfhi(vv.x)) * bfhi(gg.x);
                const float o2 = (d.z * rs * gw4.z + gb4.z + bsc * bflo(vv.y)) * bflo(gg.y), o3 = (d.w * rs * gw4.w + gb4.w + bsc * bfhi(vv.y)) * bfhi(gg.y);
                u32x2 w; w.x = cvt_pk_bf16(o0, o1); w.y = cvt_pk_bf16(o2, o3);
                *(u32x2*)(XNw + (size_t)m * 1024 + c) = w;
                const f32x4 zz = *(const f32x4*)(yb + (size_t)m * 256 + c);
                const float ms = allreduce16((zz.x * zz.x + zz.y * zz.y) + (zz.z * zz.z + zz.w * zz.w)) * (1.f / 64.f);
                const float rz = rsqrtf(ms + NORM_EPS);
                const u32x2 gt = *(const u32x2*)(pb + (size_t)m * 1024 + 768 + c);
                const float g0 = bflo(gt.x), g1 = bfhi(gt.x), g2v = bflo(gt.y), g3 = bfhi(gt.y);
                u32x2 w2; w2.x = cvt_pk_bf16(zz.x * rz * g0 * sigmoidf_(g0), zz.y * rz * g1 * sigmoidf_(g1)); w2.y = cvt_pk_bf16(zz.z * rz * g2v * sigmoidf_(g2v), zz.w * rz * g3 * sigmoidf_(g3));
                *(u32x2*)(XNw + (size_t)m * 1024 + 256 + c) = w2;
            }
            const float* Wgu = PIN(I_WGU) + (size_t)layer * 1024 * 2 * D_FF; const float* Wdn = PIN(I_WDN) + (size_t)layer * D_FF * 1024;
            bf16_t* Wgu_t = (bf16_t*)(ws + WS_WGU); bf16_t* Wdn_t = (bf16_t*)(ws + WS_WDN);
            constexpr int IT_GU = 16 * 176, IT_DN = 44 * 32;
            for (int it = gw; it < IT_GU + IT_DN; it += NGW) {
                if (it < IT_GU) transpose_item(Wgu, 1024, 2 * D_FF, Wgu_t, 2, tscr, it, lane);
                else transpose_item(Wdn, D_FF, 1024, Wdn_t, 0, tscr, it - IT_GU, lane);
            }
        } else if constexpr (k == 5) {
            const float* hin = (layer == 0) ? PIN(I_X) : hbuf;
            pg8::Gemm g{XN, (bf16_t*)(ws + WS_WO), T, 1024, 1024}; pg8::StaticOrder S; S.init(T, 1024, G, blk); pg8::EpiRes E{hin, hbuf};
            pg8::gemm_phase<pg8::EpiRes, pg8::StaticOrder, true, true>(lds, g, S, E);
        } else if constexpr (k == 6) {
            const float* g = PIN(I_FFN_NORM) + layer * 1024;
            for (int m = gw; m < T; m += 2 * NGW) rms_rows2_bf16(hbuf + (size_t)m * 1024, hbuf + (size_t)(m + NGW) * 1024, g, XN + (size_t)m * 1024, XN + (size_t)(m + NGW) * 1024, lane);
            if constexpr (layer + 1 < DEPTH) {
                LAS float* tscr = (LAS float*)(lds + wave * 16384);
                const float* Win = PIN(I_W_IN) + (size_t)(layer + 1) * DM * IN_DIM; const float* Wq = PIN(I_WQUP) + (size_t)(layer + 1) * 384 * 768;
                const float* Wkv = PIN(I_WKVUP) + (size_t)(layer + 1) * 256 * 1024; const float* Wo = PIN(I_W_OUT) + (size_t)(layer + 1) * 1024 * 1024;
                constexpr int IT_IN = 16 * 81, IT_Q = 6 * 24, IT_KV = 4 * 32, IT_O = 16 * 32;
                for (int it = gw; it < IT_IN + IT_Q + IT_KV + IT_O; it += NGW) {
                    int r = it;
                    if (r < IT_IN) { transpose_item(Win, 1024, IN_DIM, (bf16_t*)(ws + WS_WIN), 1, tscr, r, lane); continue; } r -= IT_IN;
                    if (r < IT_Q) { transpose_item(Wq, 384, 768, (bf16_t*)(ws + WS_WQ), 0, tscr, r, lane); continue; } r -= IT_Q;
                    if (r < IT_KV) { transpose_item(Wkv, 256, 1024, (bf16_t*)(ws + WS_WKV), 0, tscr, r, lane); continue; } r -= IT_KV;
                    transpose_item(Wo, 1024, 1024, (bf16_t*)(ws + WS_WO), 0, tscr, r, lane);
                }
            }
        } else if constexpr (k == 7) {
            pg8::Gemm g{XN, (bf16_t*)(ws + WS_WGU), T, 2 * D_FF, 1024}; pg8::StaticOrder S; S.init(T, 2 * D_FF, G, blk); pg8::EpiSwiGLU E{(bf16_t*)(ws + WS_ACT)};
            pg8::gemm_phase<pg8::EpiSwiGLU, pg8::StaticOrder, true, true>(lds, g, S, E);
        } else {
            pg8::Gemm g{(bf16_t*)(ws + WS_ACT), (bf16_t*)(ws + WS_WDN), T, 1024, D_FF}; pg8::StaticOrder S; S.init(T, 1024, G, blk); pg8::EpiRes E{hbuf, hbuf};
            pg8::gemm_phase<pg8::EpiRes, pg8::StaticOrder, true, true>(lds, g, S, E);
        }
}

template <int PH> __device__ __forceinline__ void run_all(const Params& P, LAS unsigned char* lds, cg::grid_group& grid, const XcdBarrier& bar) {
    run_phase<PH>(P, lds);
    if constexpr (PH < NPH * DEPTH) {
        xcd_barrier(bar, (unsigned)PH + 1u);
        run_all<PH + 1>(P, lds, grid, bar);
    }
}
__global__ void __launch_bounds__(512) hymba_fwd(Params P) {
    extern __shared__ __attribute__((aligned(16))) unsigned char lds_raw[];
    LAS unsigned char* lds = (LAS unsigned char*)lds_raw;
    cg::grid_group grid = cg::this_grid();
    LAS unsigned* misc = (LAS unsigned*)(lds + 131072);
    if (__builtin_amdgcn_workitem_id_x() < 32) misc[__builtin_amdgcn_workitem_id_x()] = 0u;
    __syncthreads();
    if (P.ws == nullptr) grid.sync();
    if (blockIdx.x >= 64 && __builtin_amdgcn_workitem_id_x() == 0) (void)xb_add((unsigned*)(P.ws + WS_CTL) + XB2_XCNT(xb_xcc_id()), 1u);
    const XcdBarrier bar = xcd_barrier_post((unsigned*)(P.ws + WS_CTL) + 4096, (volatile LAS unsigned*)(misc + 8));
    run_all<0>(P, lds, grid, bar);
}
extern "C" void kernel_launch(void* const* d_in, const int* in_sizes, int n_in, void* d_out, int out_size, void* d_ws, size_t ws_size, hipStream_t stream) {
    static int grid = 0;
    if (grid == 0) {
        if (n_in != 27 || out_size != T * DM || ws_size < WS_END) { fprintf(stderr, "kernel_launch: unexpected shapes (n_in %d, out %d, ws %zu)\n", n_in, out_size, ws_size); grid = -1; return; }
        int dev = 0, cus = 0, per_cu = 0;
        (void)hipGetDevice(&dev); (void)hipDeviceGetAttribute(&cus, hipDeviceAttributeMultiprocessorCount, dev);
        if (hipFuncSetAttribute((const void*)hymba_fwd, hipFuncAttributeMaxDynamicSharedMemorySize, LDS_BYTES) != hipSuccess) { fprintf(stderr, "kernel_launch: hipFuncSetAttribute failed\n"); grid = -1; return; }
        if (hipOccupancyMaxActiveBlocksPerMultiprocessor(&per_cu, (const void*)hymba_fwd, 512, LDS_BYTES) != hipSuccess || per_cu < 1) { fprintf(stderr, "kernel_launch: occupancy query failed (%d)\n", per_cu); grid = -1; return; }
        (void)hipGetLastError();
        grid = cus;
        if (grid < 64) { fprintf(stderr, "kernel_launch: needs >= 64 CUs\n"); grid = -1; return; }
    }
    if (grid < 0) return;
    (void)hipMemsetAsync((char*)d_ws + WS_CTL, 0, 1 * MiB, stream);
    Params p{};
    for (int i = 0; i < 27; ++i) p.in[i] = d_in[i];
    p.out = (float*)d_out; p.ws = (unsigned char*)d_ws;
    void* args[] = {&p};
    hipError_t e = hipLaunchCooperativeKernel((const void*)hymba_fwd, dim3(grid), dim3(512), args, LDS_BYTES, stream);
    if (e != hipSuccess) fprintf(stderr, "kernel_launch: cooperative launch failed: %s (grid %d)\n", hipGetErrorString(e), grid);
}
```

```cpp
#include <hip/hip_runtime.h>
#include <hip/hip_cooperative_groups.h>
#include <cstdio>
#include <cstdint>
namespace cg = cooperative_groups;

#define LAS __attribute__((address_space(3)))
typedef unsigned short bf16_t;
typedef short bf16x8 __attribute__((ext_vector_type(8)));
typedef float f32x2 __attribute__((ext_vector_type(2)));
typedef float f32x4 __attribute__((ext_vector_type(4)));
typedef float f32x16 __attribute__((ext_vector_type(16)));
typedef unsigned u32x4 __attribute__((ext_vector_type(4)));
typedef unsigned u32x2 __attribute__((ext_vector_type(2)));

constexpr int BATCH = 4, SEQ = 4096, T = BATCH * SEQ, DM = 1024, DEPTH = 2;
constexpr int RW_IN = 896, IN_DIM = 2592, D_FF = 2816;
constexpr int NPROJ = 2816;
constexpr float NORM_EPS = 1e-6f;

constexpr size_t MiB = 1u << 20;
constexpr size_t WS_CTL = 0;
constexpr size_t WS_COSR = 1 * MiB, WS_SINR = 3 * MiB, WS_COSM = 5 * MiB, WS_SINM = 6 * MiB;
constexpr size_t WS_BS = 7 * MiB;
constexpr size_t WS_RPREV = 8 * MiB;
constexpr size_t WS_WIN = 12 * MiB;
constexpr size_t WS_WQ = WS_WIN + 5632 * 1024;
constexpr size_t WS_WKV = WS_WQ + 768 * 384 * 2;
constexpr size_t WS_WO = WS_WKV + 1024 * 256 * 2;
constexpr size_t WS_VFIRST = 21 * MiB;
constexpr size_t WS_VBUF = 29 * MiB;
constexpr size_t WS_GBUF = 37 * MiB;
constexpr size_t WS_X = 45 * MiB;
constexpr size_t WS_QN = WS_X, WS_KVN = WS_X + 12 * MiB;
constexpr size_t WS_KR = 253 * MiB;
constexpr size_t WS_PA = 77 * MiB;
constexpr size_t WS_YA = WS_PA, WS_YB = WS_PA + 16 * MiB;
constexpr size_t WS_PB = 109 * MiB;
constexpr size_t WS_PC = 141 * MiB;
constexpr size_t WS_ACT = 77 * MiB;
constexpr size_t WS_KN = 165 * MiB;
constexpr size_t WS_VT = 181 * MiB;
constexpr size_t WS_REC = 197 * MiB;
constexpr size_t WS_WGU = 197 * MiB, WS_WDN = 208 * MiB;
constexpr size_t WS_KVT = 245 * MiB;
constexpr size_t WS_END = 254 * MiB;

constexpr int LDS_BYTES = 131072 + 1024;

__device__ __forceinline__ int sgpr_opaque(int v) { asm volatile("" : "+s"(v)); return v; }
__device__ __forceinline__ int tid_opaque() { int t = __builtin_amdgcn_workitem_id_x(); asm volatile("" : "+v"(t)); return t; }
__device__ __forceinline__ unsigned cvt_pk_bf16(float lo, float hi) { unsigned r; asm volatile("v_cvt_pk_bf16_f32 %0, %1, %2" : "=v"(r) : "v"(lo), "v"(hi)); return r; }
__device__ __forceinline__ bf16_t f2bf(float f) { return (bf16_t)(cvt_pk_bf16(f, 0.f) & 0xffffu); }
__device__ __forceinline__ float bf2f(bf16_t v) { return __uint_as_float(((unsigned)v) << 16); }
__device__ __forceinline__ float bflo(unsigned u) { return __uint_as_float(u << 16); }
__device__ __forceinline__ float bfhi(unsigned u) { return __uint_as_float(u & 0xffff0000u); }
__device__ __forceinline__ float sigmoidf_(float x) { return __builtin_amdgcn_rcpf(1.f + __expf(-x)); }
template <int CTRL> __device__ __forceinline__ float dpp_mov(float x) { return __builtin_bit_cast(float, __builtin_amdgcn_mov_dpp(__builtin_bit_cast(int, x), CTRL, 0xf, 0xf, true)); }
__device__ __forceinline__ float allreduce16(float x) {
    x += dpp_mov<0xB1>(x); x += dpp_mov<0x4E>(x); x += dpp_mov<0x141>(x); x += dpp_mov<0x140>(x); return x;
}
__device__ __forceinline__ float wave_sum(float v) { v = allreduce16(v); v += __shfl_xor(v, 16); v += __shfl_xor(v, 32); return v; }
__device__ __forceinline__ int crow(int r, int hi) { return (r & 3) + 8 * (r >> 2) + 4 * hi; }
#define MFMA32(a, b, c) __builtin_amdgcn_mfma_f32_32x32x16_bf16((a), (b), (c), 0, 0, 0)

namespace pg8 {
#define PG8_LAS __attribute__((address_space(3)))
constexpr int BM = 256, BK = 64, HALF = 128, HTB = HALF * BK * 2, STAGE_BYTES = 8 * HTB, NXCD = 8, WGM = 8;
__host__ __device__ __forceinline__ int lds_byte(int r, int c) { const int st = (r >> 4) * 2 + (c >> 5), rr = r & 15, cc = c & 31, ob = rr * 64 + cc * 2; return st * 1024 + (ob ^ (((ob >> 9) & 1) << 5)); }
__host__ __device__ __forceinline__ void stage_rc(int b, int& R, int& C) { const int st = b / 1024, sb = b % 1024, swz = sb ^ (((sb >> 9) & 1) << 5); R = (st >> 1) * 16 + swz / 64; C = (st & 1) * 32 + (swz % 64) / 2; }
__host__ __device__ __forceinline__ int perm32(int rho) { const int n = rho >> 4, i = rho & 15; return 8 * (i >> 2) + 4 * n + (i & 3); }
struct Unit { int pm, pn; };
struct Gemm { const bf16_t* A; const bf16_t* Bt; int M, N, K; };
struct StaticOrder {
    int nM, nN, nwg, G, c;
    __host__ __device__ void init(int M, int N, int G_, int c_) { nM = M / BM; nN = N / BM; nwg = nM * nN; G = G_; c = c_; }
    __host__ __device__ bool next(int i, Unit& u) const {
        const long L = (long)i * G + c; if (L >= nwg) return false;
        int wgid = (int)L; { const int q = nwg / NXCD, r = nwg % NXCD, xcd = wgid % NXCD, off = wgid / NXCD; wgid = (xcd < r ? xcd * (q + 1) : r * (q + 1) + (xcd - r) * q) + off; }
        const int nig = WGM * nN, gid = wgid / nig, fm = gid * WGM, gsz = (nM - fm) < WGM ? (nM - fm) : WGM;
        u.pm = fm + ((wgid % nig) % gsz); u.pn = (wgid % nig) / gsz; return true;
    }
    __device__ __forceinline__ void a_ready(const Unit&) const {}
    __device__ __forceinline__ void done(const Unit&) const {}
};

template <class Epi, class Sched, bool ALIGN_EPI = false, bool SP2 = false>
__device__ __forceinline__ void gemm_phase(PG8_LAS unsigned char* lds, const Gemm g, const Sched& S, const Epi& E) {
    const int tid = tid_opaque(), wid = __builtin_amdgcn_readfirstlane(tid >> 6), lane = tid & 63, wr = wid >> 2, wc = wid & 3, fr = lane & 15, fq = lane >> 4;
    const int K = g.K, nt = K / BK;
    unsigned voffA[2], voffB[2];
#pragma unroll
    for (int i = 0; i < 2; ++i) { int R, C; stage_rc(tid * 16 + i * 8192, R, C); const int Rb = Epi::PERM ? ((R & ~31) + perm32(R & 31)) : R;
        voffA[i] = (unsigned)(R * K + C) * 2u; voffB[i] = (unsigned)(Rb * K + C) * 2u; }
    const size_t kstep = (size_t)(BK * 2);
    const size_t hstep = (size_t)HALF * K * 2;
    const size_t tstep = 2 * hstep;
    const unsigned ldsw = (unsigned)wid * 1024u;
    const int aoff = lds_byte(wr * 64 + fr, fq * 8), boff = lds_byte(wc * 32 + fr, fq * 8);
#define PG8_SA(b, h) (((b) * 2 + (h)) * HTB)
#define PG8_SB(b, h) ((4 + (b) * 2 + (h)) * HTB)
#define PG8_STAGE(bufoff, gbase, voff) do { _Pragma("unroll") for (int _i = 0; _i < 2; ++_i) \
        __builtin_amdgcn_global_load_lds((const unsigned*)((const char*)(gbase) + (voff)[_i]), (PG8_LAS unsigned*)(lds + (bufoff) + ldsw + _i * 8192), 16, 0, 0); } while (0)
#define PG8_LDA(dst, b, h) do { _Pragma("unroll") for (int m = 0; m < 4; ++m) _Pragma("unroll") for (int k = 0; k < 2; ++k) dst[m][k] = *(const PG8_LAS bf16x8*)(lds + PG8_SA(b, h) + aoff + m * 2048 + k * 1024); } while (0)
#define PG8_LDB(dst, b, h) do { _Pragma("unroll") for (int n = 0; n < 2; ++n) _Pragma("unroll") for (int k = 0; k < 2; ++k) dst[n][k] = *(const PG8_LAS bf16x8*)(lds + PG8_SB(b, h) + boff + n * 2048 + k * 1024); } while (0)
#define PG8_MMA(ai, bj, At, Bt) do { __builtin_amdgcn_s_setprio(1); _Pragma("unroll") for (int m = 0; m < 4; ++m) _Pragma("unroll") for (int n = 0; n < 2; ++n) _Pragma("unroll") for (int k = 0; k < 2; ++k) \
        acc[ai][bj][m][n] = __builtin_amdgcn_mfma_f32_16x16x32_bf16(Bt[n][k], At[m][k], acc[ai][bj][m][n], 0, 0, 0); __builtin_amdgcn_s_setprio(0); } while (0)
#define PG8_WAIT_V(n) asm volatile("s_waitcnt vmcnt(" #n ")" ::: "memory")
#define PG8_WAIT_L(n) asm volatile("s_waitcnt lgkmcnt(" #n ")" ::: "memory")
#define PG8_BAR __builtin_amdgcn_s_barrier()
#define PG8_SCHED __builtin_amdgcn_sched_barrier(0)
    Unit cur, nxt; int ui = 0;
    if (!S.next(0, cur)) return;
    f32x4 acc[2][2][4][2];
#pragma unroll
    for (int a = 0; a < 2; ++a)
#pragma unroll
        for (int b = 0; b < 2; ++b)
#pragma unroll
            for (int m = 0; m < 4; ++m)
#pragma unroll
                for (int n = 0; n < 2; ++n) acc[a][b][m][n] = (f32x4){0.f, 0.f, 0.f, 0.f};
    bf16x8 At[4][2], B0[2][2], B1[2][2];
    const char* cA = (const char*)g.A + (size_t)cur.pm * tstep; const char* cB = (const char*)g.Bt + (size_t)cur.pn * tstep;
    S.a_ready(cur);
    if constexpr (SP2) {
        PG8_STAGE(PG8_SB(0, 0), cB, voffB); PG8_STAGE(PG8_SB(0, 1), cB + hstep, voffB); PG8_STAGE(PG8_SA(0, 0), cA, voffA); PG8_STAGE(PG8_SA(0, 1), cA + hstep, voffA);
        if (wr == 1) PG8_BAR;
        PG8_WAIT_V(2); PG8_BAR;
        PG8_STAGE(PG8_SB(1, 0), cB + kstep, voffB); PG8_STAGE(PG8_SA(1, 0), cA + kstep, voffA); PG8_STAGE(PG8_SB(1, 1), cB + hstep + kstep, voffB);
        PG8_WAIT_V(6); PG8_BAR;
    } else {
        PG8_STAGE(PG8_SB(0, 0), cB, voffB); PG8_STAGE(PG8_SA(0, 0), cA, voffA); PG8_STAGE(PG8_SB(0, 1), cB + hstep, voffB); PG8_STAGE(PG8_SA(0, 1), cA + hstep, voffA);
        if (wr == 1) PG8_BAR;
        PG8_WAIT_V(4); PG8_BAR;
        PG8_STAGE(PG8_SB(1, 0), cB + kstep, voffB); PG8_STAGE(PG8_SA(1, 0), cA + kstep, voffA); PG8_STAGE(PG8_SB(1, 1), cB + hstep + kstep, voffB);
        PG8_WAIT_V(6); PG8_BAR;
    }
    for (;;) {
        const bool has_next = S.next(ui + 1, nxt);
        const char* nA = has_next ? (const char*)g.A + (size_t)nxt.pm * tstep : cA; const char* nB = has_next ? (const char*)g.Bt + (size_t)nxt.pn * tstep : cB;
        for (int t = 0; t < nt; t += 2) {
            const bool last = (t == nt - 2);
            const char* a1 = cA + (size_t)(t + 1) * kstep;
            const char* a2 = last ? nA : cA + (size_t)(t + 2) * kstep; const char* b2 = last ? nB : cB + (size_t)(t + 2) * kstep;
            const char* a3 = a2 + kstep; const char* b3 = b2 + kstep;
            if (last && has_next) S.a_ready(nxt);
            if constexpr (SP2) {
            PG8_LDB(B0, 0, 0); PG8_LDB(B1, 0, 1); PG8_SCHED; PG8_LDA(At, 0, 0); PG8_STAGE(PG8_SA(1, 1), a1 + hstep, voffA);
            PG8_WAIT_V(8); PG8_WAIT_L(0); PG8_BAR; PG8_MMA(0, 0, At, B0); PG8_MMA(0, 1, At, B1); PG8_BAR; PG8_SCHED;
            PG8_LDA(At, 0, 1); PG8_STAGE(PG8_SB(0, 0), b2, voffB); PG8_STAGE(PG8_SB(0, 1), b2 + hstep, voffB); PG8_STAGE(PG8_SA(0, 0), a2, voffA);
            PG8_WAIT_V(8); PG8_WAIT_L(0); PG8_BAR; PG8_MMA(1, 0, At, B0); PG8_MMA(1, 1, At, B1); PG8_BAR; PG8_SCHED;
            PG8_LDB(B0, 1, 0); PG8_LDB(B1, 1, 1); PG8_SCHED; PG8_LDA(At, 1, 0); PG8_STAGE(PG8_SA(0, 1), a2 + hstep, voffA);
            PG8_WAIT_V(8); PG8_WAIT_L(0); PG8_BAR; PG8_MMA(0, 0, At, B0); PG8_MMA(0, 1, At, B1); PG8_BAR; PG8_SCHED;
            PG8_LDA(At, 1, 1); PG8_STAGE(PG8_SB(1, 0), b3, voffB); PG8_STAGE(PG8_SB(1, 1), b3 + hstep, voffB); PG8_STAGE(PG8_SA(1, 0), a3, voffA);
            PG8_WAIT_V(8); PG8_WAIT_L(0); PG8_BAR; PG8_MMA(1, 0, At, B0); PG8_MMA(1, 1, At, B1); PG8_BAR; PG8_SCHED;
            } else {
            PG8_LDB(B0, 0, 0); PG8_SCHED; PG8_LDA(At, 0, 0); PG8_STAGE(PG8_SA(1, 1), a1 + hstep, voffA);
            PG8_WAIT_L(8); PG8_BAR; PG8_WAIT_L(0); PG8_MMA(0, 0, At, B0); PG8_BAR; PG8_SCHED;
            PG8_LDB(B1, 0, 1); PG8_STAGE(PG8_SB(0, 0), b2, voffB);
            PG8_BAR; PG8_WAIT_L(0); PG8_MMA(0, 1, At, B1); PG8_BAR;
            PG8_LDA(At, 0, 1); PG8_STAGE(PG8_SA(0, 0), a2, voffA);
            PG8_BAR; PG8_WAIT_L(0); PG8_MMA(1, 0, At, B0); PG8_BAR; PG8_SCHED;
            PG8_STAGE(PG8_SB(0, 1), b2 + hstep, voffB);
            PG8_WAIT_V(6); PG8_BAR; PG8_MMA(1, 1, At, B1); PG8_BAR;
            PG8_LDB(B0, 1, 0); PG8_SCHED; PG8_LDA(At, 1, 0); PG8_STAGE(PG8_SA(0, 1), a2 + hstep, voffA);
            PG8_WAIT_L(8); PG8_BAR; PG8_WAIT_L(0); PG8_MMA(0, 0, At, B0); PG8_BAR; PG8_SCHED;
            PG8_LDB(B1, 1, 1); PG8_STAGE(PG8_SB(1, 0), b3, voffB);
            PG8_BAR; PG8_WAIT_L(0); PG8_MMA(0, 1, At, B1); PG8_BAR;
            PG8_LDA(At, 1, 1); PG8_STAGE(PG8_SA(1, 0), a3, voffA);
            PG8_BAR; PG8_WAIT_L(0); PG8_MMA(1, 0, At, B0); PG8_BAR; PG8_SCHED;
            PG8_STAGE(PG8_SB(1, 1), b3 + hstep, voffB);
            PG8_WAIT_V(6); PG8_BAR; PG8_MMA(1, 1, At, B1); PG8_BAR;
            }
        }
        if constexpr (ALIGN_EPI) { if (wr == 0) PG8_BAR; }
        E(acc, cur, wr, wc, fr, fq); S.done(cur);
        if (!has_next) break;
#pragma unroll
        for (int a = 0; a < 2; ++a)
#pragma unroll
            for (int b = 0; b < 2; ++b)
#pragma unroll
                for (int m = 0; m < 4; ++m)
#pragma unroll
                    for (int n = 0; n < 2; ++n) acc[a][b][m][n] = (f32x4){0.f, 0.f, 0.f, 0.f};
        cur = nxt; cA = nA; cB = nB; ++ui;
        if constexpr (ALIGN_EPI) { if (wr == 1) PG8_BAR; }
    }
    PG8_WAIT_V(0);
    if constexpr (!ALIGN_EPI) { if (wr == 0) PG8_BAR; }
    PG8_BAR;
#undef PG8_SA
#undef PG8_SB
#undef PG8_STAGE
#undef PG8_LDA
#undef PG8_LDB
#undef PG8_MMA
#undef PG8_WAIT_V
#undef PG8_WAIT_L
#undef PG8_BAR
#undef PG8_SCHED
}

__device__ __forceinline__ u32x4 pack8(const f32x4 v0, const f32x4 v1) { u32x4 w; w.x = cvt_pk_bf16(v0[0], v0[1]); w.y = cvt_pk_bf16(v0[2], v0[3]); w.z = cvt_pk_bf16(v1[0], v1[1]); w.w = cvt_pk_bf16(v1[2], v1[3]); return w; }

struct EpiProj {
    static constexpr bool PERM = true;
    bf16_t *pa, *pb, *pc;
    __device__ __forceinline__ void operator()(const f32x4 (&acc)[2][2][4][2], const Unit& u, int wr, int wc, int fr, int fq) const {
        bf16_t* base; int ldc, colt;
        if (u.pn < 4) { base = pa; ldc = 1024; colt = u.pn * 256; } else if (u.pn < 8) { base = pb; ldc = 1024; colt = (u.pn - 4) * 256; } else { base = pc; ldc = 768; colt = (u.pn - 8) * 256; }
        const int row0 = u.pm * BM + wr * 64 + fr, col0 = colt + wc * 32 + 8 * fq;
#pragma unroll
        for (int ai = 0; ai < 2; ++ai)
#pragma unroll
            for (int m = 0; m < 4; ++m) { bf16_t* rowp = base + (size_t)(row0 + ai * HALF + m * 16) * ldc + col0;
#pragma unroll
                for (int bj = 0; bj < 2; ++bj) *(u32x4*)(rowp + bj * HALF) = pack8(acc[ai][bj][m][0], acc[ai][bj][m][1]); }
    }
};
struct EpiPlain {
    static constexpr bool PERM = true;
    bf16_t* O; int ldc;
    __device__ __forceinline__ void operator()(const f32x4 (&acc)[2][2][4][2], const Unit& u, int wr, int wc, int fr, int fq) const {
        const int row0 = u.pm * BM + wr * 64 + fr, col0 = u.pn * BM + wc * 32 + 8 * fq;
#pragma unroll
        for (int ai = 0; ai < 2; ++ai)
#pragma unroll
            for (int m = 0; m < 4; ++m) { bf16_t* rowp = O + (size_t)(row0 + ai * HALF + m * 16) * ldc + col0;
#pragma unroll
                for (int bj = 0; bj < 2; ++bj) *(u32x4*)(rowp + bj * HALF) = pack8(acc[ai][bj][m][0], acc[ai][bj][m][1]); }
    }
};
struct EpiRes {
    static constexpr bool PERM = false;
    const float* base; float* out;
    __device__ __forceinline__ void operator()(const f32x4 (&acc)[2][2][4][2], const Unit& u, int wr, int wc, int fr, int fq) const {
        const int row0 = u.pm * BM + wr * 64 + fr, col0 = u.pn * BM + wc * 32 + 4 * fq;
#pragma unroll
        for (int ai = 0; ai < 2; ++ai)
#pragma unroll
            for (int m = 0; m < 4; ++m) { const size_t off = (size_t)(row0 + ai * HALF + m * 16) * 1024 + col0;
#pragma unroll
                for (int bj = 0; bj < 2; ++bj)
#pragma unroll
                    for (int n = 0; n < 2; ++n) { const f32x4 bs = *(const f32x4*)(base + off + bj * HALF + n * 16); *(f32x4*)(out + off + bj * HALF + n * 16) = bs + acc[ai][bj][m][n]; } }
    }
};
struct EpiSwiGLU {
    static constexpr bool PERM = true;
    bf16_t* act;
    __device__ __forceinline__ void operator()(const f32x4 (&acc)[2][2][4][2], const Unit& u, int wr, int wc, int fr, int fq) const {
        const int row0 = u.pm * BM + wr * 64 + fr, col0 = u.pn * 128 + wc * 32 + 8 * fq;
#pragma unroll
        for (int ai = 0; ai < 2; ++ai)
#pragma unroll
            for (int m = 0; m < 4; ++m) { f32x4 o[2];
#pragma unroll
                for (int n = 0; n < 2; ++n)
#pragma unroll
                    for (int i = 0; i < 4; ++i) { const float gt = acc[ai][0][m][n][i], up = acc[ai][1][m][n][i]; o[n][i] = gt * up * __builtin_amdgcn_rcpf(1.f + __expf(-gt)); }
                *(u32x4*)(act + (size_t)(row0 + ai * HALF + m * 16) * D_FF + col0) = pack8(o[0], o[1]); }
    }
};
}

struct Params { const void* in[27]; float* out; unsigned char* ws; };
enum { I_X = 0, I_POS, I_ATTN_NORM, I_W_IN, I_W_OUT, I_MU, I_W0, I_W2, I_A0, I_A2, I_G2, I_KK, I_KA, I_RK, I_GNW, I_GNB, I_V0, I_V1, I_V2,
       I_QNORM, I_KVNORM, I_WQUP, I_WKVUP, I_FFN_NORM, I_WGU, I_WDN, I_FINAL };

__device__ __forceinline__ void transpose_item(const float* W, int K, int N, bf16_t* WT, int mode, LAS float* scr, int item, int lane) {
    const int nblk = N / 32, kb = item / nblk, nb = item % nblk, k0 = 64 * kb, n0 = 32 * nb;
    int d0 = n0;
    if (mode == 1) d0 = (n0 < 896) ? n0 : n0 + 128;
    else if (mode == 2) { const int j = (n0 < D_FF) ? n0 : n0 - D_FF; d0 = 256 * (j >> 7) + (j & 127) + ((n0 < D_FF) ? 0 : 128); }
    float wv[32];
#pragma unroll
    for (int i = 0; i < 32; ++i) wv[i] = W[(size_t)(k0 + 2 * i + (lane >> 5)) * N + n0 + (lane & 31)];
#pragma unroll
    for (int i = 0; i < 32; ++i) scr[(2 * i + (lane >> 5)) * 33 + (lane & 31)] = wv[i];
    asm volatile("s_waitcnt lgkmcnt(0)" ::: "memory");
    const int c = lane & 7;
#pragma unroll
    for (int j = 0; j < 4; ++j) { const int n = (lane >> 3) + 8 * j; const LAS float* s = scr + (8 * c) * 33 + n;
        u32x4 o; o.x = cvt_pk_bf16(s[0 * 33], s[1 * 33]); o.y = cvt_pk_bf16(s[2 * 33], s[3 * 33]); o.z = cvt_pk_bf16(s[4 * 33], s[5 * 33]); o.w = cvt_pk_bf16(s[6 * 33], s[7 * 33]);
        *(u32x4*)(WT + (size_t)(d0 + n) * K + k0 + 8 * c) = o; }
    asm volatile("s_waitcnt lgkmcnt(0)" ::: "memory");
}

__device__ __forceinline__ void rms_rows2_bf16(const float* __restrict__ x0row, const float* __restrict__ x1row, const float* __restrict__ g, bf16_t* __restrict__ o0row, bf16_t* __restrict__ o1row, int lane) {
    const f32x4* xa = (const f32x4*)x0row + lane; const f32x4* xb = (const f32x4*)x1row + lane; const f32x4* gr = (const f32x4*)g + lane;
    f32x4 va[4], vb[4]; float sa = 0.f, sb = 0.f;
#pragma unroll
    for (int j = 0; j < 4; ++j) { va[j] = xa[64 * j]; vb[j] = xb[64 * j]; }
#pragma unroll
    for (int j = 0; j < 4; ++j) { sa += (va[j].x * va[j].x + va[j].y * va[j].y) + (va[j].z * va[j].z + va[j].w * va[j].w); sb += (vb[j].x * vb[j].x + vb[j].y * vb[j].y) + (vb[j].z * vb[j].z + vb[j].w * vb[j].w); }
    const float ra = rsqrtf(wave_sum(sa) * (1.f / 1024.f) + NORM_EPS), rb = rsqrtf(wave_sum(sb) * (1.f / 1024.f) + NORM_EPS);
    u32x2* oa = (u32x2*)o0row + lane; u32x2* ob = (u32x2*)o1row + lane;
#pragma unroll
    for (int j = 0; j < 4; ++j) { const f32x4 gg = gr[64 * j]; u32x2 w;
        w.x = cvt_pk_bf16(va[j].x * ra * gg.x, va[j].y * ra * gg.y); w.y = cvt_pk_bf16(va[j].z * ra * gg.z, va[j].w * ra * gg.w); oa[64 * j] = w;
        w.x = cvt_pk_bf16(vb[j].x * rb * gg.x, vb[j].y * rb * gg.y); w.y = cvt_pk_bf16(vb[j].z * rb * gg.z, vb[j].w * rb * gg.w); ob[64 * j] = w; }
}
__device__ __forceinline__ void rms_row_bf16(const float* xrow, const float* g, bf16_t* orow, int lane) {
    const f32x4* xr = (const f32x4*)xrow + lane; const f32x4* gr = (const f32x4*)g + lane;
    f32x4 v[4]; float s = 0.f;
#pragma unroll
    for (int j = 0; j < 4; ++j) { v[j] = xr[64 * j]; s += (v[j].x * v[j].x + v[j].y * v[j].y) + (v[j].z * v[j].z + v[j].w * v[j].w); }
    const float rstd = rsqrtf(wave_sum(s) * (1.f / 1024.f) + NORM_EPS);
    u32x2* o8 = (u32x2*)orow + lane;
#pragma unroll
    for (int j = 0; j < 4; ++j) { const f32x4 gg = gr[64 * j]; u32x2 w; w.x = cvt_pk_bf16(v[j].x * rstd * gg.x, v[j].y * rstd * gg.y); w.y = cvt_pk_bf16(v[j].z * rstd * gg.z, v[j].w * rstd * gg.w); o8[64 * j] = w; }
}

constexpr int KROW = 104, VROW = 72;
constexpr int ATT_KB = 64 * KROW * 2, ATT_VB = 64 * VROW * 2;
constexpr int ATT_SCR = 2 * (ATT_KB + ATT_VB);

__device__ __forceinline__ void att_unit(LAS unsigned char* lds, int b, int h, int qb, const bf16_t* __restrict__ q, const bf16_t* __restrict__ kvb, const bf16_t* __restrict__ kr,
                                         const float* __restrict__ cosM, const float* __restrict__ sinM, bf16_t* __restrict__ mix) {
    const int tid = tid_opaque(), lane = tid & 63, w = tid >> 6, r32 = lane & 31, hi = lane >> 5;
    LAS float* scr = (LAS float*)(lds + ATT_SCR) + w * 32;
    const int qrow = qb * 256 + w * 32 + r32; const size_t tok = (size_t)b * SEQ + qrow;
    bf16x8 qf[6];
    {
        const bf16_t* qp = q + tok * 768 + h * 96 + hi * 8;
#pragma unroll
        for (int d0 = 0; d0 < 4; ++d0) qf[d0] = *(const bf16x8*)(qp + d0 * 16);
        const u32x4 x1 = *(const u32x4*)(qp + 64), x2 = *(const u32x4*)(qp + 80);
        const f32x4 c0 = *(const f32x4*)(cosM + tok * 16 + hi * 8), c1 = *(const f32x4*)(cosM + tok * 16 + hi * 8 + 4);
        const f32x4 s0 = *(const f32x4*)(sinM + tok * 16 + hi * 8), s1 = *(const f32x4*)(sinM + tok * 16 + hi * 8 + 4);
        float a[8], bb[8], cs[8] = {c0.x, c0.y, c0.z, c0.w, c1.x, c1.y, c1.z, c1.w}, sn[8] = {s0.x, s0.y, s0.z, s0.w, s1.x, s1.y, s1.z, s1.w};
#pragma unroll
        for (int j = 0; j < 4; ++j) { a[2 * j] = bflo(x1[j]); a[2 * j + 1] = bfhi(x1[j]); bb[2 * j] = bflo(x2[j]); bb[2 * j + 1] = bfhi(x2[j]); }
        u32x4 o1, o2;
#pragma unroll
        for (int j = 0; j < 4; ++j) {
            o1[j] = cvt_pk_bf16(a[2 * j] * cs[2 * j] - bb[2 * j] * sn[2 * j], a[2 * j + 1] * cs[2 * j + 1] - bb[2 * j + 1] * sn[2 * j + 1]);
            o2[j] = cvt_pk_bf16(bb[2 * j] * cs[2 * j] + a[2 * j] * sn[2 * j], bb[2 * j + 1] * cs[2 * j + 1] + a[2 * j + 1] * sn[2 * j + 1]); }
        qf[4] = __builtin_bit_cast(bf16x8, o1); qf[5] = __builtin_bit_cast(bf16x8, o2);
    }
    const int k_key = tid >> 3, k_ch = tid & 7;
    const int r_key = (tid & 255) >> 2, r_ch = tid & 3;
    const bf16_t* kn_src = kvb + ((size_t)b * SEQ + k_key) * 1024 + h * 128 + k_ch * 8;
    const bf16_t* kr_src = kr + ((size_t)b * SEQ + r_key) * 32 + r_ch * 8;
    const int kn_dst = (k_key * KROW + k_ch * 8) * 2, kr_dst = (r_key * KROW + 64 + r_ch * 8) * 2, vt_dst = (k_ch * 8 * VROW + k_key) * 2;
#define ATT_VWRITE(bufoff, gv) do { LAS bf16_t* vd_ = (LAS bf16_t*)(lds + 2 * ATT_KB + (bufoff) + vt_dst); _Pragma("unroll") for (int j_ = 0; j_ < 4; ++j_) { \
        vd_[(2 * j_) * VROW] = (bf16_t)((gv)[j_] & 0xffffu); vd_[(2 * j_ + 1) * VROW] = (bf16_t)((gv)[j_] >> 16); } } while (0)
    const int ntiles = 4 * qb + 4;
    u32x4 gk, gr, gv;
    gk = *(const u32x4*)kn_src; gv = *(const u32x4*)(kn_src + 64); if (tid < 256) gr = *(const u32x4*)kr_src;
    *(LAS u32x4*)(lds + kn_dst) = gk; ATT_VWRITE(0, gv); if (tid < 256) *(LAS u32x4*)(lds + kr_dst) = gr;
    __syncthreads();
    f32x16 o0, o1;
#pragma unroll
    for (int r = 0; r < 16; ++r) { o0[r] = 0.f; o1[r] = 0.f; }
    float mrow = -1e30f, lrow = 0.f;
    const float SC = 0.10206207261596577f * 1.4426950408889634f;
    const int wq0 = qb * 256 + w * 32;
    for (int kt = 0; kt < ntiles; ++kt) {
        const int cur = kt & 1;
        if (kt + 1 < ntiles) { const size_t ko = (size_t)(kt + 1) * 64; gk = *(const u32x4*)(kn_src + ko * 1024); gv = *(const u32x4*)(kn_src + ko * 1024 + 64); if (tid < 256) gr = *(const u32x4*)(kr_src + ko * 32); }
        const int k0 = kt * 64;
        if (k0 <= wq0 + 31) {
            const LAS unsigned char* Kb = lds + cur * ATT_KB; const LAS unsigned char* Vb = lds + 2 * ATT_KB + cur * ATT_VB;
            f32x16 p0, p1;
#pragma unroll
            for (int r = 0; r < 16; ++r) { p0[r] = 0.f; p1[r] = 0.f; }
#pragma unroll
            for (int d0 = 0; d0 < 6; ++d0) {
                const bf16x8 k0f = *(const LAS bf16x8*)(Kb + (r32 * KROW + d0 * 16 + hi * 8) * 2);
                const bf16x8 k1f = *(const LAS bf16x8*)(Kb + ((32 + r32) * KROW + d0 * 16 + hi * 8) * 2);
                p0 = MFMA32(k0f, qf[d0], p0); p1 = MFMA32(k1f, qf[d0], p1);
            }
            const bool need_mask = (k0 + 63 > wq0);
            float mx = -1e30f;
            if (need_mask) {
#pragma unroll
                for (int r = 0; r < 16; ++r) { const int key = k0 + crow(r, hi); if (key > qrow) p0[r] = -1e30f; if (key + 32 > qrow) p1[r] = -1e30f; }
            }
#pragma unroll
            for (int r = 0; r < 16; ++r) mx = fmaxf(mx, fmaxf(p0[r], p1[r]));
            mx = fmaxf(mx, __shfl_xor(mx, 32)) * SC;
            const bool grew = __any(mx > mrow + 8.f);
            const float mnew = grew ? fmaxf(mrow, mx) : mrow;
            const float alpha = __builtin_amdgcn_exp2f(mrow - mnew); mrow = mnew;
            float ls = 0.f;
#pragma unroll
            for (int r = 0; r < 16; ++r) { p0[r] = __builtin_amdgcn_exp2f(__builtin_fmaf(p0[r], SC, -mnew)); p1[r] = __builtin_amdgcn_exp2f(__builtin_fmaf(p1[r], SC, -mnew)); ls += p0[r] + p1[r]; }
            lrow = lrow * alpha + ls;
            if (grew) {
                if (hi == 0) scr[r32] = alpha;
                asm volatile("s_waitcnt lgkmcnt(0)" ::: "memory");
#pragma unroll
                for (int i = 0; i < 4; ++i) { const f32x4 al = *(const LAS f32x4*)(scr + 8 * i + 4 * hi);
#pragma unroll
                    for (int j = 0; j < 4; ++j) { o0[4 * i + j] *= al[j]; o1[4 * i + j] *= al[j]; } }
                asm volatile("s_waitcnt lgkmcnt(0)" ::: "memory");
            }
#pragma unroll
            for (int s = 0; s < 4; ++s) {
                u32x4 pw;
#pragma unroll
                for (int j = 0; j < 4; ++j) pw[j] = (s < 2) ? cvt_pk_bf16(p0[8 * (s & 1) + 2 * j], p0[8 * (s & 1) + 2 * j + 1]) : cvt_pk_bf16(p1[8 * (s & 1) + 2 * j], p1[8 * (s & 1) + 2 * j + 1]);
                const bf16x8 pa = __builtin_bit_cast(bf16x8, pw);
#pragma unroll
                for (int dvh = 0; dvh < 2; ++dvh) {
                    const LAS unsigned char* vp = Vb + ((dvh * 32 + r32) * VROW + 16 * s + 4 * hi) * 2;
                    const u32x2 lo = *(const LAS u32x2*)vp, hh = *(const LAS u32x2*)(vp + 16);
                    u32x4 vv; vv.x = lo.x; vv.y = lo.y; vv.z = hh.x; vv.w = hh.y;
                    if (dvh == 0) o0 = MFMA32(pa, __builtin_bit_cast(bf16x8, vv), o0); else o1 = MFMA32(pa, __builtin_bit_cast(bf16x8, vv), o1);
                }
            }
        }
        if (kt + 1 < ntiles) { const int nx = cur ^ 1; *(LAS u32x4*)(lds + nx * ATT_KB + kn_dst) = gk; ATT_VWRITE(nx * ATT_VB, gv); if (tid < 256) *(LAS u32x4*)(lds + nx * ATT_KB + kr_dst) = gr; }
        __syncthreads();
    }
    float lt = lrow + __shfl_xor(lrow, 32);
    if (hi == 0) scr[r32] = 1.f / lt;
    asm volatile("s_waitcnt lgkmcnt(0)" ::: "memory");
#pragma unroll
    for (int i = 0; i < 4; ++i) { const f32x4 il = *(const LAS f32x4*)(scr + 8 * i + 4 * hi);
#pragma unroll
        for (int j = 0; j < 4; ++j) { const int r = 4 * i + j; const size_t orow = (size_t)b * SEQ + qb * 256 + w * 32 + crow(r, hi);
            mix[orow * 1024 + 512 + h * 64 + r32] = f2bf(o0[r] * il[j]); mix[orow * 1024 + 512 + h * 64 + 32 + r32] = f2bf(o1[r] * il[j]); } }
    asm volatile("s_waitcnt lgkmcnt(0)" ::: "memory");
}

__device__ __forceinline__ void ret_unit(LAS unsigned char* lds, int b, int h, int jb, const bf16_t* __restrict__ pb, const float* __restrict__ cosR, const float* __restrict__ sinR,
                                         const bf16_t* __restrict__ rprev, float* __restrict__ yb) {
    const int tid = tid_opaque(), lane = tid & 63, w = tid >> 6, r32 = lane & 31, hi = lane >> 5;
    const float lg2 = log2f(1.f - exp2f(-5.f - (float)h));
    const int qrow = jb * 256 + w * 32 + r32; const size_t tok = (size_t)b * SEQ + qrow;
    const int chunk = qrow >> 7;
    bf16x8 qf[4], qx[4];
    {
        const bf16_t* qp = pb + tok * 1024 + h * 64 + hi * 8;
        const float qdec = exp2f(lg2 * (float)((qrow & 127) + 1));
#pragma unroll
        for (int d0 = 0; d0 < 2; ++d0) {
            const u32x4 x1 = *(const u32x4*)(qp + d0 * 16), x2 = *(const u32x4*)(qp + d0 * 16 + 32);
            const float* cp = cosR + tok * 32 + d0 * 16 + hi * 8; const float* sp = sinR + tok * 32 + d0 * 16 + hi * 8;
            const f32x4 c0 = *(const f32x4*)cp, c1 = *(const f32x4*)(cp + 4), s0 = *(const f32x4*)sp, s1 = *(const f32x4*)(sp + 4);
            const float cs[8] = {c0.x, c0.y, c0.z, c0.w, c1.x, c1.y, c1.z, c1.w}, sn[8] = {s0.x, s0.y, s0.z, s0.w, s1.x, s1.y, s1.z, s1.w};
            u32x4 o1, o2, y1, y2;
#pragma unroll
            for (int j = 0; j < 4; ++j) {
                const float a0 = bflo(x1[j]), a1 = bfhi(x1[j]), b0 = bflo(x2[j]), b1 = bfhi(x2[j]);
                const float r0 = a0 * cs[2 * j] - b0 * sn[2 * j], r1 = a1 * cs[2 * j + 1] - b1 * sn[2 * j + 1];
                const float t0 = b0 * cs[2 * j] + a0 * sn[2 * j], t1 = b1 * cs[2 * j + 1] + a1 * sn[2 * j + 1];
                o1[j] = cvt_pk_bf16(r0, r1); o2[j] = cvt_pk_bf16(t0, t1); y1[j] = cvt_pk_bf16(r0 * qdec, r1 * qdec); y2[j] = cvt_pk_bf16(t0 * qdec, t1 * qdec); }
            qf[d0] = __builtin_bit_cast(bf16x8, o1); qf[d0 + 2] = __builtin_bit_cast(bf16x8, o2); qx[d0] = __builtin_bit_cast(bf16x8, y1); qx[d0 + 2] = __builtin_bit_cast(bf16x8, y2);
        }
    }
    f32x16 o0, o1;
#pragma unroll
    for (int r = 0; r < 16; ++r) { o0[r] = 0.f; o1[r] = 0.f; }
    {
        const bf16_t* rp = rprev + ((size_t)((b * 4 + h) * 32 + chunk)) * 4096;
#pragma unroll
        for (int d0 = 0; d0 < 4; ++d0) {
            const bf16x8 r0 = *(const bf16x8*)(rp + (size_t)r32 * 64 + d0 * 16 + hi * 8), r1 = *(const bf16x8*)(rp + (size_t)(32 + r32) * 64 + d0 * 16 + hi * 8);
            o0 = MFMA32(qx[d0], r0, o0); o1 = MFMA32(qx[d0], r1, o1);
        }
    }
    const int l_key = (tid & 255) >> 2, l_c = tid & 3;
    for (int kt = 0; kt < 4; ++kt) {
        const int k0 = jb * 256 + kt * 64;
        __syncthreads();
        if (tid < 256) {
            const size_t kt_tok = (size_t)b * SEQ + k0 + l_key; const bf16_t* kp = pb + kt_tok * 1024 + 256 + h * 64 + l_c * 8;
            const u32x4 x1 = *(const u32x4*)kp, x2 = *(const u32x4*)(kp + 32);
            const float* cp = cosR + kt_tok * 32 + l_c * 8; const float* sp = sinR + kt_tok * 32 + l_c * 8;
            const f32x4 c0 = *(const f32x4*)cp, c1 = *(const f32x4*)(cp + 4), s0 = *(const f32x4*)sp, s1 = *(const f32x4*)(sp + 4);
            const float cs[8] = {c0.x, c0.y, c0.z, c0.w, c1.x, c1.y, c1.z, c1.w}, sn[8] = {s0.x, s0.y, s0.z, s0.w, s1.x, s1.y, s1.z, s1.w};
            u32x4 o1v, o2v;
#pragma unroll
            for (int j = 0; j < 4; ++j) {
                const float a0 = bflo(x1[j]), a1 = bfhi(x1[j]), b0 = bflo(x2[j]), b1 = bfhi(x2[j]);
                o1v[j] = cvt_pk_bf16((a0 * cs[2 * j] - b0 * sn[2 * j]) * 0.125f, (a1 * cs[2 * j + 1] - b1 * sn[2 * j + 1]) * 0.125f);
                o2v[j] = cvt_pk_bf16((b0 * cs[2 * j] + a0 * sn[2 * j]) * 0.125f, (b1 * cs[2 * j + 1] + a1 * sn[2 * j + 1]) * 0.125f); }
            *(LAS u32x4*)(lds + (l_key * KROW + l_c * 8) * 2) = o1v; *(LAS u32x4*)(lds + (l_key * KROW + 32 + l_c * 8) * 2) = o2v;
        } else {
            const size_t vt_tok = (size_t)b * SEQ + k0 + l_key; const bf16_t* vp = pb + vt_tok * 1024 + 512 + h * 64 + l_c * 16;
            const u32x4 x1 = *(const u32x4*)vp, x2 = *(const u32x4*)(vp + 8);
            LAS bf16_t* vd = (LAS bf16_t*)(lds + 2 * ATT_KB) + l_key;
#pragma unroll
            for (int j = 0; j < 4; ++j) { vd[(l_c * 16 + 2 * j) * VROW] = (bf16_t)(x1[j] & 0xffffu); vd[(l_c * 16 + 2 * j + 1) * VROW] = (bf16_t)(x1[j] >> 16);
                                          vd[(l_c * 16 + 8 + 2 * j) * VROW] = (bf16_t)(x2[j] & 0xffffu); vd[(l_c * 16 + 8 + 2 * j + 1) * VROW] = (bf16_t)(x2[j] >> 16); }
        }
        __syncthreads();
        if ((k0 >> 7) == chunk && k0 <= jb * 256 + w * 32 + 31) {
            const LAS unsigned char* Kb = lds; const LAS unsigned char* Vb = lds + 2 * ATT_KB;
            f32x16 p0, p1;
#pragma unroll
            for (int r = 0; r < 16; ++r) { p0[r] = 0.f; p1[r] = 0.f; }
#pragma unroll
            for (int d0 = 0; d0 < 4; ++d0) {
                const bf16x8 k0f = *(const LAS bf16x8*)(Kb + (r32 * KROW + d0 * 16 + hi * 8) * 2);
                const bf16x8 k1f = *(const LAS bf16x8*)(Kb + ((32 + r32) * KROW + d0 * 16 + hi * 8) * 2);
                p0 = MFMA32(k0f, qf[d0], p0); p1 = MFMA32(k1f, qf[d0], p1);
            }
#pragma unroll
            for (int r = 0; r < 16; ++r) {
                const int df0 = qrow - (k0 + crow(r, hi)), df1 = df0 - 32;
                p0[r] = (df0 >= 0) ? p0[r] * __builtin_amdgcn_exp2f(lg2 * (float)df0) : 0.f;
                p1[r] = (df1 >= 0) ? p1[r] * __builtin_amdgcn_exp2f(lg2 * (float)df1) : 0.f;
            }
#pragma unroll
            for (int s = 0; s < 4; ++s) {
                u32x4 pw;
#pragma unroll
                for (int j = 0; j < 4; ++j) pw[j] = (s < 2) ? cvt_pk_bf16(p0[8 * (s & 1) + 2 * j], p0[8 * (s & 1) + 2 * j + 1]) : cvt_pk_bf16(p1[8 * (s & 1) + 2 * j], p1[8 * (s & 1) + 2 * j + 1]);
                const bf16x8 pa = __builtin_bit_cast(bf16x8, pw);
#pragma unroll
                for (int dvh = 0; dvh < 2; ++dvh) {
                    const LAS unsigned char* vp = Vb + ((dvh * 32 + r32) * VROW + 16 * s + 4 * hi) * 2;
                    const u32x2 lo = *(const LAS u32x2*)vp, hh = *(const LAS u32x2*)(vp + 16);
                    u32x4 vv; vv.x = lo.x; vv.y = lo.y; vv.z = hh.x; vv.w = hh.y;
                    if (dvh == 0) o0 = MFMA32(pa, __builtin_bit_cast(bf16x8, vv), o0); else o1 = MFMA32(pa, __builtin_bit_cast(bf16x8, vv), o1);
                }
            }
        }
    }
#pragma unroll
    for (int r = 0; r < 16; ++r) { const size_t orow = (size_t)b * SEQ + jb * 256 + w * 32 + crow(r, hi);
        yb[orow * 256 + h * 64 + r32] = o0[r]; yb[orow * 256 + h * 64 + 32 + r32] = o1[r]; }
}

__device__ __forceinline__ void ret_kv_unit(LAS unsigned char* lds, int bh, int ci, const bf16_t* __restrict__ pb, const float* __restrict__ cosR, const float* __restrict__ sinR, float* __restrict__ kvt) {
    const int tid = tid_opaque(); const int b = bh >> 2, h = bh & 3;
    LAS float* Ks = (LAS float*)lds;
    LAS float* Vs = Ks + 128 * 64;
    const float lg2 = log2f(1.f - exp2f(-5.f - (float)h));
    __syncthreads();
    {
        const int i = tid & 31; float x1[8], x2[8], cc[8], ss[8];
#pragma unroll
        for (int it = 0; it < 8; ++it) { const int t = (tid >> 5) + 16 * it; const size_t tok = (size_t)b * SEQ + ci * 128 + t;
            x1[it] = bf2f(pb[tok * 1024 + 256 + h * 64 + i]); x2[it] = bf2f(pb[tok * 1024 + 256 + h * 64 + 32 + i]); cc[it] = cosR[tok * 32 + i]; ss[it] = sinR[tok * 32 + i]; }
#pragma unroll
        for (int it = 0; it < 8; ++it) { const int t = (tid >> 5) + 16 * it; const float sc = 0.125f * exp2f(lg2 * (float)(127 - t));
            Ks[t * 64 + i] = (x1[it] * cc[it] - x2[it] * ss[it]) * sc; Ks[t * 64 + 32 + i] = (x2[it] * cc[it] + x1[it] * ss[it]) * sc; }
        u32x4 vr[2];
#pragma unroll
        for (int it = 0; it < 2; ++it) { const int ch = tid + 512 * it, t = ch >> 3, c8 = ch & 7; vr[it] = *(const u32x4*)(pb + ((size_t)b * SEQ + ci * 128 + t) * 1024 + 512 + h * 64 + c8 * 8); }
#pragma unroll
        for (int it = 0; it < 2; ++it) { const int ch = tid + 512 * it, t = ch >> 3, c8 = ch & 7; LAS float* d = Vs + t * 64 + c8 * 8;
            *(LAS f32x4*)d = (f32x4){bflo(vr[it].x), bfhi(vr[it].x), bflo(vr[it].y), bfhi(vr[it].y)}; *(LAS f32x4*)(d + 4) = (f32x4){bflo(vr[it].z), bfhi(vr[it].z), bflo(vr[it].w), bfhi(vr[it].w)}; }
    }
    __syncthreads();
    const int e = tid >> 3, d0 = (tid & 7) * 8;
    float acc[8];
#pragma unroll
    for (int j = 0; j < 8; ++j) acc[j] = 0.f;
    for (int t = 0; t < 128; ++t) {
        const float v = Vs[t * 64 + e]; const f32x4 ka = *(const LAS f32x4*)(Ks + t * 64 + d0), kb = *(const LAS f32x4*)(Ks + t * 64 + d0 + 4);
        acc[0] += v * ka.x; acc[1] += v * ka.y; acc[2] += v * ka.z; acc[3] += v * ka.w; acc[4] += v * kb.x; acc[5] += v * kb.y; acc[6] += v * kb.z; acc[7] += v * kb.w;
    }
    float* o = kvt + ((size_t)(bh * 32 + ci)) * 4096 + e * 64 + d0;
    *(f32x4*)o = (f32x4){acc[0], acc[1], acc[2], acc[3]}; *(f32x4*)(o + 4) = (f32x4){acc[4], acc[5], acc[6], acc[7]};
}

struct PrepW { bf16x8 Bw[2], Ba[2], Bv[2], Bg[2][2], Bv1[2]; };
__device__ __forceinline__ bf16x8 pack_col8(const float* W, int ld, int k0, int n) {
    float t[8];
#pragma unroll
    for (int j = 0; j < 8; ++j) t[j] = W[(size_t)(k0 + j) * ld + n];
    u32x4 o; o.x = cvt_pk_bf16(t[0], t[1]); o.y = cvt_pk_bf16(t[2], t[3]); o.z = cvt_pk_bf16(t[4], t[5]); o.w = cvt_pk_bf16(t[6], t[7]);
    return __builtin_bit_cast(bf16x8, o);
}
__device__ __forceinline__ bf16x8 pack_f8(const f32x4 a, const f32x4 b) {
    u32x4 o; o.x = cvt_pk_bf16(a.x, a.y); o.y = cvt_pk_bf16(a.z, a.w); o.z = cvt_pk_bf16(b.x, b.y); o.w = cvt_pk_bf16(b.z, b.w);
    return __builtin_bit_cast(bf16x8, o);
}
#define MFMA16(a, b, c) __builtin_amdgcn_mfma_f32_16x16x32_bf16((a), (b), (c), 0, 0, 0)
__device__ __forceinline__ void prep_fetch_rows(unsigned (&raw)[17], const bf16_t* __restrict__ pa, int t0, int c2) {
    raw[0] = ((t0 & (SEQ - 1)) == 0) ? 0u : *(const unsigned*)(pa + (size_t)(t0 - 1) * 1024 + c2);
#pragma unroll
    for (int t = 0; t < 16; ++t) raw[t + 1] = *(const unsigned*)(pa + (size_t)(t0 + t) * 1024 + c2);
}
constexpr int PSW = 900;
struct PrepC { float mu0, mu1, w0c, a0c, kkc, kac, rkc, v0c; };
__device__ __forceinline__ void rwkv_prep_tile(LAS unsigned char* lds, int tile, int next_tile, unsigned (&raw)[17], const PrepC& PC, int layer, const Params& P, int z, const PrepW& W, const bf16_t* __restrict__ pa, unsigned char* __restrict__ rec,
                                               bf16_t* __restrict__ vbuf, bf16_t* __restrict__ gbuf, bf16_t* __restrict__ vfirst, float* __restrict__ bs, float* __restrict__ cs) {
    const int tid = tid_opaque(), lane = tid & 63;
    LAS float* PS = (LAS float*)lds;
    LAS float* VV = PS + 16 * PSW;
    const float* mu = (const float*)P.in[I_MU + z] + layer * RW_IN;
    const float* w0 = (const float*)P.in[I_W0 + z] + layer * 256; const float* w2 = (const float*)P.in[I_W2 + z] + layer * 32 * 256;
    const float* a0 = (const float*)P.in[I_A0 + z] + layer * 256; const float* a2 = (const float*)P.in[I_A2 + z] + layer * 32 * 256;
    const float* g2 = (const float*)P.in[I_G2 + z] + layer * 64 * 256;
    const float* k_k = (const float*)P.in[I_KK + z] + layer * 256; const float* k_a = (const float*)P.in[I_KA + z] + layer * 256; const float* r_k = (const float*)P.in[I_RK + z] + layer * 256;
    const float* v0 = (const float*)P.in[I_V0 + z] + (layer > 0 ? (layer - 1) * 256 : 0);
    const float* v1 = (const float*)P.in[I_V1 + z] + (layer > 0 ? (layer - 1) * 256 * 32 : 0);
    const float* v2 = (const float*)P.in[I_V2 + z] + (layer > 0 ? (layer - 1) * 32 * 256 : 0);
    const int t0 = tile * 16;
    __syncthreads();
    if (tid < 448) {
        const int c2 = tid * 2; const float mu0 = PC.mu0, mu1 = PC.mu1;
#pragma unroll
        for (int t = 0; t < 16; ++t) {
            float x0 = bflo(raw[t + 1]), x1 = bfhi(raw[t + 1]); const float y0 = bflo(raw[t]), y1 = bfhi(raw[t]);
            x0 = x0 + (y0 - x0) * mu0; x1 = x1 + (y1 - x1) * mu1;
            if (c2 >= 768) { if (c2 < 800) { x0 = 2.f * sigmoidf_(2.f * x0) - 1.f; x1 = 2.f * sigmoidf_(2.f * x1) - 1.f; } else if (c2 >= 832) { x0 = sigmoidf_(x0); x1 = sigmoidf_(x1); } }
            *(LAS f32x2*)(PS + t * PSW + c2) = (f32x2){x0, x1};
        }
        if (next_tile >= 0) prep_fetch_rows(raw, pa, next_tile * 16, c2);
    }
    if (layer > 0) VV[tid] = 0.f;
    __syncthreads();
    const int wv = tid >> 6, l16 = lane & 15, lq = lane >> 4;
    LAS float* LR = VV + 512;
    const f32x4 zero4 = {0.f, 0.f, 0.f, 0.f};
    if (layer > 0) {
        const LAS float* ap = PS + l16 * PSW + 512 + 32 * wv + 8 * lq;
        const bf16x8 A = pack_f8(*(const LAS f32x4*)ap, *(const LAS f32x4*)(ap + 4));
#pragma unroll
        for (int nt = 0; nt < 2; ++nt) { const f32x4 d = MFMA16(A, W.Bv1[nt], zero4);
#pragma unroll
            for (int r = 0; r < 4; ++r) (void)__builtin_amdgcn_ds_faddf(VV + (4 * lq + r) * 32 + 16 * nt + l16, d[r], 0, 0, false); }
        __syncthreads();
    }
    {
        const LAS float* ap = PS + l16 * PSW + 768 + 8 * lq;
        const bf16x8 Aw = pack_f8(*(const LAS f32x4*)ap, *(const LAS f32x4*)(ap + 4)), Aa = pack_f8(*(const LAS f32x4*)(ap + 32), *(const LAS f32x4*)(ap + 36));
        const bf16x8 Ag0 = pack_f8(*(const LAS f32x4*)(ap + 64), *(const LAS f32x4*)(ap + 68)), Ag1 = pack_f8(*(const LAS f32x4*)(ap + 96), *(const LAS f32x4*)(ap + 100));
        bf16x8 Av = Aw;
        if (layer > 0) { const LAS float* vp = VV + l16 * 32 + 8 * lq; Av = pack_f8(*(const LAS f32x4*)vp, *(const LAS f32x4*)(vp + 4)); }
#pragma unroll
        for (int nt = 0; nt < 2; ++nt) {
            const f32x4 dw = MFMA16(Aw, W.Bw[nt], zero4), da = MFMA16(Aa, W.Ba[nt], zero4);
            f32x4 dg = MFMA16(Ag0, W.Bg[nt][0], zero4); dg = MFMA16(Ag1, W.Bg[nt][1], dg);
            f32x4 dv = zero4; if (layer > 0) dv = MFMA16(Av, W.Bv[nt], zero4);
            const int ch = 16 * (2 * wv + nt) + l16;
#pragma unroll
            for (int r = 0; r < 4; ++r) { LAS float* o = LR + (4 * lq + r) * 256 + ch; o[0] = dw[r]; o[4096] = da[r]; o[8192] = dg[r]; o[12288] = dv[r]; }
        }
    }
    __syncthreads();
    const int c = tid & 255, th = tid >> 8;
    float aw[8], aa[8], ag[8], av[8];
#pragma unroll
    for (int i = 0; i < 8; ++i) { const LAS float* o = LR + (th * 8 + i) * 256 + c; aw[i] = o[0]; aa[i] = o[4096]; ag[i] = o[8192]; av[i] = o[12288]; }
    const float w0c = PC.w0c, a0c = PC.a0c, kkc = PC.kkc, kac = PC.kac, rkc = PC.rkc, v0c = PC.v0c;
    const int head = c >> 6, kq = (c & 63) >> 2, e = c & 3;
    float kk_[8], b_[8], kp_[8], dec_[8], r_[8], v_[8], a_[8], q_[8];
#pragma unroll
    for (int i = 0; i < 8; ++i) {
        const int t = th * 8 + i; const size_t tok = (size_t)t0 + t;
        const float r = PS[t * PSW + c], k = PS[t * PSW + 256 + c]; float v = PS[t * PSW + 512 + c];
        dec_[i] = __expf(-0.6065306597126334f * sigmoidf_(w0c + aw[i]));
        const float a = sigmoidf_(a0c + aa[i]);
        if (layer > 0) { const float vf = bf2f(vfirst[tok * 256 + c]); v = v + (vf - v) * sigmoidf_(v0c + av[i]); }
        else vfirst[tok * 256 + c] = f2bf(v);
        r_[i] = r; v_[i] = v; a_[i] = a; kk_[i] = k * kkc; kp_[i] = k * (1.f + (a - 1.f) * kac);
        q_[i] = kk_[i] * kk_[i];
    }
#pragma unroll
    for (int i = 0; i < 8; ++i) q_[i] = wave_sum(q_[i]);
#pragma unroll
    for (int i = 0; i < 8; ++i) { kk_[i] *= rsqrtf(fmaxf(q_[i], 1e-24f)); b_[i] = kk_[i] * a_[i]; q_[i] = r_[i] * kp_[i] * rkc; }
#pragma unroll
    for (int i = 0; i < 8; ++i) q_[i] = wave_sum(q_[i]);
    float d1_[4], d2_[4];
#pragma unroll
    for (int j = 0; j < 4; ++j) { d1_[j] = b_[2 * j] * kk_[2 * j + 1]; d2_[j] = kp_[2 * j] * kk_[2 * j + 1]; }
#pragma unroll
    for (int j = 0; j < 4; ++j) { d1_[j] = wave_sum(d1_[j]); d2_[j] = wave_sum(d2_[j]); }
#pragma unroll
    for (int i = 0; i < 8; ++i) {
        const int t = th * 8 + i; const size_t tok = (size_t)t0 + t;
        const size_t ri = tok * 256 + c;
        ((float*)rec)[ri] = dec_[i]; ((bf16_t*)(rec + 16 * MiB))[ri] = f2bf(r_[i]); ((bf16_t*)(rec + 24 * MiB))[ri] = f2bf(kp_[i]); ((bf16_t*)(rec + 40 * MiB))[ri] = f2bf(b_[i]);
        if ((i & 1) == 0) ((bf16_t*)(rec + 32 * MiB))[ri] = f2bf(-kk_[i]);
        else {
            ((bf16_t*)(rec + 32 * MiB))[ri] = f2bf(kk_[i - 1] * d1_[i >> 1] - dec_[i - 1] * kk_[i]);
            if (lane == 0) cs[tok * 4 + head] = -d2_[i >> 1];
        }
        vbuf[tok * 256 + c] = f2bf(v_[i]); gbuf[tok * 256 + c] = f2bf(ag[i]);
        if (lane == 0) bs[tok * 4 + head] = q_[i];
    }
}

constexpr int SC_TC = 32;
constexpr int SC_REC_F = SC_TC * 16 * 20;
constexpr int SC_V_F = SC_TC * 20;
__device__ __forceinline__ void scan_load_chunk(LAS float* recb, LAS float* vb, const unsigned char* __restrict__ rec, const bf16_t* __restrict__ vbuf, const float* __restrict__ cs, size_t tok0, int h, int v0, int lt) {
#pragma unroll
    for (int it = 0; it < 2; ++it) {
        const int p = lt + it * 256, step = p >> 4, kq = p & 15;
        const size_t ri = (tok0 + step) * 256 + h * 64 + 4 * kq;
        const f32x4 wv = *(const f32x4*)((const float*)rec + ri);
        const u32x2 rr = *(const u32x2*)((const bf16_t*)(rec + 16 * MiB) + ri), kk2 = *(const u32x2*)((const bf16_t*)(rec + 24 * MiB) + ri);
        const u32x2 nn = *(const u32x2*)((const bf16_t*)(rec + 32 * MiB) + ri), bb = *(const u32x2*)((const bf16_t*)(rec + 40 * MiB) + ri);
        const u32x4 a = {rr.x, rr.y, kk2.x, kk2.y}, bq = {nn.x, nn.y, bb.x, bb.y};
        LAS float* d = recb + (step * 16 + kq) * 20;
        *(LAS f32x4*)d = wv;
        *(LAS f32x4*)(d + 4) = (f32x4){bflo(a.x), bfhi(a.x), bflo(a.y), bfhi(a.y)};
        *(LAS f32x4*)(d + 8) = (f32x4){bflo(a.z), bfhi(a.z), bflo(a.w), bfhi(a.w)};
        *(LAS f32x4*)(d + 12) = (f32x4){bflo(bq.x), bfhi(bq.x), bflo(bq.y), bfhi(bq.y)};
        *(LAS f32x4*)(d + 16) = (f32x4){bflo(bq.z), bfhi(bq.z), bflo(bq.w), bfhi(bq.w)};
    }
    if (lt < 128) { const int step = lt >> 2, qd = lt & 3;
        const u32x2 x = *(const u32x2*)(vbuf + (tok0 + step) * 256 + h * 64 + v0 + 4 * qd);
        *(LAS f32x4*)(vb + step * 20 + 4 * qd) = (f32x4){bflo(x.x), bfhi(x.x), bflo(x.y), bfhi(x.y)}; }
    else if (lt < 128 + SC_TC) { const int step = lt - 128; vb[step * 20 + 16] = cs[(tok0 + step) * 4 + h]; }
}
__device__ __forceinline__ void rwkv_scan_block(LAS unsigned char* lds, int blk, const unsigned char* __restrict__ rec, const bf16_t* __restrict__ vbuf, const float* __restrict__ cs, float* __restrict__ ya) {
    const int tid = tid_opaque(), lane = tid & 63, w = tid >> 6;
    const int bh = blk >> 2, b = bh >> 2, h = bh & 3, v0 = (blk & 3) * 16;
    LAS float* RECB = (LAS float*)lds;
    LAS float* VB = RECB + 2 * SC_REC_F;
    const size_t tokb = (size_t)b * SEQ;
    const int rowl = lane >> 4, kq = lane & 15, row = v0 + 4 * (w & 3) + rowl;
    f32x2 Sa = {0.f, 0.f}, Sb = {0.f, 0.f}; float ykeep = 0.f;
    if (w < 4) __builtin_amdgcn_s_setprio(3);
    __syncthreads();
    if (w >= 4) scan_load_chunk(RECB, VB, rec, vbuf, cs, tokb, h, v0, tid - 256);
    for (int c = 0; c < SEQ / SC_TC; ++c) {
        __syncthreads();
        const int buf = c & 1;
        if (w >= 4) { if (c + 1 < SEQ / SC_TC) scan_load_chunk(RECB + (buf ^ 1) * SC_REC_F, VB + (buf ^ 1) * SC_V_F, rec, vbuf, cs, tokb + (size_t)(c + 1) * SC_TC, h, v0, tid - 256); }
        else {
            const LAS float* rb = RECB + buf * SC_REC_F + kq * 20; const LAS float* vb = VB + buf * SC_V_F;
            float* yo = ya + (tokb + (size_t)c * SC_TC + kq) * 256 + h * 64 + row;
#define SC_LD(P, st) do { const LAS float* R_ = rb + (st) * 320; P##w = *(const LAS f32x4*)R_; P##r = *(const LAS f32x4*)(R_ + 4); P##k = *(const LAS f32x4*)(R_ + 8); \
                          P##n = *(const LAS f32x4*)(R_ + 12); P##b = *(const LAS f32x4*)(R_ + 16); P##v = vb[(st) * 20 + 4 * w + rowl]; } while (0)
#define LO2(q_) ((f32x2){(q_).x, (q_).y})
#define HI2(q_) ((f32x2){(q_).z, (q_).w})
            f32x4 Aw, Ar, Ak, An, Ab, Bw, Br, Bk, Bn, Bb, Cw, Cr, Ck, Cn, Cb, Dw, Dr, Dk, Dn, Db; float Av, Bv, Cv, Dv, Bc, Dc;
            SC_LD(A, 0); SC_LD(B, 1); Bc = vb[1 * 20 + 16];
#pragma unroll
            for (int st = 0; st < SC_TC; st += 4) {
                if (st + 2 < SC_TC) { SC_LD(C, st + 2); SC_LD(D, st + 3); Dc = vb[(st + 3) * 20 + 16]; }
#define SC_PAIR(E, O, Oc, S0) do { \
                f32x2 d0 = Sa * LO2(E##n); d0 = Sb * HI2(E##n) + d0; f32x2 d1 = Sa * LO2(O##n); d1 = Sb * HI2(O##n) + d1; \
                const f32x2 ve = {E##v, E##v}, vo = {O##v, O##v}; \
                f32x2 ta = ve * LO2(E##k), tb = ve * HI2(E##k); ta = Sa * LO2(E##w) + ta; tb = Sb * HI2(E##w) + tb; \
                const float sa0 = allreduce16(d0.x + d0.y); const float sa1 = allreduce16(d1.x + d1.y) + E##v * Oc; \
                const f32x2 s0 = {sa0, sa0}, s1 = {sa1, sa1}; \
                Sa = s0 * LO2(E##b) + ta; Sb = s0 * HI2(E##b) + tb; \
                f32x2 e0 = Sa * LO2(E##r); e0 = Sb * HI2(E##r) + e0; \
                f32x2 ua = vo * LO2(O##k), ub = vo * HI2(O##k); ua = Sa * LO2(O##w) + ua; ub = Sb * HI2(O##w) + ub; \
                Sa = s1 * LO2(O##b) + ua; Sb = s1 * HI2(O##b) + ub; \
                f32x2 e1 = Sa * LO2(O##r); e1 = Sb * HI2(O##r) + e1; \
                Y0 = e0.x + e0.y; Y1 = e1.x + e1.y; } while (0)
                float yp0, yp1, yp2, yp3;
#define Y0 yp0
#define Y1 yp1
                SC_PAIR(A, B, Bc, st);
#undef Y0
#undef Y1
                if (st + 4 < SC_TC) { SC_LD(A, st + 4); SC_LD(B, st + 5); Bc = vb[(st + 5) * 20 + 16]; }
#define Y0 yp2
#define Y1 yp3
                SC_PAIR(C, D, Dc, st + 2);
#undef Y0
#undef Y1
                {
                    const unsigned long long b0 = 0xAAAAAAAAAAAAAAAAull, b1 = 0xCCCCCCCCCCCCCCCCull;
                    float s01, x01, s23, x23;
                    asm volatile("v_cndmask_b32_e64 %0, %1, %2, %3" : "=v"(s01) : "v"(yp0), "v"(yp1), "s"(b0));
                    asm volatile("v_cndmask_b32_e64 %0, %1, %2, %3" : "=v"(x01) : "v"(yp1), "v"(yp0), "s"(b0));
                    asm volatile("v_cndmask_b32_e64 %0, %1, %2, %3" : "=v"(s23) : "v"(yp2), "v"(yp3), "s"(b0));
                    asm volatile("v_cndmask_b32_e64 %0, %1, %2, %3" : "=v"(x23) : "v"(yp3), "v"(yp2), "s"(b0));
                    const float a01 = s01 + dpp_mov<0xB1>(x01), a23 = s23 + dpp_mov<0xB1>(x23);
                    float sq, xq;
                    asm volatile("v_cndmask_b32_e64 %0, %1, %2, %3" : "=v"(sq) : "v"(a01), "v"(a23), "s"(b1));
                    asm volatile("v_cndmask_b32_e64 %0, %1, %2, %3" : "=v"(xq) : "v"(a23), "v"(a01), "s"(b1));
                    float yq = sq + dpp_mov<0x4E>(xq);
                    yq += dpp_mov<0x128>(yq); yq += dpp_mov<0x124>(yq);
                    const unsigned long long mk = 0x000F000F000F000Full << (st & 15);
                    asm volatile("v_cndmask_b32_e64 %0, %0, %1, %2" : "+v"(ykeep) : "v"(yq), "s"(mk));
                }
                if ((st & 15) == 12) yo[(size_t)(st - 12) * 256] = ykeep;
            }
#undef SC_PAIR
#undef SC_LD
#undef LO2
#undef HI2
        }
    }
    __builtin_amdgcn_s_setprio(0);
}

#define XB_TMO      128
#define XB_XCNT(j)  (256  + 64 * (j))
#define XB_XSUB(j)  (1280 + 64 * (j))
#define XB_XGEN(j)  (2304 + 64 * (j))
#define XB_TOP      3328
#define XB_TOPGEN   3392
#define XB_SPIN_CAP (1u << 20)
__device__ __forceinline__ unsigned xb_ld(unsigned* p)              { return __hip_atomic_load(p, __ATOMIC_RELAXED, __HIP_MEMORY_SCOPE_AGENT); }
__device__ __forceinline__ unsigned xb_add(unsigned* p, unsigned v) { return __hip_atomic_fetch_add(p, v, __ATOMIC_RELAXED, __HIP_MEMORY_SCOPE_AGENT); }
__device__ __forceinline__ unsigned xb_xcc_id() { return (unsigned)__builtin_amdgcn_s_getreg((3 << 11) | 20) & 0xFu; }
#define XB_SPIN(cond, bar) do { unsigned _sp = 0; while (cond) { __builtin_amdgcn_s_sleep(1); \
    if ((++_sp & 255u) == 0u) { if (xb_ld(&(bar)[XB_TMO])) break; if (_sp > XB_SPIN_CAP) { atomicAdd(&(bar)[XB_TMO], 1u); break; } } } } while (0)
struct XcdBarrier { unsigned* bar; unsigned x; volatile LAS unsigned* st; };
__device__ __forceinline__ XcdBarrier xcd_barrier_post(unsigned* bar, volatile LAS unsigned* st) {
    XcdBarrier b; b.bar = bar; b.x = xb_xcc_id(); b.st = st;
    if (__builtin_amdgcn_workitem_id_x() == 0) (void)xb_add(&bar[XB_XCNT(b.x)], 1u);
    return b;
}
__device__ __forceinline__ void xcd_barrier_complete(unsigned* bar, unsigned x, unsigned& nloc, unsigned& nx) {
    const unsigned G = gridDim.x * gridDim.y * gridDim.z;
    unsigned sum, cnt, mine, sp = 0u;
    for (;;) {
        sum = 0u; cnt = 0u; mine = 0u;
#pragma unroll
        for (unsigned j = 0; j < 16; ++j) { const unsigned c = xb_ld(&bar[XB_XCNT(j)]); sum += c; cnt += (c > 0u) ? 1u : 0u; mine = (j == x) ? c : mine; }
        if (sum == G) break;
        __builtin_amdgcn_s_sleep(1);
        if ((++sp & 255u) == 0u) { if (xb_ld(&bar[XB_TMO])) break; if (sp > XB_SPIN_CAP) { atomicAdd(&bar[XB_TMO], 1u); break; } }
    }
    nloc = mine > 0u ? mine : 1u; nx = cnt > 0u ? cnt : 1u;
}
__device__ __forceinline__ void xcd_barrier(const XcdBarrier& b, const unsigned k) {
    asm volatile("s_waitcnt vmcnt(0)" ::: "memory");
    __syncthreads();
    if (__builtin_amdgcn_workitem_id_x() == 0) {
        unsigned* bar = b.bar;
        __builtin_amdgcn_s_waitcnt(0);
        unsigned nloc = b.st[0], nx = b.st[1];
        if (nloc == 0u) { xcd_barrier_complete(bar, b.x, nloc, nx); b.st[0] = nloc; b.st[1] = nx; }
        const unsigned old = xb_add(&bar[XB_XSUB(b.x)], 1u);
        const unsigned gen = old / nloc;
        if (old + 1u == (gen + 1u) * nloc) {
            __builtin_amdgcn_fence(__ATOMIC_RELEASE, "agent");
            asm volatile("s_waitcnt vmcnt(0)" ::: "memory");
            const unsigned og = xb_add(&bar[XB_TOP], 1u);
            const unsigned tg = og / nx;
            if (og + 1u == (tg + 1u) * nx) xb_add(&bar[XB_TOPGEN], 1u);
            else XB_SPIN(xb_ld(&bar[XB_TOPGEN]) == tg, bar);
            __builtin_amdgcn_fence(__ATOMIC_ACQUIRE, "agent");
            asm volatile("s_waitcnt vmcnt(0)" ::: "memory");
        } else {
            XB_SPIN(xb_ld(&bar[XB_TOPGEN]) < k, bar);
            __builtin_amdgcn_fence(__ATOMIC_ACQUIRE, "agent");
            asm volatile("s_waitcnt vmcnt(0)" ::: "memory");
        }
    }
    __syncthreads();
}


#define XB2_XCNT(j) (8192 + 64 * (j))
#define XB2_XSUB(j) (9216 + 64 * (j))
#define XB2_TOP     10240
#define XB2_TOPGEN  10304
__device__ __forceinline__ void sub_barrier_nonscan(unsigned* ctl, volatile LAS unsigned* st2, const unsigned k) {
    asm volatile("s_waitcnt vmcnt(0)" ::: "memory");
    __syncthreads();
    if (__builtin_amdgcn_workitem_id_x() == 0) {
        const unsigned x = xb_xcc_id();
        unsigned nloc = st2[0], nx = st2[1];
        if (nloc == 0u) {
            unsigned cnts[16];
#pragma unroll
            for (unsigned j = 0; j < 16; ++j) cnts[j] = xb_ld(&ctl[XB2_XCNT(j)]);
#pragma unroll
            for (unsigned j = 0; j < 16; ++j) { nloc = (j == x) ? cnts[j] : nloc; nx += (cnts[j] > 0u) ? 1u : 0u; }
            nloc = nloc ? nloc : 1u; nx = nx ? nx : 1u; st2[0] = nloc; st2[1] = nx;
        }
        const unsigned old = xb_add(&ctl[XB2_XSUB(x)], 1u);
        if ((old + 1u) % nloc == 0u) {
            __builtin_amdgcn_fence(__ATOMIC_RELEASE, "agent"); asm volatile("s_waitcnt vmcnt(0)" ::: "memory");
            const unsigned og = xb_add(&ctl[XB2_TOP], 1u);
            if ((og + 1u) % nx == 0u) xb_add(&ctl[XB2_TOPGEN], 1u);
        }
        unsigned sp = 0; while (xb_ld(&ctl[XB2_TOPGEN]) < k) { __builtin_amdgcn_s_sleep(1); if (++sp > (1u << 22)) break; }
        __builtin_amdgcn_fence(__ATOMIC_ACQUIRE, "agent"); asm volatile("s_waitcnt vmcnt(0)" ::: "memory");
    }
    __syncthreads();
}
#define PIN(i) ((const float*)P.in[(i) + z])
constexpr int NPH = 9;
template <int PH> __device__ __forceinline__ void run_phase(const Params& P, LAS unsigned char* lds) {
        int z; asm volatile("s_mov_b32 %0, 0" : "=s"(z));
        unsigned char* ws = P.ws + z;
        constexpr int layer = PH / NPH, k = PH - layer * NPH;
        const int tid = tid_opaque(), lane = tid & 63, wave = __builtin_amdgcn_readfirstlane(tid >> 6), G = sgpr_opaque(gridDim.x), blk = sgpr_opaque(blockIdx.x);
        const int gw = blk * 8 + wave, NGW = G * 8;
        float* hbuf = P.out + z;
        bf16_t* XN = (bf16_t*)(ws + WS_X);
        if constexpr (PH == NPH * DEPTH) {
            const float* g = PIN(I_FINAL);
            const f32x4* gr = (const f32x4*)g + lane;
            f32x4 gg[4];
#pragma unroll
            for (int j = 0; j < 4; ++j) gg[j] = gr[64 * j];
            for (int m = gw; m < T; m += 4 * NGW) {
                f32x4 v[4][4]; float rs[4];
#pragma unroll
                for (int r = 0; r < 4; ++r)
#pragma unroll
                    for (int j = 0; j < 4; ++j) v[r][j] = ((const f32x4*)(hbuf + (size_t)(m + r * NGW) * 1024) + lane)[64 * j];
#pragma unroll
                for (int r = 0; r < 4; ++r) { float s2 = 0.f;
#pragma unroll
                    for (int j = 0; j < 4; ++j) s2 += (v[r][j].x * v[r][j].x + v[r][j].y * v[r][j].y) + (v[r][j].z * v[r][j].z + v[r][j].w * v[r][j].w);
                    rs[r] = s2; }
#pragma unroll
                for (int r = 0; r < 4; ++r) rs[r] = rsqrtf(wave_sum(rs[r]) * (1.f / 1024.f) + NORM_EPS);
#pragma unroll
                for (int r = 0; r < 4; ++r)
#pragma unroll
                    for (int j = 0; j < 4; ++j) ((f32x4*)(hbuf + (size_t)(m + r * NGW) * 1024) + lane)[64 * j] = v[r][j] * rs[r] * gg[j];
            }
            return;
        } else if constexpr (k == 0) {
            const float* hin = (layer == 0) ? PIN(I_X) : hbuf;
            LAS float* tscr = (LAS float*)(lds + wave * 16384);
            bf16_t* Win_t = (bf16_t*)(ws + WS_WIN); bf16_t* Wq_t = (bf16_t*)(ws + WS_WQ); bf16_t* Wkv_t = (bf16_t*)(ws + WS_WKV); bf16_t* Wo_t = (bf16_t*)(ws + WS_WO);
            const float* Win = PIN(I_W_IN) + (size_t)layer * DM * IN_DIM;
            const float* Wq = PIN(I_WQUP) + (size_t)layer * 384 * 768;
            const float* Wkv = PIN(I_WKVUP) + (size_t)layer * 256 * 1024;
            const float* Wo = PIN(I_W_OUT) + (size_t)layer * 1024 * 1024;
            constexpr int IT_IN = 16 * 81, IT_Q = 6 * 24, IT_KV = 4 * 32, IT_O = 16 * 32;
            if (layer == 0) for (int it = gw; it < IT_IN + IT_Q + IT_KV + IT_O; it += NGW) {
                int r = it;
                if (r < IT_IN) { transpose_item(Win, 1024, IN_DIM, Win_t, 1, tscr, r, lane); continue; } r -= IT_IN;
                if (r < IT_Q) { transpose_item(Wq, 384, 768, Wq_t, 0, tscr, r, lane); continue; } r -= IT_Q;
                if (r < IT_KV) { transpose_item(Wkv, 256, 1024, Wkv_t, 0, tscr, r, lane); continue; } r -= IT_KV;
                transpose_item(Wo, 1024, 1024, Wo_t, 0, tscr, r, lane);
            }
            for (int i = blk * 512 + tid; i < 224 * 128; i += G * 512) { const int rr = i >> 7, cc = i & 127; const int row = (rr < 128) ? 896 + rr : 2720 + (rr - 128);
                *(u32x4*)(Win_t + (size_t)row * 1024 + cc * 8) = (u32x4){0u, 0u, 0u, 0u}; }
            if (layer == 0) {
                const int* pos = (const int*)P.in[I_POS + z];
                float* cosR = (float*)(ws + WS_COSR); float* sinR = (float*)(ws + WS_SINR); float* cosM = (float*)(ws + WS_COSM); float* sinM = (float*)(ws + WS_SINM);
                for (int i = blk * 512 + tid; i < T * 32; i += G * 512) { const int tok = i >> 5, f = i & 31;
                    const float inv = exp2f(-(float)f * (1.f / 32.f) * 13.287712379549449f); const float ang = (float)pos[tok] * inv;
                    double rev = (double)ang * 0.15915494309189535; rev -= floor(rev); const float a = (float)(rev * 6.283185307179586);
                    cosR[i] = __cosf(a); sinR[i] = __sinf(a); }
                for (int i = blk * 512 + tid; i < T * 16; i += G * 512) { const int tok = i >> 4, f = i & 15;
                    const float inv = exp2f(-(float)f * (1.f / 16.f) * 13.287712379549449f); const float ang = (float)pos[tok] * inv;
                    double rev = (double)ang * 0.15915494309189535; rev -= floor(rev); const float a = (float)(rev * 6.283185307179586);
                    cosM[i] = __cosf(a); sinM[i] = __sinf(a); }
            }
            const float* g = PIN(I_ATTN_NORM) + layer * 1024;
            for (int m = gw; m < T; m += 2 * NGW) rms_rows2_bf16(hin + (size_t)m * 1024, hin + (size_t)(m + NGW) * 1024, g, XN + (size_t)m * 1024, XN + (size_t)(m + NGW) * 1024, lane);
        } else if constexpr (k == 1) {
            pg8::Gemm g{XN, (bf16_t*)(ws + WS_WIN), T, NPROJ, 1024}; pg8::StaticOrder S; S.init(T, NPROJ, G, blk);
            pg8::EpiProj E{(bf16_t*)(ws + WS_PA), (bf16_t*)(ws + WS_PB), (bf16_t*)(ws + WS_PC)};
            pg8::gemm_phase<pg8::EpiProj, pg8::StaticOrder, true, true>(lds, g, S, E);
        } else if constexpr (k == 2) {
            bf16_t* pa = (bf16_t*)(ws + WS_PA); bf16_t* pb = (bf16_t*)(ws + WS_PB); bf16_t* pc = (bf16_t*)(ws + WS_PC);
            float* cosR = (float*)(ws + WS_COSR); float* sinR = (float*)(ws + WS_SINR); float* cosM = (float*)(ws + WS_COSM); float* sinM = (float*)(ws + WS_SINM);
            PrepW W;
            {
                const int l16 = lane & 15, lq = lane >> 4;
                const float* w2 = PIN(I_W2) + layer * 32 * 256; const float* a2 = PIN(I_A2) + layer * 32 * 256; const float* g2 = PIN(I_G2) + layer * 64 * 256;
                const float* v1 = PIN(I_V1) + (layer > 0 ? (layer - 1) * 256 * 32 : 0); const float* v2 = PIN(I_V2) + (layer > 0 ? (layer - 1) * 32 * 256 : 0);
#pragma unroll
                for (int nt = 0; nt < 2; ++nt) { const int n = 16 * (2 * wave + nt) + l16;
                    W.Bw[nt] = pack_col8(w2, 256, 8 * lq, n); W.Ba[nt] = pack_col8(a2, 256, 8 * lq, n);
                    W.Bg[nt][0] = pack_col8(g2, 256, 8 * lq, n); W.Bg[nt][1] = pack_col8(g2, 256, 32 + 8 * lq, n);
                    W.Bv[nt] = pack_col8(v2, 256, 8 * lq, n); W.Bv1[nt] = pack_col8(v1, 32, 32 * wave + 8 * lq, 16 * nt + l16); }
            }
            unsigned raw[17];
            if (tid < 448 && blk < T / 16) prep_fetch_rows(raw, pa, blk * 16, tid * 2);
            PrepC PC;
            { const int cc = tid & 255, c2 = (tid < 448) ? tid * 2 : 0;
              const float* mu = PIN(I_MU) + layer * RW_IN;
              PC.mu0 = mu[c2]; PC.mu1 = mu[c2 + 1]; PC.w0c = (PIN(I_W0) + layer * 256)[cc]; PC.a0c = (PIN(I_A0) + layer * 256)[cc]; PC.kkc = (PIN(I_KK) + layer * 256)[cc];
              PC.kac = (PIN(I_KA) + layer * 256)[cc]; PC.rkc = (PIN(I_RK) + layer * 256)[cc]; PC.v0c = (layer > 0) ? (PIN(I_V0) + (layer - 1) * 256)[cc] : 0.f; }
            for (int tile = blk; tile < T / 16; tile += G) rwkv_prep_tile(lds, tile, (tile + G < T / 16) ? tile + G : -1, raw, PC, layer, P, z, W, pa, ws + WS_REC, (bf16_t*)(ws + WS_VBUF), (bf16_t*)(ws + WS_GBUF), (bf16_t*)(ws + WS_VFIRST), (float*)(ws + WS_BS), (float*)(ws + WS_BS + 512 * 1024));
        } else if constexpr (k == 3) {
            LAS unsigned* misc = (LAS unsigned*)(lds + 131072);
            unsigned* ctl = (unsigned*)(ws + WS_CTL);
            float* cosR = (float*)(ws + WS_COSR); float* sinR = (float*)(ws + WS_SINR); float* cosM = (float*)(ws + WS_COSM); float* sinM = (float*)(ws + WS_SINM);
            unsigned* sbar = ctl + 64 * (8 + layer);
            const int NB = G - 64;
            if (blk < 64) {
                rwkv_scan_block(lds, blk, ws + WS_REC, (bf16_t*)(ws + WS_VBUF), (const float*)(ws + WS_BS + 512 * 1024), (float*)(ws + WS_YA));
                if (tid == 0) { unsigned sp = 0; while (xb_ld((unsigned*)ctl + XB2_TOPGEN) < 2u * layer + 2u) { __builtin_amdgcn_s_sleep(4); if (++sp > (1u << 22)) break; }
                    __builtin_amdgcn_fence(__ATOMIC_ACQUIRE, "agent"); asm volatile("s_waitcnt vmcnt(0)" ::: "memory"); }
                __syncthreads();
            } else {
                const int cb = blk - 64;
                for (int u = cb; u < 512; u += NB) ret_kv_unit(lds, u >> 5, u & 31, (bf16_t*)(ws + WS_PB), cosR, sinR, (float*)(ws + WS_KVT));
                __syncthreads();
                {
                    const int gwn = cb * 8 + wave, NGWn = NB * 8;
                    bf16_t* pc = (bf16_t*)(ws + WS_PC);
            bf16_t* qn = (bf16_t*)(ws + WS_QN); bf16_t* kvn = (bf16_t*)(ws + WS_KVN); bf16_t* kr = (bf16_t*)(ws + WS_KR);
            const float* qg = PIN(I_QNORM) + layer * 384; const float* kg = PIN(I_KVNORM) + layer * 256;
            const int lq_ = (lane < 48) ? lane : 0, lk_ = lane & 31, lr_ = lane & 1;
            const f32x4 qg0 = *(const f32x4*)(qg + 8 * lq_), qg1 = *(const f32x4*)(qg + 8 * lq_ + 4), kg0 = *(const f32x4*)(kg + 8 * lk_), kg1 = *(const f32x4*)(kg + 8 * lk_ + 4);
            for (int m0 = gwn; m0 < T; m0 += 2 * NGWn) {
                u32x4 rq_[2], rk_[2], r1_[2], r2_[2]; f32x4 cA[2], cB[2], sA[2], sB[2];
#pragma unroll
                for (int u = 0; u < 2; ++u) { const int m = (m0 + u * NGWn < T) ? m0 + u * NGWn : T - 1; const bf16_t* row = pc + (size_t)m * 768;
                    rq_[u] = *(const u32x4*)(row + 8 * lq_); rk_[u] = *(const u32x4*)(row + 384 + 8 * lk_);
                    r1_[u] = *(const u32x4*)(row + 640 + 8 * lr_); r2_[u] = *(const u32x4*)(row + 656 + 8 * lr_);
                    cA[u] = *(const f32x4*)(cosM + (size_t)m * 16 + 8 * lr_); cB[u] = *(const f32x4*)(cosM + (size_t)m * 16 + 8 * lr_ + 4);
                    sA[u] = *(const f32x4*)(sinM + (size_t)m * 16 + 8 * lr_); sB[u] = *(const f32x4*)(sinM + (size_t)m * 16 + 8 * lr_ + 4); }
#pragma unroll
                for (int u = 0; u < 2; ++u) { const int m = m0 + u * NGWn; if (m >= T) continue;
                    float q8[8], k8[8];
#pragma unroll
                    for (int j = 0; j < 4; ++j) { q8[2 * j] = bflo(rq_[u][j]); q8[2 * j + 1] = bfhi(rq_[u][j]); k8[2 * j] = bflo(rk_[u][j]); k8[2 * j + 1] = bfhi(rk_[u][j]); }
                    float sq = 0.f, sk = 0.f;
#pragma unroll
                    for (int j = 0; j < 8; ++j) { sq += q8[j] * q8[j]; sk += k8[j] * k8[j]; }
                    if (lane >= 48) sq = 0.f;
                    if (lane >= 32) sk = 0.f;
                    const float rq = rsqrtf(wave_sum(sq) * (1.f / 384.f) + NORM_EPS), rk = rsqrtf(wave_sum(sk) * (1.f / 256.f) + NORM_EPS);
                    if (lane < 48) { u32x4 o; o.x = cvt_pk_bf16(q8[0] * rq * qg0.x, q8[1] * rq * qg0.y); o.y = cvt_pk_bf16(q8[2] * rq * qg0.z, q8[3] * rq * qg0.w);
                        o.z = cvt_pk_bf16(q8[4] * rq * qg1.x, q8[5] * rq * qg1.y); o.w = cvt_pk_bf16(q8[6] * rq * qg1.z, q8[7] * rq * qg1.w); *(u32x4*)(qn + (size_t)m * 384 + 8 * lane) = o; }
                    if (lane < 32) { u32x4 o; o.x = cvt_pk_bf16(k8[0] * rk * kg0.x, k8[1] * rk * kg0.y); o.y = cvt_pk_bf16(k8[2] * rk * kg0.z, k8[3] * rk * kg0.w);
                        o.z = cvt_pk_bf16(k8[4] * rk * kg1.x, k8[5] * rk * kg1.y); o.w = cvt_pk_bf16(k8[6] * rk * kg1.z, k8[7] * rk * kg1.w); *(u32x4*)(kvn + (size_t)m * 256 + 8 * lane) = o; }
                    if (lane < 2) { const float cs8[8] = {cA[u].x, cA[u].y, cA[u].z, cA[u].w, cB[u].x, cB[u].y, cB[u].z, cB[u].w}, sn8[8] = {sA[u].x, sA[u].y, sA[u].z, sA[u].w, sB[u].x, sB[u].y, sB[u].z, sB[u].w};
                        u32x4 o1, o2;
#pragma unroll
                        for (int j = 0; j < 4; ++j) { const float a0 = bflo(r1_[u][j]), a1 = bfhi(r1_[u][j]), b0 = bflo(r2_[u][j]), b1 = bfhi(r2_[u][j]);
                            o1[j] = cvt_pk_bf16(a0 * cs8[2 * j] - b0 * sn8[2 * j], a1 * cs8[2 * j + 1] - b1 * sn8[2 * j + 1]); o2[j] = cvt_pk_bf16(b0 * cs8[2 * j] + a0 * sn8[2 * j], b1 * cs8[2 * j + 1] + a1 * sn8[2 * j + 1]); }
                        *(u32x4*)(kr + (size_t)m * 32 + 8 * lane) = o1; *(u32x4*)(kr + (size_t)m * 32 + 16 + 8 * lane) = o2; }
                }
            }
                    sub_barrier_nonscan((unsigned*)ctl, (volatile LAS unsigned*)(misc + 12), 2u * layer + 1u);
                }
                bf16_t* rprev = (bf16_t*)(ws + WS_RPREV); const float* kvt = (const float*)(ws + WS_KVT);
                for (int i = cb * 512 + tid; i < 16 * 4096; i += NB * 512) { const int bh = i >> 12, el = i & 4095; const int h = bh & 3;
                    const float cd = exp2f(128.f * log2f(1.f - exp2f(-5.f - (float)h)));
                    float R = 0.f;
#pragma unroll 8
                    for (int ci = 0; ci < 32; ++ci) { rprev[((size_t)(bh * 32 + ci)) * 4096 + el] = f2bf(R); R = R * cd + kvt[((size_t)(bh * 32 + ci)) * 4096 + el]; } }
                __syncthreads();
                { pg8::Gemm g{(bf16_t*)(ws + WS_QN), (bf16_t*)(ws + WS_WQ), T, 768, 384}; pg8::StaticOrder S; S.init(T, 768, NB, cb); pg8::EpiPlain E{(bf16_t*)(ws + WS_PC), 768};
                  pg8::gemm_phase<pg8::EpiPlain, pg8::StaticOrder, true, true>(lds, g, S, E); }
                { pg8::Gemm g{(bf16_t*)(ws + WS_KVN), (bf16_t*)(ws + WS_WKV), T, 1024, 256}; pg8::StaticOrder S; S.init(T, 1024, NB, cb); pg8::EpiPlain E{(bf16_t*)(ws + WS_KN), 1024};
                  pg8::gemm_phase<pg8::EpiPlain, pg8::StaticOrder, true, true>(lds, g, S, E); }
                sub_barrier_nonscan((unsigned*)ctl, (volatile LAS unsigned*)(misc + 12), 2u * layer + 2u);
            }
            unsigned* qctr = ctl + 64 * (1 + layer);
            for (;;) {
                __syncthreads();
                if (tid == 0) misc[0] = atomicAdd(qctr, 1u);
                __syncthreads();
                const int u = (int)misc[0];
                if (u >= 768) break;
                if (u < 512) { const int qb = 15 - (u >> 5), bh = u & 31; att_unit(lds, bh >> 3, bh & 7, qb, (bf16_t*)(ws + WS_PC), (bf16_t*)(ws + WS_KN), (bf16_t*)(ws + WS_KR), cosM, sinM, XN); }
                else { const int v = u - 512; const int bh = v & 15, jb = v >> 4; ret_unit(lds, bh >> 2, bh & 3, jb, (bf16_t*)(ws + WS_PB), cosR, sinR, (bf16_t*)(ws + WS_RPREV), (float*)(ws + WS_YB)); }
            }
        } else if constexpr (k == 4) {
            LAS float* tscr = (LAS float*)(lds + wave * 16384);
            const float* __restrict__ ya = (const float*)(ws + WS_YA); const float* __restrict__ yb = (const float*)(ws + WS_YB); const float* __restrict__ bs = (const float*)(ws + WS_BS);
            const bf16_t* __restrict__ vbuf = (const bf16_t*)(ws + WS_VBUF); const bf16_t* __restrict__ gbuf = (const bf16_t*)(ws + WS_GBUF); const bf16_t* __restrict__ pb = (const bf16_t*)(ws + WS_PB);
            const float* __restrict__ gnw = PIN(I_GNW) + layer * 256; const float* __restrict__ gnb = PIN(I_GNB) + layer * 256;
            bf16_t* __restrict__ XNw = XN;
            const f32x4 gw4 = *(const f32x4*)(gnw + 4 * lane), gb4 = *(const f32x4*)(gnb + 4 * lane);
#pragma unroll 4
            for (int m = gw; m < T; m += NGW) {
                const int c = 4 * lane, head = lane >> 4;
                const f32x4 y = *(const f32x4*)(ya + (size_t)m * 256 + c);
                const float mean = allreduce16((y.x + y.y) + (y.z + y.w)) * (1.f / 64.f);
                const f32x4 d = y - mean;
                const float var = allreduce16((d.x * d.x + d.y * d.y) + (d.z * d.z + d.w * d.w)) * (1.f / 64.f);
                const float rs = rsqrtf(var + 64e-5f);
                const u32x2 vv = *(const u32x2*)(vbuf + (size_t)m * 256 + c), gg = *(const u32x2*)(gbuf + (size_t)m * 256 + c);
                const float bsc = bs[(size_t)m * 4 + head];
                const float o0 = (d.x * rs * gw4.x + gb4.x + bsc * bflo(vv.x)) * bflo(gg.x), o1 = (d.y * rs * gw4.y + gb4.y + bsc * bfhi(vv.x)) * bfhi(gg.x);
                const float o2 = (d.z * rs * gw4.z + gb4.z + bsc * bflo(vv.y)) * bflo(gg.y), o3 = (d.w * rs * gw4.w + gb4.w + bsc * bfhi(vv.y)) * bfhi(gg.y);
                u32x2 w; w.x = cvt_pk_bf16(o0, o1); w.y = cvt_pk_bf16(o2, o3);
                *(u32x2*)(XNw + (size_t)m * 1024 + c) = w;
                const f32x4 zz = *(const f32x4*)(yb + (size_t)m * 256 + c);
                const float ms = allreduce16((zz.x * zz.x + zz.y * zz.y) + (zz.z * zz.z + zz.w * zz.w)) * (1.f / 64.f);
                const float rz = rsqrtf(ms + NORM_EPS);
                const u32x2 gt = *(const u32x2*)(pb + (size_t)m * 1024 + 768 + c);
                const float g0 = bflo(gt.x), g1 = bfhi(gt.x), g2v = bflo(gt.y), g3 = bfhi(gt.y);
                u32x2 w2; w2.x = cvt_pk_bf16(zz.x * rz * g0 * sigmoidf_(g0), zz.y * rz * g1 * sigmoidf_(g1)); w2.y = cvt_pk_bf16(zz.z * rz * g2v * sigmoidf_(g2v), zz.w * rz * g3 * sigmoidf_(g3));
                *(u32x2*)(XNw + (size_t)m * 1024 + 256 + c) = w2;
            }
            const float* Wgu = PIN(I_WGU) + (size_t)layer * 1024 * 2 * D_FF; const float* Wdn = PIN(I_WDN) + (size_t)layer * D_FF * 1024;
            bf16_t* Wgu_t = (bf16_t*)(ws + WS_WGU); bf16_t* Wdn_t = (bf16_t*)(ws + WS_WDN);
            constexpr int IT_GU = 16 * 176, IT_DN = 44 * 32;
            for (int it = gw; it < IT_GU + IT_DN; it += NGW) {
                if (it < IT_GU) transpose_item(Wgu, 1024, 2 * D_FF, Wgu_t, 2, tscr, it, lane);
                else transpose_item(Wdn, D_FF, 1024, Wdn_t, 0, tscr, it - IT_GU, lane);
            }
        } else if constexpr (k == 5) {
            const float* hin = (layer == 0) ? PIN(I_X) : hbuf;
            pg8::Gemm g{XN, (bf16_t*)(ws + WS_WO), T, 1024, 1024}; pg8::StaticOrder S; S.init(T, 1024, G, blk); pg8::EpiRes E{hin, hbuf};
            pg8::gemm_phase<pg8::EpiRes, pg8::StaticOrder, true, true>(lds, g, S, E);
        } else if constexpr (k == 6) {
            const float* g = PIN(I_FFN_NORM) + layer * 1024;
            for (int m = gw; m < T; m += 2 * NGW) rms_rows2_bf16(hbuf + (size_t)m * 1024, hbuf + (size_t)(m + NGW) * 1024, g, XN + (size_t)m * 1024, XN + (size_t)(m + NGW) * 1024, lane);
            if constexpr (layer + 1 < DEPTH) {
                LAS float* tscr = (LAS float*)(lds + wave * 16384);
                const float* Win = PIN(I_W_IN) + (size_t)(layer + 1) * DM * IN_DIM; const float* Wq = PIN(I_WQUP) + (size_t)(layer + 1) * 384 * 768;
                const float* Wkv = PIN(I_WKVUP) + (size_t)(layer + 1) * 256 * 1024; const float* Wo = PIN(I_W_OUT) + (size_t)(layer + 1) * 1024 * 1024;
                constexpr int IT_IN = 16 * 81, IT_Q = 6 * 24, IT_KV = 4 * 32, IT_O = 16 * 32;
                for (int it = gw; it < IT_IN + IT_Q + IT_KV + IT_O; it += NGW) {
                    int r = it;
                    if (r < IT_IN) { transpose_item(Win, 1024, IN_DIM, (bf16_t*)(ws + WS_WIN), 1, tscr, r, lane); continue; } r -= IT_IN;
                    if (r < IT_Q) { transpose_item(Wq, 384, 768, (bf16_t*)(ws + WS_WQ), 0, tscr, r, lane); continue; } r -= IT_Q;
                    if (r < IT_KV) { transpose_item(Wkv, 256, 1024, (bf16_t*)(ws + WS_WKV), 0, tscr, r, lane); continue; } r -= IT_KV;
                    transpose_item(Wo, 1024, 1024, (bf16_t*)(ws + WS_WO), 0, tscr, r, lane);
                }
            }
        } else if constexpr (k == 7) {
            pg8::Gemm g{XN, (bf16_t*)(ws + WS_WGU), T, 2 * D_FF, 1024}; pg8::StaticOrder S; S.init(T, 2 * D_FF, G, blk); pg8::EpiSwiGLU E{(bf16_t*)(ws + WS_ACT)};
            pg8::gemm_phase<pg8::EpiSwiGLU, pg8::StaticOrder, true, true>(lds, g, S, E);
        } else {
            pg8::Gemm g{(bf16_t*)(ws + WS_ACT), (bf16_t*)(ws + WS_WDN), T, 1024, D_FF}; pg8::StaticOrder S; S.init(T, 1024, G, blk); pg8::EpiRes E{hbuf, hbuf};
            pg8::gemm_phase<pg8::EpiRes, pg8::StaticOrder, true, true>(lds, g, S, E);
        }
}

template <int PH> __device__ __forceinline__ void run_all(const Params& P, LAS unsigned char* lds, cg::grid_group& grid, const XcdBarrier& bar) {
    run_phase<PH>(P, lds);
    if constexpr (PH < NPH * DEPTH) {
        xcd_barrier(bar, (unsigned)PH + 1u);
        run_all<PH + 1>(P, lds, grid, bar);
    }
}
__global__ void __launch_bounds__(512) hymba_fwd(Params P) {
    extern __shared__ __attribute__((aligned(16))) unsigned char lds_raw[];
    LAS unsigned char* lds = (LAS unsigned char*)lds_raw;
    cg::grid_group grid = cg::this_grid();
    LAS unsigned* misc = (LAS unsigned*)(lds + 131072);
    if (__builtin_amdgcn_workitem_id_x() < 32) misc[__builtin_amdgcn_workitem_id_x()] = 0u;
    __syncthreads();
    if (P.ws == nullptr) grid.sync();
    if (blockIdx.x >= 64 && __builtin_amdgcn_workitem_id_x() == 0) (void)xb_add((unsigned*)(P.ws + WS_CTL) + XB2_XCNT(xb_xcc_id()), 1u);
    const XcdBarrier bar = xcd_barrier_post((unsigned*)(P.ws + WS_CTL) + 4096, (volatile LAS unsigned*)(misc + 8));
    run_all<0>(P, lds, grid, bar);
}
extern "C" void kernel_launch(void* const* d_in, const int* in_sizes, int n_in, void* d_out, int out_size, void* d_ws, size_t ws_size, hipStream_t stream) {
    static int grid = 0;
    if (grid == 0) {
        if (n_in != 27 || out_size != T * DM || ws_size < WS_END) { fprintf(stderr, "kernel_launch: unexpected shapes (n_in %d, out %d, ws %zu)\n", n_in, out_size, ws_size); grid = -1; return; }
        int dev = 0, cus = 0, per_cu = 0;
        (void)hipGetDevice(&dev); (void)hipDeviceGetAttribute(&cus, hipDeviceAttributeMultiprocessorCount, dev);
        if (hipFuncSetAttribute((const void*)hymba_fwd, hipFuncAttributeMaxDynamicSharedMemorySize, LDS_BYTES) != hipSuccess) { fprintf(stderr, "kernel_launch: hipFuncSetAttribute failed\n"); grid = -1; return; }
        if (hipOccupancyMaxActiveBlocksPerMultiprocessor(&per_cu, (const void*)hymba_fwd, 512, LDS_BYTES) != hipSuccess || per_cu < 1) { fprintf(stderr, "kernel_launch: occupancy query failed (%d)\n", per_cu); grid = -1; return; }
        (void)hipGetLastError();
        grid = cus;
        if (grid < 64) { fprintf(stderr, "kernel_launch: needs >= 64 CUs\n"); grid = -1; return; }
    }
    if (grid < 0) return;
    (void)hipMemsetAsync((char*)d_ws + WS_CTL, 0, 1 * MiB, stream);
    Params p{};
    for (int i = 0; i < 27; ++i) p.in[i] = d_in[i];
    p.out = (float*)d_out; p.ws = (unsigned char*)d_ws;
    void* args[] = {&p};
    hipError_t e = hipLaunchCooperativeKernel((const void*)hymba_fwd, dim3(grid), dim3(512), args, LDS_BYTES, stream);
    if (e != hipSuccess) fprintf(stderr, "kernel_launch: cooperative launch failed: %s (grid %d)\n", hipGetErrorString(e), grid);
}
```
